# Optimizing an MI355X kernel written in HIP

```python
import math
import jax, jax.numpy as jnp
from jax import lax
import numpy as np

D_MODEL = 2048
BATCH = 8
SEQ = 2048
DEPTH = 1

HEAD_DIM = 128
N_ATTN_HEADS = 12
N_MLSTM_HEADS = 4
ATTN_WIDTH = N_ATTN_HEADS * HEAD_DIM
MLSTM_WIDTH = N_MLSTM_HEADS * HEAD_DIM
MIX_WIDTH = ATTN_WIDTH + MLSTM_WIDTH
WINDOWS = (128, 512, 2048)
DILATIONS = (1, 4, 16)
PAD_MULT = max(WINDOWS)
ROPE_THETA = 10000.0
MLSTM_CHUNK = 128
MLSTM_CONV = 4
D_FF = 5632
FFN_CONV = 3
EPS = 1e-6
IN_WIDTH = 3 * ATTN_WIDTH + 4 * MLSTM_WIDTH + 2 * N_MLSTM_HEADS
IN_SPLITS = (ATTN_WIDTH, 2 * ATTN_WIDTH, 3 * ATTN_WIDTH,
             3 * ATTN_WIDTH + MLSTM_WIDTH, 3 * ATTN_WIDTH + 2 * MLSTM_WIDTH,
             3 * ATTN_WIDTH + 3 * MLSTM_WIDTH, 3 * ATTN_WIDTH + 4 * MLSTM_WIDTH,
             3 * ATTN_WIDTH + 4 * MLSTM_WIDTH + N_MLSTM_HEADS)

kernel_name = 'hymba_mlstm_dilated_attn_convffn'


def _rmsnorm(x, g):
    xf = x.astype(jnp.float32)
    return xf * lax.rsqrt(jnp.mean(xf * xf, axis=-1, keepdims=True) + EPS) * g.astype(jnp.float32)


def _causal_dwconv(x, w, b):
    k_taps = w.shape[0]
    s = x.shape[1]
    xp = jnp.pad(x, ((0, 0), (k_taps - 1, 0), (0, 0)))
    y = b
    for tap in range(k_taps):
        y = y + w[tap] * xp[:, tap:tap + s]
    return y


def _rope(x, pos):
    half = x.shape[-1] // 2
    inv_freq = ROPE_THETA ** (-jnp.arange(half, dtype=jnp.float32) / half)
    ang = pos[:, None] * inv_freq[None, :]
    cos = jnp.cos(ang)[None, :, None, :]
    sin = jnp.sin(ang)[None, :, None, :]
    x1, x2 = x[..., :half], x[..., half:]
    return jnp.concatenate([x1 * cos - x2 * sin, x1 * sin + x2 * cos], axis=-1)


def _dilated_branch(q, k, v, dil, n_back):
    b, h, sp, dh = q.shape
    blk = n_back
    sub = sp // dil
    nb = sub // blk

    def to_blocks(t):
        return t.reshape(b, h, sub, dil, dh).transpose(0, 1, 3, 2, 4).reshape(b, h, dil, nb, blk, dh)

    def with_prev(t):
        prev = jnp.pad(t, ((0, 0), (0, 0), (0, 0), (1, 0), (0, 0), (0, 0)))[:, :, :, :-1]
        return jnp.concatenate([prev, t], axis=4)

    qb = to_blocks(q)
    kb = with_prev(to_blocks(k))
    vb = with_prev(to_blocks(v))
    s = jnp.einsum('bhrnqd,bhrnkd->bhrnqk', qb, kb)
    qi = jnp.arange(blk)[:, None]
    kj = jnp.arange(2 * blk)[None, :]
    dist = blk + qi - kj
    band = (dist >= 0) & (dist <= n_back)
    valid = (jnp.arange(nb)[:, None, None] > 0) | (kj[None] >= blk)
    mask = band[None] & valid
    s = jnp.where(mask, s, -jnp.inf)
    m = jnp.max(s, axis=-1, keepdims=True)
    p = jnp.exp(s - m)
    l = jnp.sum(p, axis=-1, keepdims=True)
    o = jnp.einsum('bhrnqk,bhrnkd->bhrnqd', p, vb) / l
    lse = (m + jnp.log(l))[..., 0]
    o = o.reshape(b, h, dil, sub, dh).transpose(0, 1, 3, 2, 4).reshape(b, h, sp, dh)
    lse = lse.reshape(b, h, dil, sub).transpose(0, 1, 3, 2).reshape(b, h, sp)
    return o, lse


def _dilated_attention(q, k, v, q_g, k_g):
    bsz, s, h, dh = q.shape
    pos = jnp.arange(s, dtype=jnp.float32)
    q = _rope(_rmsnorm(q, q_g), pos) * (dh ** -0.5)
    k = _rope(_rmsnorm(k, k_g), pos)
    v = v.astype(jnp.float32)
    sp = -(-s // PAD_MULT) * PAD_MULT

    def prep(t):
        return jnp.pad(t.transpose(0, 2, 1, 3), ((0, 0), (0, 0), (0, sp - s), (0, 0)))

    q, k, v = prep(q), prep(k), prep(v)
    outs, lses = [], []
    for window, dil in zip(WINDOWS, DILATIONS):
        o, l = _dilated_branch(q, k, v, dil, window // dil)
        outs.append(o)
        lses.append(l)
    wts = jax.nn.softmax(jnp.stack(lses, axis=0), axis=0)
    o = jnp.einsum('gbhs,gbhsd->bhsd', wts, jnp.stack(outs, axis=0))
    return o[:, :, :s].transpose(0, 2, 1, 3).reshape(bsz, s, h * dh)


def _mlstm(q, k, v, i_pre, f_pre):
    bsz, s, h, dh = q.shape
    L = MLSTM_CHUNK
    nc = s // L
    q = q.astype(jnp.float32)
    k = k.astype(jnp.float32) * (dh ** -0.5)
    v = v.astype(jnp.float32)
    log_f = jax.nn.log_sigmoid(f_pre.astype(jnp.float32))
    i_log = i_pre.astype(jnp.float32)

    def chunks(t):
        return t.reshape(bsz, nc, L, h, dh).transpose(1, 0, 3, 2, 4)

    def gchunks(t):
        return t.reshape(bsz, nc, L, h).transpose(1, 0, 3, 2)

    causal = jnp.tril(jnp.ones((L, L), dtype=bool))

    def step(carry, inp):
        c, n, m = carry
        qc, kc, vc, ic, fc = inp
        b = jnp.cumsum(fc, axis=-1)
        a_inter = b + m[..., None]
        d_log = jnp.where(causal, b[..., :, None] - b[..., None, :] + ic[..., None, :], -jnp.inf)
        m_t = jnp.maximum(a_inter, jnp.max(d_log, axis=-1))
        w_intra = jnp.exp(d_log - m_t[..., None])
        w_inter = jnp.exp(a_inter - m_t)
        scores = jnp.einsum('bhtd,bhsd->bhts', qc, kc) * w_intra
        num = w_inter[..., None] * jnp.einsum('bhtd,bhde->bhte', qc, c) + jnp.einsum('bhts,bhse->bhte', scores, vc)
        den = w_inter * jnp.einsum('bhtd,bhd->bht', qc, n) + jnp.sum(scores, axis=-1)
        h_out = num / jnp.maximum(jnp.abs(den), jnp.exp(-m_t))[..., None]
        b_last = b[..., -1]
        g_log = b_last[..., None] - b + ic
        m_new = jnp.maximum(b_last + m, jnp.max(g_log, axis=-1))
        w_k = jnp.exp(g_log - m_new[..., None])
        decay = jnp.exp(b_last + m - m_new)
        kw = w_k[..., None] * kc
        c_new = decay[..., None, None] * c + jnp.einsum('bhsd,bhse->bhde', kw, vc)
        n_new = decay[..., None] * n + jnp.sum(kw, axis=2)
        return (c_new, n_new, m_new), h_out

    init = (jnp.zeros((bsz, h, dh, dh), jnp.float32),
            jnp.zeros((bsz, h, dh), jnp.float32),
            jnp.zeros((bsz, h), jnp.float32))
    _, hs = lax.scan(step, init, (chunks(q), chunks(k), chunks(v), gchunks(i_log), gchunks(log_f)))
    return hs.transpose(1, 0, 3, 2, 4).reshape(bsz, s, h, dh)


def setup_inputs(seed: int = 0) -> dict:
    key = jax.random.key(seed)
    ks = jax.random.split(key, 17)
    f32 = jnp.float32
    nrm = jax.random.normal
    x = nrm(ks[0], (BATCH, SEQ, D_MODEL), f32)
    norm_mix_g = 1.0 + 0.02 * nrm(ks[1], (DEPTH, D_MODEL), f32)
    w_in = nrm(ks[2], (DEPTH, D_MODEL, IN_WIDTH), f32) * D_MODEL ** -0.5
    q_norm_g = 1.0 + 0.02 * nrm(ks[3], (DEPTH, HEAD_DIM), f32)
    k_norm_g = 1.0 + 0.02 * nrm(ks[4], (DEPTH, HEAD_DIM), f32)
    mlstm_conv_w = nrm(ks[5], (DEPTH, MLSTM_CONV, 2 * MLSTM_WIDTH), f32) * MLSTM_CONV ** -0.5
    mlstm_conv_b = 0.02 * nrm(ks[6], (DEPTH, 2 * MLSTM_WIDTH), f32)
    b_igate = 0.1 * nrm(ks[7], (DEPTH, N_MLSTM_HEADS), f32)
    b_fgate = jnp.linspace(3.0, 6.0, N_MLSTM_HEADS, dtype=f32)[None, :] + 0.1 * nrm(ks[8], (DEPTH, N_MLSTM_HEADS), f32)
    mlstm_norm_g = 1.0 + 0.02 * nrm(ks[9], (DEPTH, MLSTM_WIDTH), f32)
    w_out = nrm(ks[10], (DEPTH, MIX_WIDTH, D_MODEL), f32) * MIX_WIDTH ** -0.5
    norm_ffn_g = 1.0 + 0.02 * nrm(ks[11], (DEPTH, D_MODEL), f32)
    w_up = nrm(ks[12], (DEPTH, D_MODEL, 2 * D_FF), f32) * D_MODEL ** -0.5
    ffn_conv_w = nrm(ks[13], (DEPTH, FFN_CONV, 2 * D_FF), f32) * FFN_CONV ** -0.5
    ffn_conv_b = 0.02 * nrm(ks[14], (DEPTH, 2 * D_FF), f32)
    w_down = nrm(ks[15], (DEPTH, D_FF, D_MODEL), f32) * D_FF ** -0.5
    return {'x': x, 'norm_mix_g': norm_mix_g, 'w_in': w_in, 'q_norm_g': q_norm_g, 'k_norm_g': k_norm_g,
            'mlstm_conv_w': mlstm_conv_w, 'mlstm_conv_b': mlstm_conv_b, 'b_igate': b_igate, 'b_fgate': b_fgate,
            'mlstm_norm_g': mlstm_norm_g, 'w_out': w_out, 'norm_ffn_g': norm_ffn_g, 'w_up': w_up,
            'ffn_conv_w': ffn_conv_w, 'ffn_conv_b': ffn_conv_b, 'w_down': w_down}


def reference(x, norm_mix_g, w_in, q_norm_g, k_norm_g, mlstm_conv_w, mlstm_conv_b, b_igate, b_fgate,
              mlstm_norm_g, w_out, norm_ffn_g, w_up, ffn_conv_w, ffn_conv_b, w_down):
    bsz, s, _ = x.shape

    def heads(t, n):
        return t.reshape(bsz, s, n, HEAD_DIM)

    for layer in range(DEPTH):
        h = _rmsnorm(x, norm_mix_g[layer]).astype(x.dtype)
        proj = h @ w_in[layer]
        aq, ak, av, mq, mk, mv, mo, mi, mf = jnp.split(proj, IN_SPLITS, axis=-1)
        attn = _dilated_attention(heads(aq, N_ATTN_HEADS), heads(ak, N_ATTN_HEADS), heads(av, N_ATTN_HEADS),
                                  q_norm_g[layer], k_norm_g[layer])
        qk = jax.nn.silu(_causal_dwconv(jnp.concatenate([mq, mk], axis=-1), mlstm_conv_w[layer], mlstm_conv_b[layer]))
        mq_c, mk_c = jnp.split(qk, 2, axis=-1)
        hm = _mlstm(heads(mq_c, N_MLSTM_HEADS), heads(mk_c, N_MLSTM_HEADS), heads(mv, N_MLSTM_HEADS),
                    mi + b_igate[layer], mf + b_fgate[layer])
        hm = hm * jax.nn.sigmoid(heads(mo, N_MLSTM_HEADS).astype(jnp.float32))
        hm = _rmsnorm(hm, mlstm_norm_g[layer].reshape(N_MLSTM_HEADS, HEAD_DIM)).reshape(bsz, s, MLSTM_WIDTH)
        mix = jnp.concatenate([attn, hm], axis=-1).astype(x.dtype)
        x = x + mix @ w_out[layer]
        h2 = _rmsnorm(x, norm_ffn_g[layer]).astype(x.dtype)
        u = _causal_dwconv(h2 @ w_up[layer], ffn_conv_w[layer], ffn_conv_b[layer])
        gate, val = jnp.split(u, 2, axis=-1)
        x = x + (jax.nn.silu(gate) * val) @ w_down[layer]
    return x
```

```cpp
#include <hip/hip_runtime.h>
#include <cstdio>
#include <cstdint>
#include <cmath>
#define MK_N_LAUNCHES 7
namespace pg8 {
#define PG8_LAS __attribute__((address_space(3)))
typedef unsigned short bf16_t;
typedef short bf16x8 __attribute__((ext_vector_type(8)));
typedef float f32x4 __attribute__((ext_vector_type(4)));
typedef unsigned u32x4 __attribute__((ext_vector_type(4)));
constexpr int BM = 256, BK = 64, HALF = 128, HTB = HALF * BK * 2  , STAGE_BYTES = 8 * HTB, NXCD = 8, WGM = 8;

__host__ __device__ __forceinline__ int lds_byte(int r, int c) { const int st = (r >> 4) * 2 + (c >> 5), rr = r & 15, cc = c & 31, ob = rr * 64 + cc * 2; return st * 1024 + (ob ^ (((ob >> 9) & 1) << 5)); }
__host__ __device__ __forceinline__ void stage_rc(int b, int& R, int& C) { const int st = b / 1024, sb = b % 1024, swz = sb ^ (((sb >> 9) & 1) << 5); R = (st >> 1) * 16 + swz / 64; C = (st & 1) * 32 + (swz % 64) / 2; }
__host__ __device__ __forceinline__ int perm32(int rho) { const int n = rho >> 4, i = rho & 15; return 8 * (i >> 2) + 4 * n + (i & 3); }

struct Unit { int pm, pn; };
struct Gemm { const bf16_t* A; const bf16_t* Bt; int M, N, K; };

struct StaticOrder {
    int nM, nN, nwg, G, c;
    __host__ __device__ void init(int M, int N, int G_, int c_) { nM = M / BM; nN = N / BM; nwg = nM * nN; G = G_; c = c_; }
    __host__ __device__ bool next(int i, Unit& u) const {
        const long L = (long)i * G + c; if (L >= nwg) return false;
        int wgid = (int)L; { const int q = nwg / NXCD, r = nwg % NXCD, xcd = wgid % NXCD, off = wgid / NXCD; wgid = (xcd < r ? xcd * (q + 1) : r * (q + 1) + (xcd - r) * q) + off; }
        const int nig = WGM * nN, gid = wgid / nig, fm = gid * WGM, gsz = (nM - fm) < WGM ? (nM - fm) : WGM;
        u.pm = fm + ((wgid % nig) % gsz); u.pn = (wgid % nig) / gsz; return true;
    }
    __device__ __forceinline__ void a_ready(const Unit&) const {}
    __device__ __forceinline__ void done(const Unit&) const {}
};

__device__ __forceinline__ unsigned cvt_pk_bf16(float lo, float hi) { unsigned r; asm volatile("v_cvt_pk_bf16_f32 %0, %1, %2" : "=v"(r) : "v"(lo), "v"(hi)); return r; }

typedef float f32x2 __attribute__((ext_vector_type(2)));
#define EPI_BAR() do { asm volatile("s_waitcnt lgkmcnt(0)" ::: "memory"); __builtin_amdgcn_s_barrier(); asm volatile("" ::: "memory"); } while (0)
constexpr float kEps = 1e-6f;

struct Epi1 {
    static constexpr bool PERM = true, AFTER_DRAIN = false, APERM = false;
    bf16_t *QB, *KB, *VB, *ML; float* G; const float* rope; const float *qg, *kg, *b_i, *b_f; PG8_LAS float* scr;
    __device__ __forceinline__ void operator()(const f32x4 (&acc)[2][2][4][2], const Unit& u, int wr, int wc, int fr, int fq) const {
        const int pn = u.pn;
        if (pn < 12) {
            const bool isq = pn < 6;
#pragma unroll
            for (int ai = 0; ai < 2; ++ai)
#pragma unroll
                for (int m = 0; m < 4; ++m)
#pragma unroll
                    for (int bj = 0; bj < 2; ++bj) {
                        const f32x4 a = acc[ai][bj][m][0], b = acc[ai][bj][m][1];
                        float s = (a[0] * a[0] + a[1] * a[1]) + (a[2] * a[2] + a[3] * a[3]) + (b[0] * b[0] + b[1] * b[1]) + (b[2] * b[2] + b[3] * b[3]);
                        s += __shfl_xor(s, 16); s += __shfl_xor(s, 32);
                        if (fq == 0) scr[((ai * HALF + wr * 64 + m * 16 + fr) * 2 + bj) * 4 + wc] = s;
                    }
            EPI_BAR();
            const float* gsrc = isq ? qg : kg; const float gscale = isq ? 0.08838834764831845f * 1.4426950408889634f : 1.0f;
            float gv[8];
#pragma unroll
            for (int e = 0; e < 8; ++e) { const int p = 32 * wc + 8 * fq + e; gv[e] = gsrc[(p >> 1) + 64 * (p & 1)] * gscale; }
            bf16_t* dst = isq ? QB : KB; const int head0 = (isq ? pn : pn - 6) * 2;
#pragma unroll
            for (int ai = 0; ai < 2; ++ai)
#pragma unroll
                for (int m = 0; m < 4; ++m) {
                    const int rl = ai * HALF + wr * 64 + m * 16 + fr, grow = u.pm * BM + rl, t = grow & 2047, bb = grow >> 11;
                    const size_t drow = (size_t)bb * 2048 + (size_t)(t & 3) * 512 + (t >> 2);
                    const f32x4 cs0 = *(const f32x4*)(rope + ((size_t)t * 64 + 16 * wc + 4 * fq) * 2), cs1 = *(const f32x4*)(rope + ((size_t)t * 64 + 16 * wc + 4 * fq) * 2 + 4);
#pragma unroll
                    for (int bj = 0; bj < 2; ++bj) {
                        const f32x4 pp = *(const PG8_LAS f32x4*)(scr + (rl * 2 + bj) * 4);
                        const float rstd = 1.0f / sqrtf(((pp[0] + pp[1]) + (pp[2] + pp[3])) * (1.0f / 128.0f) + kEps);
                        const f32x4 a = acc[ai][bj][m][0] * rstd, b = acc[ai][bj][m][1] * rstd;
                        const float x0 = a[0] * gv[0], x1 = a[1] * gv[1], x2 = a[2] * gv[2], x3 = a[3] * gv[3], x4 = b[0] * gv[4], x5 = b[1] * gv[5], x6 = b[2] * gv[6], x7 = b[3] * gv[7];
                        u32x4 w;
                        w.x = cvt_pk_bf16(x0 * cs0[0] - x1 * cs0[1], x0 * cs0[1] + x1 * cs0[0]);
                        w.y = cvt_pk_bf16(x2 * cs0[2] - x3 * cs0[3], x2 * cs0[3] + x3 * cs0[2]);
                        w.z = cvt_pk_bf16(x4 * cs1[0] - x5 * cs1[1], x4 * cs1[1] + x5 * cs1[0]);
                        w.w = cvt_pk_bf16(x6 * cs1[2] - x7 * cs1[3], x6 * cs1[3] + x7 * cs1[2]);
                        *(u32x4*)(dst + drow * 1536 + (head0 + bj) * 128 + 32 * wc + 8 * fq) = w;
                    }
                }
        } else if (pn < 26) {
            const bool isv = pn < 18;
#pragma unroll
            for (int ai = 0; ai < 2; ++ai)
#pragma unroll
                for (int m = 0; m < 4; ++m) {
                    const int rl = ai * HALF + wr * 64 + m * 16 + fr, grow = u.pm * BM + rl, t = grow & 2047, bb = grow >> 11;
                    bf16_t* rowp = isv ? VB + ((size_t)bb * 2048 + (size_t)(t & 3) * 512 + (t >> 2)) * 1536 + (pn - 12) * 256 : ML + (size_t)grow * 2048 + (pn - 18) * 256;
#pragma unroll
                    for (int bj = 0; bj < 2; ++bj) {
                        const f32x4 a = acc[ai][bj][m][0], b = acc[ai][bj][m][1];
                        u32x4 w; w.x = cvt_pk_bf16(a[0], a[1]); w.y = cvt_pk_bf16(a[2], a[3]); w.z = cvt_pk_bf16(b[0], b[1]); w.w = cvt_pk_bf16(b[2], b[3]);
                        *(u32x4*)(rowp + bj * HALF + 32 * wc + 8 * fq) = w;
                    }
                }
        } else {
            if (wc == 0 && fq == 0) {
                const f32x4 bi = *(const f32x4*)b_i, bf = *(const f32x4*)b_f;
#pragma unroll
                for (int ai = 0; ai < 2; ++ai)
#pragma unroll
                    for (int m = 0; m < 4; ++m) {
                        const int grow = u.pm * BM + ai * HALF + wr * 64 + m * 16 + fr;
                        *(f32x4*)(G + (size_t)grow * 8) = acc[ai][0][m][0] + bi; *(f32x4*)(G + (size_t)grow * 8 + 4) = acc[ai][0][m][1] + bf;
                    }
            }
        }
    }
};

struct Epi3 {
    static constexpr bool PERM = true, AFTER_DRAIN = false, APERM = false;
    const float* x; float* out; bf16_t* XN2; float* SS; const float* g2; PG8_LAS float* scr;
    __device__ __forceinline__ void operator()(const f32x4 (&acc)[2][2][4][2], const Unit& u, int wr, int wc, int fr, int fq) const {
        const int col0 = u.pn * BM + 32 * wc + 8 * fq;
        f32x4 gv[2][2];
#pragma unroll
        for (int bj = 0; bj < 2; ++bj) { gv[bj][0] = *(const f32x4*)(g2 + col0 + bj * HALF); gv[bj][1] = *(const f32x4*)(g2 + col0 + bj * HALF + 4); }
#pragma unroll
        for (int ai = 0; ai < 2; ++ai)
#pragma unroll
            for (int m = 0; m < 4; ++m) {
                const int rl = ai * HALF + wr * 64 + m * 16 + fr; const size_t off = (size_t)(u.pm * BM + rl) * 2048 + col0;
                float s = 0.f;
#pragma unroll
                for (int bj = 0; bj < 2; ++bj) {
                    const f32x4 a = acc[ai][bj][m][0] + *(const f32x4*)(x + off + bj * HALF), b = acc[ai][bj][m][1] + *(const f32x4*)(x + off + bj * HALF + 4);
                    *(f32x4*)(out + off + bj * HALF) = a; *(f32x4*)(out + off + bj * HALF + 4) = b;
                    s += (a[0] * a[0] + a[1] * a[1]) + (a[2] * a[2] + a[3] * a[3]) + (b[0] * b[0] + b[1] * b[1]) + (b[2] * b[2] + b[3] * b[3]);
                    const f32x4 ga = a * gv[bj][0], gb = b * gv[bj][1];
                    u32x4 w; w.x = cvt_pk_bf16(ga[0], ga[1]); w.y = cvt_pk_bf16(ga[2], ga[3]); w.z = cvt_pk_bf16(gb[0], gb[1]); w.w = cvt_pk_bf16(gb[2], gb[3]);
                    *(u32x4*)(XN2 + off + bj * HALF) = w;
                }
                s += __shfl_xor(s, 16); s += __shfl_xor(s, 32);
                if (fq == 0) scr[rl * 4 + wc] = s;
            }
        EPI_BAR();
        if (wc == 0 && fq == 0) {
#pragma unroll
            for (int ai = 0; ai < 2; ++ai)
#pragma unroll
                for (int m = 0; m < 4; ++m) {
                    const int rl = ai * HALF + wr * 64 + m * 16 + fr; const f32x4 pp = *(const PG8_LAS f32x4*)(scr + rl * 4);
                    SS[(size_t)(u.pm * BM + rl) * 8 + u.pn] = (pp[0] + pp[1]) + (pp[2] + pp[3]);
                }
        }
    }
};

__device__ __forceinline__ float dpp_shr1(float v) { return __builtin_bit_cast(float, __builtin_amdgcn_update_dpp(0, __builtin_bit_cast(int, v), 0x111, 0xf, 0xf, true)); }
struct Epi4 {
    static constexpr bool PERM = true, AFTER_DRAIN = false, APERM = true;
    bf16_t* ACT; float* RAWB; const float* SS; const float *cw, *cb;
    __device__ __forceinline__ void operator()(f32x4 (&acc)[2][2][4][2], const Unit& u, int wr, int wc, int fr, int fq) const {
        const int j0 = u.pn * 128 + 32 * wc + 8 * fq;
#pragma unroll
        for (int ai = 0; ai < 2; ++ai)
#pragma unroll
            for (int m = 0; m < 4; ++m) {
                const int grow = u.pm * BM + ai * HALF + wr * 64 + 4 * fr + m;
                const f32x4 s0 = *(const f32x4*)(SS + (size_t)grow * 8), s1 = *(const f32x4*)(SS + (size_t)grow * 8 + 4);
                const float ss = ((s0[0] + s0[1]) + (s0[2] + s0[3])) + ((s1[0] + s1[1]) + (s1[2] + s1[3]));
                const float rstd = 1.0f / sqrtf(ss * (1.0f / 2048.0f) + kEps);
#pragma unroll
                for (int bj = 0; bj < 2; ++bj) { acc[ai][bj][m][0] = acc[ai][bj][m][0] * rstd; acc[ai][bj][m][1] = acc[ai][bj][m][1] * rstd; }
            }
        if (fr == 0 || fr == 15) {
            const int mb = fr == 0 ? 0 : 2;
#pragma unroll
            for (int ai = 0; ai < 2; ++ai) {
                const int strip = u.pm * 4 + ai * 2 + wr;
#pragma unroll
                for (int mm = 0; mm < 2; ++mm)
#pragma unroll
                    for (int bj = 0; bj < 2; ++bj) {
                        float* p = RAWB + ((size_t)strip * 4 + mb + mm) * 11264 + u.pn * 256 + bj * HALF + 32 * wc + 8 * fq;
                        *(f32x4*)p = fr == 0 ? acc[ai][bj][mm][0] : acc[ai][bj][2 + mm][0]; *(f32x4*)(p + 4) = fr == 0 ? acc[ai][bj][mm][1] : acc[ai][bj][2 + mm][1];
                    }
            }
        }
#pragma unroll
        for (int ai = 0; ai < 2; ++ai) {
            unsigned pk[4][4];
#pragma unroll
            for (int n = 0; n < 2; ++n) {
                const f32x4 wg0 = *(const f32x4*)(cw + j0 + 4 * n), wg1 = *(const f32x4*)(cw + 11264 + j0 + 4 * n), wg2 = *(const f32x4*)(cw + 22528 + j0 + 4 * n), bg = *(const f32x4*)(cb + j0 + 4 * n);
                const f32x4 wv0 = *(const f32x4*)(cw + 5632 + j0 + 4 * n), wv1 = *(const f32x4*)(cw + 11264 + 5632 + j0 + 4 * n), wv2 = *(const f32x4*)(cw + 22528 + 5632 + j0 + 4 * n), bv = *(const f32x4*)(cb + 5632 + j0 + 4 * n);
                float res[4][4];
#pragma unroll
                for (int j = 0; j < 4; ++j) {
                    float ug[6], uv[6];
                    ug[0] = dpp_shr1(acc[ai][0][2][n][j]); ug[1] = dpp_shr1(acc[ai][0][3][n][j]); uv[0] = dpp_shr1(acc[ai][1][2][n][j]); uv[1] = dpp_shr1(acc[ai][1][3][n][j]);
#pragma unroll
                    for (int m = 0; m < 4; ++m) { ug[2 + m] = acc[ai][0][m][n][j]; uv[2 + m] = acc[ai][1][m][n][j]; }
#pragma unroll
                    for (int m = 0; m < 4; ++m) {
                        const float yg = bg[j] + wg0[j] * ug[m] + wg1[j] * ug[m + 1] + wg2[j] * ug[m + 2];
                        const float yv = bv[j] + wv0[j] * uv[m] + wv1[j] * uv[m + 1] + wv2[j] * uv[m + 2];
                        res[m][j] = yg * __builtin_amdgcn_rcpf(1.0f + __builtin_amdgcn_exp2f(-1.4426950408889634f * yg)) * yv;
                    }
                }
#pragma unroll
                for (int m = 0; m < 4; ++m) { pk[m][2 * n] = cvt_pk_bf16(res[m][0], res[m][1]); pk[m][2 * n + 1] = cvt_pk_bf16(res[m][2], res[m][3]); }
            }
#pragma unroll
            for (int m = 0; m < 4; ++m) {
                if (m < 2 && fr == 0) continue;
                const int grow = u.pm * BM + ai * HALF + wr * 64 + 4 * fr + m;
                u32x4 w; w.x = pk[m][0]; w.y = pk[m][1]; w.z = pk[m][2]; w.w = pk[m][3];
                *(u32x4*)(ACT + (size_t)grow * 5632 + j0) = w;
            }
        }
    }
};

struct Epi5 {
    static constexpr bool PERM = true, AFTER_DRAIN = false, APERM = false;
    float* out;
    __device__ __forceinline__ void operator()(const f32x4 (&acc)[2][2][4][2], const Unit& u, int wr, int wc, int fr, int fq) const {
        const int col0 = u.pn * BM + 32 * wc + 8 * fq;
#pragma unroll
        for (int ai = 0; ai < 2; ++ai)
#pragma unroll
            for (int m = 0; m < 4; ++m) {
                float* rowp = out + (size_t)(u.pm * BM + ai * HALF + wr * 64 + m * 16 + fr) * 2048 + col0;
#pragma unroll
                for (int bj = 0; bj < 2; ++bj) { *(f32x4*)(rowp + bj * HALF) = acc[ai][bj][m][0] + *(const f32x4*)(rowp + bj * HALF); *(f32x4*)(rowp + bj * HALF + 4) = acc[ai][bj][m][1] + *(const f32x4*)(rowp + bj * HALF + 4); }
            }
    }
};
template <class Epi, class Sched, bool ALIGN_EPI = false, bool SP2 = false>
__device__ __forceinline__ void gemm_phase(PG8_LAS unsigned char* lds, const Gemm g, const Sched& S, const Epi& E) {
    const int tid = threadIdx.x, wid = __builtin_amdgcn_readfirstlane(tid >> 6), lane = tid & 63, wr = wid >> 2, wc = wid & 3, fr = lane & 15, fq = lane >> 4;
    const int K = g.K, nt = K / BK;
    unsigned voffA[2], voffB[2];
#pragma unroll
    for (int i = 0; i < 2; ++i) { int R, C; stage_rc(tid * 16 + i * 8192, R, C); const int Rb = Epi::PERM ? ((R & ~31) + perm32(R & 31)) : R;
        const int Ra = Epi::APERM ? ((R & ~63) + 4 * (R & 15) + ((R >> 4) & 3)) : R;
        voffA[i] = (unsigned)(Ra * K + C) * 2u; voffB[i] = (unsigned)(Rb * K + C) * 2u; }
    const size_t kstep = (size_t)(BK * 2);
    const size_t hstep = (size_t)HALF * K * 2;
    const size_t tstep = 2 * hstep;
    const unsigned ldsw = (unsigned)wid * 1024u;
    const int aoff = lds_byte(wr * 64 + fr, fq * 8), boff = lds_byte(wc * 32 + fr, fq * 8);
#define PG8_SA(b, h) (((b) * 2 + (h)) * HTB)
#define PG8_SB(b, h) ((4 + (b) * 2 + (h)) * HTB)
#define PG8_STAGE(bufoff, gbase, voff) do { _Pragma("unroll") for (int _i = 0; _i < 2; ++_i) \
        __builtin_amdgcn_global_load_lds((const unsigned*)((const char*)(gbase) + (voff)[_i]), (PG8_LAS unsigned*)(lds + (bufoff) + ldsw + _i * 8192), 16, 0, 0); } while (0)
#define PG8_LDA(dst, b, h) do { _Pragma("unroll") for (int m = 0; m < 4; ++m) _Pragma("unroll") for (int k = 0; k < 2; ++k) dst[m][k] = *(const PG8_LAS bf16x8*)(lds + PG8_SA(b, h) + aoff + m * 2048 + k * 1024); } while (0)
#define PG8_LDB(dst, b, h) do { _Pragma("unroll") for (int n = 0; n < 2; ++n) _Pragma("unroll") for (int k = 0; k < 2; ++k) dst[n][k] = *(const PG8_LAS bf16x8*)(lds + PG8_SB(b, h) + boff + n * 2048 + k * 1024); } while (0)
#define PG8_MMA(ai, bj, At, Bt) do { __builtin_amdgcn_s_setprio(1); _Pragma("unroll") for (int m = 0; m < 4; ++m) _Pragma("unroll") for (int n = 0; n < 2; ++n) _Pragma("unroll") for (int k = 0; k < 2; ++k) \
        acc[ai][bj][m][n] = __builtin_amdgcn_mfma_f32_16x16x32_bf16(Bt[n][k], At[m][k], acc[ai][bj][m][n], 0, 0, 0); __builtin_amdgcn_s_setprio(0); } while (0)
#define PG8_WAIT_V(n) asm volatile("s_waitcnt vmcnt(" #n ")" ::: "memory")
#define PG8_WAIT_L(n) asm volatile("s_waitcnt lgkmcnt(" #n ")" ::: "memory")
#define PG8_BAR __builtin_amdgcn_s_barrier()
#define PG8_SCHED __builtin_amdgcn_sched_barrier(0)
    Unit cur, nxt; int ui = 0;
    if (!S.next(0, cur)) return;
    f32x4 acc[2][2][4][2];
#pragma unroll
    for (int a = 0; a < 2; ++a)
#pragma unroll
        for (int b = 0; b < 2; ++b)
#pragma unroll
            for (int m = 0; m < 4; ++m)
#pragma unroll
                for (int n = 0; n < 2; ++n) acc[a][b][m][n] = (f32x4){0.f, 0.f, 0.f, 0.f};
    bf16x8 At[4][2], B0[2][2], B1[2][2];
    const char* cA = (const char*)g.A + (size_t)cur.pm * tstep; const char* cB = (const char*)g.Bt + (size_t)cur.pn * tstep;
    S.a_ready(cur);
    if constexpr (SP2) {
        PG8_STAGE(PG8_SB(0, 0), cB, voffB); PG8_STAGE(PG8_SB(0, 1), cB + hstep, voffB); PG8_STAGE(PG8_SA(0, 0), cA, voffA); PG8_STAGE(PG8_SA(0, 1), cA + hstep, voffA);
        if (wr == 1) PG8_BAR;
        PG8_WAIT_V(2); PG8_BAR;
        PG8_STAGE(PG8_SB(1, 0), cB + kstep, voffB); PG8_STAGE(PG8_SA(1, 0), cA + kstep, voffA); PG8_STAGE(PG8_SB(1, 1), cB + hstep + kstep, voffB);
        PG8_WAIT_V(6); PG8_BAR;
    } else {
        PG8_STAGE(PG8_SB(0, 0), cB, voffB); PG8_STAGE(PG8_SA(0, 0), cA, voffA); PG8_STAGE(PG8_SB(0, 1), cB + hstep, voffB); PG8_STAGE(PG8_SA(0, 1), cA + hstep, voffA);
        if (wr == 1) PG8_BAR;
        PG8_WAIT_V(4); PG8_BAR;
        PG8_STAGE(PG8_SB(1, 0), cB + kstep, voffB); PG8_STAGE(PG8_SA(1, 0), cA + kstep, voffA); PG8_STAGE(PG8_SB(1, 1), cB + hstep + kstep, voffB);
        PG8_WAIT_V(6); PG8_BAR;
    }
    for (;;) {
        const bool has_next = S.next(ui + 1, nxt);
        const char* nA = has_next ? (const char*)g.A + (size_t)nxt.pm * tstep : cA; const char* nB = has_next ? (const char*)g.Bt + (size_t)nxt.pn * tstep : cB;
        for (int t = 0; t < nt; t += 2) {
            const bool last = (t == nt - 2);
            const char* a1 = cA + (size_t)(t + 1) * kstep;
            const char* a2 = last ? nA : cA + (size_t)(t + 2) * kstep; const char* b2 = last ? nB : cB + (size_t)(t + 2) * kstep;
            const char* a3 = a2 + kstep; const char* b3 = b2 + kstep;
            if (last && has_next) S.a_ready(nxt);
            if constexpr (SP2) {
            PG8_LDB(B0, 0, 0); PG8_LDB(B1, 0, 1); PG8_SCHED; PG8_LDA(At, 0, 0); PG8_STAGE(PG8_SA(1, 1), a1 + hstep, voffA);
            PG8_WAIT_V(8); PG8_WAIT_L(0); PG8_BAR; PG8_MMA(0, 0, At, B0); PG8_MMA(0, 1, At, B1); PG8_BAR; PG8_SCHED;
            PG8_LDA(At, 0, 1); PG8_STAGE(PG8_SB(0, 0), b2, voffB); PG8_STAGE(PG8_SB(0, 1), b2 + hstep, voffB); PG8_STAGE(PG8_SA(0, 0), a2, voffA);
            PG8_WAIT_V(8); PG8_WAIT_L(0); PG8_BAR; PG8_MMA(1, 0, At, B0); PG8_MMA(1, 1, At, B1); PG8_BAR; PG8_SCHED;
            PG8_LDB(B0, 1, 0); PG8_LDB(B1, 1, 1); PG8_SCHED; PG8_LDA(At, 1, 0); PG8_STAGE(PG8_SA(0, 1), a2 + hstep, voffA);
            PG8_WAIT_V(8); PG8_WAIT_L(0); PG8_BAR; PG8_MMA(0, 0, At, B0); PG8_MMA(0, 1, At, B1); PG8_BAR; PG8_SCHED;
            PG8_LDA(At, 1, 1); PG8_STAGE(PG8_SB(1, 0), b3, voffB); PG8_STAGE(PG8_SB(1, 1), b3 + hstep, voffB); PG8_STAGE(PG8_SA(1, 0), a3, voffA);
            PG8_WAIT_V(8); PG8_WAIT_L(0); PG8_BAR; PG8_MMA(1, 0, At, B0); PG8_MMA(1, 1, At, B1); PG8_BAR; PG8_SCHED;
            } else {
            PG8_LDB(B0, 0, 0); PG8_SCHED; PG8_LDA(At, 0, 0); PG8_STAGE(PG8_SA(1, 1), a1 + hstep, voffA);
            PG8_WAIT_L(8); PG8_BAR; PG8_WAIT_L(0); PG8_MMA(0, 0, At, B0); PG8_BAR; PG8_SCHED;
            PG8_LDB(B1, 0, 1); PG8_STAGE(PG8_SB(0, 0), b2, voffB);
            PG8_BAR; PG8_WAIT_L(0); PG8_MMA(0, 1, At, B1); PG8_BAR;
            PG8_LDA(At, 0, 1); PG8_STAGE(PG8_SA(0, 0), a2, voffA);
            PG8_BAR; PG8_WAIT_L(0); PG8_MMA(1, 0, At, B0); PG8_BAR; PG8_SCHED;
            PG8_STAGE(PG8_SB(0, 1), b2 + hstep, voffB);
            PG8_WAIT_V(6); PG8_BAR; PG8_MMA(1, 1, At, B1); PG8_BAR;
            PG8_LDB(B0, 1, 0); PG8_SCHED; PG8_LDA(At, 1, 0); PG8_STAGE(PG8_SA(0, 1), a2 + hstep, voffA);
            PG8_WAIT_L(8); PG8_BAR; PG8_WAIT_L(0); PG8_MMA(0, 0, At, B0); PG8_BAR; PG8_SCHED;
            PG8_LDB(B1, 1, 1); PG8_STAGE(PG8_SB(1, 0), b3, voffB);
            PG8_BAR; PG8_WAIT_L(0); PG8_MMA(0, 1, At, B1); PG8_BAR;
            PG8_LDA(At, 1, 1); PG8_STAGE(PG8_SA(1, 0), a3, voffA);
            PG8_BAR; PG8_WAIT_L(0); PG8_MMA(1, 0, At, B0); PG8_BAR; PG8_SCHED;
            PG8_STAGE(PG8_SB(1, 1), b3 + hstep, voffB);
            PG8_WAIT_V(6); PG8_BAR; PG8_MMA(1, 1, At, B1); PG8_BAR;
            }
        }
        if constexpr (ALIGN_EPI) { if (wr == 0) PG8_BAR; }
        if constexpr (!Epi::AFTER_DRAIN) { E(acc, cur, wr, wc, fr, fq); S.done(cur); }
        if (!has_next) break;
#pragma unroll
        for (int a = 0; a < 2; ++a)
#pragma unroll
            for (int b = 0; b < 2; ++b)
#pragma unroll
                for (int m = 0; m < 4; ++m)
#pragma unroll
                    for (int n = 0; n < 2; ++n) acc[a][b][m][n] = (f32x4){0.f, 0.f, 0.f, 0.f};
        cur = nxt; cA = nA; cB = nB; ++ui;
        if constexpr (ALIGN_EPI) { if (wr == 1) PG8_BAR; }
    }
    PG8_WAIT_V(0);
    if constexpr (!ALIGN_EPI) { if (wr == 0) PG8_BAR; }
    PG8_BAR;
    if constexpr (Epi::AFTER_DRAIN) { E.fused(acc, cur, wr, wc, fr, fq, lds, wid, lane); S.done(cur); }
#undef PG8_SA
#undef PG8_SB
#undef PG8_STAGE
#undef PG8_LDA
#undef PG8_LDB
#undef PG8_MMA
#undef PG8_WAIT_V
#undef PG8_WAIT_L
#undef PG8_BAR
#undef PG8_SCHED
}
}
#define GAS __attribute__((address_space(1)))
#define LAS __attribute__((address_space(3)))
typedef unsigned short bf16;
typedef unsigned v4u __attribute__((ext_vector_type(4)));
typedef float f32x4 __attribute__((ext_vector_type(4)));
typedef short bf16x8 __attribute__((ext_vector_type(8)));
typedef GAS unsigned gu32;
typedef GAS unsigned long long gu64;
#define RLX_AGENT __ATOMIC_RELAXED, __HIP_MEMORY_SCOPE_AGENT
#define LDS_WAIT() asm volatile("s_waitcnt lgkmcnt(0)" ::: "memory")
#define VM_WAIT() asm volatile("s_waitcnt vmcnt(0)" ::: "memory")
__device__ __forceinline__ unsigned long long rt() { return __builtin_amdgcn_s_memrealtime(); }
__device__ __forceinline__ unsigned f2bf(float f) { unsigned u = __builtin_bit_cast(unsigned, f); return (u + 0x7fffu + ((u >> 16) & 1u)) >> 16; }
__device__ __forceinline__ unsigned pk2(float lo, float hi) { return f2bf(lo) | (f2bf(hi) << 16); }

#define XB_TMO      128
#define XB_XCNT(j)  (256  + 64 * (j))
#define XB_XSUB(j)  (1280 + 64 * (j))
#define XB_XGEN(j)  (2304 + 64 * (j))
#define XB_TOP      3328
#define XB_TOPGEN   3392
#define XCD_BAR_WORDS 3456
#define XB_SPIN_CAP (1u << 18)

__device__ __forceinline__ unsigned xb_ld(unsigned* p)              { return __hip_atomic_load(p, __ATOMIC_RELAXED, __HIP_MEMORY_SCOPE_AGENT); }
__device__ __forceinline__ unsigned xb_add(unsigned* p, unsigned v) { return __hip_atomic_fetch_add(p, v, __ATOMIC_RELAXED, __HIP_MEMORY_SCOPE_AGENT); }
__device__ __forceinline__ unsigned xb_xcc_id() { return (unsigned)__builtin_amdgcn_s_getreg((3 << 11) | 20) & 0xFu; }
#define XB_SPIN(cond, bar) do { unsigned _sp = 0; while (cond) { __builtin_amdgcn_s_sleep(1); \
    if ((++_sp & 255u) == 0u) { if (xb_ld(&(bar)[XB_TMO])) break; if (_sp > XB_SPIN_CAP) { atomicAdd(&(bar)[XB_TMO], 1u); break; } } } } while (0)

struct XcdBarrier {
    unsigned* bar; unsigned x;
    volatile LAS unsigned* st;
};

__device__ __forceinline__ XcdBarrier xcd_barrier_post(unsigned* bar, volatile LAS unsigned* st) {
    XcdBarrier b; b.bar = bar; b.x = xb_xcc_id(); b.st = st;
    if (threadIdx.x == 0) (void)xb_add(&bar[XB_XCNT(b.x)], 1u);
    return b;
}
__device__ __forceinline__ void xcd_barrier_complete(unsigned* bar, unsigned x, unsigned& nloc, unsigned& nx) {
    const unsigned G = gridDim.x * gridDim.y * gridDim.z;
    unsigned sum, cnt, mine, sp = 0u;
    for (;;) {
        sum = 0u; cnt = 0u; mine = 0u;
#pragma unroll
        for (unsigned j = 0; j < 16; ++j) { const unsigned c = xb_ld(&bar[XB_XCNT(j)]); sum += c; cnt += (c > 0u) ? 1u : 0u; mine = (j == x) ? c : mine; }
        if (sum == G) break;
        __builtin_amdgcn_s_sleep(1);
        if ((++sp & 255u) == 0u) { if (xb_ld(&bar[XB_TMO])) break; if (sp > XB_SPIN_CAP) { atomicAdd(&bar[XB_TMO], 1u); break; } }
    }
    nloc = mine > 0u ? mine : 1u; nx = cnt > 0u ? cnt : 1u;
}

__device__ __forceinline__ void xcd_barrier(const XcdBarrier& b) {
    asm volatile("s_waitcnt vmcnt(0)" ::: "memory");
    __syncthreads();
    if (threadIdx.x == 0) {
        unsigned* bar = b.bar;
        __builtin_amdgcn_s_waitcnt(0);
        unsigned nloc = b.st[0], nx = b.st[1];
        if (nloc == 0u) { xcd_barrier_complete(bar, b.x, nloc, nx); b.st[0] = nloc; b.st[1] = nx; }
        const unsigned old = xb_add(&bar[XB_XSUB(b.x)], 1u);
        const unsigned gen = old / nloc;
        if (old + 1u == (gen + 1u) * nloc) {
            __builtin_amdgcn_fence(__ATOMIC_RELEASE, "agent");
            asm volatile("s_waitcnt vmcnt(0)" ::: "memory");
            const unsigned og = xb_add(&bar[XB_TOP], 1u);
            const unsigned tg = og / nx;
            if (og + 1u == (tg + 1u) * nx) xb_add(&bar[XB_TOPGEN], 1u);
            else XB_SPIN(xb_ld(&bar[XB_TOPGEN]) == tg, bar);
            __builtin_amdgcn_fence(__ATOMIC_ACQUIRE, "agent");
            xb_add(&bar[XB_XGEN(b.x)], 1u);
            asm volatile("s_waitcnt vmcnt(0)" ::: "memory");
        } else {
            XB_SPIN(xb_ld(&bar[XB_XGEN(b.x)]) == gen, bar);
            __builtin_amdgcn_fence(__ATOMIC_ACQUIRE, "agent");
            asm volatile("s_waitcnt vmcnt(0)" ::: "memory");
        }
    }
    __syncthreads();
}

constexpr int NWAVES = 8;
constexpr int BATCH = 8, SEQ = 2048, DM = 2048, M = BATCH * SEQ;
constexpr int NAH = 12, NMH = 4, ATTN_W = 1536, IN_W = 6664, IN_WP = 6912, DFF = 5632, UPW = 11264;
#ifndef MK_N_LAUNCHES
#define MK_N_LAUNCHES 1
#endif
constexpr int N_LAUNCHES = MK_N_LAUNCHES;
constexpr int PER_PHASE = 7;

constexpr size_t MiB = 1u << 20;
constexpr size_t WS_CTL = 0, CTL_ZERO_BYTES = 64 * 1024;
constexpr size_t WS_ROPE = 1 * MiB, WS_G = 2 * MiB, WS_SS = 2 * MiB + 512 * 1024;
constexpr size_t WS_WIN = 4 * MiB, WS_WOUT = 31 * MiB, WS_WUP = 39 * MiB, WS_WDN = 83 * MiB;
constexpr size_t WS_XN = 105 * MiB;
constexpr size_t WS_QB = 169 * MiB, WS_KB = 217 * MiB, WS_VB = 265 * MiB, WS_ML = 313 * MiB;
constexpr size_t WS_MIX = 377 * MiB;
constexpr size_t WS_RAW = 377 * MiB;
constexpr size_t WS_ACT = 169 * MiB;
constexpr size_t WS_END = 441 * MiB;
static_assert(WS_WIN + (size_t)IN_WP * DM * 2 <= WS_WOUT && WS_WOUT + (size_t)DM * DM * 2 <= WS_WUP && WS_WUP + (size_t)UPW * DM * 2 <= WS_WDN && WS_WDN + (size_t)DM * DFF * 2 <= WS_XN, "weights map");
static_assert(WS_XN + (size_t)M * DM * 2 <= WS_QB && WS_ML + (size_t)M * 2048 * 2 <= WS_MIX && WS_MIX + (size_t)M * 2048 * 2 <= WS_END && WS_RAW + (size_t)256 * 4 * UPW * 4 <= WS_END && WS_ACT + (size_t)M * DFF * 2 <= WS_MIX, "activation map");
constexpr int CW_TMO = 0, CW_BAR = 4096, CW_QUEUE = 8192;

constexpr int RING_OFF = 0, RING_BYTES = 131072;
constexpr int SCR_OFF = RING_BYTES, SCR_BYTES = 24576;
constexpr int LDSCTL_OFF = SCR_OFF + SCR_BYTES, MISC_OFF = LDSCTL_OFF + 320;
constexpr int LDS_BYTES = 156672;
static_assert(MISC_OFF + 128 <= LDS_BYTES, "LDS map");

#define DI __device__ __forceinline__
typedef float f32x16 __attribute__((ext_vector_type(16)));
typedef short s16x4 __attribute__((ext_vector_type(4)));
typedef unsigned u32x2 __attribute__((ext_vector_type(2)));
#define MFMA32(a, b, c) __builtin_amdgcn_mfma_f32_32x32x16_bf16((a), (b), (c), 0, 0, 0)
constexpr float LOG2E = 1.4426950408889634f;

struct Frame {
    LAS unsigned char* lds; volatile LAS unsigned* MISC; gu32* ctl;
    int tid, lane, wave, vcu, G;
    float* out; unsigned char* ws;
};

DI unsigned swz_b(unsigned row) { return ((row & 3u) << 2) | ((row >> 2) & 3u); }
DI unsigned off_b(unsigned row, unsigned ch) { return 256u * row + 16u * (ch ^ swz_b(row)); }
DI bf16x8 lds_b128(LAS unsigned char* p) { return *(const LAS bf16x8*)p; }
DI LAS unsigned char* lp(unsigned a) { return (LAS unsigned char*)(size_t)a; }
typedef short v4i16_t __attribute__((ext_vector_type(4)));
DI s16x4 lds_tr(LAS unsigned char* p) { return __builtin_bit_cast(s16x4, __builtin_amdgcn_ds_read_tr16_b64_v4i16((LAS v4i16_t*)p)); }
DI int crow(int reg, int hh) { return (reg & 3) + 8 * (reg >> 2) + 4 * hh; }
typedef unsigned u32x4 __attribute__((ext_vector_type(4)));
typedef float f32x2_t __attribute__((ext_vector_type(2)));
typedef __bf16 bf16x2_t __attribute__((ext_vector_type(2)));
DI unsigned cvtpk(float lo, float hi) { f32x2_t v = {lo, hi}; bf16x2_t b = __builtin_convertvector(v, bf16x2_t); return __builtin_bit_cast(unsigned, b); }
DI bf16x8 pack8(float a0, float a1, float a2, float a3, float a4, float a5, float a6, float a7) {
    u32x4 p; p.x = cvtpk(a0, a1); p.y = cvtpk(a2, a3); p.z = cvtpk(a4, a5); p.w = cvtpk(a6, a7); return __builtin_bit_cast(bf16x8, p);
}
DI float bf_lo(unsigned w) { return __builtin_bit_cast(float, w << 16); }
DI float bf_hi(unsigned w) { return __builtin_bit_cast(float, w & 0xffff0000u); }

DI float wave_sum(float v) {
#pragma unroll
    for (int o = 1; o < 64; o <<= 1) v += __shfl_xor(v, o);
    return v;
}
template <int MAT> DI int colmap(int n) {
    if (MAT == 0) return n < 2 * ATTN_W ? (n & ~127) + ((n & 127) >> 1) + 64 * (n & 1) : (n < IN_W ? n : -1);
    if (MAT == 2) return DFF * ((n >> 7) & 1) + 128 * (n >> 8) + (n & 127);
    return n;
}
template <int MAT> DI void p0_transpose_item(const float* W, int K, int N, bf16* WT, LAS float* scr, int item, int nblk, int lane) {
    const int kb = item / nblk, nb = item % nblk, k0 = 64 * kb, n0 = 32 * nb;
    const int col = colmap<MAT>(n0 + (lane & 31));
#pragma unroll 8
    for (int i = 0; i < 32; ++i) { const int kk = 2 * i + (lane >> 5); scr[kk * 33 + (lane & 31)] = col >= 0 ? W[(size_t)(k0 + kk) * N + col] : 0.f; }
    LDS_WAIT(); asm volatile("" ::: "memory");
    const int c = lane & 7;
#pragma unroll
    for (int j = 0; j < 4; ++j) { const int n = (lane >> 3) + 8 * j; const LAS float* s = scr + (8 * c) * 33 + n;
        v4u o; o.x = pk2(s[0 * 33], s[1 * 33]); o.y = pk2(s[2 * 33], s[3 * 33]); o.z = pk2(s[4 * 33], s[5 * 33]); o.w = pk2(s[6 * 33], s[7 * 33]);
        *(GAS v4u*)(WT + (size_t)(n0 + n) * K + k0 + 8 * c) = o; }
    LDS_WAIT(); asm volatile("" ::: "memory");
}
DI void p0_prologue(Frame& F, const float* x, const float* g1, const float* w_in, const float* w_out, const float* w_up, const float* w_down) {
    LAS float* scr = (LAS float*)(F.lds + RING_OFF + F.wave * 16384);
    const int gw = F.vcu * NWAVES + F.wave, NGW = F.G * NWAVES;
    constexpr int NB0 = IN_WP / 32, NB1 = DM / 32, NB2 = UPW / 32, NB3 = DM / 32;
    constexpr int I0 = (DM / 64) * NB0, I1 = (DM / 64) * NB1, I2 = (DM / 64) * NB2, I3 = (DFF / 64) * NB3;
    bf16* Win = (bf16*)(F.ws + WS_WIN); bf16* Wout = (bf16*)(F.ws + WS_WOUT); bf16* Wup = (bf16*)(F.ws + WS_WUP); bf16* Wdn = (bf16*)(F.ws + WS_WDN);
    for (int it = gw; it < I0 + I1 + I2 + I3; it += NGW) {
        int r = it;
        if (r < I0) { p0_transpose_item<0>(w_in, DM, IN_W, Win, scr, r, NB0, F.lane); continue; } r -= I0;
        if (r < I1) { p0_transpose_item<1>(w_out, DM, DM, Wout, scr, r, NB1, F.lane); continue; } r -= I1;
        if (r < I2) { p0_transpose_item<2>(w_up, DM, UPW, Wup, scr, r, NB2, F.lane); continue; } r -= I2;
        p0_transpose_item<3>(w_down, DFF, DM, Wdn, scr, r, NB3, F.lane);
    }
    {
        const GAS f32x4* gp = (const GAS f32x4*)g1 + F.lane; bf16* XN = (bf16*)(F.ws + WS_XN);
        for (int m = gw; m < M; m += NGW) {
            const GAS f32x4* xr = (const GAS f32x4*)(x + (size_t)m * DM) + F.lane;
            f32x4 v[8]; float s = 0.f;
#pragma unroll
            for (int j = 0; j < 8; ++j) { v[j] = xr[64 * j]; s += (v[j].x * v[j].x + v[j].y * v[j].y) + (v[j].z * v[j].z + v[j].w * v[j].w); }
            const float rstd = 1.f / sqrtf(wave_sum(s) * (1.f / DM) + 1e-6f);
            GAS unsigned long long* o8 = (GAS unsigned long long*)(XN + (size_t)m * DM) + F.lane;
#pragma unroll
            for (int j = 0; j < 8; ++j) { const f32x4 g = gp[64 * j]; o8[64 * j] = (unsigned long long)pk2(v[j].x * rstd * g.x, v[j].y * rstd * g.y) | ((unsigned long long)pk2(v[j].z * rstd * g.z, v[j].w * rstd * g.w) << 32); }
        }
    }
    {
        float* rope = (float*)(F.ws + WS_ROPE);
        for (int idx = gw * 64 + F.lane; idx < SEQ * 64; idx += NGW * 64) {
            const int t = idx >> 6, i = idx & 63; const double ang = (double)t * pow(10000.0, -(double)i / 64.0);
            rope[2 * idx] = (float)cos(ang); rope[2 * idx + 1] = (float)sin(ang);
        }
    }
}

DI void att_dma_tile(const unsigned char* gbase, LAS unsigned char* ldst, int lane) {
#pragma unroll
    for (int it = 0; it < 8; ++it) {
        const unsigned row = 4 * it + (lane >> 4), ch = (lane & 15) ^ swz_b(row);
        __builtin_amdgcn_global_load_lds((const unsigned*)(gbase + (size_t)row * 3072 + ch * 16), (LAS unsigned*)(ldst + it * 1024), 16, 0, 0);
    }
}
DI void attn_unit(int b, int h, int r, int ib, const bf16* QB, const bf16* KB, const bf16* VB, bf16* MIX, LAS unsigned char* wl, int lane) {
    const int q = lane & 31, hh = lane >> 5, i0 = 32 * ib;
    const size_t rowb = (size_t)b * 2048;
    bf16x8 qf[8];
    { const bf16* qp = QB + (rowb + r * 512 + i0 + q) * 1536 + h * 128 + 8 * hh;
#pragma unroll
      for (int ks = 0; ks < 8; ++ks) qf[ks] = *(const GAS bf16x8*)(qp + 16 * ks); }
#pragma unroll
    for (int ks = 0; ks < 8; ++ks) asm volatile("" : "+v"(qf[ks]));
    f32x16 o[4];
#pragma unroll
    for (int c = 0; c < 4; ++c)
#pragma unroll
        for (int e = 0; e < 16; ++e) o[c][e] = 0.f;
    float mrun = -1e30f, lsum = 0.f;
    LAS unsigned char* Kt = wl; LAS unsigned char* Vt = wl + 8192;
    const int nt = (ib + 1) + (ib ? 6 : 3);
    auto tile_of = [&](int k, int& rc, int& j0) { if (k <= ib) { rc = r; j0 = 32 * k; } else { const int kk = k - (ib + 1); if (ib) { rc = (r + 1 + (kk >> 1)) & 3; j0 = 32 * (ib - 1 + (kk & 1)); } else { rc = (r + 1 + kk) & 3; j0 = 0; } } };
    const unsigned qi = (lane & 15) >> 2, pp = lane & 3, g16 = (lane >> 4) & 1;
    { int rc, j0; tile_of(0, rc, j0);
      att_dma_tile((const unsigned char*)(KB + (rowb + rc * 512 + j0) * 1536 + h * 128), Kt, lane);
      att_dma_tile((const unsigned char*)(VB + (rowb + rc * 512 + j0) * 1536 + h * 128), Vt, lane); }
    for (int k = 0; k < nt; ++k) {
        int rc, j0; tile_of(k, rc, j0);
        const bool has_next = k + 1 < nt; int rcn = 0, j0n = 0; if (has_next) tile_of(k + 1, rcn, j0n);
        asm volatile("s_waitcnt vmcnt(8)" ::: "memory");
        bf16x8 kf[8];
#pragma unroll
        for (int ks = 0; ks < 8; ++ks) kf[ks] = lds_b128(Kt + off_b(q, 2 * ks + hh));
        asm volatile("s_waitcnt lgkmcnt(0)" ::: "memory");
        if (has_next) att_dma_tile((const unsigned char*)(KB + (rowb + rcn * 512 + j0n) * 1536 + h * 128), Kt, lane);
        f32x16 s;
#pragma unroll
        for (int e = 0; e < 16; ++e) s[e] = 0.f;
#pragma unroll
        for (int ks = 0; ks < 8; ++ks) s = MFMA32(kf[ks], qf[ks], s);
        const int dbase = (i0 - j0) + q - 4 * hh, dr = r - rc; const bool own = rc == r;
        float cntf[16]; float mx = -INFINITY;
#pragma unroll
        for (int e = 0; e < 16; ++e) {
            const int d = dbase - ((e & 3) + 8 * (e >> 2)), t4 = 4 * d + dr;
            int c = ((unsigned)t4 <= 128u) ? 1 : 0;
            if (own) c += (((unsigned)d <= 128u) ? 1 : 0) + ((d >= 0 && (d & 3) == 0) ? 1 : 0);
            cntf[e] = (float)c; s[e] = c ? s[e] : -INFINITY; mx = fmaxf(mx, s[e]);
        }
        mx = fmaxf(mx, __shfl_xor(mx, 32));
        const float mnew = fmaxf(mrun, mx), alpha = __builtin_amdgcn_exp2f(mrun - mnew);
        float ps = 0.f;
#pragma unroll
        for (int e = 0; e < 16; ++e) { s[e] = cntf[e] * __builtin_amdgcn_exp2f(s[e] - mnew); ps += s[e]; }
        lsum = lsum * alpha + ps;
        if (__any(mnew > mrun)) {
#pragma unroll
            for (int c = 0; c < 4; ++c)
#pragma unroll
                for (int e = 0; e < 16; ++e) o[c][e] *= alpha;
        }
        mrun = mnew;
        const bf16x8 pf0 = pack8(s[0], s[1], s[2], s[3], s[4], s[5], s[6], s[7]), pf1 = pack8(s[8], s[9], s[10], s[11], s[12], s[13], s[14], s[15]);
        if (has_next) asm volatile("s_waitcnt vmcnt(8)" ::: "memory"); else asm volatile("s_waitcnt vmcnt(0)" ::: "memory");
#pragma unroll
        for (int c = 0; c < 4; ++c)
#pragma unroll
            for (int s2 = 0; s2 < 2; ++s2) {
                const s16x4 lo = lds_tr(Vt + off_b(16 * s2 + 4 * hh + qi, 4 * c + 2 * g16 + (pp >> 1)) + 8 * (pp & 1));
                const s16x4 hi = lds_tr(Vt + off_b(16 * s2 + 8 + 4 * hh + qi, 4 * c + 2 * g16 + (pp >> 1)) + 8 * (pp & 1));
                const bf16x8 vf = __builtin_shufflevector(lo, hi, 0, 1, 2, 3, 4, 5, 6, 7);
                o[c] = MFMA32(vf, s2 ? pf1 : pf0, o[c]);
            }
        asm volatile("s_waitcnt lgkmcnt(0)" ::: "memory");
        if (has_next) att_dma_tile((const unsigned char*)(VB + (rowb + rcn * 512 + j0n) * 1536 + h * 128), Vt, lane);
    }
    lsum += __shfl_xor(lsum, 32);
    const float inv = 1.0f / lsum;
    bf16* op = MIX + ((size_t)b * 2048 + 4 * (i0 + q) + r) * 2048 + h * 128 + 4 * hh;
#pragma unroll
    for (int c = 0; c < 4; ++c)
#pragma unroll
        for (int g = 0; g < 4; ++g) {
            u32x2 w; w.x = cvtpk(o[c][4 * g] * inv, o[c][4 * g + 1] * inv); w.y = cvtpk(o[c][4 * g + 2] * inv, o[c][4 * g + 3] * inv);
            *(GAS u32x2*)(op + 32 * c + 8 * g) = w;
        }
}
DI void attn_phase(Frame& F) {
    const bf16* QB = (const bf16*)(F.ws + WS_QB); const bf16* KB = (const bf16*)(F.ws + WS_KB); const bf16* VB = (const bf16*)(F.ws + WS_VB); bf16* MIX = (bf16*)(F.ws + WS_MIX);
    LAS unsigned char* wl = F.lds + RING_OFF + F.wave * 16384;
    int qsel = (int)(xb_xcc_id() & 7u);
    for (int tries = 0; tries < 8;) {
        unsigned u = 0; if (F.lane == 0) u = xb_add((unsigned*)(F.ctl + CW_QUEUE + 64 * qsel), 1u);
        u = (unsigned)__builtin_amdgcn_readfirstlane((int)u);
        if (u >= 768u) { qsel = (qsel + 1) & 7; ++tries; continue; }
        const int g = u >> 8, idx = u & 255, ib = 15 - (idx >> 4), sub = idx & 15, bh = qsel * 12 + g * 4 + (sub >> 2), r = sub & 3;
        attn_unit(bh / 12, bh % 12, r, ib, QB, KB, VB, MIX, wl, F.lane);
    }
}

constexpr int ML_Q = 0, ML_K = 32768, ML_V = 65536, ML_C = 98304;
constexpr int MS_A = 0, MS_U = 512, MS_WI = 1024, MS_WK = 1536, MS_EM = 2048, MS_NV = 2560, MS_GV = 3072, MS_CW = 3584, MS_NR = 8704, MS_RS = 12800, MS_SC = 13824;
DI float scan_add64(float v, int lane) {
#pragma unroll
    for (int d = 1; d < 64; d <<= 1) { const float t = __shfl_up(v, d); if (lane >= d) v += t; }
    return v;
}
DI float scan_max64(float v, int lane) {
#pragma unroll
    for (int d = 1; d < 64; d <<= 1) { const float t = __shfl_up(v, d); if (lane >= d) v = fmaxf(v, t); }
    return v;
}
DI float silu_f(float y) { return y * __builtin_amdgcn_rcpf(1.0f + __builtin_amdgcn_exp2f(-LOG2E * y)); }
DI void mlstm_seq(Frame& F, int b, int hm, const float* mcw, const float* mcb, const float* mng) {
    LAS unsigned char* L = F.lds + RING_OFF; LAS unsigned char* S = F.lds + SCR_OFF;
    LAS float* A_ = (LAS float*)(S + MS_A); LAS float* U_ = (LAS float*)(S + MS_U); LAS float* WI = (LAS float*)(S + MS_WI); LAS float* WK = (LAS float*)(S + MS_WK); LAS float* EM = (LAS float*)(S + MS_EM);
    LAS float* NV = (LAS float*)(S + MS_NV); LAS float* GV = (LAS float*)(S + MS_GV); LAS float* CW = (LAS float*)(S + MS_CW); LAS float* NR = (LAS float*)(S + MS_NR); LAS float* RS = (LAS float*)(S + MS_RS); LAS float* SC = (LAS float*)(S + MS_SC);
    const int w = F.wave;
    const bf16* ML = (const bf16*)(F.ws + WS_ML); const float* G = (const float*)(F.ws + WS_G); bf16* MIX = (bf16*)(F.ws + WS_MIX);
    for (int i = F.tid; i < 2 * 5 * 128; i += 512) { const int qk = i / 640, rem = i % 640, tap = rem >> 7, j = rem & 127; const int ch = qk * 512 + hm * 128 + j; CW[i] = tap < 4 ? mcw[tap * 1024 + ch] : mcb[ch]; }
    if (F.tid < 128) { GV[F.tid] = mng[hm * 128 + F.tid]; NV[F.tid] = 0.f; }
    for (int i = F.tid; i < 32768 / 16; i += 512) *(LAS u32x4*)(L + ML_C + 16 * i) = (u32x4){0u, 0u, 0u, 0u};
    f32x16 Cacc[2];
#pragma unroll
    for (int i = 0; i < 2; ++i)
#pragma unroll
        for (int e = 0; e < 16; ++e) Cacc[i][e] = 0.f;
    float mc = 0.f;
    const int tb = w & 3, eh = w >> 2;
    const int ebF = w >> 1, dbF0 = 2 * (w & 1);
    __syncthreads();
    for (int ch = 0; ch < SEQ / 128; ++ch) {
        int tid = F.tid; asm volatile("" : "+v"(tid));
        const int lane = tid & 63, hh = lane >> 5, l31 = lane & 31;
        const unsigned qi = (lane & 15) >> 2, pp = lane & 3, g16 = (lane >> 4) & 1;
        const int c16 = tid & 15, rg = tid >> 4;
        const unsigned swl_ = 16u * swz_b((unsigned)l31), rowb_ = 256u * (unsigned)l31, hh8 = 8u * hh, hh16 = 16u * hh, rg16 = 16u * rg, c32 = 32u * c16, t4 = 4u * tid, l4 = 4u * lane, tq4 = 4u * (32u * tb + l31);
        unsigned tn[2], tp[2];
#pragma unroll
        for (int t = 0; t < 2; ++t) {
            tn[t] = 2048u * hh + 1024u * t + 256u * qi + 8u * (pp & 1) + 16u * ((2u * g16 + (pp >> 1)) ^ ((2u * hh + t) & 3u));
            tp[t] = 2048u * t + 1024u * hh + 256u * qi + 8u * (pp & 1) + 16u * ((2u * g16 + (pp >> 1)) ^ ((2u * t + hh) & 3u));
        }
        const unsigned xc_e0 = 64u * ((unsigned)(2 * eh) ^ qi), xc_e1 = 64u * ((unsigned)(2 * eh + 1) ^ qi), xc_eF = 64u * ((unsigned)ebF ^ qi), xc_d0 = 64u * ((unsigned)dbF0 ^ qi), xc_d1 = 64u * ((unsigned)(dbF0 + 1) ^ qi);
        const unsigned voffA = 16384u * rg + 256u * hm + 16u * c16;
        const unsigned voffO = 4096u * (32u * tb + l31) + 3072u + 256u * hm + 128u * eh + 8u * hh;
        const unsigned voffG = 32u * lane + 4u * hm;
        unsigned rk[8];
#pragma unroll
        for (int ks = 0; ks < 8; ++ks) rk[ks] = rowb_ + ((unsigned)(32 * ks + 2 * hh8) ^ swl_);
        unsigned cwr[4];
#pragma unroll
        for (int g = 0; g < 4; ++g) cwr[g] = rowb_ + ((unsigned)(16 * (4 * ebF + g)) ^ swl_) + hh8;
        unsigned sa[4];
#pragma unroll
        for (int rho = 0; rho < 4; ++rho) sa[rho] = 1024u * rg + 256u * rho + 64u * (((unsigned)c16 >> 2) ^ (unsigned)rho) + 16u * (((unsigned)c16 & 3u) ^ ((unsigned)rg & 3u));
        const unsigned aC00 = ML_C + tn[0] + xc_e0, aC01 = ML_C + tn[1] + xc_e0, aC10 = ML_C + tn[0] + xc_e1, aC11 = ML_C + tn[1] + xc_e1;
        const unsigned aV00 = ML_V + tp[0] + xc_e0, aV01 = ML_V + tp[1] + xc_e0, aV10 = ML_V + tp[0] + xc_e1, aV11 = ML_V + tp[1] + xc_e1;
        const unsigned aF0 = ML_V + tn[0] + xc_eF, aF1 = ML_V + tn[1] + xc_eF, aK00 = ML_Q + tn[0] + xc_d0, aK01 = ML_Q + tn[1] + xc_d0, aK10 = ML_Q + tn[0] + xc_d1, aK11 = ML_Q + tn[1] + xc_d1;
#define SF(off) (*(LAS float*)(S + (off)))
#define SF4(off) (*(const LAS f32x4*)(S + (off)))
        int t0 = ch * 128; asm volatile("" : "+s"(t0));
        const size_t mrow0 = (size_t)b * 2048 + t0;
        const unsigned char* cb0 = (const unsigned char*)ML + mrow0 * 4096;
        unsigned char* mb0 = (unsigned char*)MIX + mrow0 * 4096;
#pragma unroll
        for (int qk = 0; qk < 2; ++qk) {
            __builtin_amdgcn_sched_barrier(0);
            u32x4 raw[7];
#pragma unroll
            for (int i = 0; i < 7; ++i) { const int t = t0 + 4 * rg - 3 + i; u32x4 rv = *(const GAS u32x4*)(cb0 + (i - 3) * 4096 + qk * 1024 + voffA); if (t < 0) rv = (u32x4){0u, 0u, 0u, 0u}; raw[i] = rv; }
            float wt[5][8];
#pragma unroll
            for (int tap = 0; tap < 5; ++tap) { const f32x4 a = SF4(MS_CW + 4 * (qk * 640 + tap * 128) + c32), bq = SF4(MS_CW + 4 * (qk * 640 + tap * 128) + 16 + c32);
                wt[tap][0] = a[0]; wt[tap][1] = a[1]; wt[tap][2] = a[2]; wt[tap][3] = a[3]; wt[tap][4] = bq[0]; wt[tap][5] = bq[1]; wt[tap][6] = bq[2]; wt[tap][7] = bq[3]; }
            const float osc = qk ? 0.08838834764831845f : 1.0f;
#pragma unroll
            for (int rho = 0; rho < 4; ++rho) {
                float y[8];
#pragma unroll
                for (int j = 0; j < 8; ++j) y[j] = wt[4][j];
#pragma unroll
                for (int tap = 0; tap < 4; ++tap) { const u32x4 x = raw[rho + tap];
                    y[0] += wt[tap][0] * bf_lo(x.x); y[1] += wt[tap][1] * bf_hi(x.x); y[2] += wt[tap][2] * bf_lo(x.y); y[3] += wt[tap][3] * bf_hi(x.y);
                    y[4] += wt[tap][4] * bf_lo(x.z); y[5] += wt[tap][5] * bf_hi(x.z); y[6] += wt[tap][6] * bf_lo(x.w); y[7] += wt[tap][7] * bf_hi(x.w); }
#pragma unroll
                for (int j = 0; j < 8; ++j) y[j] = silu_f(y[j]) * osc;
                *(LAS bf16x8*)(lp(sa[rho]) + (qk ? ML_K : ML_Q)) = pack8(y[0], y[1], y[2], y[3], y[4], y[5], y[6], y[7]);
            }
        }
        __builtin_amdgcn_sched_barrier(0);
#pragma unroll
        for (int rho = 0; rho < 4; ++rho) *(LAS u32x4*)lp(sa[rho] + ML_V) = *(const GAS u32x4*)(cb0 + rho * 4096 + 2048 + voffA);
        __builtin_amdgcn_sched_barrier(0);
        if (w == 0) {
            const unsigned char* gb0 = (const unsigned char*)G + mrow0 * 32;
            const float gi0 = *(const GAS float*)(gb0 + voffG), gf0 = *(const GAS float*)(gb0 + 16 + voffG), gi1 = *(const GAS float*)(gb0 + 2048 + voffG), gf1 = *(const GAS float*)(gb0 + 2048 + 16 + voffG);
            const float lf0 = fminf(gf0, 0.f) - log1pf(expf(-fabsf(gf0))), lf1 = fminf(gf1, 0.f) - log1pf(expf(-fabsf(gf1)));
            const float b0 = scan_add64(lf0, lane); const float tot0 = __shfl(b0, 63); const float b1 = scan_add64(lf1, lane) + tot0;
            const float a0 = gi0 - b0, a1 = gi1 - b1;
            const float cm0 = scan_max64(a0, lane); const float M0 = __shfl(cm0, 63); const float cm1 = fmaxf(scan_max64(a1, lane), M0);
            const float mx0 = fmaxf(mc, cm0), mx1 = fmaxf(mc, cm1);
            SF(MS_A + l4) = a0; SF(MS_A + 256 + l4) = a1; SF(MS_U + l4) = -mx0; SF(MS_U + 256 + l4) = -mx1;
            SF(MS_WI + l4) = expf(mc - mx0); SF(MS_WI + 256 + l4) = expf(mc - mx1); SF(MS_EM + l4) = expf(-(b0 + mx0)); SF(MS_EM + 256 + l4) = expf(-(b1 + mx1));
            const float Mall = __shfl(cm1, 63), blast = __shfl(b1, 63), mxa = fmaxf(mc, Mall);
            SF(MS_WK + l4) = expf(a0 - mxa); SF(MS_WK + 256 + l4) = expf(a1 - mxa);
            if (lane == 0) SC[0] = expf(mc - mxa);
            mc = blast + mxa;
        }
        __syncthreads();
        __builtin_amdgcn_sched_barrier(0);
        const int tq = 32 * tb + l31;
        const unsigned qoff = ML_Q + 8192u * tb;
        const float ut = SF(MS_U + tq4), wint = SF(MS_WI + tq4), emt = SF(MS_EM + tq4);
        f32x16 acc[2];
#pragma unroll
        for (int c = 0; c < 2; ++c) {
            __builtin_amdgcn_sched_barrier(0);
#pragma unroll
            for (int e = 0; e < 16; ++e) acc[c][e] = 0.f;
#pragma unroll
            for (int ks = 0; ks < 8; ++ks) {
                const s16x4 lo = lds_tr(lp(c ? aC10 : aC00) + 4096 * ks);
                const s16x4 hi = lds_tr(lp(c ? aC11 : aC01) + 4096 * ks);
                acc[c] = MFMA32(__builtin_shufflevector(lo, hi, 0, 1, 2, 3, 4, 5, 6, 7), lds_b128(lp(rk[ks] + qoff)), acc[c]);
            }
#pragma unroll
            for (int e = 0; e < 16; ++e) acc[c][e] *= wint;
        }
        float qn = 0.f;
#pragma unroll
        for (int ks = 0; ks < 8; ++ks) { const f32x4 n0 = SF4(MS_NV + 64 * ks + 2 * hh16), n1 = SF4(MS_NV + 64 * ks + 16 + 2 * hh16); const u32x4 qq = __builtin_bit_cast(u32x4, lds_b128(lp(rk[ks] + qoff)));
            qn += bf_lo(qq.x) * n0[0] + bf_hi(qq.x) * n0[1] + bf_lo(qq.y) * n0[2] + bf_hi(qq.y) * n0[3] + bf_lo(qq.z) * n1[0] + bf_hi(qq.z) * n1[1] + bf_lo(qq.w) * n1[2] + bf_hi(qq.w) * n1[3]; }
        __builtin_amdgcn_sched_barrier(0);
        u32x2 og[2][4];
#pragma unroll
        for (int c = 0; c < 2; ++c)
#pragma unroll
            for (int g = 0; g < 4; ++g) og[c][g] = *(const GAS u32x2*)(cb0 + 64 * c + 16 * g + voffO);
        float sumP = 0.f;
#pragma unroll
        for (int sb = 0; sb < 4; ++sb) {
            if (sb <= tb) {
                __builtin_amdgcn_sched_barrier(0);
                f32x16 s;
#pragma unroll
                for (int e = 0; e < 16; ++e) s[e] = 0.f;
#pragma unroll
                for (int ks = 0; ks < 8; ++ks) s = MFMA32(lds_b128(lp(rk[ks]) + ML_K + 8192 * sb), lds_b128(lp(rk[ks] + qoff)), s);
#pragma unroll
                for (int g = 0; g < 4; ++g) { const f32x4 av = SF4(MS_A + 4 * (32 * sb + 8 * g) + hh16);
#pragma unroll
                    for (int j = 0; j < 4; ++j) { const int e = 4 * g + j; float p = s[e] * __builtin_amdgcn_exp2f(LOG2E * (ut + av[j])); if (sb == tb && crow(e, hh) > l31) p = 0.f; s[e] = p; sumP += p; } }
                const bf16x8 pf0 = pack8(s[0], s[1], s[2], s[3], s[4], s[5], s[6], s[7]), pf1 = pack8(s[8], s[9], s[10], s[11], s[12], s[13], s[14], s[15]);
                __builtin_amdgcn_sched_barrier(0);
#pragma unroll
                for (int c = 0; c < 2; ++c)
#pragma unroll
                    for (int s2 = 0; s2 < 2; ++s2) {
                        const s16x4 lo = lds_tr(lp(c ? aV10 : aV00) + 8192 * sb + 4096 * s2);
                        const s16x4 hi = lds_tr(lp(c ? aV11 : aV01) + 8192 * sb + 4096 * s2);
                        acc[c] = MFMA32(__builtin_shufflevector(lo, hi, 0, 1, 2, 3, 4, 5, 6, 7), s2 ? pf1 : pf0, acc[c]);
                    }
            }
        }
        qn += __shfl_xor(qn, 32); sumP += __shfl_xor(sumP, 32);
        const float den = wint * qn + sumP, rden = 1.0f / fmaxf(fabsf(den), emt);
        __builtin_amdgcn_sched_barrier(0);
        float ssq = 0.f;
#pragma unroll
        for (int c = 0; c < 2; ++c)
#pragma unroll
            for (int g = 0; g < 4; ++g) {
                const float o0 = bf_lo(og[c][g].x), o1 = bf_hi(og[c][g].x), o2 = bf_lo(og[c][g].y), o3 = bf_hi(og[c][g].y);
                float h0 = acc[c][4 * g] * rden, h1 = acc[c][4 * g + 1] * rden, h2 = acc[c][4 * g + 2] * rden, h3 = acc[c][4 * g + 3] * rden;
                h0 *= __builtin_amdgcn_rcpf(1.0f + __builtin_amdgcn_exp2f(-LOG2E * o0)); h1 *= __builtin_amdgcn_rcpf(1.0f + __builtin_amdgcn_exp2f(-LOG2E * o1));
                h2 *= __builtin_amdgcn_rcpf(1.0f + __builtin_amdgcn_exp2f(-LOG2E * o2)); h3 *= __builtin_amdgcn_rcpf(1.0f + __builtin_amdgcn_exp2f(-LOG2E * o3));
                acc[c][4 * g] = h0; acc[c][4 * g + 1] = h1; acc[c][4 * g + 2] = h2; acc[c][4 * g + 3] = h3;
                ssq += (h0 * h0 + h1 * h1) + (h2 * h2 + h3 * h3);
            }
        ssq += __shfl_xor(ssq, 32);
        if (hh == 0) SF(MS_RS + 4 * eh + 2 * tq4) = ssq;
        __syncthreads();
        {
            const float rstd = 1.0f / sqrtf((SF(MS_RS + 2 * tq4) + SF(MS_RS + 4 + 2 * tq4)) * (1.0f / 128.0f) + 1e-6f);
#pragma unroll
            for (int c = 0; c < 2; ++c)
#pragma unroll
                for (int g = 0; g < 4; ++g) {
                    const f32x4 gv = SF4(MS_GV + 4 * (32 * (2 * eh + c) + 8 * g) + hh16);
                    u32x2 wv; wv.x = cvtpk(acc[c][4 * g] * rstd * gv[0], acc[c][4 * g + 1] * rstd * gv[1]); wv.y = cvtpk(acc[c][4 * g + 2] * rstd * gv[2], acc[c][4 * g + 3] * rstd * gv[3]);
                    *(GAS u32x2*)(mb0 + 64 * c + 16 * g + voffO) = wv;
                }
        }
        __builtin_amdgcn_sched_barrier(0);
        {
            float ps[8] = {0.f, 0.f, 0.f, 0.f, 0.f, 0.f, 0.f, 0.f};
#pragma unroll
            for (int rho = 0; rho < 4; ++rho) {
                const float wk = SF(MS_WK + 4 * rho + rg16); const u32x4 kk = *(const LAS u32x4*)(lp(sa[rho]) + ML_K);
                const float v0 = bf_lo(kk.x) * wk, v1 = bf_hi(kk.x) * wk, v2 = bf_lo(kk.y) * wk, v3 = bf_hi(kk.y) * wk, v4 = bf_lo(kk.z) * wk, v5 = bf_hi(kk.z) * wk, v6 = bf_lo(kk.w) * wk, v7 = bf_hi(kk.w) * wk;
                ps[0] += v0; ps[1] += v1; ps[2] += v2; ps[3] += v3; ps[4] += v4; ps[5] += v5; ps[6] += v6; ps[7] += v7;
                *(LAS bf16x8*)(lp(sa[rho]) + ML_Q) = pack8(v0, v1, v2, v3, v4, v5, v6, v7);
            }
#pragma unroll
            for (int j = 0; j < 8; ++j) { ps[j] += __shfl_xor(ps[j], 16); ps[j] += __shfl_xor(ps[j], 32); }
            if ((lane >> 4) == 0) {
#pragma unroll
                for (int j = 0; j < 8; ++j) SF(MS_NR + 512 * w + 4 * j + c32) = ps[j];
            }
        }
        __syncthreads();
        __builtin_amdgcn_sched_barrier(0);
        const float decay = SC[0];
        if (tid < 128) { float a = 0.f;
#pragma unroll
            for (int ww = 0; ww < 8; ++ww) a += SF(MS_NR + 512 * ww + t4);
            SF(MS_NV + t4) = decay * SF(MS_NV + t4) + a; }
#pragma unroll
        for (int i = 0; i < 2; ++i)
#pragma unroll
            for (int e = 0; e < 16; ++e) Cacc[i][e] *= decay;
#pragma unroll
        for (int ks = 0; ks < 8; ++ks) {
            const s16x4 alo = lds_tr(lp(aF0) + 4096 * ks);
            const s16x4 ahi = lds_tr(lp(aF1) + 4096 * ks);
            const bf16x8 af = __builtin_shufflevector(alo, ahi, 0, 1, 2, 3, 4, 5, 6, 7);
#pragma unroll
            for (int i = 0; i < 2; ++i) {
                const s16x4 blo = lds_tr(lp(i ? aK10 : aK00) + 4096 * ks);
                const s16x4 bhi = lds_tr(lp(i ? aK11 : aK01) + 4096 * ks);
                Cacc[i] = MFMA32(af, __builtin_shufflevector(blo, bhi, 0, 1, 2, 3, 4, 5, 6, 7), Cacc[i]);
            }
        }
#pragma unroll
        for (int i = 0; i < 2; ++i)
#pragma unroll
            for (int g = 0; g < 4; ++g) {
                u32x2 wv; wv.x = cvtpk(Cacc[i][4 * g], Cacc[i][4 * g + 1]); wv.y = cvtpk(Cacc[i][4 * g + 2], Cacc[i][4 * g + 3]);
                *(LAS u32x2*)lp(cwr[g] + ML_C + 8192u * (dbF0 + i)) = wv;
            }
        __syncthreads();
    }
}

DI void ffn_fixup(Frame& F, const float* cw, const float* cb) {
    const float* RAWB = (const float*)(F.ws + WS_RAW); bf16* ACT = (bf16*)(F.ws + WS_ACT);
    const int gt = (F.vcu * NWAVES + F.wave) * 64 + F.lane, NT = F.G * NWAVES * 64;
    for (int it = gt; it < 256 * 2 * (DFF / 4); it += NT) {
        const int j4 = it % (DFF / 4), rs = it / (DFF / 4), rho = rs & 1, strip = rs >> 1, j = 4 * j4;
        const int pg = (j >> 7) * 256 + (j & 127);
        const bool first = (strip & 31) == 0;
        const float* own = RAWB + (size_t)strip * 4 * UPW; const float* prv = RAWB + (size_t)(strip - 1) * 4 * UPW;
        const f32x4 z = {0.f, 0.f, 0.f, 0.f};
        f32x4 gm2, gm1, g0, vm2, vm1, v0;
        if (rho == 0) { gm2 = first ? z : *(const f32x4*)(prv + 2 * UPW + pg); gm1 = first ? z : *(const f32x4*)(prv + 3 * UPW + pg); g0 = *(const f32x4*)(own + pg);
                        vm2 = first ? z : *(const f32x4*)(prv + 2 * UPW + pg + 128); vm1 = first ? z : *(const f32x4*)(prv + 3 * UPW + pg + 128); v0 = *(const f32x4*)(own + pg + 128); }
        else { gm2 = first ? z : *(const f32x4*)(prv + 3 * UPW + pg); gm1 = *(const f32x4*)(own + pg); g0 = *(const f32x4*)(own + UPW + pg);
               vm2 = first ? z : *(const f32x4*)(prv + 3 * UPW + pg + 128); vm1 = *(const f32x4*)(own + pg + 128); v0 = *(const f32x4*)(own + UPW + pg + 128); }
        const f32x4 yg = *(const f32x4*)(cb + j) + *(const f32x4*)(cw + j) * gm2 + *(const f32x4*)(cw + UPW + j) * gm1 + *(const f32x4*)(cw + 2 * UPW + j) * g0;
        const f32x4 yv = *(const f32x4*)(cb + DFF + j) + *(const f32x4*)(cw + DFF + j) * vm2 + *(const f32x4*)(cw + UPW + DFF + j) * vm1 + *(const f32x4*)(cw + 2 * UPW + DFF + j) * v0;
        u32x2 wv; wv.x = cvtpk(silu_f(yg[0]) * yv[0], silu_f(yg[1]) * yv[1]); wv.y = cvtpk(silu_f(yg[2]) * yv[2], silu_f(yg[3]) * yv[3]);
        *(GAS u32x2*)(ACT + (size_t)(64 * strip + rho) * DFF + j) = wv;
    }
}

struct Args { const float* in[16]; float* out; unsigned char* ws; int ph_lo, ph_hi; };
__global__ void __launch_bounds__(NWAVES * 64, 2) fwd_kernel(Args args) {
    extern __shared__ __attribute__((aligned(16))) unsigned char lds[];
    Frame F;
    F.lds = (LAS unsigned char*)lds; F.MISC = (volatile LAS unsigned*)(F.lds + MISC_OFF);
    F.tid = threadIdx.x; F.lane = F.tid & 63; F.wave = __builtin_amdgcn_readfirstlane(F.tid >> 6);
    F.G = gridDim.x; { const int bx = blockIdx.x; F.vcu = (F.G % 8 == 0) ? (bx % 8) * (F.G / 8) + bx / 8 : bx; }
    F.ws = args.ws; F.ctl = (gu32*)(args.ws + WS_CTL); F.out = args.out;
    for (int u = F.tid; u < (LDS_BYTES - LDSCTL_OFF) / 4; u += NWAVES * 64) ((LAS unsigned*)(F.lds + LDSCTL_OFF))[u] = 0u;
    __syncthreads();
    XcdBarrier bar; bar.bar = (unsigned*)(F.ctl + CW_BAR); bar.x = 0; bar.st = nullptr;
    if (N_LAUNCHES != PER_PHASE) bar = xcd_barrier_post((unsigned*)(F.ctl + CW_BAR), F.MISC + 8);
#define GRID_BAR(seam) do { if (N_LAUNCHES == PER_PHASE) { if (F.tid == 0) __hip_atomic_store(F.ctl + CW_TMO, 0xBADBA0u | (unsigned)(seam), RLX_AGENT); } else { xcd_barrier(bar); } } while (0)
    const int lo = args.ph_lo, hi = args.ph_hi;
#define IN(k) (lo <= (k) && (k) < hi)
#define BOTH(k) (IN(k) && IN((k) + 1))
    PG8_LAS float* escr = (PG8_LAS float*)(F.lds + SCR_OFF);
    if (IN(0)) { p0_prologue(F, args.in[0], args.in[1], args.in[2], args.in[10], args.in[12], args.in[15]); if (BOTH(0)) GRID_BAR(0); }
    if (IN(1)) {
        pg8::Gemm g{(const pg8::bf16_t*)(F.ws + WS_XN), (const pg8::bf16_t*)(F.ws + WS_WIN), M, IN_WP, DM}; pg8::StaticOrder S; S.init(M, IN_WP, F.G, (int)blockIdx.x);
        pg8::Epi1 E{(pg8::bf16_t*)(F.ws + WS_QB), (pg8::bf16_t*)(F.ws + WS_KB), (pg8::bf16_t*)(F.ws + WS_VB), (pg8::bf16_t*)(F.ws + WS_ML), (float*)(F.ws + WS_G), (const float*)(F.ws + WS_ROPE), args.in[3], args.in[4], args.in[7], args.in[8], escr};
        pg8::gemm_phase<pg8::Epi1, pg8::StaticOrder, true, true>(F.lds + RING_OFF, g, S, E);
        if (BOTH(1)) GRID_BAR(1);
    }
    if (IN(2)) {
        if ((int)blockIdx.x < BATCH * NMH) mlstm_seq(F, (int)blockIdx.x >> 2, (int)blockIdx.x & 3, args.in[5], args.in[6], args.in[9]);
        else attn_phase(F);
        if (BOTH(2)) GRID_BAR(2);
    }
    if (IN(3)) {
        pg8::Gemm g{(const pg8::bf16_t*)(F.ws + WS_MIX), (const pg8::bf16_t*)(F.ws + WS_WOUT), M, DM, DM}; pg8::StaticOrder S; S.init(M, DM, F.G, (int)blockIdx.x);
        pg8::Epi3 E{args.in[0], F.out, (pg8::bf16_t*)(F.ws + WS_XN), (float*)(F.ws + WS_SS), args.in[11], escr};
        pg8::gemm_phase<pg8::Epi3, pg8::StaticOrder, true, true>(F.lds + RING_OFF, g, S, E);
        if (BOTH(3)) GRID_BAR(3);
    }
    if (IN(4)) {
        pg8::Gemm g{(const pg8::bf16_t*)(F.ws + WS_XN), (const pg8::bf16_t*)(F.ws + WS_WUP), M, UPW, DM}; pg8::StaticOrder S; S.init(M, UPW, F.G, (int)blockIdx.x);
        pg8::Epi4 E{(pg8::bf16_t*)(F.ws + WS_ACT), (float*)(F.ws + WS_RAW), (const float*)(F.ws + WS_SS), args.in[13], args.in[14]};
        pg8::gemm_phase<pg8::Epi4, pg8::StaticOrder, true, true>(F.lds + RING_OFF, g, S, E);
        if (BOTH(4)) GRID_BAR(4);
    }
    if (IN(5)) { ffn_fixup(F, args.in[13], args.in[14]); if (BOTH(5)) GRID_BAR(5); }
    if (IN(6)) {
        pg8::Gemm g{(const pg8::bf16_t*)(F.ws + WS_ACT), (const pg8::bf16_t*)(F.ws + WS_WDN), M, DM, DFF}; pg8::StaticOrder S; S.init(M, DM, F.G, (int)blockIdx.x);
        pg8::Epi5 E{F.out};
        pg8::gemm_phase<pg8::Epi5, pg8::StaticOrder, true, true>(F.lds + RING_OFF, g, S, E);
    }
#undef IN
#undef BOTH
}

extern "C" void kernel_launch(void* const* d_in, const int* in_sizes, int n_in, void* d_out, int out_size, void* d_ws, size_t ws_size, hipStream_t stream) {
    static int grid = 0;
    if (grid == 0) {
        if (n_in != 16 || in_sizes[0] != M * DM || out_size != M * DM || ws_size < WS_END) { fprintf(stderr, "kernel_launch: unexpected shapes (n_in %d in0 %d out %d ws %zu)\n", n_in, n_in > 0 ? in_sizes[0] : -1, out_size, ws_size); grid = -1; return; }
        int dev = 0, cus = 0, per_cu = 0;
        if (hipGetDevice(&dev) != hipSuccess || hipDeviceGetAttribute(&cus, hipDeviceAttributeMultiprocessorCount, dev) != hipSuccess) { grid = -1; return; }
        if (hipFuncSetAttribute((const void*)fwd_kernel, hipFuncAttributeMaxDynamicSharedMemorySize, LDS_BYTES) != hipSuccess) { fprintf(stderr, "kernel_launch: hipFuncSetAttribute failed\n"); grid = -1; return; }
        if (hipOccupancyMaxActiveBlocksPerMultiprocessor(&per_cu, (const void*)fwd_kernel, NWAVES * 64, LDS_BYTES) != hipSuccess || per_cu < 1) fprintf(stderr, "kernel_launch: occupancy query reports %d blocks per CU\n", per_cu);
        (void)hipGetLastError();
        grid = cus;
    }
    if (grid < 0) return;
    if (hipMemsetAsync((char*)d_ws + WS_CTL, 0, CTL_ZERO_BYTES, stream) != hipSuccess) return;
    Args a{};
    for (int i = 0; i < 16; ++i) a.in[i] = (const float*)d_in[i];
    a.out = (float*)d_out; a.ws = (unsigned char*)d_ws;
    if (N_LAUNCHES == 1) { a.ph_lo = 0; a.ph_hi = PER_PHASE; hipLaunchKernelGGL(fwd_kernel, dim3(grid), dim3(NWAVES * 64), LDS_BYTES, stream, a); }
    else for (int li = 0; li < PER_PHASE; ++li) { a.ph_lo = li; a.ph_hi = li + 1; hipLaunchKernelGGL(fwd_kernel, dim3(grid), dim3(NWAVES * 64), LDS_BYTES, stream, a); }
}
```

```cpp
#include <hip/hip_runtime.h>
#include <cstdio>
#include <cstdint>
#include <cmath>
namespace pg8 {
#define PG8_LAS __attribute__((address_space(3)))
typedef unsigned short bf16_t;
typedef short bf16x8 __attribute__((ext_vector_type(8)));
typedef float f32x4 __attribute__((ext_vector_type(4)));
typedef unsigned u32x4 __attribute__((ext_vector_type(4)));
constexpr int BM = 256, BK = 64, HALF = 128, HTB = HALF * BK * 2  , STAGE_BYTES = 8 * HTB, NXCD = 8, WGM = 8;

__host__ __device__ __forceinline__ int lds_byte(int r, int c) { const int st = (r >> 4) * 2 + (c >> 5), rr = r & 15, cc = c & 31, ob = rr * 64 + cc * 2; return st * 1024 + (ob ^ (((ob >> 9) & 1) << 5)); }
__host__ __device__ __forceinline__ void stage_rc(int b, int& R, int& C) { const int st = b / 1024, sb = b % 1024, swz = sb ^ (((sb >> 9) & 1) << 5); R = (st >> 1) * 16 + swz / 64; C = (st & 1) * 32 + (swz % 64) / 2; }
__host__ __device__ __forceinline__ int perm32(int rho) { const int n = rho >> 4, i = rho & 15; return 8 * (i >> 2) + 4 * n + (i & 3); }

struct Unit { int pm, pn; };
struct Gemm { const bf16_t* A; const bf16_t* Bt; int M, N, K; };

struct StaticOrder {
    int nM, nN, nwg, G, c, wgm;
    __host__ __device__ void init(int M, int N, int G_, int c_, int wgm_ = WGM) { nM = M / BM; nN = N / BM; nwg = nM * nN; G = G_; c = c_; wgm = wgm_; }
    __host__ __device__ bool next(int i, Unit& u) const {
        const long L = (long)i * G + c; if (L >= nwg) return false;
        int wgid = (int)L; { const int q = nwg / NXCD, r = nwg % NXCD, xcd = wgid % NXCD, off = wgid / NXCD; wgid = (xcd < r ? xcd * (q + 1) : r * (q + 1) + (xcd - r) * q) + off; }
        const int nig = wgm * nN, gid = wgid / nig, fm = gid * wgm, gsz = (nM - fm) < wgm ? (nM - fm) : wgm;
        u.pm = fm + ((wgid % nig) % gsz); u.pn = (wgid % nig) / gsz; return true;
    }
    __device__ __forceinline__ void a_ready(const Unit&) const {}
    __device__ __forceinline__ void done(const Unit&) const {}
};

__device__ __forceinline__ unsigned cvt_pk_bf16(float lo, float hi) { unsigned r; asm volatile("v_cvt_pk_bf16_f32 %0, %1, %2" : "=v"(r) : "v"(lo), "v"(hi)); return r; }

typedef float f32x2 __attribute__((ext_vector_type(2)));
#define EPI_BAR() do { asm volatile("s_waitcnt lgkmcnt(0)" ::: "memory"); __builtin_amdgcn_s_barrier(); asm volatile("" ::: "memory"); } while (0)
constexpr float kEps = 1e-6f;

struct Epi1 {
    static constexpr bool PERM = true, AFTER_DRAIN = false, APERM = false;
    __device__ __forceinline__ void pre(const Unit&, int, int) const {}
    bf16_t *QB, *KB, *VB, *ML; float* G; const float* rope; const float *qg, *kg, *b_i, *b_f; PG8_LAS float* scr;
    __device__ __forceinline__ void operator()(const f32x4 (&acc)[2][2][4][2], const Unit& u, int wr, int wc, int fr, int fq) const {
        const int pn = u.pn;
        if (pn < 12) {
            const bool isq = pn < 6;
#pragma unroll
            for (int ai = 0; ai < 2; ++ai)
#pragma unroll
                for (int m = 0; m < 4; ++m)
#pragma unroll
                    for (int bj = 0; bj < 2; ++bj) {
                        const f32x4 a = acc[ai][bj][m][0], b = acc[ai][bj][m][1];
                        float s = (a[0] * a[0] + a[1] * a[1]) + (a[2] * a[2] + a[3] * a[3]) + (b[0] * b[0] + b[1] * b[1]) + (b[2] * b[2] + b[3] * b[3]);
                        s += __shfl_xor(s, 16); s += __shfl_xor(s, 32);
                        if (fq == 0) scr[((ai * HALF + wr * 64 + m * 16 + fr) * 2 + bj) * 4 + wc] = s;
                    }
            EPI_BAR();
            const float* gsrc = isq ? qg : kg; const float gscale = isq ? 0.08838834764831845f * 1.4426950408889634f : 1.0f;
            f32x4 gva, gvb;
#pragma unroll
            for (int e = 0; e < 4; ++e) { const int p = 32 * wc + 8 * fq + e; gva[e] = gsrc[(p >> 1) + 64 * (p & 1)] * gscale; gvb[e] = gsrc[((p + 4) >> 1) + 64 * (p & 1)] * gscale; }
            bf16_t* dst = isq ? QB : KB; const int head0 = (isq ? pn : pn - 6) * 2;
#pragma unroll
            for (int ai = 0; ai < 2; ++ai)
#pragma unroll
                for (int m = 0; m < 4; ++m) {
                    const int rl = ai * HALF + wr * 64 + m * 16 + fr, grow = u.pm * BM + rl, t = grow & 2047, bb = grow >> 11;
                    const size_t drow = (size_t)bb * 2048 + (size_t)(t & 3) * 512 + (t >> 2);
                    const f32x4 cs0 = *(const f32x4*)(rope + ((size_t)t * 64 + 16 * wc + 4 * fq) * 2), cs1 = *(const f32x4*)(rope + ((size_t)t * 64 + 16 * wc + 4 * fq) * 2 + 4);
#pragma unroll
                    for (int bj = 0; bj < 2; ++bj) {
                        const f32x4 pp = *(const PG8_LAS f32x4*)(scr + (rl * 2 + bj) * 4);
                        const float rstd = 1.0f / sqrtf(((pp[0] + pp[1]) + (pp[2] + pp[3])) * (1.0f / 128.0f) + kEps);
                        const f32x4 a = acc[ai][bj][m][0] * (gva * rstd), b = acc[ai][bj][m][1] * (gvb * rstd);
                        const f32x2 xe0 = {a[0], a[2]}, xo0 = {a[1], a[3]}, xe1 = {b[0], b[2]}, xo1 = {b[1], b[3]};
                        const f32x2 c0 = {cs0[0], cs0[2]}, s0 = {cs0[1], cs0[3]}, c1 = {cs1[0], cs1[2]}, s1 = {cs1[1], cs1[3]};
                        const f32x2 oe0 = xe0 * c0 - xo0 * s0, oo0 = xe0 * s0 + xo0 * c0, oe1 = xe1 * c1 - xo1 * s1, oo1 = xe1 * s1 + xo1 * c1;
                        u32x4 w;
                        w.x = cvt_pk_bf16(oe0[0], oo0[0]); w.y = cvt_pk_bf16(oe0[1], oo0[1]); w.z = cvt_pk_bf16(oe1[0], oo1[0]); w.w = cvt_pk_bf16(oe1[1], oo1[1]);
                        *(u32x4*)(dst + drow * 1536 + (head0 + bj) * 128 + 32 * wc + 8 * fq) = w;
                    }
                }
        } else if (pn < 26) {
            const bool isv = pn < 18;
#pragma unroll
            for (int ai = 0; ai < 2; ++ai)
#pragma unroll
                for (int m = 0; m < 4; ++m) {
                    const int rl = ai * HALF + wr * 64 + m * 16 + fr, grow = u.pm * BM + rl, t = grow & 2047, bb = grow >> 11;
                    bf16_t* rowp = isv ? VB + ((size_t)bb * 2048 + (size_t)(t & 3) * 512 + (t >> 2)) * 1536 + (pn - 12) * 256 : ML + (size_t)grow * 2048 + (pn - 18) * 256;
#pragma unroll
                    for (int bj = 0; bj < 2; ++bj) {
                        const f32x4 a = acc[ai][bj][m][0], b = acc[ai][bj][m][1];
                        u32x4 w; w.x = cvt_pk_bf16(a[0], a[1]); w.y = cvt_pk_bf16(a[2], a[3]); w.z = cvt_pk_bf16(b[0], b[1]); w.w = cvt_pk_bf16(b[2], b[3]);
                        *(u32x4*)(rowp + bj * HALF + 32 * wc + 8 * fq) = w;
                    }
                }
        } else {
            if (wc == 0 && fq == 0) {
                const f32x4 bi = *(const f32x4*)b_i, bf = *(const f32x4*)b_f;
#pragma unroll
                for (int ai = 0; ai < 2; ++ai)
#pragma unroll
                    for (int m = 0; m < 4; ++m) {
                        const int grow = u.pm * BM + ai * HALF + wr * 64 + m * 16 + fr;
                        *(f32x4*)(G + (size_t)grow * 8) = acc[ai][0][m][0] + bi; *(f32x4*)(G + (size_t)grow * 8 + 4) = acc[ai][0][m][1] + bf;
                    }
            }
        }
    }
};

struct Epi3 {
    static constexpr bool PERM = true, AFTER_DRAIN = false, APERM = false;
    __device__ __forceinline__ void pre(const Unit&, int, int) const {}
    const float* x; bf16_t* X1; float* SS; PG8_LAS float* scr;
    __device__ __forceinline__ void operator()(const f32x4 (&acc)[2][2][4][2], const Unit& u, int wr, int wc, int fr, int fq) const {
        const int col0 = u.pn * BM + 32 * wc + 8 * fq;
#pragma unroll
        for (int ai = 0; ai < 2; ++ai)
#pragma unroll
            for (int m = 0; m < 4; ++m) {
                const int rl = ai * HALF + wr * 64 + m * 16 + fr; const size_t off = (size_t)(u.pm * BM + rl) * 2048 + col0;
                float s = 0.f;
#pragma unroll
                for (int bj = 0; bj < 2; ++bj) {
                    const f32x4 a = acc[ai][bj][m][0] + __builtin_nontemporal_load((const f32x4*)(x + off + bj * HALF)), b = acc[ai][bj][m][1] + __builtin_nontemporal_load((const f32x4*)(x + off + bj * HALF + 4));
                    s += (a[0] * a[0] + a[1] * a[1]) + (a[2] * a[2] + a[3] * a[3]) + (b[0] * b[0] + b[1] * b[1]) + (b[2] * b[2] + b[3] * b[3]);
                    u32x4 w; w.x = cvt_pk_bf16(a[0], a[1]); w.y = cvt_pk_bf16(a[2], a[3]); w.z = cvt_pk_bf16(b[0], b[1]); w.w = cvt_pk_bf16(b[2], b[3]);
                    *(u32x4*)(X1 + off + bj * HALF) = w;
                }
                s += __shfl_xor(s, 16); s += __shfl_xor(s, 32);
                if (fq == 0) scr[rl * 4 + wc] = s;
            }
        EPI_BAR();
        if (wc == 0 && fq == 0) {
#pragma unroll
            for (int ai = 0; ai < 2; ++ai)
#pragma unroll
                for (int m = 0; m < 4; ++m) {
                    const int rl = ai * HALF + wr * 64 + m * 16 + fr; const f32x4 pp = *(const PG8_LAS f32x4*)(scr + rl * 4);
                    SS[(size_t)(u.pm * BM + rl) * 8 + u.pn] = (pp[0] + pp[1]) + (pp[2] + pp[3]);
                }
        }
    }
};

__device__ __forceinline__ float dpp_shr1(float v) { return __builtin_bit_cast(float, __builtin_amdgcn_update_dpp(0, __builtin_bit_cast(int, v), 0x111, 0xf, 0xf, true)); }
struct Epi4 {
    static constexpr bool PERM = true, AFTER_DRAIN = false, APERM = true;
    bf16_t* ACT; float* RAWB; const float* SS; const float *cw, *cb; PG8_LAS float* scr; int light;
    __device__ __forceinline__ void pre(const Unit& u, int wid, int lane) const {
        __builtin_amdgcn_global_load_lds((const unsigned*)((const char*)(SS + (size_t)u.pm * BM * 8) + wid * 1024 + lane * 16), (PG8_LAS unsigned*)((PG8_LAS char*)scr + wid * 1024), 16, 0, 0);
        if (wid < 4) { const int seg = 2 * wid + (lane >> 5), q4 = seg >> 1, gv = seg & 1;
            const float* src = (q4 < 3 ? cw + q4 * 11264 : cb) + (gv ? 5632 : 0) + u.pn * 128 + 4 * (lane & 31);
            __builtin_amdgcn_global_load_lds((const unsigned*)src, (PG8_LAS unsigned*)((PG8_LAS char*)scr + 8192 + wid * 1024), 16, 0, 0); }
    }
    __device__ __forceinline__ void operator()(f32x4 (&acc)[2][2][4][2], const Unit& u, int wr, int wc, int fr, int fq) const {
        if (light == 1) return;
        const int j0 = u.pn * 128 + 32 * wc + 8 * fq;
#pragma unroll
        for (int ai = 0; ai < 2; ++ai)
#pragma unroll
            for (int m = 0; m < 4; ++m) {
                const PG8_LAS float* sp = scr + (ai * HALF + wr * 64 + 4 * fr + m) * 8; const f32x4 s0 = *(const PG8_LAS f32x4*)sp, s1 = *(const PG8_LAS f32x4*)(sp + 4);
                const float rstd = 1.0f / sqrtf((((s0[0] + s0[1]) + (s0[2] + s0[3])) + ((s1[0] + s1[1]) + (s1[2] + s1[3]))) * (1.0f / 2048.0f) + kEps);
#pragma unroll
                for (int bj = 0; bj < 2; ++bj) { acc[ai][bj][m][0] = acc[ai][bj][m][0] * rstd; acc[ai][bj][m][1] = acc[ai][bj][m][1] * rstd; }
            }
        if (fr == 0 && light != 2) {
#pragma unroll
            for (int ai = 0; ai < 2; ++ai)
#pragma unroll
                for (int mm = 0; mm < 2; ++mm)
#pragma unroll
                    for (int bj = 0; bj < 2; ++bj) { float* p = RAWB + ((size_t)(u.pm * 4 + ai * 2 + wr) * 4 + mm) * 11264 + u.pn * 256 + bj * HALF + 32 * wc + 8 * fq; *(f32x4*)p = acc[ai][bj][mm][0]; *(f32x4*)(p + 4) = acc[ai][bj][mm][1]; }
        }
        if (fr == 15 && light != 2) {
#pragma unroll
            for (int ai = 0; ai < 2; ++ai)
#pragma unroll
                for (int mm = 0; mm < 2; ++mm)
#pragma unroll
                    for (int bj = 0; bj < 2; ++bj) { float* p = RAWB + ((size_t)(u.pm * 4 + ai * 2 + wr) * 4 + 2 + mm) * 11264 + u.pn * 256 + bj * HALF + 32 * wc + 8 * fq; *(f32x4*)p = acc[ai][bj][2 + mm][0]; *(f32x4*)(p + 4) = acc[ai][bj][2 + mm][1]; }
        }
#pragma unroll
        for (int ai = 0; ai < 2; ++ai) {
            unsigned pk[4][4];
#pragma unroll
            for (int n = 0; n < 2; ++n) {
                const PG8_LAS float* wl = scr + 2048 + 32 * wc + 8 * fq + 4 * n;
                const f32x4 wg0 = *(const PG8_LAS f32x4*)wl, wg1 = *(const PG8_LAS f32x4*)(wl + 256), wg2 = *(const PG8_LAS f32x4*)(wl + 512), bg = *(const PG8_LAS f32x4*)(wl + 768);
                const f32x4 wv0 = *(const PG8_LAS f32x4*)(wl + 128), wv1 = *(const PG8_LAS f32x4*)(wl + 384), wv2 = *(const PG8_LAS f32x4*)(wl + 640), bv = *(const PG8_LAS f32x4*)(wl + 896);
                f32x4 ug[6], uv[6];
#pragma unroll
                for (int j = 0; j < 4; ++j) { ug[0][j] = dpp_shr1(acc[ai][0][2][n][j]); ug[1][j] = dpp_shr1(acc[ai][0][3][n][j]); uv[0][j] = dpp_shr1(acc[ai][1][2][n][j]); uv[1][j] = dpp_shr1(acc[ai][1][3][n][j]); }
#pragma unroll
                for (int m = 0; m < 4; ++m) { ug[2 + m] = acc[ai][0][m][n]; uv[2 + m] = acc[ai][1][m][n]; }
#pragma unroll
                for (int m = 0; m < 4; ++m) {
                    const f32x4 yg = bg + wg0 * ug[m] + wg1 * ug[m + 1] + wg2 * ug[m + 2];
                    const f32x4 yv = bv + wv0 * uv[m] + wv1 * uv[m + 1] + wv2 * uv[m + 2];
                    const f32x4 t = yg * -1.4426950408889634f;
                    f32x4 sg; sg[0] = __builtin_amdgcn_rcpf(1.0f + __builtin_amdgcn_exp2f(t[0])); sg[1] = __builtin_amdgcn_rcpf(1.0f + __builtin_amdgcn_exp2f(t[1])); sg[2] = __builtin_amdgcn_rcpf(1.0f + __builtin_amdgcn_exp2f(t[2])); sg[3] = __builtin_amdgcn_rcpf(1.0f + __builtin_amdgcn_exp2f(t[3]));
                    const f32x4 res = (yg * yv) * sg;
                    pk[m][2 * n] = cvt_pk_bf16(res[0], res[1]); pk[m][2 * n + 1] = cvt_pk_bf16(res[2], res[3]);
                }
            }
#pragma unroll
            for (int m = 0; m < 4; ++m) {
                if ((m < 2 && fr == 0) || (light == 2 && pk[m][0] != 0x12345678u)) continue;
                const int grow = u.pm * BM + ai * HALF + wr * 64 + 4 * fr + m;
                u32x4 w; w.x = pk[m][0]; w.y = pk[m][1]; w.z = pk[m][2]; w.w = pk[m][3];
                *(u32x4*)(ACT + (size_t)grow * 5632 + j0) = w;
            }
        }
    }
};

struct Epi5 {
    static constexpr bool PERM = true, AFTER_DRAIN = false, APERM = false;
    __device__ __forceinline__ void pre(const Unit&, int, int) const {}
    float* out; const bf16_t* X1;
    __device__ __forceinline__ void operator()(const f32x4 (&acc)[2][2][4][2], const Unit& u, int wr, int wc, int fr, int fq) const {
        const int col0 = u.pn * BM + 32 * wc + 8 * fq;
#pragma unroll
        for (int ai = 0; ai < 2; ++ai)
#pragma unroll
            for (int m = 0; m < 4; ++m) {
                const size_t off = (size_t)(u.pm * BM + ai * HALF + wr * 64 + m * 16 + fr) * 2048 + col0;
#pragma unroll
                for (int bj = 0; bj < 2; ++bj) {
                    const u32x4 w = __builtin_nontemporal_load((const u32x4*)(X1 + off + bj * HALF));
                    const f32x4 r0 = {__builtin_bit_cast(float, w.x << 16), __builtin_bit_cast(float, w.x & 0xffff0000u), __builtin_bit_cast(float, w.y << 16), __builtin_bit_cast(float, w.y & 0xffff0000u)};
                    const f32x4 r1 = {__builtin_bit_cast(float, w.z << 16), __builtin_bit_cast(float, w.z & 0xffff0000u), __builtin_bit_cast(float, w.w << 16), __builtin_bit_cast(float, w.w & 0xffff0000u)};
                    __builtin_nontemporal_store(acc[ai][bj][m][0] + r0, (f32x4*)(out + off + bj * HALF)); __builtin_nontemporal_store(acc[ai][bj][m][1] + r1, (f32x4*)(out + off + bj * HALF + 4));
                }
            }
    }
};
template <class Epi, class Sched, bool ALIGN_EPI = false, bool SP2 = false>
__device__ __forceinline__ void gemm_phase(PG8_LAS unsigned char* lds, const Gemm g, const Sched& S, const Epi& E) {
    const int tid = threadIdx.x, wid = __builtin_amdgcn_readfirstlane(tid >> 6), lane = tid & 63, wr = wid >> 2, wc = wid & 3, fr = lane & 15, fq = lane >> 4;
    const int K = g.K, nt = K / BK;
    unsigned voffA[2], voffB[2];
#pragma unroll
    for (int i = 0; i < 2; ++i) { int R, C; stage_rc(tid * 16 + i * 8192, R, C); const int Rb = Epi::PERM ? ((R & ~31) + perm32(R & 31)) : R;
        const int Ra = Epi::APERM ? ((R & ~63) + 4 * (R & 15) + ((R >> 4) & 3)) : R;
        voffA[i] = (unsigned)(Ra * K + C) * 2u; voffB[i] = (unsigned)(Rb * K + C) * 2u; }
    const size_t kstep = (size_t)(BK * 2);
    const size_t hstep = (size_t)HALF * K * 2;
    const size_t tstep = 2 * hstep;
    const unsigned ldsw = (unsigned)wid * 1024u;
    const int aoff = lds_byte(wr * 64 + fr, fq * 8), boff = lds_byte(wc * 32 + fr, fq * 8);
#define PG8_SA(b, h) (((b) * 2 + (h)) * HTB)
#define PG8_SB(b, h) ((4 + (b) * 2 + (h)) * HTB)
#define PG8_STAGE(bufoff, gbase, voff) do { _Pragma("unroll") for (int _i = 0; _i < 2; ++_i) \
        __builtin_amdgcn_global_load_lds((const unsigned*)((const char*)(gbase) + (voff)[_i]), (PG8_LAS unsigned*)(lds + (bufoff) + ldsw + _i * 8192), 16, 0, 0); } while (0)
#define PG8_LDA(dst, b, h) do { _Pragma("unroll") for (int m = 0; m < 4; ++m) _Pragma("unroll") for (int k = 0; k < 2; ++k) dst[m][k] = *(const PG8_LAS bf16x8*)(lds + PG8_SA(b, h) + aoff + m * 2048 + k * 1024); } while (0)
#define PG8_LDB(dst, b, h) do { _Pragma("unroll") for (int n = 0; n < 2; ++n) _Pragma("unroll") for (int k = 0; k < 2; ++k) dst[n][k] = *(const PG8_LAS bf16x8*)(lds + PG8_SB(b, h) + boff + n * 2048 + k * 1024); } while (0)
#define PG8_MMA(ai, bj, At, Bt) do { __builtin_amdgcn_s_setprio(1); _Pragma("unroll") for (int m = 0; m < 4; ++m) _Pragma("unroll") for (int n = 0; n < 2; ++n) _Pragma("unroll") for (int k = 0; k < 2; ++k) \
        acc[ai][bj][m][n] = __builtin_amdgcn_mfma_f32_16x16x32_bf16(Bt[n][k], At[m][k], acc[ai][bj][m][n], 0, 0, 0); __builtin_amdgcn_s_setprio(0); } while (0)
#define PG8_WAIT_V(n) asm volatile("s_waitcnt vmcnt(" #n ")" ::: "memory")
#define PG8_WAIT_L(n) asm volatile("s_waitcnt lgkmcnt(" #n ")" ::: "memory")
#define PG8_BAR __builtin_amdgcn_s_barrier()
#define PG8_SCHED __builtin_amdgcn_sched_barrier(0)
    Unit cur, nxt; int ui = 0;
    if (!S.next(0, cur)) return;
    f32x4 acc[2][2][4][2];
#pragma unroll
    for (int a = 0; a < 2; ++a)
#pragma unroll
        for (int b = 0; b < 2; ++b)
#pragma unroll
            for (int m = 0; m < 4; ++m)
#pragma unroll
                for (int n = 0; n < 2; ++n) acc[a][b][m][n] = (f32x4){0.f, 0.f, 0.f, 0.f};
    bf16x8 At[4][2], B0[2][2], B1[2][2];
    const char* cA = (const char*)g.A + (size_t)cur.pm * tstep; const char* cB = (const char*)g.Bt + (size_t)cur.pn * tstep;
    S.a_ready(cur);
    if constexpr (SP2) {
        PG8_STAGE(PG8_SB(0, 0), cB, voffB); PG8_STAGE(PG8_SB(0, 1), cB + hstep, voffB); PG8_STAGE(PG8_SA(0, 0), cA, voffA); PG8_STAGE(PG8_SA(0, 1), cA + hstep, voffA);
        if (wr == 1) PG8_BAR;
        PG8_WAIT_V(2); PG8_BAR;
        PG8_STAGE(PG8_SB(1, 0), cB + kstep, voffB); PG8_STAGE(PG8_SA(1, 0), cA + kstep, voffA); PG8_STAGE(PG8_SB(1, 1), cB + hstep + kstep, voffB);
        PG8_WAIT_V(6); PG8_BAR;
    } else {
        PG8_STAGE(PG8_SB(0, 0), cB, voffB); PG8_STAGE(PG8_SA(0, 0), cA, voffA); PG8_STAGE(PG8_SB(0, 1), cB + hstep, voffB); PG8_STAGE(PG8_SA(0, 1), cA + hstep, voffA);
        if (wr == 1) PG8_BAR;
        PG8_WAIT_V(4); PG8_BAR;
        PG8_STAGE(PG8_SB(1, 0), cB + kstep, voffB); PG8_STAGE(PG8_SA(1, 0), cA + kstep, voffA); PG8_STAGE(PG8_SB(1, 1), cB + hstep + kstep, voffB);
        PG8_WAIT_V(6); PG8_BAR;
    }
    for (;;) {
        const bool has_next = S.next(ui + 1, nxt);
        const char* nA = has_next ? (const char*)g.A + (size_t)nxt.pm * tstep : cA; const char* nB = has_next ? (const char*)g.Bt + (size_t)nxt.pn * tstep : cB;
        for (int t = 0; t < nt; t += 2) {
            const bool last = (t == nt - 2);
            const char* a1 = cA + (size_t)(t + 1) * kstep;
            const char* a2 = last ? nA : cA + (size_t)(t + 2) * kstep; const char* b2 = last ? nB : cB + (size_t)(t + 2) * kstep;
            const char* a3 = a2 + kstep; const char* b3 = b2 + kstep;
            if (last && has_next) S.a_ready(nxt);
            if (last) E.pre(cur, wid, lane);
            if constexpr (SP2) {
            PG8_LDB(B0, 0, 0); PG8_LDB(B1, 0, 1); PG8_SCHED; PG8_LDA(At, 0, 0); PG8_STAGE(PG8_SA(1, 1), a1 + hstep, voffA);
            PG8_WAIT_V(8); PG8_WAIT_L(0); PG8_BAR; PG8_MMA(0, 0, At, B0); PG8_MMA(0, 1, At, B1); PG8_BAR; PG8_SCHED;
            PG8_LDA(At, 0, 1); PG8_STAGE(PG8_SB(0, 0), b2, voffB); PG8_STAGE(PG8_SB(0, 1), b2 + hstep, voffB); PG8_STAGE(PG8_SA(0, 0), a2, voffA);
            PG8_WAIT_V(8); PG8_WAIT_L(0); PG8_BAR; PG8_MMA(1, 0, At, B0); PG8_MMA(1, 1, At, B1); PG8_BAR; PG8_SCHED;
            PG8_LDB(B0, 1, 0); PG8_LDB(B1, 1, 1); PG8_SCHED; PG8_LDA(At, 1, 0); PG8_STAGE(PG8_SA(0, 1), a2 + hstep, voffA);
            PG8_WAIT_V(8); PG8_WAIT_L(0); PG8_BAR; PG8_MMA(0, 0, At, B0); PG8_MMA(0, 1, At, B1); PG8_BAR; PG8_SCHED;
            PG8_LDA(At, 1, 1); PG8_STAGE(PG8_SB(1, 0), b3, voffB); PG8_STAGE(PG8_SB(1, 1), b3 + hstep, voffB); PG8_STAGE(PG8_SA(1, 0), a3, voffA);
            PG8_WAIT_V(8); PG8_WAIT_L(0); PG8_BAR; PG8_MMA(1, 0, At, B0); PG8_MMA(1, 1, At, B1); PG8_BAR; PG8_SCHED;
            } else {
            PG8_LDB(B0, 0, 0); PG8_SCHED; PG8_LDA(At, 0, 0); PG8_STAGE(PG8_SA(1, 1), a1 + hstep, voffA);
            PG8_WAIT_L(8); PG8_BAR; PG8_WAIT_L(0); PG8_MMA(0, 0, At, B0); PG8_BAR; PG8_SCHED;
            PG8_LDB(B1, 0, 1); PG8_STAGE(PG8_SB(0, 0), b2, voffB);
            PG8_BAR; PG8_WAIT_L(0); PG8_MMA(0, 1, At, B1); PG8_BAR;
            PG8_LDA(At, 0, 1); PG8_STAGE(PG8_SA(0, 0), a2, voffA);
            PG8_BAR; PG8_WAIT_L(0); PG8_MMA(1, 0, At, B0); PG8_BAR; PG8_SCHED;
            PG8_STAGE(PG8_SB(0, 1), b2 + hstep, voffB);
            PG8_WAIT_V(6); PG8_BAR; PG8_MMA(1, 1, At, B1); PG8_BAR;
            PG8_LDB(B0, 1, 0); PG8_SCHED; PG8_LDA(At, 1, 0); PG8_STAGE(PG8_SA(0, 1), a2 + hstep, voffA);
            PG8_WAIT_L(8); PG8_BAR; PG8_WAIT_L(0); PG8_MMA(0, 0, At, B0); PG8_BAR; PG8_SCHED;
            PG8_LDB(B1, 1, 1); PG8_STAGE(PG8_SB(1, 0), b3, voffB);
            PG8_BAR; PG8_WAIT_L(0); PG8_MMA(0, 1, At, B1); PG8_BAR;
            PG8_LDA(At, 1, 1); PG8_STAGE(PG8_SA(1, 0), a3, voffA);
            PG8_BAR; PG8_WAIT_L(0); PG8_MMA(1, 0, At, B0); PG8_BAR; PG8_SCHED;
            PG8_STAGE(PG8_SB(1, 1), b3 + hstep, voffB);
            PG8_WAIT_V(6); PG8_BAR; PG8_MMA(1, 1, At, B1); PG8_BAR;
            }
        }
        if constexpr (ALIGN_EPI) { if (wr == 0) PG8_BAR; }
        if constexpr (!Epi::AFTER_DRAIN) { E(acc, cur, wr, wc, fr, fq); S.done(cur); }
        if (!has_next) break;
#pragma unroll
        for (int a = 0; a < 2; ++a)
#pragma unroll
            for (int b = 0; b < 2; ++b)
#pragma unroll
                for (int m = 0; m < 4; ++m)
#pragma unroll
                    for (int n = 0; n < 2; ++n) acc[a][b][m][n] = (f32x4){0.f, 0.f, 0.f, 0.f};
        cur = nxt; cA = nA; cB = nB; ++ui;
        if constexpr (ALIGN_EPI) { if (wr == 1) PG8_BAR; }
    }
    PG8_WAIT_V(0);
    if constexpr (!ALIGN_EPI) { if (wr == 0) PG8_BAR; }
    PG8_BAR;
    if constexpr (Epi::AFTER_DRAIN) { E.fused(acc, cur, wr, wc, fr, fq, lds, wid, lane); S.done(cur); }
#undef PG8_SA
#undef PG8_SB
#undef PG8_STAGE
#undef PG8_LDA
#undef PG8_LDB
#undef PG8_MMA
#undef PG8_WAIT_V
#undef PG8_WAIT_L
#undef PG8_BAR
#undef PG8_SCHED
}
}
#define GAS __attribute__((address_space(1)))
#define LAS __attribute__((address_space(3)))
typedef unsigned short bf16;
typedef unsigned v4u __attribute__((ext_vector_type(4)));
typedef float f32x4 __attribute__((ext_vector_type(4)));
typedef short bf16x8 __attribute__((ext_vector_type(8)));
typedef GAS unsigned gu32;
typedef GAS unsigned long long gu64;
#define RLX_AGENT __ATOMIC_RELAXED, __HIP_MEMORY_SCOPE_AGENT
#define LDS_WAIT() asm volatile("s_waitcnt lgkmcnt(0)" ::: "memory")
#define VM_WAIT() asm volatile("s_waitcnt vmcnt(0)" ::: "memory")
__device__ __forceinline__ unsigned long long rt() { return __builtin_amdgcn_s_memrealtime(); }
__device__ __forceinline__ unsigned f2bf(float f) { unsigned u = __builtin_bit_cast(unsigned, f); return (u + 0x7fffu + ((u >> 16) & 1u)) >> 16; }
__device__ __forceinline__ unsigned pk2(float lo, float hi) { return f2bf(lo) | (f2bf(hi) << 16); }

#define XB_TMO      128
#define XB_XCNT(j)  (256  + 64 * (j))
#define XB_XSUB(j)  (1280 + 64 * (j))
#define XB_XGEN(j)  (2304 + 64 * (j))
#define XB_TOP      3328
#define XB_TOPGEN   3392
#define XCD_BAR_WORDS 3456
#define XB_SPIN_CAP (1u << 18)

__device__ __forceinline__ unsigned xb_ld(unsigned* p)              { return __hip_atomic_load(p, __ATOMIC_RELAXED, __HIP_MEMORY_SCOPE_AGENT); }
__device__ __forceinline__ unsigned xb_add(unsigned* p, unsigned v) { return __hip_atomic_fetch_add(p, v, __ATOMIC_RELAXED, __HIP_MEMORY_SCOPE_AGENT); }
__device__ __forceinline__ unsigned xb_xcc_id() { return (unsigned)__builtin_amdgcn_s_getreg((3 << 11) | 20) & 0xFu; }
#define XB_SPIN(cond, bar) do { unsigned _sp = 0; while (cond) { __builtin_amdgcn_s_sleep(1); \
    if ((++_sp & 255u) == 0u) { if (xb_ld(&(bar)[XB_TMO])) break; if (_sp > XB_SPIN_CAP) { atomicAdd(&(bar)[XB_TMO], 1u); break; } } } } while (0)

struct XcdBarrier {
    unsigned* bar; unsigned x;
    volatile LAS unsigned* st;
};

__device__ __forceinline__ XcdBarrier xcd_barrier_post(unsigned* bar, volatile LAS unsigned* st) {
    XcdBarrier b; b.bar = bar; b.x = xb_xcc_id(); b.st = st;
    if (threadIdx.x == 0) (void)xb_add(&bar[XB_XCNT(b.x)], 1u);
    return b;
}
__device__ __forceinline__ void xcd_barrier_complete(unsigned* bar, unsigned x, unsigned& nloc, unsigned& nx) {
    const unsigned G = gridDim.x * gridDim.y * gridDim.z;
    unsigned sum, cnt, mine, sp = 0u;
    for (;;) {
        sum = 0u; cnt = 0u; mine = 0u;
#pragma unroll
        for (unsigned j = 0; j < 16; ++j) { const unsigned c = xb_ld(&bar[XB_XCNT(j)]); sum += c; cnt += (c > 0u) ? 1u : 0u; mine = (j == x) ? c : mine; }
        if (sum == G) break;
        __builtin_amdgcn_s_sleep(1);
        if ((++sp & 255u) == 0u) { if (xb_ld(&bar[XB_TMO])) break; if (sp > XB_SPIN_CAP) { atomicAdd(&bar[XB_TMO], 1u); break; } }
    }
    nloc = mine > 0u ? mine : 1u; nx = cnt > 0u ? cnt : 1u;
}

__device__ __forceinline__ void xcd_barrier(const XcdBarrier& b) {
    asm volatile("s_waitcnt vmcnt(0)" ::: "memory");
    __syncthreads();
    if (threadIdx.x == 0) {
        unsigned* bar = b.bar;
        __builtin_amdgcn_s_waitcnt(0);
        unsigned nloc = b.st[0], nx = b.st[1];
        if (nloc == 0u) { xcd_barrier_complete(bar, b.x, nloc, nx); b.st[0] = nloc; b.st[1] = nx; }
        const unsigned old = xb_add(&bar[XB_XSUB(b.x)], 1u);
        const unsigned gen = old / nloc;
        if (old + 1u == (gen + 1u) * nloc) {
            __builtin_amdgcn_fence(__ATOMIC_RELEASE, "agent");
            asm volatile("s_waitcnt vmcnt(0)" ::: "memory");
            const unsigned og = xb_add(&bar[XB_TOP], 1u);
            const unsigned tg = og / nx;
            if (og + 1u == (tg + 1u) * nx) xb_add(&bar[XB_TOPGEN], 1u);
            else XB_SPIN(xb_ld(&bar[XB_TOPGEN]) == tg, bar);
            __builtin_amdgcn_fence(__ATOMIC_ACQUIRE, "agent");
            xb_add(&bar[XB_XGEN(b.x)], 1u);
            asm volatile("s_waitcnt vmcnt(0)" ::: "memory");
        } else {
            XB_SPIN(xb_ld(&bar[XB_XGEN(b.x)]) == gen, bar);
            __builtin_amdgcn_fence(__ATOMIC_ACQUIRE, "agent");
            asm volatile("s_waitcnt vmcnt(0)" ::: "memory");
        }
    }
    __syncthreads();
}

constexpr int NWAVES = 8;
constexpr int BATCH = 8, SEQ = 2048, DM = 2048, M = BATCH * SEQ;
constexpr int NAH = 12, NMH = 4, ATTN_W = 1536, IN_W = 6664, IN_WP = 6912, DFF = 5632, UPW = 11264;
#ifndef MK_N_LAUNCHES
#define MK_N_LAUNCHES 1
#endif
#ifndef WGM_IN
#define WGM_IN 8
#endif
#ifndef WGM_OUT
#define WGM_OUT 4
#endif
#ifndef WGM_UP
#define WGM_UP 8
#endif
#ifndef WGM_DOWN
#define WGM_DOWN 4
#endif
constexpr int N_LAUNCHES = MK_N_LAUNCHES;
enum { PH_PRO = 0, PH_IN = 1, PH_PRE = 2, PH_MIX = 3, PH_OUT = 4, PH_UP = 5, PH_FIX = 6, PH_DOWN = 7 };
constexpr int PER_PHASE = 8;

constexpr size_t MiB = 1u << 20;
constexpr size_t WS_CTL = 0, CTL_ZERO_BYTES = 128 * 1024;
constexpr size_t WS_ROPE = 1 * MiB, WS_G = 2 * MiB, WS_SS = 2 * MiB + 512 * 1024;
constexpr size_t WS_WIN = 4 * MiB, WS_WOUT = 31 * MiB, WS_WUP = 39 * MiB, WS_WDN = 83 * MiB;
constexpr size_t WS_XN = 105 * MiB;
constexpr size_t WS_QB = 169 * MiB, WS_KB = 217 * MiB, WS_VB = 265 * MiB, WS_ML = 313 * MiB;
constexpr size_t WS_MIX = 377 * MiB;
constexpr size_t WS_RAW = 377 * MiB;
constexpr size_t WS_ACT = 169 * MiB;
constexpr size_t WS_MLC = 441 * MiB;
constexpr size_t WS_GA = 473 * MiB;
constexpr size_t WS_END = 475 * MiB;
static_assert(WS_WIN + (size_t)IN_WP * DM * 2 <= WS_WOUT && WS_WOUT + (size_t)DM * DM * 2 <= WS_WUP && WS_WUP + (size_t)UPW * DM * 2 <= WS_WDN && WS_WDN + (size_t)DM * DFF * 2 <= WS_XN, "weights map");
static_assert(WS_XN + (size_t)M * DM * 2 <= WS_QB && WS_ML + (size_t)M * 2048 * 2 <= WS_MIX && WS_MIX + (size_t)M * 2048 * 2 <= WS_MLC && WS_MLC + (size_t)M * 1024 * 2 <= WS_GA && WS_GA + (size_t)32 * 16 * 3 * 128 * 4 <= WS_END && WS_RAW + (size_t)256 * 4 * UPW * 4 <= WS_MLC && WS_ACT + (size_t)M * DFF * 2 <= WS_MIX, "activation map");
constexpr int CW_TMO = 0, CW_BAR = 4096, CW_QUEUE = 16384;

constexpr int RING_OFF = 0, RING_BYTES = 131072;
constexpr int SCR_OFF = RING_BYTES, SCR_BYTES = 24576;
constexpr int LDSCTL_OFF = SCR_OFF + SCR_BYTES, MISC_OFF = LDSCTL_OFF + 320;
constexpr int LDS_BYTES = 156672;
static_assert(MISC_OFF + 128 <= LDS_BYTES, "LDS map");

#define DI __device__ __forceinline__
typedef float f32x16 __attribute__((ext_vector_type(16)));
typedef short s16x4 __attribute__((ext_vector_type(4)));
typedef unsigned u32x2 __attribute__((ext_vector_type(2)));
#define MFMA32(a, b, c) __builtin_amdgcn_mfma_f32_32x32x16_bf16((a), (b), (c), 0, 0, 0)
constexpr float LOG2E = 1.4426950408889634f;

struct Frame {
    LAS unsigned char* lds; volatile LAS unsigned* MISC; gu32* ctl;
    int tid, lane, wave, vcu, G;
    float* out; unsigned char* ws;
};

DI unsigned swz_b(unsigned row) { return ((row & 3u) << 2) | ((row >> 2) & 3u); }
DI unsigned off_b(unsigned row, unsigned ch) { return 256u * row + 16u * (ch ^ swz_b(row)); }
DI bf16x8 lds_b128(LAS unsigned char* p) { return *(const LAS bf16x8*)p; }
DI LAS unsigned char* lp(unsigned a) { return (LAS unsigned char*)(size_t)a; }
typedef short v4i16_t __attribute__((ext_vector_type(4)));
DI s16x4 lds_tr(LAS unsigned char* p) { return __builtin_bit_cast(s16x4, __builtin_amdgcn_ds_read_tr16_b64_v4i16((LAS v4i16_t*)p)); }
DI int crow(int reg, int hh) { return (reg & 3) + 8 * (reg >> 2) + 4 * hh; }
typedef unsigned u32x4 __attribute__((ext_vector_type(4)));
typedef float f32x2_t __attribute__((ext_vector_type(2)));
typedef __bf16 bf16x2_t __attribute__((ext_vector_type(2)));
DI unsigned cvtpk(float lo, float hi) { f32x2_t v = {lo, hi}; bf16x2_t b = __builtin_convertvector(v, bf16x2_t); return __builtin_bit_cast(unsigned, b); }
DI bf16x8 pack8(float a0, float a1, float a2, float a3, float a4, float a5, float a6, float a7) {
    u32x4 p; p.x = cvtpk(a0, a1); p.y = cvtpk(a2, a3); p.z = cvtpk(a4, a5); p.w = cvtpk(a6, a7); return __builtin_bit_cast(bf16x8, p);
}
DI float bf_lo(unsigned w) { return __builtin_bit_cast(float, w << 16); }
DI float bf_hi(unsigned w) { return __builtin_bit_cast(float, w & 0xffff0000u); }

DI float wave_sum(float v) {
#pragma unroll
    for (int o = 1; o < 64; o <<= 1) v += __shfl_xor(v, o);
    return v;
}
template <int MAT> DI int colmap(int n) {
    if (MAT == 0) return n < 2 * ATTN_W ? (n & ~127) + ((n & 127) >> 1) + 64 * (n & 1) : (n < IN_W ? n : -1);
    if (MAT == 2) return DFF * ((n >> 7) & 1) + 128 * (n >> 8) + (n & 127);
    return n;
}
template <int MAT, bool SCALE, bool VEC> DI void transpose_items(const float* W, const float* gk, int K, int N, bf16* WT, LAS float* scr, int it0, int step, int it_end, int nblk, int lane) {
    if (it0 >= it_end) return;
    float cur[32], nxt[32];
    auto issue = [&](float (&r)[32], int item) {
        const int kb = item / nblk, nb = item % nblk, k0 = 64 * kb, n0 = 32 * nb;
        if (VEC) { const int q = lane & 7, kr = lane >> 3; const int col = colmap<MAT>(n0 + 4 * q);
#pragma unroll
            for (int i = 0; i < 8; ++i) { const f32x4 v = __builtin_nontemporal_load((const GAS f32x4*)(W + (size_t)(k0 + 8 * i + kr) * N + col)); r[4 * i] = v[0]; r[4 * i + 1] = v[1]; r[4 * i + 2] = v[2]; r[4 * i + 3] = v[3]; } }
        else { const int col = colmap<MAT>(n0 + (lane & 31));
#pragma unroll
            for (int i = 0; i < 32; ++i) r[i] = col >= 0 ? W[(size_t)(k0 + 2 * i + (lane >> 5)) * N + col] : 0.f; }
    };
    issue(cur, it0);
    for (int item = it0; item < it_end; item += step) {
        const bool has_next = item + step < it_end;
        if (has_next) issue(nxt, item + step);
        const int kb = item / nblk, nb = item % nblk, k0 = 64 * kb, n0 = 32 * nb;
        if (VEC) { const int q = lane & 7, kr = lane >> 3;
#pragma unroll
            for (int i = 0; i < 8; ++i)
#pragma unroll
                for (int j = 0; j < 4; ++j) scr[(8 * i + kr) * 33 + 4 * q + j] = cur[4 * i + j]; }
        else {
#pragma unroll
            for (int i = 0; i < 32; ++i) scr[(2 * i + (lane >> 5)) * 33 + (lane & 31)] = cur[i]; }
        const int c = lane & 7;
        f32x4 g0 = {1.f, 1.f, 1.f, 1.f}, g1v = g0;
        if (SCALE) { g0 = *(const GAS f32x4*)(gk + k0 + 8 * c); g1v = *(const GAS f32x4*)(gk + k0 + 8 * c + 4); }
        LDS_WAIT(); asm volatile("" ::: "memory");
#pragma unroll
        for (int j = 0; j < 4; ++j) { const int n = (lane >> 3) + 8 * j; const LAS float* sp = scr + (8 * c) * 33 + n;
            v4u o; o.x = cvtpk(sp[0 * 33] * g0[0], sp[1 * 33] * g0[1]); o.y = cvtpk(sp[2 * 33] * g0[2], sp[3 * 33] * g0[3]); o.z = cvtpk(sp[4 * 33] * g1v[0], sp[5 * 33] * g1v[1]); o.w = cvtpk(sp[6 * 33] * g1v[2], sp[7 * 33] * g1v[3]);
            if (VEC) __builtin_nontemporal_store(o, (GAS v4u*)(WT + (size_t)(n0 + n) * K + k0 + 8 * c)); else *(GAS v4u*)(WT + (size_t)(n0 + n) * K + k0 + 8 * c) = o; }
        LDS_WAIT(); asm volatile("" ::: "memory");
        if (has_next) {
#pragma unroll
            for (int i = 0; i < 32; ++i) cur[i] = nxt[i]; }
    }
}
DI void p0_prologue(Frame& F, const float* x, const float* g1, const float* w_in) {
    LAS float* scr = (LAS float*)(F.lds + RING_OFF + F.wave * 16384);
    const int gw = F.vcu * NWAVES + F.wave, NGW = F.G * NWAVES;
    constexpr int NB0 = IN_WP / 32, I0 = (DM / 64) * NB0;
    bf16* Win = (bf16*)(F.ws + WS_WIN);
    transpose_items<0, true, false>(w_in, g1, DM, IN_W, Win, scr, gw, NGW, I0, NB0, F.lane);
    {
        bf16* XN = (bf16*)(F.ws + WS_XN);
        f32x4 v[8], vn[8];
#pragma unroll
        for (int j = 0; j < 8; ++j) v[j] = ((const GAS f32x4*)(x + (size_t)gw * DM) + F.lane)[64 * j];
        for (int m = gw; m < M; m += NGW) {
            const bool has_next = m + NGW < M;
            if (has_next) {
#pragma unroll
                for (int j = 0; j < 8; ++j) vn[j] = ((const GAS f32x4*)(x + (size_t)(m + NGW) * DM) + F.lane)[64 * j]; }
            float s = 0.f;
#pragma unroll
            for (int j = 0; j < 8; ++j) s += (v[j].x * v[j].x + v[j].y * v[j].y) + (v[j].z * v[j].z + v[j].w * v[j].w);
            const float rstd = 1.f / sqrtf(wave_sum(s) * (1.f / DM) + 1e-6f);
            GAS unsigned long long* o8 = (GAS unsigned long long*)(XN + (size_t)m * DM) + F.lane;
#pragma unroll
            for (int j = 0; j < 8; ++j) o8[64 * j] = (unsigned long long)cvtpk(v[j].x * rstd, v[j].y * rstd) | ((unsigned long long)cvtpk(v[j].z * rstd, v[j].w * rstd) << 32);
            if (has_next) {
#pragma unroll
                for (int j = 0; j < 8; ++j) v[j] = vn[j]; }
        }
    }
    {
        float* rope = (float*)(F.ws + WS_ROPE);
        for (int idx = gw * 64 + F.lane; idx < SEQ * 64; idx += NGW * 64) {
            const int t = idx >> 6, i = idx & 63; const double ang = (double)t * pow(10000.0, -(double)i / 64.0);
            rope[2 * idx] = (float)cos(ang); rope[2 * idx + 1] = (float)sin(ang);
        }
    }
}

DI void att_dma_tile(const unsigned char* gbase, const unsigned (&voff)[8], LAS unsigned char* ldst) {
#pragma unroll
    for (int it = 0; it < 8; ++it) __builtin_amdgcn_global_load_lds((const unsigned*)(gbase + voff[it]), (LAS unsigned*)(ldst + it * 1024), 16, 0, 0);
}
constexpr int ATT_LUT_BYTES = 10 * 2048;
DI void att_build_lut(LAS unsigned char* lut, int tid) {
    for (int idx = tid; idx < 10 * 64 * 8; idx += NWAVES * 64) {
        const int type = idx >> 9, rem = idx & 511, ln = rem >> 3, pair = rem & 7, q = ln & 31, hh = ln >> 5;
        const int d0 = type < 6 ? 32 * type : 32 * (type & 1);
        unsigned w = 0;
#pragma unroll
        for (int k = 0; k < 2; ++k) {
            const int e = 2 * pair + k, d = d0 + q - 4 * hh - ((e & 3) + 8 * (e >> 2));
            int c;
            if (type < 6) c = (d >= 0 && d <= 128 ? 1 : 0) + (d >= 0 && (d & 3) == 0 ? 1 : 0) + (d >= 0 && d <= 32 ? 1 : 0);
            else if (type < 8) c = (d >= 0 && d <= 31) ? 1 : 0;
            else c = (d >= 1 && d <= 32) ? 1 : 0;
            const unsigned bits = c == 0 ? 0xFF80u : (c == 1 ? 0x0000u : (c == 2 ? 0x3F80u : 0x3FCBu));
            w |= bits << (16 * k);
        }
        *(LAS unsigned*)(lut + type * 2048 + (pair >> 2) * 1024 + ln * 16 + (pair & 3) * 4) = w;
    }
}
DI void attn_unit(int b, int h, int r, int ib, const bf16* QB, const bf16* KB, const bf16* VB, bf16* MIX, LAS unsigned char* wl, LAS unsigned char* lut, int lane) {
    const int q = lane & 31, hh = lane >> 5, i0 = 32 * ib;
    const size_t rowb = (size_t)b * 2048;
    bf16x8 qf[8];
    { const bf16* qp = QB + (rowb + r * 512 + i0 + q) * 1536 + h * 128 + 8 * hh;
#pragma unroll
      for (int ks = 0; ks < 8; ++ks) qf[ks] = *(const GAS bf16x8*)(qp + 16 * ks); }
#pragma unroll
    for (int ks = 0; ks < 8; ++ks) asm volatile("" : "+v"(qf[ks]));
    f32x16 o[4];
#pragma unroll
    for (int c = 0; c < 4; ++c)
#pragma unroll
        for (int e = 0; e < 16; ++e) o[c][e] = 0.f;
    float mrun = -1e30f, lsum = 0.f;
    LAS unsigned char* Kt = wl; LAS unsigned char* Vt = wl + 8192;
    const int nt = (ib + 1) + (ib ? 6 : 3);
    auto tile_of = [&](int k, int& rc, int& j0, int& ty) {
        if (k <= ib) { rc = r; j0 = 32 * k; ty = ib - k < 5 ? ib - k : 5; }
        else { const int kk = k - (ib + 1); int far; if (ib) { rc = (r + 1 + (kk >> 1)) & 3; far = 1 - (kk & 1); } else { rc = (r + 1 + kk) & 3; far = 0; } j0 = i0 - 32 * far; ty = (r > rc ? 6 : 8) + far; } };
    unsigned voff[8];
#pragma unroll
    for (int it = 0; it < 8; ++it) { const unsigned row = 4 * it + (lane >> 4); voff[it] = row * 3072u + (((unsigned)lane & 15u) ^ swz_b(row)) * 16u; }
    const unsigned qi = (lane & 15) >> 2, pp = lane & 3, g16 = (lane >> 4) & 1;
    const unsigned swl = 16u * swz_b((unsigned)q), rowb_l = 256u * (unsigned)q;
    unsigned rk[8];
#pragma unroll
    for (int ks = 0; ks < 8; ++ks) rk[ks] = rowb_l + ((unsigned)(32 * ks + 16 * hh) ^ swl);
    unsigned tp[2];
#pragma unroll
    for (int t = 0; t < 2; ++t) tp[t] = 2048u * t + 1024u * hh + 256u * qi + 8u * (pp & 1) + 16u * ((2u * g16 + (pp >> 1)) ^ ((2u * t + hh) & 3u));
    const unsigned char* kbase = (const unsigned char*)(KB + rowb * 1536 + h * 128); const unsigned char* vbase = (const unsigned char*)(VB + rowb * 1536 + h * 128);
    { int rc, j0, ty; tile_of(0, rc, j0, ty);
      att_dma_tile(kbase + (size_t)(rc * 512 + j0) * 3072, voff, Kt);
      att_dma_tile(vbase + (size_t)(rc * 512 + j0) * 3072, voff, Vt); }
    for (int k = 0; k < nt; ++k) {
        int rc, j0, ty; tile_of(k, rc, j0, ty);
        const bool has_next = k + 1 < nt; int rcn = 0, j0n = 0, tyn = 0; if (has_next) tile_of(k + 1, rcn, j0n, tyn);
        const u32x4 bw0 = *(const LAS u32x4*)(lut + ty * 2048 + lane * 16), bw1 = *(const LAS u32x4*)(lut + ty * 2048 + 1024 + lane * 16);
        asm volatile("s_waitcnt vmcnt(8)" ::: "memory");
        bf16x8 kf[8];
#pragma unroll
        for (int ks = 0; ks < 8; ++ks) kf[ks] = lds_b128(Kt + rk[ks]);
        asm volatile("s_waitcnt lgkmcnt(0)" ::: "memory");
        if (has_next) att_dma_tile(kbase + (size_t)(rcn * 512 + j0n) * 3072, voff, Kt);
        f32x16 s;
#pragma unroll
        for (int e = 0; e < 16; ++e) s[e] = 0.f;
#pragma unroll
        for (int ks = 0; ks < 8; ++ks) s = MFMA32(kf[ks], qf[ks], s);
        s[0] += bf_lo(bw0.x); s[1] += bf_hi(bw0.x); s[2] += bf_lo(bw0.y); s[3] += bf_hi(bw0.y); s[4] += bf_lo(bw0.z); s[5] += bf_hi(bw0.z); s[6] += bf_lo(bw0.w); s[7] += bf_hi(bw0.w);
        s[8] += bf_lo(bw1.x); s[9] += bf_hi(bw1.x); s[10] += bf_lo(bw1.y); s[11] += bf_hi(bw1.y); s[12] += bf_lo(bw1.z); s[13] += bf_hi(bw1.z); s[14] += bf_lo(bw1.w); s[15] += bf_hi(bw1.w);
        float mx = fmaxf(fmaxf(fmaxf(s[0], s[1]), fmaxf(s[2], s[3])), fmaxf(fmaxf(s[4], s[5]), fmaxf(s[6], s[7])));
        mx = fmaxf(mx, fmaxf(fmaxf(fmaxf(s[8], s[9]), fmaxf(s[10], s[11])), fmaxf(fmaxf(s[12], s[13]), fmaxf(s[14], s[15]))));
        mx = fmaxf(mx, __shfl_xor(mx, 32));
        const float mnew = fmaxf(mrun, mx), alpha = __builtin_amdgcn_exp2f(mrun - mnew);
        float ps = 0.f;
#pragma unroll
        for (int e = 0; e < 16; ++e) { s[e] = __builtin_amdgcn_exp2f(s[e] - mnew); ps += s[e]; }
        lsum = lsum * alpha + ps;
        if (__any(mnew > mrun)) {
#pragma unroll
            for (int c = 0; c < 4; ++c)
#pragma unroll
                for (int e = 0; e < 16; ++e) o[c][e] *= alpha;
        }
        mrun = mnew;
        const bf16x8 pf0 = pack8(s[0], s[1], s[2], s[3], s[4], s[5], s[6], s[7]), pf1 = pack8(s[8], s[9], s[10], s[11], s[12], s[13], s[14], s[15]);
        if (has_next) asm volatile("s_waitcnt vmcnt(8)" ::: "memory"); else asm volatile("s_waitcnt vmcnt(0)" ::: "memory");
        bf16x8 vf[4][2];
#pragma unroll
        for (int c = 0; c < 4; ++c)
#pragma unroll
            for (int s2 = 0; s2 < 2; ++s2) {
                const unsigned xc = 64u * ((unsigned)c ^ qi);
                const s16x4 lo = lds_tr(Vt + 4096 * s2 + tp[0] + xc);
                const s16x4 hi = lds_tr(Vt + 4096 * s2 + tp[1] + xc);
                vf[c][s2] = __builtin_shufflevector(lo, hi, 0, 1, 2, 3, 4, 5, 6, 7);
            }
        asm volatile("s_waitcnt lgkmcnt(0)" ::: "memory");
        if (has_next) att_dma_tile(vbase + (size_t)(rcn * 512 + j0n) * 3072, voff, Vt);
#pragma unroll
        for (int c = 0; c < 4; ++c) { o[c] = MFMA32(vf[c][0], pf0, o[c]); o[c] = MFMA32(vf[c][1], pf1, o[c]); }
    }
    lsum += __shfl_xor(lsum, 32);
    const float inv = 1.0f / lsum;
#pragma unroll
    for (int c = 0; c < 4; ++c)
#pragma unroll
        for (int g = 0; g < 4; ++g) {
            u32x2 w; w.x = cvtpk(o[c][4 * g] * inv, o[c][4 * g + 1] * inv); w.y = cvtpk(o[c][4 * g + 2] * inv, o[c][4 * g + 3] * inv);
            *(LAS u32x2*)(Kt + rowb_l + ((unsigned)(16 * (4 * c + g)) ^ swl) + 8u * hh) = w;
        }
    asm volatile("s_waitcnt lgkmcnt(0)" ::: "memory");
    {
        unsigned char* ob = (unsigned char*)(MIX + ((size_t)b * 2048 + 4 * i0 + r) * 2048 + h * 128);
#pragma unroll
        for (int it = 0; it < 8; ++it) {
            const unsigned row = 4 * it + (lane >> 4), ch = lane & 15;
            const u32x4 v = *(const LAS u32x4*)(Kt + off_b(row, ch));
            *(GAS u32x4*)(ob + (size_t)row * 16384 + ch * 16) = v;
        }
    }
    asm volatile("s_waitcnt lgkmcnt(0)" ::: "memory");
}
constexpr int CV_NB1 = DM / 32, CV_NB2 = UPW / 32, CV_NB3 = DM / 32, CV_I1 = (DM / 64) * CV_NB1, CV_I2 = (DM / 64) * CV_NB2, CV_I3 = (DFF / 64) * CV_NB3;
constexpr int CV_EARLY = 0;
DI void convert_range(Frame& F, LAS float* scr, const float* w_out, const float* w_up, const float* g2, const float* w_down, int lo, int hi, int cw0, int cwn) {
    bf16* Wout = (bf16*)(F.ws + WS_WOUT); bf16* Wup = (bf16*)(F.ws + WS_WUP); bf16* Wdn = (bf16*)(F.ws + WS_WDN);
    auto clampi = [](int v, int a, int b) { return v < a ? a : (v > b ? b : v); };
    { const int a = clampi(lo, 0, CV_I1), b = clampi(hi, 0, CV_I1); if (b > a) transpose_items<1, false, true>(w_out, nullptr, DM, DM, Wout, scr, a + cw0, cwn, b, CV_NB1, F.lane); }
    { const int a = clampi(lo - CV_I1, 0, CV_I2), b = clampi(hi - CV_I1, 0, CV_I2); if (b > a) transpose_items<2, true, true>(w_up, g2, DM, UPW, Wup, scr, a + cw0, cwn, b, CV_NB2, F.lane); }
    { const int a = clampi(lo - CV_I1 - CV_I2, 0, CV_I3), b = clampi(hi - CV_I1 - CV_I2, 0, CV_I3); if (b > a) transpose_items<3, false, true>(w_down, nullptr, DFF, DM, Wdn, scr, a + cw0, cwn, b, CV_NB3, F.lane); }
}
constexpr int ML_SPLIT = 11;
constexpr int ML_WGS = 2 * BATCH * NMH;
DI void attn_phase(Frame& F, int qword0, const float* w_out, const float* w_up, const float* g2, const float* w_down, bool skip_conv) {
    const bf16* QB = (const bf16*)(F.ws + WS_QB); const bf16* KB = (const bf16*)(F.ws + WS_KB); const bf16* VB = (const bf16*)(F.ws + WS_VB); bf16* MIX = (bf16*)(F.ws + WS_MIX);
    LAS unsigned char* wl = F.lds + RING_OFF + F.wave * 16384; LAS unsigned char* lut = F.lds + SCR_OFF;
    att_build_lut(lut, F.tid);
    __syncthreads();
    constexpr int NCW = 3;
    if (F.wave >= NWAVES - NCW && !skip_conv)
        convert_range(F, (LAS float*)wl, w_out, w_up, g2, w_down, F.G == 256 ? CV_EARLY : 0, CV_I1 + CV_I2 + CV_I3, ((int)blockIdx.x - ML_WGS) * NCW + (F.wave - (NWAVES - NCW)), (F.G - ML_WGS) * NCW);
    int qsel = (int)(xb_xcc_id() & 7u);
    for (int tries = 0; tries < 8;) {
        unsigned u = 0; if (F.lane == 0) u = xb_add((unsigned*)(F.ctl + qword0 + 64 * qsel), 1u);
        u = (unsigned)__builtin_amdgcn_readfirstlane((int)u);
        if (u >= 768u) { qsel = (qsel + 1) & 7; ++tries; continue; }
        const int pair = u >> 4, ib = 15 - (u & 15), bh = qsel * 12 + (pair >> 2), r = pair & 3;
        attn_unit(bh / 12, bh % 12, r, ib, QB, KB, VB, MIX, wl, lut, F.lane);
    }
}

DI float scan_add64(float v, int lane) {
#pragma unroll
    for (int d = 1; d < 64; d <<= 1) { const float t = __shfl_up(v, d); if (lane >= d) v += t; }
    return v;
}
DI float scan_max64(float v, int lane) {
#pragma unroll
    for (int d = 1; d < 64; d <<= 1) { const float t = __shfl_up(v, d); if (lane >= d) v = fmaxf(v, t); }
    return v;
}
DI float silu_f(float y) { return y * __builtin_amdgcn_rcpf(1.0f + __builtin_amdgcn_exp2f(-LOG2E * y)); }
DI void mixer_prepass(Frame& F, const float* mcw, const float* mcb) {
    const bf16* ML = (const bf16*)(F.ws + WS_ML); bf16* MLC = (bf16*)(F.ws + WS_MLC); const float* G = (const float*)(F.ws + WS_G); float* GA = (float*)(F.ws + WS_GA);
    const int gw = F.vcu * NWAVES + F.wave, NGW = F.G * NWAVES;
    for (int it = gw; it < 32 * 16; it += NGW) {
        const int seq = it >> 4, ch = it & 15, b = seq >> 2, hm = seq & 3; const size_t mrow0 = (size_t)b * 2048 + ch * 128;
        const float gi0 = G[(mrow0 + F.lane) * 8 + hm], gf0 = G[(mrow0 + F.lane) * 8 + 4 + hm], gi1 = G[(mrow0 + 64 + F.lane) * 8 + hm], gf1 = G[(mrow0 + 64 + F.lane) * 8 + 4 + hm];
        const float lf0 = fminf(gf0, 0.f) - log1pf(expf(-fabsf(gf0))), lf1 = fminf(gf1, 0.f) - log1pf(expf(-fabsf(gf1)));
        const float b0 = scan_add64(lf0, F.lane); const float tot0 = __shfl(b0, 63); const float b1 = scan_add64(lf1, F.lane) + tot0;
        const float a0 = gi0 - b0, a1 = gi1 - b1;
        const float cm0 = scan_max64(a0, F.lane); const float M0 = __shfl(cm0, 63); const float cm1 = fmaxf(scan_max64(a1, F.lane), M0);
        float* o = GA + (size_t)it * 384;
        o[F.lane] = b0; o[64 + F.lane] = b1; o[128 + F.lane] = a0; o[192 + F.lane] = a1; o[256 + F.lane] = cm0; o[320 + F.lane] = cm1;
    }
    for (int it = gw * 64 + F.lane; it < (M / 4) * 128; it += NGW * 64) {
        const int c8 = it & 127, r4 = it >> 7, m0 = 4 * r4, t0 = m0 & 2047, ch0 = 8 * c8;
        u32x4 raw[7];
#pragma unroll
        for (int i = 0; i < 7; ++i) { u32x4 rv = *(const GAS u32x4*)(ML + (size_t)(m0 - 3 + i) * 2048 + ch0); if (t0 - 3 + i < 0) rv = (u32x4){0u, 0u, 0u, 0u}; raw[i] = rv; }
        float wt[5][8];
#pragma unroll
        for (int tap = 0; tap < 5; ++tap) { const float* wp = tap < 4 ? mcw + tap * 1024 + ch0 : mcb + ch0; const f32x4 a = *(const f32x4*)wp, bq = *(const f32x4*)(wp + 4);
            wt[tap][0] = a[0]; wt[tap][1] = a[1]; wt[tap][2] = a[2]; wt[tap][3] = a[3]; wt[tap][4] = bq[0]; wt[tap][5] = bq[1]; wt[tap][6] = bq[2]; wt[tap][7] = bq[3]; }
        const float osc = ch0 >= 512 ? 0.08838834764831845f : 1.0f;
#pragma unroll
        for (int rho = 0; rho < 4; ++rho) {
            float y[8];
#pragma unroll
            for (int j = 0; j < 8; ++j) y[j] = wt[4][j];
#pragma unroll
            for (int tap = 0; tap < 4; ++tap) { const u32x4 x = raw[rho + tap];
                y[0] += wt[tap][0] * bf_lo(x.x); y[1] += wt[tap][1] * bf_hi(x.x); y[2] += wt[tap][2] * bf_lo(x.y); y[3] += wt[tap][3] * bf_hi(x.y);
                y[4] += wt[tap][4] * bf_lo(x.z); y[5] += wt[tap][5] * bf_hi(x.z); y[6] += wt[tap][6] * bf_lo(x.w); y[7] += wt[tap][7] * bf_hi(x.w); }
#pragma unroll
            for (int j = 0; j < 8; ++j) y[j] = silu_f(y[j]) * osc;
            *(GAS bf16x8*)(MLC + (size_t)(m0 + rho) * 1024 + ch0) = pack8(y[0], y[1], y[2], y[3], y[4], y[5], y[6], y[7]);
        }
    }
}

constexpr int ML_Q = 0, ML_K = 32768, ML_V = 65536, ML_C = 98304;
constexpr int MS_A = 0, MS_U = 512, MS_WI = 1024, MS_WK = 1536, MS_EM = 2048, MS_NV = 2560, MS_GV = 3072, MS_CW = 3584, MS_NR = 8704, MS_RS = 12800, MS_SC = 13824;
DI void mlstm_seq(Frame& F, int b, int hm, const float* mng, int c0, int c1) {
    LAS unsigned char* L = F.lds + RING_OFF; LAS unsigned char* S = F.lds + SCR_OFF;
    LAS float* A_ = (LAS float*)(S + MS_A); LAS float* U_ = (LAS float*)(S + MS_U); LAS float* WI = (LAS float*)(S + MS_WI); LAS float* WK = (LAS float*)(S + MS_WK); LAS float* EM = (LAS float*)(S + MS_EM);
    LAS float* NV = (LAS float*)(S + MS_NV); LAS float* GV = (LAS float*)(S + MS_GV); LAS float* CW = (LAS float*)(S + MS_CW); LAS float* NR = (LAS float*)(S + MS_NR); LAS float* RS = (LAS float*)(S + MS_RS); LAS float* SC = (LAS float*)(S + MS_SC);
    const int w = F.wave;
    const bf16* ML = (const bf16*)(F.ws + WS_ML); const bf16* MLC = (const bf16*)(F.ws + WS_MLC); const float* GA = (const float*)(F.ws + WS_GA) + (size_t)(b * 4 + hm) * 16 * 384; bf16* MIX = (bf16*)(F.ws + WS_MIX);
    if (F.tid < 128) { GV[F.tid] = mng[hm * 128 + F.tid]; NV[F.tid] = 0.f; }
    for (int i = F.tid; i < 32768 / 16; i += 512) *(LAS u32x4*)(L + ML_C + 16 * i) = (u32x4){0u, 0u, 0u, 0u};
    f32x16 Cacc[2];
#pragma unroll
    for (int i = 0; i < 2; ++i)
#pragma unroll
        for (int e = 0; e < 16; ++e) Cacc[i][e] = 0.f;
    float mc = 0.f;
    const int tb = (w & 3) ^ (3 * (w >> 2)), eh = w >> 2;
    const int ebF = w >> 1, dbF0 = 2 * (w & 1);
#define ML_BAR() do { asm volatile("s_waitcnt lgkmcnt(0)" ::: "memory"); __builtin_amdgcn_s_barrier(); asm volatile("" ::: "memory"); } while (0)
#define ML_OPAQUE_TID(name) int name = F.tid; asm volatile("" : "+v"(name))
#define ML_THREAD_MAP(tidv) const int c16 = (tidv) & 15, rg = (tidv) >> 4; const unsigned rg16 = 16u * rg, c32 = 32u * c16; unsigned sa[4]; \
        _Pragma("unroll") for (int rho = 0; rho < 4; ++rho) sa[rho] = 1024u * rg + 256u * rho + 64u * (((unsigned)c16 >> 2) ^ (unsigned)rho) + 16u * (((unsigned)c16 & 3u) ^ ((unsigned)rg & 3u))
#define ML_LANE_MAP(tidv) const int lane = (tidv) & 63, hh = lane >> 5, l31 = lane & 31; const unsigned qi = (lane & 15) >> 2, pp = lane & 3, g16 = (lane >> 4) & 1; \
        const unsigned swl_ = 16u * swz_b((unsigned)l31), rowb_ = 256u * (unsigned)l31, hh8 = 8u * hh, hh16 = 16u * hh; unsigned tn[2], tp[2]; \
        _Pragma("unroll") for (int t = 0; t < 2; ++t) { tn[t] = 2048u * hh + 1024u * t + 256u * qi + 8u * (pp & 1) + 16u * ((2u * g16 + (pp >> 1)) ^ ((2u * hh + t) & 3u)); \
                                                       tp[t] = 2048u * t + 1024u * hh + 256u * qi + 8u * (pp & 1) + 16u * ((2u * g16 + (pp >> 1)) ^ ((2u * t + hh) & 3u)); }
#define SF(off) (*(LAS float*)(S + (off)))
#define SF4(off) (*(const LAS f32x4*)(S + (off)))
    u32x4 rq[4], rk_[4], rv4[4]; float pgt[6] = {0.f, 0.f, 0.f, 0.f, 0.f, 0.f};
    {
        const int c16 = F.tid & 15, rg = F.tid >> 4;
        const unsigned char* cq0 = (const unsigned char*)MLC + (size_t)b * 2048 * 2048 + 8192u * rg + 256u * hm + 16u * c16;
        const unsigned char* cv0 = (const unsigned char*)ML + (size_t)b * 2048 * 4096 + 16384u * rg + 2048 + 256u * hm + 16u * c16;
#pragma unroll
        for (int rho = 0; rho < 4; ++rho) { rk_[rho] = *(const GAS u32x4*)(cq0 + rho * 2048 + 1024); rv4[rho] = *(const GAS u32x4*)(cv0 + rho * 4096); }
        if (w == 0) {
#pragma unroll
            for (int i = 0; i < 6; ++i) pgt[i] = GA[64 * i + F.lane]; }
    }
    __syncthreads();
    for (int ch = 0; ch < c0; ++ch) {
        {
        ML_OPAQUE_TID(tidA); ML_THREAD_MAP(tidA);
#pragma unroll
        for (int rho = 0; rho < 4; ++rho) { *(LAS u32x4*)(lp(sa[rho]) + ML_K) = rk_[rho]; *(LAS u32x4*)lp(sa[rho] + ML_V) = rv4[rho]; }
        }
        if (w == 0) {
            ML_OPAQUE_TID(tidB); const int lane = tidB & 63; const unsigned l4 = 4u * lane;
            const float b1 = pgt[1], a0 = pgt[2], a1 = pgt[3], cm1 = pgt[5];
            const float Mall = __shfl(cm1, 63), blast = __shfl(b1, 63), mxa = fmaxf(mc, Mall);
            SF(MS_WK + l4) = __builtin_amdgcn_exp2f(LOG2E * (a0 - mxa)); SF(MS_WK + 256 + l4) = __builtin_amdgcn_exp2f(LOG2E * (a1 - mxa));
            if (lane == 0) SC[0] = __builtin_amdgcn_exp2f(LOG2E * (mc - mxa));
            mc = blast + mxa;
        }
        ML_BAR();
        {
            ML_OPAQUE_TID(tidP); const int c16 = tidP & 15, rg = tidP >> 4;
            int cn = ch + 1; asm volatile("" : "+s"(cn));
            const unsigned char* cq1 = (const unsigned char*)MLC + ((size_t)b * 2048 + cn * 128) * 2048 + 8192u * rg + 256u * hm + 16u * c16;
            const unsigned char* cv1 = (const unsigned char*)ML + ((size_t)b * 2048 + cn * 128) * 4096 + 16384u * rg + 2048 + 256u * hm + 16u * c16;
#pragma unroll
            for (int rho = 0; rho < 4; ++rho) { rk_[rho] = *(const GAS u32x4*)(cq1 + rho * 2048 + 1024); rv4[rho] = *(const GAS u32x4*)(cv1 + rho * 4096); }
            if (w == 0) { const float* ga1 = GA + cn * 384 + (tidP & 63);
#pragma unroll
                for (int i = 0; i < 6; ++i) pgt[i] = ga1[64 * i]; }
        }
        {
            ML_OPAQUE_TID(tidK); ML_THREAD_MAP(tidK); const int lane = tidK & 63;
            float ps[8] = {0.f, 0.f, 0.f, 0.f, 0.f, 0.f, 0.f, 0.f};
#pragma unroll
            for (int rho = 0; rho < 4; ++rho) {
                const float wk = SF(MS_WK + 4 * rho + rg16); const u32x4 kk = *(const LAS u32x4*)(lp(sa[rho]) + ML_K);
                const float v0 = bf_lo(kk.x) * wk, v1 = bf_hi(kk.x) * wk, v2 = bf_lo(kk.y) * wk, v3 = bf_hi(kk.y) * wk, v4 = bf_lo(kk.z) * wk, v5 = bf_hi(kk.z) * wk, v6 = bf_lo(kk.w) * wk, v7 = bf_hi(kk.w) * wk;
                ps[0] += v0; ps[1] += v1; ps[2] += v2; ps[3] += v3; ps[4] += v4; ps[5] += v5; ps[6] += v6; ps[7] += v7;
                *(LAS bf16x8*)(lp(sa[rho]) + ML_Q) = pack8(v0, v1, v2, v3, v4, v5, v6, v7);
            }
#pragma unroll
            for (int j = 0; j < 8; ++j) { ps[j] += __shfl_xor(ps[j], 16); ps[j] += __shfl_xor(ps[j], 32); }
            if ((lane >> 4) == 0) {
#pragma unroll
                for (int j = 0; j < 8; ++j) SF(MS_NR + 512 * w + 4 * j + c32) = ps[j];
            }
        }
        ML_BAR();
        {
        const float decay = SC[0];
        ML_OPAQUE_TID(tidF); const unsigned t4 = 4u * tidF;
        if (tidF < 128) { float a = 0.f;
#pragma unroll
            for (int ww = 0; ww < 8; ++ww) a += SF(MS_NR + 512 * ww + t4);
            SF(MS_NV + t4) = decay * SF(MS_NV + t4) + a; }
#pragma unroll
        for (int i = 0; i < 2; ++i)
#pragma unroll
            for (int e = 0; e < 16; ++e) Cacc[i][e] *= decay;
        ML_LANE_MAP(tidF);
        const unsigned xc_eF = 64u * ((unsigned)ebF ^ qi), xc_d0 = 64u * ((unsigned)dbF0 ^ qi), xc_d1 = 64u * ((unsigned)(dbF0 + 1) ^ qi);
        const unsigned aF0 = ML_V + tn[0] + xc_eF, aF1 = ML_V + tn[1] + xc_eF, aK00 = ML_Q + tn[0] + xc_d0, aK01 = ML_Q + tn[1] + xc_d0, aK10 = ML_Q + tn[0] + xc_d1, aK11 = ML_Q + tn[1] + xc_d1;
        bf16x8 af[8];
#pragma unroll
        for (int ks = 0; ks < 8; ++ks) { const s16x4 alo = lds_tr(lp(aF0) + 4096 * ks), ahi = lds_tr(lp(aF1) + 4096 * ks); af[ks] = __builtin_shufflevector(alo, ahi, 0, 1, 2, 3, 4, 5, 6, 7); }
#pragma unroll
        for (int i = 0; i < 2; ++i) {
            bf16x8 bk[8];
#pragma unroll
            for (int ks = 0; ks < 8; ++ks) { const s16x4 blo = lds_tr(lp(i ? aK10 : aK00) + 4096 * ks), bhi = lds_tr(lp(i ? aK11 : aK01) + 4096 * ks); bk[ks] = __builtin_shufflevector(blo, bhi, 0, 1, 2, 3, 4, 5, 6, 7); }
#pragma unroll
            for (int ks = 0; ks < 8; ++ks) Cacc[i] = MFMA32(af[ks], bk[ks], Cacc[i]);
        }
        }
        ML_BAR();
    }
    if (c0 > 0) {
        ML_OPAQUE_TID(tidW); ML_LANE_MAP(tidW);
#pragma unroll
        for (int i = 0; i < 2; ++i)
#pragma unroll
            for (int g = 0; g < 4; ++g) {
                u32x2 wv; wv.x = cvtpk(Cacc[i][4 * g], Cacc[i][4 * g + 1]); wv.y = cvtpk(Cacc[i][4 * g + 2], Cacc[i][4 * g + 3]);
                *(LAS u32x2*)lp(rowb_ + ((unsigned)(16 * (4 * ebF + g)) ^ swl_) + hh8 + ML_C + 8192u * (dbF0 + i)) = wv;
            }
    }
    {
        const int c16 = F.tid & 15, rg = F.tid >> 4;
        const unsigned char* cq0 = (const unsigned char*)MLC + ((size_t)b * 2048 + c0 * 128) * 2048 + 8192u * rg + 256u * hm + 16u * c16;
#pragma unroll
        for (int rho = 0; rho < 4; ++rho) rq[rho] = *(const GAS u32x4*)(cq0 + rho * 2048);
    }
    __syncthreads();
    for (int ch = c0; ch < c1; ++ch) {
        int t0 = ch * 128; asm volatile("" : "+s"(t0));
        const size_t mrow0 = (size_t)b * 2048 + t0;
        const unsigned char* cb0 = (const unsigned char*)ML + mrow0 * 4096;
        unsigned char* mb0 = (unsigned char*)MIX + mrow0 * 4096;
        {
        ML_OPAQUE_TID(tidA); ML_THREAD_MAP(tidA);
#pragma unroll
        for (int rho = 0; rho < 4; ++rho) { *(LAS u32x4*)(lp(sa[rho]) + ML_Q) = rq[rho]; *(LAS u32x4*)(lp(sa[rho]) + ML_K) = rk_[rho]; *(LAS u32x4*)lp(sa[rho] + ML_V) = rv4[rho]; }
        }
        __builtin_amdgcn_sched_barrier(0);
        if (w == 0) {
            ML_OPAQUE_TID(tidB); const int lane = tidB & 63; const unsigned l4 = 4u * lane;
            const float b0 = pgt[0], b1 = pgt[1], a0 = pgt[2], a1 = pgt[3], cm0 = pgt[4], cm1 = pgt[5];
            const float mx0 = fmaxf(mc, cm0), mx1 = fmaxf(mc, cm1);
            SF(MS_A + l4) = a0; SF(MS_A + 256 + l4) = a1; SF(MS_U + l4) = -mx0; SF(MS_U + 256 + l4) = -mx1;
            SF(MS_WI + l4) = __builtin_amdgcn_exp2f(LOG2E * (mc - mx0)); SF(MS_WI + 256 + l4) = __builtin_amdgcn_exp2f(LOG2E * (mc - mx1));
            SF(MS_EM + l4) = __builtin_amdgcn_exp2f(-LOG2E * (b0 + mx0)); SF(MS_EM + 256 + l4) = __builtin_amdgcn_exp2f(-LOG2E * (b1 + mx1));
            const float Mall = __shfl(cm1, 63), blast = __shfl(b1, 63), mxa = fmaxf(mc, Mall);
            SF(MS_WK + l4) = __builtin_amdgcn_exp2f(LOG2E * (a0 - mxa)); SF(MS_WK + 256 + l4) = __builtin_amdgcn_exp2f(LOG2E * (a1 - mxa));
            if (lane == 0) SC[0] = __builtin_amdgcn_exp2f(LOG2E * (mc - mxa));
            mc = blast + mxa;
        }
        ML_BAR();
        ML_OPAQUE_TID(tidC); ML_LANE_MAP(tidC);
        const unsigned tq4 = 4u * (32u * tb + l31);
        const unsigned voffO = 4096u * (32u * tb + l31) + 3072u + 256u * hm + 128u * eh + 8u * hh;
        unsigned rk[8];
#pragma unroll
        for (int ks = 0; ks < 8; ++ks) rk[ks] = rowb_ + ((unsigned)(32 * ks + 2 * hh8) ^ swl_);
        const unsigned xc_e0 = 64u * ((unsigned)(2 * eh) ^ qi), xc_e1 = 64u * ((unsigned)(2 * eh + 1) ^ qi);
        const unsigned aC00 = ML_C + tn[0] + xc_e0, aC01 = ML_C + tn[1] + xc_e0, aC10 = ML_C + tn[0] + xc_e1, aC11 = ML_C + tn[1] + xc_e1;
        const unsigned aV00 = ML_V + tp[0] + xc_e0, aV01 = ML_V + tp[1] + xc_e0, aV10 = ML_V + tp[0] + xc_e1, aV11 = ML_V + tp[1] + xc_e1;
        __builtin_amdgcn_sched_barrier(0);
        const int tq = 32 * tb + l31;
        const unsigned qoff = ML_Q + 8192u * tb;
        const float ut = SF(MS_U + tq4), wint = SF(MS_WI + tq4), emt = SF(MS_EM + tq4);
        bf16x8 qf[8];
#pragma unroll
        for (int ks = 0; ks < 8; ++ks) qf[ks] = lds_b128(lp(rk[ks] + qoff));
        f32x16 acc[2];
#pragma unroll
        for (int c = 0; c < 2; ++c) {
            __builtin_amdgcn_sched_barrier(0);
            bf16x8 cf[8];
#pragma unroll
            for (int ks = 0; ks < 8; ++ks) {
                const s16x4 lo = lds_tr(lp(c ? aC10 : aC00) + 4096 * ks);
                const s16x4 hi = lds_tr(lp(c ? aC11 : aC01) + 4096 * ks);
                cf[ks] = __builtin_shufflevector(lo, hi, 0, 1, 2, 3, 4, 5, 6, 7);
            }
#pragma unroll
            for (int e = 0; e < 16; ++e) acc[c][e] = 0.f;
#pragma unroll
            for (int ks = 0; ks < 8; ++ks) acc[c] = MFMA32(cf[ks], qf[ks], acc[c]);
#pragma unroll
            for (int e = 0; e < 16; ++e) acc[c][e] *= wint;
        }
        float qn = 0.f;
#pragma unroll
        for (int ks = 0; ks < 8; ++ks) { const f32x4 n0 = SF4(MS_NV + 64 * ks + 2 * hh16), n1 = SF4(MS_NV + 64 * ks + 16 + 2 * hh16); const u32x4 qq = __builtin_bit_cast(u32x4, qf[ks]);
            qn += bf_lo(qq.x) * n0[0] + bf_hi(qq.x) * n0[1] + bf_lo(qq.y) * n0[2] + bf_hi(qq.y) * n0[3] + bf_lo(qq.z) * n1[0] + bf_hi(qq.z) * n1[1] + bf_lo(qq.w) * n1[2] + bf_hi(qq.w) * n1[3]; }
        __builtin_amdgcn_sched_barrier(0);
        u32x4 og[4];
        { ML_OPAQUE_TID(tidO); const unsigned char* co = cb0 + 3072 + 256u * hm + 16384u * (tidO >> 4) + 16u * (tidO & 15);
#pragma unroll
          for (int rho = 0; rho < 4; ++rho) og[rho] = *(const GAS u32x4*)(co + rho * 4096); }
        float sumP = 0.f;
#pragma unroll
        for (int sb = 0; sb < 4; ++sb) {
            if (sb <= tb) {
                __builtin_amdgcn_sched_barrier(0);
                f32x16 s; bf16x8 kf[8];
#pragma unroll
                for (int e = 0; e < 16; ++e) s[e] = 0.f;
#pragma unroll
                for (int ks = 0; ks < 8; ++ks) kf[ks] = lds_b128(lp(rk[ks]) + ML_K + 8192 * sb);
#pragma unroll
                for (int ks = 0; ks < 8; ++ks) s = MFMA32(kf[ks], qf[ks], s);
#pragma unroll
                for (int g = 0; g < 4; ++g) { const f32x4 av = SF4(MS_A + 4 * (32 * sb + 8 * g) + hh16);
#pragma unroll
                    for (int j = 0; j < 4; ++j) { const int e = 4 * g + j; float p = s[e] * __builtin_amdgcn_exp2f(LOG2E * (ut + av[j])); if (sb == tb && crow(e, hh) > l31) p = 0.f; s[e] = p; sumP += p; } }
                const bf16x8 pf0 = pack8(s[0], s[1], s[2], s[3], s[4], s[5], s[6], s[7]), pf1 = pack8(s[8], s[9], s[10], s[11], s[12], s[13], s[14], s[15]);
                __builtin_amdgcn_sched_barrier(0);
                bf16x8 vf[2][2];
#pragma unroll
                for (int c = 0; c < 2; ++c)
#pragma unroll
                    for (int s2 = 0; s2 < 2; ++s2) {
                        const s16x4 lo = lds_tr(lp(c ? aV10 : aV00) + 8192 * sb + 4096 * s2);
                        const s16x4 hi = lds_tr(lp(c ? aV11 : aV01) + 8192 * sb + 4096 * s2);
                        vf[c][s2] = __builtin_shufflevector(lo, hi, 0, 1, 2, 3, 4, 5, 6, 7);
                    }
#pragma unroll
                for (int c = 0; c < 2; ++c) { acc[c] = MFMA32(vf[c][0], pf0, acc[c]); acc[c] = MFMA32(vf[c][1], pf1, acc[c]); }
            }
        }
        qn += __shfl_xor(qn, 32); sumP += __shfl_xor(sumP, 32);
        const float den = wint * qn + sumP, rden = 1.0f / fmaxf(fabsf(den), emt);
        __builtin_amdgcn_sched_barrier(0);
        ML_BAR();
#pragma unroll
        for (int c = 0; c < 2; ++c)
#pragma unroll
            for (int g = 0; g < 4; ++g) {
                u32x2 wv; wv.x = cvtpk(acc[c][4 * g] * rden, acc[c][4 * g + 1] * rden); wv.y = cvtpk(acc[c][4 * g + 2] * rden, acc[c][4 * g + 3] * rden);
                *(LAS u32x2*)lp(ML_Q + 8192u * tb + rowb_ + ((unsigned)(16 * (4 * (2 * eh + c) + g)) ^ swl_) + hh8) = wv;
            }
        ML_BAR();
        {
            ML_OPAQUE_TID(tidE); ML_THREAD_MAP(tidE);
            const f32x4 g0 = SF4(MS_GV + c32), g1v = SF4(MS_GV + 16 + c32);
            unsigned char* mo = mb0 + 3072 + 256u * hm + 16384u * rg + 16u * c16;
#pragma unroll
            for (int rho = 0; rho < 4; ++rho) {
                const u32x4 hv = *(const LAS u32x4*)(lp(sa[rho]) + ML_Q); const u32x4 ov = og[rho];
                float h[8] = {bf_lo(hv.x), bf_hi(hv.x), bf_lo(hv.y), bf_hi(hv.y), bf_lo(hv.z), bf_hi(hv.z), bf_lo(hv.w), bf_hi(hv.w)};
                const float o[8] = {bf_lo(ov.x), bf_hi(ov.x), bf_lo(ov.y), bf_hi(ov.y), bf_lo(ov.z), bf_hi(ov.z), bf_lo(ov.w), bf_hi(ov.w)};
                float ssq = 0.f;
#pragma unroll
                for (int j = 0; j < 8; ++j) { h[j] *= __builtin_amdgcn_rcpf(1.0f + __builtin_amdgcn_exp2f(-LOG2E * o[j])); ssq += h[j] * h[j]; }
                ssq += __shfl_xor(ssq, 1); ssq += __shfl_xor(ssq, 2); ssq += __shfl_xor(ssq, 4); ssq += __shfl_xor(ssq, 8);
                const float rstd = 1.0f / sqrtf(ssq * (1.0f / 128.0f) + 1e-6f);
                u32x4 wv; wv.x = cvtpk(h[0] * rstd * g0[0], h[1] * rstd * g0[1]); wv.y = cvtpk(h[2] * rstd * g0[2], h[3] * rstd * g0[3]); wv.z = cvtpk(h[4] * rstd * g1v[0], h[5] * rstd * g1v[1]); wv.w = cvtpk(h[6] * rstd * g1v[2], h[7] * rstd * g1v[3]);
                *(GAS u32x4*)(mo + rho * 4096) = wv;
            }
        }
        __builtin_amdgcn_sched_barrier(0);
        __builtin_amdgcn_sched_barrier(0);
        {
            ML_OPAQUE_TID(tidP); const int c16 = tidP & 15, rg = tidP >> 4;
            int cn1 = (ch + 1 < c1 ? ch + 1 : ch); asm volatile("" : "+s"(cn1));
            const unsigned char* cq1 = (const unsigned char*)MLC + ((size_t)b * 2048 + cn1 * 128) * 2048 + 8192u * rg + 256u * hm + 16u * c16;
            const unsigned char* cv1 = (const unsigned char*)ML + ((size_t)b * 2048 + cn1 * 128) * 4096 + 16384u * rg + 2048 + 256u * hm + 16u * c16;
#pragma unroll
            for (int rho = 0; rho < 4; ++rho) { rk_[rho] = *(const GAS u32x4*)(cq1 + rho * 2048 + 1024); rv4[rho] = *(const GAS u32x4*)(cv1 + rho * 4096); }
        }
        __builtin_amdgcn_sched_barrier(0);
        {
            ML_OPAQUE_TID(tidK); ML_THREAD_MAP(tidK); const int lane = tidK & 63;
            float ps[8] = {0.f, 0.f, 0.f, 0.f, 0.f, 0.f, 0.f, 0.f};
#pragma unroll
            for (int rho = 0; rho < 4; ++rho) {
                const float wk = SF(MS_WK + 4 * rho + rg16); const u32x4 kk = *(const LAS u32x4*)(lp(sa[rho]) + ML_K);
                const float v0 = bf_lo(kk.x) * wk, v1 = bf_hi(kk.x) * wk, v2 = bf_lo(kk.y) * wk, v3 = bf_hi(kk.y) * wk, v4 = bf_lo(kk.z) * wk, v5 = bf_hi(kk.z) * wk, v6 = bf_lo(kk.w) * wk, v7 = bf_hi(kk.w) * wk;
                ps[0] += v0; ps[1] += v1; ps[2] += v2; ps[3] += v3; ps[4] += v4; ps[5] += v5; ps[6] += v6; ps[7] += v7;
                *(LAS bf16x8*)(lp(sa[rho]) + ML_Q) = pack8(v0, v1, v2, v3, v4, v5, v6, v7);
            }
#pragma unroll
            for (int j = 0; j < 8; ++j) { ps[j] += __shfl_xor(ps[j], 16); ps[j] += __shfl_xor(ps[j], 32); }
            if ((lane >> 4) == 0) {
#pragma unroll
                for (int j = 0; j < 8; ++j) SF(MS_NR + 512 * w + 4 * j + c32) = ps[j];
            }
        }
        ML_BAR();
        {
            ML_OPAQUE_TID(tidP2); const int c16 = tidP2 & 15, rg = tidP2 >> 4;
            int cn1 = (ch + 1 < c1 ? ch + 1 : ch); asm volatile("" : "+s"(cn1));
            const unsigned char* cq1 = (const unsigned char*)MLC + ((size_t)b * 2048 + cn1 * 128) * 2048 + 8192u * rg + 256u * hm + 16u * c16;
#pragma unroll
            for (int rho = 0; rho < 4; ++rho) rq[rho] = *(const GAS u32x4*)(cq1 + rho * 2048);
            if (w == 0) { const float* ga1 = GA + cn1 * 384 + (tidP2 & 63);
#pragma unroll
                for (int i = 0; i < 6; ++i) pgt[i] = ga1[64 * i]; }
        }
        __builtin_amdgcn_sched_barrier(0);
        const float decay = SC[0];
        ML_OPAQUE_TID(tidF); const unsigned t4 = 4u * tidF;
        if (tidF < 128) { float a = 0.f;
#pragma unroll
            for (int ww = 0; ww < 8; ++ww) a += SF(MS_NR + 512 * ww + t4);
            SF(MS_NV + t4) = decay * SF(MS_NV + t4) + a; }
#pragma unroll
        for (int i = 0; i < 2; ++i)
#pragma unroll
            for (int e = 0; e < 16; ++e) Cacc[i][e] *= decay;
        {
        ML_LANE_MAP(tidF);
        const unsigned xc_eF = 64u * ((unsigned)ebF ^ qi), xc_d0 = 64u * ((unsigned)dbF0 ^ qi), xc_d1 = 64u * ((unsigned)(dbF0 + 1) ^ qi);
        const unsigned aF0 = ML_V + tn[0] + xc_eF, aF1 = ML_V + tn[1] + xc_eF, aK00 = ML_Q + tn[0] + xc_d0, aK01 = ML_Q + tn[1] + xc_d0, aK10 = ML_Q + tn[0] + xc_d1, aK11 = ML_Q + tn[1] + xc_d1;
        unsigned cwr[4];
#pragma unroll
        for (int g = 0; g < 4; ++g) cwr[g] = rowb_ + ((unsigned)(16 * (4 * ebF + g)) ^ swl_) + hh8;
        bf16x8 af[8];
#pragma unroll
        for (int ks = 0; ks < 8; ++ks) {
            const s16x4 alo = lds_tr(lp(aF0) + 4096 * ks);
            const s16x4 ahi = lds_tr(lp(aF1) + 4096 * ks);
            af[ks] = __builtin_shufflevector(alo, ahi, 0, 1, 2, 3, 4, 5, 6, 7);
        }
#pragma unroll
        for (int i = 0; i < 2; ++i) {
            bf16x8 bk[8];
#pragma unroll
            for (int ks = 0; ks < 8; ++ks) {
                const s16x4 blo = lds_tr(lp(i ? aK10 : aK00) + 4096 * ks);
                const s16x4 bhi = lds_tr(lp(i ? aK11 : aK01) + 4096 * ks);
                bk[ks] = __builtin_shufflevector(blo, bhi, 0, 1, 2, 3, 4, 5, 6, 7);
            }
#pragma unroll
            for (int ks = 0; ks < 8; ++ks) Cacc[i] = MFMA32(af[ks], bk[ks], Cacc[i]);
        }
#pragma unroll
        for (int i = 0; i < 2; ++i)
#pragma unroll
            for (int g = 0; g < 4; ++g) {
                u32x2 wv; wv.x = cvtpk(Cacc[i][4 * g], Cacc[i][4 * g + 1]); wv.y = cvtpk(Cacc[i][4 * g + 2], Cacc[i][4 * g + 3]);
                *(LAS u32x2*)lp(cwr[g] + ML_C + 8192u * (dbF0 + i)) = wv;
            }
        }
        ML_BAR();
    }
}

DI void ffn_fixup(Frame& F, const float* cw, const float* cb) {
    const float* RAWB = (const float*)(F.ws + WS_RAW); bf16* ACT = (bf16*)(F.ws + WS_ACT);
    const int gt = (F.vcu * NWAVES + F.wave) * 64 + F.lane, NT = F.G * NWAVES * 64;
    for (int it = gt; it < 256 * 2 * (DFF / 4); it += NT) {
        const int j4 = it % (DFF / 4), rs = it / (DFF / 4), rho = rs & 1, strip = rs >> 1, j = 4 * j4;
        const int pg = (j >> 7) * 256 + (j & 127);
        const bool first = (strip & 31) == 0;
        const float* own = RAWB + (size_t)strip * 4 * UPW; const float* prv = RAWB + (size_t)(strip - 1) * 4 * UPW;
        const f32x4 z = {0.f, 0.f, 0.f, 0.f};
        f32x4 gm2, gm1, g0, vm2, vm1, v0;
        if (rho == 0) { gm2 = first ? z : *(const f32x4*)(prv + 2 * UPW + pg); gm1 = first ? z : *(const f32x4*)(prv + 3 * UPW + pg); g0 = *(const f32x4*)(own + pg);
                        vm2 = first ? z : *(const f32x4*)(prv + 2 * UPW + pg + 128); vm1 = first ? z : *(const f32x4*)(prv + 3 * UPW + pg + 128); v0 = *(const f32x4*)(own + pg + 128); }
        else { gm2 = first ? z : *(const f32x4*)(prv + 3 * UPW + pg); gm1 = *(const f32x4*)(own + pg); g0 = *(const f32x4*)(own + UPW + pg);
               vm2 = first ? z : *(const f32x4*)(prv + 3 * UPW + pg + 128); vm1 = *(const f32x4*)(own + pg + 128); v0 = *(const f32x4*)(own + UPW + pg + 128); }
        const f32x4 yg = *(const f32x4*)(cb + j) + *(const f32x4*)(cw + j) * gm2 + *(const f32x4*)(cw + UPW + j) * gm1 + *(const f32x4*)(cw + 2 * UPW + j) * g0;
        const f32x4 yv = *(const f32x4*)(cb + DFF + j) + *(const f32x4*)(cw + DFF + j) * vm2 + *(const f32x4*)(cw + UPW + DFF + j) * vm1 + *(const f32x4*)(cw + 2 * UPW + DFF + j) * v0;
        u32x2 wv; wv.x = cvtpk(silu_f(yg[0]) * yv[0], silu_f(yg[1]) * yv[1]); wv.y = cvtpk(silu_f(yg[2]) * yv[2], silu_f(yg[3]) * yv[3]);
        *(GAS u32x2*)(ACT + (size_t)(64 * strip + rho) * DFF + j) = wv;
    }
}

struct Args { const float* in[16]; float* out; unsigned char* ws; int ph_lo, ph_hi, li, pad; };
__global__ void __launch_bounds__(NWAVES * 64, 2) fwd_kernel(Args args) {
    extern __shared__ __attribute__((aligned(16))) unsigned char lds[];
    Frame F;
    F.lds = (LAS unsigned char*)lds; F.MISC = (volatile LAS unsigned*)(F.lds + MISC_OFF);
    F.tid = threadIdx.x; F.lane = F.tid & 63; F.wave = __builtin_amdgcn_readfirstlane(F.tid >> 6);
    F.G = gridDim.x; { const int bx = blockIdx.x; F.vcu = (F.G % 8 == 0) ? (bx % 8) * (F.G / 8) + bx / 8 : bx; }
    F.ws = args.ws; F.ctl = (gu32*)(args.ws + WS_CTL); F.out = args.out;
    for (int u = F.tid; u < (LDS_BYTES - LDSCTL_OFF) / 4; u += NWAVES * 64) ((LAS unsigned*)(F.lds + LDSCTL_OFF))[u] = 0u;
    __syncthreads();
    XcdBarrier bar; bar.bar = (unsigned*)(F.ctl + CW_BAR) + args.li * XCD_BAR_WORDS; bar.x = 0; bar.st = nullptr;
    if (N_LAUNCHES != PER_PHASE) bar = xcd_barrier_post((unsigned*)(F.ctl + CW_BAR) + args.li * XCD_BAR_WORDS, F.MISC + 8);
#define GRID_BAR(seam) do { if (N_LAUNCHES == PER_PHASE) { if (F.tid == 0) __hip_atomic_store(F.ctl + CW_TMO, 0xBADBA0u | (unsigned)(seam), RLX_AGENT); } else { xcd_barrier(bar); } } while (0)
    const int lo = args.ph_lo, hi = args.ph_hi;
#define IN(k) (lo <= (k) && (k) < hi)
#define BOTH(k) (IN(k) && IN((k) + 1))
    PG8_LAS float* escr = (PG8_LAS float*)(F.lds + SCR_OFF);
    if (IN(PH_PRO)) { p0_prologue(F, args.in[0], args.in[1], args.in[2]); if (BOTH(PH_PRO)) GRID_BAR(PH_PRO); }
    if (IN(PH_IN)) {
        pg8::Gemm g{(const pg8::bf16_t*)(F.ws + WS_XN), (const pg8::bf16_t*)(F.ws + WS_WIN), M, IN_WP, DM}; pg8::StaticOrder S; S.init(M, IN_WP, F.G, (int)blockIdx.x, WGM_IN);
        pg8::Epi1 E{(pg8::bf16_t*)(F.ws + WS_QB), (pg8::bf16_t*)(F.ws + WS_KB), (pg8::bf16_t*)(F.ws + WS_VB), (pg8::bf16_t*)(F.ws + WS_ML), (float*)(F.ws + WS_G), (const float*)(F.ws + WS_ROPE), args.in[3], args.in[4], args.in[7], args.in[8], escr};
        pg8::gemm_phase<pg8::Epi1, pg8::StaticOrder, true, true>(F.lds + RING_OFF, g, S, E);
        { constexpr int IDLE0 = (M / 256) * (IN_WP / 256) % 256;
          if (F.G == 256 && (int)blockIdx.x >= IDLE0)
              convert_range(F, (LAS float*)(F.lds + RING_OFF + F.wave * 16384), args.in[10], args.in[12], args.in[11], args.in[15], 0, CV_EARLY, ((int)blockIdx.x - IDLE0) * NWAVES + F.wave, (256 - IDLE0) * NWAVES);
        }
        if (BOTH(PH_IN)) GRID_BAR(PH_IN);
    }
    if (IN(PH_PRE)) { mixer_prepass(F, args.in[5], args.in[6]); if (BOTH(PH_PRE)) GRID_BAR(PH_PRE); }
    if (IN(PH_MIX)) {
#ifndef PROBE_P2
#define PROBE_P2 0
#endif
#ifndef PROBE_LIGHT_UP
#define PROBE_LIGHT_UP 0
#endif
        const bool skip_ml = PROBE_P2 >= 2 && args.li == 1, skip_at = PROBE_P2 == 1 && args.li == 1;
        const bool is_ml = (int)blockIdx.x < ML_WGS;
        if (is_ml && !skip_ml) { const int seq = (int)blockIdx.x & 31, part = (int)blockIdx.x >> 5; mlstm_seq(F, seq >> 2, seq & 3, args.in[9], part ? ML_SPLIT : 0, part ? SEQ / 128 : ML_SPLIT); __syncthreads(); }
        if (!skip_at) attn_phase(F, CW_QUEUE + 1024 * args.li, args.in[10], args.in[12], args.in[11], args.in[15], is_ml || (PROBE_P2 == 3 && args.li == 1));
        if (BOTH(PH_MIX)) GRID_BAR(PH_MIX);
    }
    if (IN(PH_OUT)) {
        pg8::Gemm g{(const pg8::bf16_t*)(F.ws + WS_MIX), (const pg8::bf16_t*)(F.ws + WS_WOUT), M, DM, DM}; pg8::StaticOrder S; S.init(M, DM, F.G, (int)blockIdx.x, WGM_OUT);
        pg8::Epi3 E{args.in[0], (pg8::bf16_t*)(F.ws + WS_XN), (float*)(F.ws + WS_SS), escr};
        pg8::gemm_phase<pg8::Epi3, pg8::StaticOrder, true, true>(F.lds + RING_OFF, g, S, E);
        if (BOTH(PH_OUT)) GRID_BAR(PH_OUT);
    }
    if (IN(PH_UP)) {
        pg8::Gemm g{(const pg8::bf16_t*)(F.ws + WS_XN), (const pg8::bf16_t*)(F.ws + WS_WUP), M, UPW, DM}; pg8::StaticOrder S; S.init(M, UPW, F.G, (int)blockIdx.x, WGM_UP);
        pg8::Epi4 E{(pg8::bf16_t*)(F.ws + WS_ACT), (float*)(F.ws + WS_RAW), (const float*)(F.ws + WS_SS), args.in[13], args.in[14], escr, args.li == 0 ? PROBE_LIGHT_UP : 0};
        pg8::gemm_phase<pg8::Epi4, pg8::StaticOrder, true, true>(F.lds + RING_OFF, g, S, E);
        if (BOTH(PH_UP)) GRID_BAR(PH_UP);
    }
    if (IN(PH_FIX)) { ffn_fixup(F, args.in[13], args.in[14]); if (BOTH(PH_FIX)) GRID_BAR(PH_FIX); }
    if (IN(PH_DOWN)) {
        pg8::Gemm g{(const pg8::bf16_t*)(F.ws + WS_ACT), (const pg8::bf16_t*)(F.ws + WS_WDN), M, DM, DFF}; pg8::StaticOrder S; S.init(M, DM, F.G, (int)blockIdx.x, WGM_DOWN);
        pg8::Epi5 E{F.out, (const pg8::bf16_t*)(F.ws + WS_XN)};
        pg8::gemm_phase<pg8::Epi5, pg8::StaticOrder, true, true>(F.lds + RING_OFF, g, S, E);
    }
#undef IN
#undef BOTH
}

extern "C" void kernel_launch(void* const* d_in, const int* in_sizes, int n_in, void* d_out, int out_size, void* d_ws, size_t ws_size, hipStream_t stream) {
    static int grid = 0;
    if (grid == 0) {
        if (n_in != 16 || in_sizes[0] != M * DM || out_size != M * DM || ws_size < WS_END) { fprintf(stderr, "kernel_launch: unexpected shapes (n_in %d in0 %d out %d ws %zu)\n", n_in, n_in > 0 ? in_sizes[0] : -1, out_size, ws_size); grid = -1; return; }
        int dev = 0, cus = 0, per_cu = 0;
        if (hipGetDevice(&dev) != hipSuccess || hipDeviceGetAttribute(&cus, hipDeviceAttributeMultiprocessorCount, dev) != hipSuccess) { grid = -1; return; }
        if (hipFuncSetAttribute((const void*)fwd_kernel, hipFuncAttributeMaxDynamicSharedMemorySize, LDS_BYTES) != hipSuccess) { fprintf(stderr, "kernel_launch: hipFuncSetAttribute failed\n"); grid = -1; return; }
        if (hipOccupancyMaxActiveBlocksPerMultiprocessor(&per_cu, (const void*)fwd_kernel, NWAVES * 64, LDS_BYTES) != hipSuccess || per_cu < 1) fprintf(stderr, "kernel_launch: occupancy query reports %d blocks per CU\n", per_cu);
        (void)hipGetLastError();
        grid = cus;
    }
    if (grid < 0) return;
    if (hipMemsetAsync((char*)d_ws + WS_CTL, 0, CTL_ZERO_BYTES, stream) != hipSuccess) return;
    Args a{};
    for (int i = 0; i < 16; ++i) a.in[i] = (const float*)d_in[i];
    a.out = (float*)d_out; a.ws = (unsigned char*)d_ws;
#ifdef PROBE_REPEAT
    { const int k = PROBE_REPEAT; const int lo[3] = {0, k, k + 1}, hi[3] = {k + 1, k + 1, PER_PHASE};
      for (int li = 0; li < 3; ++li) { a.ph_lo = lo[li]; a.ph_hi = hi[li]; a.li = li; hipLaunchKernelGGL(fwd_kernel, dim3(grid), dim3(NWAVES * 64), LDS_BYTES, stream, a); } }
#else
    if (N_LAUNCHES == 1) { a.ph_lo = 0; a.ph_hi = PER_PHASE; a.li = 0; hipLaunchKernelGGL(fwd_kernel, dim3(grid), dim3(NWAVES * 64), LDS_BYTES, stream, a); }
    else for (int li = 0; li < PER_PHASE; ++li) { a.ph_lo = li; a.ph_hi = li + 1; a.li = 0; hipLaunchKernelGGL(fwd_kernel, dim3(grid), dim3(NWAVES * 64), LDS_BYTES, stream, a); }
#endif
}
```

```cpp
#include <hip/hip_runtime.h>
#include <cstdio>
#include <cstdint>
#include <cmath>
namespace pg8 {
#define PG8_LAS __attribute__((address_space(3)))
typedef unsigned short bf16_t;
typedef short bf16x8 __attribute__((ext_vector_type(8)));
typedef float f32x4 __attribute__((ext_vector_type(4)));
typedef unsigned u32x4 __attribute__((ext_vector_type(4)));
constexpr int BM = 256, BK = 64, HALF = 128, HTB = HALF * BK * 2  , STAGE_BYTES = 8 * HTB, NXCD = 8, WGM = 8;

__host__ __device__ __forceinline__ int lds_byte(int r, int c) { const int st = (r >> 4) * 2 + (c >> 5), rr = r & 15, cc = c & 31, ob = rr * 64 + cc * 2; return st * 1024 + (ob ^ (((ob >> 9) & 1) << 5)); }
__host__ __device__ __forceinline__ void stage_rc(int b, int& R, int& C) { const int st = b / 1024, sb = b % 1024, swz = sb ^ (((sb >> 9) & 1) << 5); R = (st >> 1) * 16 + swz / 64; C = (st & 1) * 32 + (swz % 64) / 2; }
__host__ __device__ __forceinline__ int perm32(int rho) { const int n = rho >> 4, i = rho & 15; return 8 * (i >> 2) + 4 * n + (i & 3); }

struct Unit { int pm, pn; };
struct Gemm { const bf16_t* A; const bf16_t* Bt; int M, N, K; };

struct StaticOrder {
    int nM, nN, nwg, G, c, wgm;
    __host__ __device__ void init(int M, int N, int G_, int c_, int wgm_ = WGM) { nM = M / BM; nN = N / BM; nwg = nM * nN; G = G_; c = c_; wgm = wgm_; }
    __host__ __device__ bool next(int i, Unit& u) const {
        const long L = (long)i * G + c; if (L >= nwg) return false;
        int wgid = (int)L; { const int q = nwg / NXCD, r = nwg % NXCD, xcd = wgid % NXCD, off = wgid / NXCD; wgid = (xcd < r ? xcd * (q + 1) : r * (q + 1) + (xcd - r) * q) + off; }
        const int nig = wgm * nN, gid = wgid / nig, fm = gid * wgm, gsz = (nM - fm) < wgm ? (nM - fm) : wgm;
        u.pm = fm + ((wgid % nig) % gsz); u.pn = (wgid % nig) / gsz; return true;
    }
    __device__ __forceinline__ void a_ready(const Unit&) const {}
    __device__ __forceinline__ void done(const Unit&) const {}
};

__device__ __forceinline__ unsigned cvt_pk_bf16(float lo, float hi) { unsigned r; asm volatile("v_cvt_pk_bf16_f32 %0, %1, %2" : "=v"(r) : "v"(lo), "v"(hi)); return r; }

typedef float f32x2 __attribute__((ext_vector_type(2)));
#define EPI_BAR() do { asm volatile("s_waitcnt lgkmcnt(0)" ::: "memory"); __builtin_amdgcn_s_barrier(); asm volatile("" ::: "memory"); } while (0)
constexpr float kEps = 1e-6f;

struct Epi1 {
    static constexpr bool PERM = true, AFTER_DRAIN = false, APERM = false;
    __device__ __forceinline__ void pre(const Unit&, int, int) const {}
    bf16_t *QB, *KB, *VB, *ML; float* G; const float* rope; const float *qg, *kg, *b_i, *b_f; PG8_LAS float* scr;
    __device__ __forceinline__ void operator()(const f32x4 (&acc)[2][2][4][2], const Unit& u, int wr, int wc, int fr, int fq) const {
        const int pn = u.pn;
        if (pn < 12) {
            const bool isq = pn < 6;
#pragma unroll
            for (int ai = 0; ai < 2; ++ai)
#pragma unroll
                for (int m = 0; m < 4; ++m)
#pragma unroll
                    for (int bj = 0; bj < 2; ++bj) {
                        const f32x4 a = acc[ai][bj][m][0], b = acc[ai][bj][m][1];
                        float s = (a[0] * a[0] + a[1] * a[1]) + (a[2] * a[2] + a[3] * a[3]) + (b[0] * b[0] + b[1] * b[1]) + (b[2] * b[2] + b[3] * b[3]);
                        s += __shfl_xor(s, 16); s += __shfl_xor(s, 32);
                        if (fq == 0) scr[((ai * HALF + wr * 64 + m * 16 + fr) * 2 + bj) * 4 + wc] = s;
                    }
            EPI_BAR();
            const float* gsrc = isq ? qg : kg; const float gscale = isq ? 0.08838834764831845f * 1.4426950408889634f : 1.0f;
            f32x4 gva, gvb;
#pragma unroll
            for (int e = 0; e < 4; ++e) { const int p = 32 * wc + 8 * fq + e; gva[e] = gsrc[(p >> 1) + 64 * (p & 1)] * gscale; gvb[e] = gsrc[((p + 4) >> 1) + 64 * (p & 1)] * gscale; }
            bf16_t* dst = isq ? QB : KB; const int head0 = (isq ? pn : pn - 6) * 2;
#pragma unroll
            for (int ai = 0; ai < 2; ++ai)
#pragma unroll
                for (int m = 0; m < 4; ++m) {
                    const int rl = ai * HALF + wr * 64 + m * 16 + fr, grow = u.pm * BM + rl, t = grow & 2047, bb = grow >> 11;
                    const size_t drow = (size_t)bb * 2048 + (size_t)(t & 3) * 512 + (t >> 2);
                    const f32x4 cs0 = *(const f32x4*)(rope + ((size_t)t * 64 + 16 * wc + 4 * fq) * 2), cs1 = *(const f32x4*)(rope + ((size_t)t * 64 + 16 * wc + 4 * fq) * 2 + 4);
#pragma unroll
                    for (int bj = 0; bj < 2; ++bj) {
                        const f32x4 pp = *(const PG8_LAS f32x4*)(scr + (rl * 2 + bj) * 4);
                        const float rstd = 1.0f / sqrtf(((pp[0] + pp[1]) + (pp[2] + pp[3])) * (1.0f / 128.0f) + kEps);
                        const f32x4 a = acc[ai][bj][m][0] * (gva * rstd), b = acc[ai][bj][m][1] * (gvb * rstd);
                        const f32x2 xe0 = {a[0], a[2]}, xo0 = {a[1], a[3]}, xe1 = {b[0], b[2]}, xo1 = {b[1], b[3]};
                        const f32x2 c0 = {cs0[0], cs0[2]}, s0 = {cs0[1], cs0[3]}, c1 = {cs1[0], cs1[2]}, s1 = {cs1[1], cs1[3]};
                        const f32x2 oe0 = xe0 * c0 - xo0 * s0, oo0 = xe0 * s0 + xo0 * c0, oe1 = xe1 * c1 - xo1 * s1, oo1 = xe1 * s1 + xo1 * c1;
                        u32x4 w;
                        w.x = cvt_pk_bf16(oe0[0], oo0[0]); w.y = cvt_pk_bf16(oe0[1], oo0[1]); w.z = cvt_pk_bf16(oe1[0], oo1[0]); w.w = cvt_pk_bf16(oe1[1], oo1[1]);
                        *(u32x4*)(dst + drow * 1536 + (head0 + bj) * 128 + 32 * wc + 8 * fq) = w;
                    }
                }
        } else if (pn < 26) {
            const bool isv = pn < 18;
#pragma unroll
            for (int ai = 0; ai < 2; ++ai)
#pragma unroll
                for (int m = 0; m < 4; ++m) {
                    const int rl = ai * HALF + wr * 64 + m * 16 + fr, grow = u.pm * BM + rl, t = grow & 2047, bb = grow >> 11;
                    bf16_t* rowp = isv ? VB + ((size_t)bb * 2048 + (size_t)(t & 3) * 512 + (t >> 2)) * 1536 + (pn - 12) * 256 : ML + (size_t)grow * 2048 + (pn - 18) * 256;
#pragma unroll
                    for (int bj = 0; bj < 2; ++bj) {
                        const f32x4 a = acc[ai][bj][m][0], b = acc[ai][bj][m][1];
                        u32x4 w; w.x = cvt_pk_bf16(a[0], a[1]); w.y = cvt_pk_bf16(a[2], a[3]); w.z = cvt_pk_bf16(b[0], b[1]); w.w = cvt_pk_bf16(b[2], b[3]);
                        *(u32x4*)(rowp + bj * HALF + 32 * wc + 8 * fq) = w;
                    }
                }
        } else {
            if (wc == 0 && fq == 0) {
                const f32x4 bi = *(const f32x4*)b_i, bf = *(const f32x4*)b_f;
#pragma unroll
                for (int ai = 0; ai < 2; ++ai)
#pragma unroll
                    for (int m = 0; m < 4; ++m) {
                        const int grow = u.pm * BM + ai * HALF + wr * 64 + m * 16 + fr;
                        *(f32x4*)(G + (size_t)grow * 8) = acc[ai][0][m][0] + bi; *(f32x4*)(G + (size_t)grow * 8 + 4) = acc[ai][0][m][1] + bf;
                    }
            }
        }
    }
};

struct Epi3 {
    static constexpr bool PERM = true, AFTER_DRAIN = false, APERM = false;
    __device__ __forceinline__ void pre(const Unit&, int, int) const {}
    const float* x; bf16_t* X1; float* SS; PG8_LAS float* scr;
    __device__ __forceinline__ void operator()(const f32x4 (&acc)[2][2][4][2], const Unit& u, int wr, int wc, int fr, int fq) const {
        const int col0 = u.pn * BM + 32 * wc + 8 * fq;
#pragma unroll
        for (int ai = 0; ai < 2; ++ai)
#pragma unroll
            for (int m = 0; m < 4; ++m) {
                const int rl = ai * HALF + wr * 64 + m * 16 + fr; const size_t off = (size_t)(u.pm * BM + rl) * 2048 + col0;
                float s = 0.f;
#pragma unroll
                for (int bj = 0; bj < 2; ++bj) {
                    const f32x4 a = acc[ai][bj][m][0] + __builtin_nontemporal_load((const f32x4*)(x + off + bj * HALF)), b = acc[ai][bj][m][1] + __builtin_nontemporal_load((const f32x4*)(x + off + bj * HALF + 4));
                    s += (a[0] * a[0] + a[1] * a[1]) + (a[2] * a[2] + a[3] * a[3]) + (b[0] * b[0] + b[1] * b[1]) + (b[2] * b[2] + b[3] * b[3]);
                    u32x4 w; w.x = cvt_pk_bf16(a[0], a[1]); w.y = cvt_pk_bf16(a[2], a[3]); w.z = cvt_pk_bf16(b[0], b[1]); w.w = cvt_pk_bf16(b[2], b[3]);
                    *(u32x4*)(X1 + off + bj * HALF) = w;
                }
                s += __shfl_xor(s, 16); s += __shfl_xor(s, 32);
                if (fq == 0) scr[rl * 4 + wc] = s;
            }
        EPI_BAR();
        if (wc == 0 && fq == 0) {
#pragma unroll
            for (int ai = 0; ai < 2; ++ai)
#pragma unroll
                for (int m = 0; m < 4; ++m) {
                    const int rl = ai * HALF + wr * 64 + m * 16 + fr; const f32x4 pp = *(const PG8_LAS f32x4*)(scr + rl * 4);
                    SS[(size_t)(u.pm * BM + rl) * 8 + u.pn] = (pp[0] + pp[1]) + (pp[2] + pp[3]);
                }
        }
    }
};

__device__ __forceinline__ float dpp_shr1(float v) { return __builtin_bit_cast(float, __builtin_amdgcn_update_dpp(0, __builtin_bit_cast(int, v), 0x111, 0xf, 0xf, true)); }
struct Epi4 {
    static constexpr bool PERM = true, AFTER_DRAIN = false, APERM = true;
    bf16_t* ACT; float* RAWB; const float* SS; const float *cw, *cb; PG8_LAS float* scr; int light;
    __device__ __forceinline__ void pre(const Unit& u, int wid, int lane) const {
        __builtin_amdgcn_global_load_lds((const unsigned*)((const char*)(SS + (size_t)u.pm * BM * 8) + wid * 1024 + lane * 16), (PG8_LAS unsigned*)((PG8_LAS char*)scr + wid * 1024), 16, 0, 0);
        if (wid < 4) { const int seg = 2 * wid + (lane >> 5), q4 = seg >> 1, gv = seg & 1;
            const float* src = (q4 < 3 ? cw + q4 * 11264 : cb) + (gv ? 5632 : 0) + u.pn * 128 + 4 * (lane & 31);
            __builtin_amdgcn_global_load_lds((const unsigned*)src, (PG8_LAS unsigned*)((PG8_LAS char*)scr + 8192 + wid * 1024), 16, 0, 0); }
    }
    __device__ __forceinline__ void operator()(f32x4 (&acc)[2][2][4][2], const Unit& u, int wr, int wc, int fr, int fq) const {
        if (light == 1) return;
        const int j0 = u.pn * 128 + 32 * wc + 8 * fq;
#pragma unroll
        for (int ai = 0; ai < 2; ++ai)
#pragma unroll
            for (int m = 0; m < 4; ++m) {
                const PG8_LAS float* sp = scr + (ai * HALF + wr * 64 + 4 * fr + m) * 8; const f32x4 s0 = *(const PG8_LAS f32x4*)sp, s1 = *(const PG8_LAS f32x4*)(sp + 4);
                const float rstd = 1.0f / sqrtf((((s0[0] + s0[1]) + (s0[2] + s0[3])) + ((s1[0] + s1[1]) + (s1[2] + s1[3]))) * (1.0f / 2048.0f) + kEps);
#pragma unroll
                for (int bj = 0; bj < 2; ++bj) { acc[ai][bj][m][0] = acc[ai][bj][m][0] * rstd; acc[ai][bj][m][1] = acc[ai][bj][m][1] * rstd; }
            }
        if (fr == 0 && light != 2) {
#pragma unroll
            for (int ai = 0; ai < 2; ++ai)
#pragma unroll
                for (int mm = 0; mm < 2; ++mm)
#pragma unroll
                    for (int bj = 0; bj < 2; ++bj) { float* p = RAWB + ((size_t)(u.pm * 4 + ai * 2 + wr) * 4 + mm) * 11264 + u.pn * 256 + bj * HALF + 32 * wc + 8 * fq; *(f32x4*)p = acc[ai][bj][mm][0]; *(f32x4*)(p + 4) = acc[ai][bj][mm][1]; }
        }
        if (fr == 15 && light != 2) {
#pragma unroll
            for (int ai = 0; ai < 2; ++ai)
#pragma unroll
                for (int mm = 0; mm < 2; ++mm)
#pragma unroll
                    for (int bj = 0; bj < 2; ++bj) { float* p = RAWB + ((size_t)(u.pm * 4 + ai * 2 + wr) * 4 + 2 + mm) * 11264 + u.pn * 256 + bj * HALF + 32 * wc + 8 * fq; *(f32x4*)p = acc[ai][bj][2 + mm][0]; *(f32x4*)(p + 4) = acc[ai][bj][2 + mm][1]; }
        }
#pragma unroll
        for (int ai = 0; ai < 2; ++ai) {
            unsigned pk[4][4];
#pragma unroll
            for (int n = 0; n < 2; ++n) {
                const PG8_LAS float* wl = scr + 2048 + 32 * wc + 8 * fq + 4 * n;
                const f32x4 wg0 = *(const PG8_LAS f32x4*)wl, wg1 = *(const PG8_LAS f32x4*)(wl + 256), wg2 = *(const PG8_LAS f32x4*)(wl + 512), bg = *(const PG8_LAS f32x4*)(wl + 768);
                const f32x4 wv0 = *(const PG8_LAS f32x4*)(wl + 128), wv1 = *(const PG8_LAS f32x4*)(wl + 384), wv2 = *(const PG8_LAS f32x4*)(wl + 640), bv = *(const PG8_LAS f32x4*)(wl + 896);
                f32x4 ug[6], uv[6];
#pragma unroll
                for (int j = 0; j < 4; ++j) { ug[0][j] = dpp_shr1(acc[ai][0][2][n][j]); ug[1][j] = dpp_shr1(acc[ai][0][3][n][j]); uv[0][j] = dpp_shr1(acc[ai][1][2][n][j]); uv[1][j] = dpp_shr1(acc[ai][1][3][n][j]); }
#pragma unroll
                for (int m = 0; m < 4; ++m) { ug[2 + m] = acc[ai][0][m][n]; uv[2 + m] = acc[ai][1][m][n]; }
#pragma unroll
                for (int m = 0; m < 4; ++m) {
                    const f32x4 yg = bg + wg0 * ug[m] + wg1 * ug[m + 1] + wg2 * ug[m + 2];
                    const f32x4 yv = bv + wv0 * uv[m] + wv1 * uv[m + 1] + wv2 * uv[m + 2];
                    const f32x4 t = yg * -1.4426950408889634f;
                    f32x4 sg; sg[0] = __builtin_amdgcn_rcpf(1.0f + __builtin_amdgcn_exp2f(t[0])); sg[1] = __builtin_amdgcn_rcpf(1.0f + __builtin_amdgcn_exp2f(t[1])); sg[2] = __builtin_amdgcn_rcpf(1.0f + __builtin_amdgcn_exp2f(t[2])); sg[3] = __builtin_amdgcn_rcpf(1.0f + __builtin_amdgcn_exp2f(t[3]));
                    const f32x4 res = (yg * yv) * sg;
                    pk[m][2 * n] = cvt_pk_bf16(res[0], res[1]); pk[m][2 * n + 1] = cvt_pk_bf16(res[2], res[3]);
                }
            }
#pragma unroll
            for (int m = 0; m < 4; ++m) {
                if ((m < 2 && fr == 0) || (light == 2 && pk[m][0] != 0x12345678u)) continue;
                const int grow = u.pm * BM + ai * HALF + wr * 64 + 4 * fr + m;
                u32x4 w; w.x = pk[m][0]; w.y = pk[m][1]; w.z = pk[m][2]; w.w = pk[m][3];
                *(u32x4*)(ACT + (size_t)grow * 5632 + j0) = w;
            }
        }
    }
};

struct Epi5 {
    static constexpr bool PERM = true, AFTER_DRAIN = false, APERM = false;
    __device__ __forceinline__ void pre(const Unit&, int, int) const {}
    float* out; const bf16_t* X1;
    __device__ __forceinline__ void operator()(const f32x4 (&acc)[2][2][4][2], const Unit& u, int wr, int wc, int fr, int fq) const {
        const int col0 = u.pn * BM + 32 * wc + 8 * fq;
#pragma unroll
        for (int ai = 0; ai < 2; ++ai)
#pragma unroll
            for (int m = 0; m < 4; ++m) {
                const size_t off = (size_t)(u.pm * BM + ai * HALF + wr * 64 + m * 16 + fr) * 2048 + col0;
#pragma unroll
                for (int bj = 0; bj < 2; ++bj) {
                    const u32x4 w = __builtin_nontemporal_load((const u32x4*)(X1 + off + bj * HALF));
                    const f32x4 r0 = {__builtin_bit_cast(float, w.x << 16), __builtin_bit_cast(float, w.x & 0xffff0000u), __builtin_bit_cast(float, w.y << 16), __builtin_bit_cast(float, w.y & 0xffff0000u)};
                    const f32x4 r1 = {__builtin_bit_cast(float, w.z << 16), __builtin_bit_cast(float, w.z & 0xffff0000u), __builtin_bit_cast(float, w.w << 16), __builtin_bit_cast(float, w.w & 0xffff0000u)};
                    __builtin_nontemporal_store(acc[ai][bj][m][0] + r0, (f32x4*)(out + off + bj * HALF)); __builtin_nontemporal_store(acc[ai][bj][m][1] + r1, (f32x4*)(out + off + bj * HALF + 4));
                }
            }
    }
};
template <class Epi, class Sched, bool ALIGN_EPI = false, bool SP2 = false>
__device__ __forceinline__ void gemm_phase(PG8_LAS unsigned char* lds, const Gemm g, const Sched& S, const Epi& E) {
    const int tid = threadIdx.x, wid = __builtin_amdgcn_readfirstlane(tid >> 6), lane = tid & 63, wr = wid >> 2, wc = wid & 3, fr = lane & 15, fq = lane >> 4;
    const int K = g.K, nt = K / BK;
    unsigned voffA[2], voffB[2];
#pragma unroll
    for (int i = 0; i < 2; ++i) { int R, C; stage_rc(tid * 16 + i * 8192, R, C); const int Rb = Epi::PERM ? ((R & ~31) + perm32(R & 31)) : R;
        const int Ra = Epi::APERM ? ((R & ~63) + 4 * (R & 15) + ((R >> 4) & 3)) : R;
        voffA[i] = (unsigned)(Ra * K + C) * 2u; voffB[i] = (unsigned)(Rb * K + C) * 2u; }
    const size_t kstep = (size_t)(BK * 2);
    const size_t hstep = (size_t)HALF * K * 2;
    const size_t tstep = 2 * hstep;
    const unsigned ldsw = (unsigned)wid * 1024u;
    const int aoff = lds_byte(wr * 64 + fr, fq * 8), boff = lds_byte(wc * 32 + fr, fq * 8);
#define PG8_SA(b, h) (((b) * 2 + (h)) * HTB)
#define PG8_SB(b, h) ((4 + (b) * 2 + (h)) * HTB)
#define PG8_STAGE(bufoff, gbase, voff) do { _Pragma("unroll") for (int _i = 0; _i < 2; ++_i) \
        __builtin_amdgcn_global_load_lds((const unsigned*)((const char*)(gbase) + (voff)[_i]), (PG8_LAS unsigned*)(lds + (bufoff) + ldsw + _i * 8192), 16, 0, 0); } while (0)
#define PG8_LDA(dst, b, h) do { _Pragma("unroll") for (int m = 0; m < 4; ++m) _Pragma("unroll") for (int k = 0; k < 2; ++k) dst[m][k] = *(const PG8_LAS bf16x8*)(lds + PG8_SA(b, h) + aoff + m * 2048 + k * 1024); } while (0)
#define PG8_LDB(dst, b, h) do { _Pragma("unroll") for (int n = 0; n < 2; ++n) _Pragma("unroll") for (int k = 0; k < 2; ++k) dst[n][k] = *(const PG8_LAS bf16x8*)(lds + PG8_SB(b, h) + boff + n * 2048 + k * 1024); } while (0)
#define PG8_MMA(ai, bj, At, Bt) do { __builtin_amdgcn_s_setprio(1); _Pragma("unroll") for (int m = 0; m < 4; ++m) _Pragma("unroll") for (int n = 0; n < 2; ++n) _Pragma("unroll") for (int k = 0; k < 2; ++k) \
        acc[ai][bj][m][n] = __builtin_amdgcn_mfma_f32_16x16x32_bf16(Bt[n][k], At[m][k], acc[ai][bj][m][n], 0, 0, 0); __builtin_amdgcn_s_setprio(0); } while (0)
#define PG8_WAIT_V(n) asm volatile("s_waitcnt vmcnt(" #n ")" ::: "memory")
#define PG8_WAIT_L(n) asm volatile("s_waitcnt lgkmcnt(" #n ")" ::: "memory")
#define PG8_BAR __builtin_amdgcn_s_barrier()
#define PG8_SCHED __builtin_amdgcn_sched_barrier(0)
    Unit cur, nxt; int ui = 0;
    if (!S.next(0, cur)) return;
    f32x4 acc[2][2][4][2];
#pragma unroll
    for (int a = 0; a < 2; ++a)
#pragma unroll
        for (int b = 0; b < 2; ++b)
#pragma unroll
            for (int m = 0; m < 4; ++m)
#pragma unroll
                for (int n = 0; n < 2; ++n) acc[a][b][m][n] = (f32x4){0.f, 0.f, 0.f, 0.f};
    bf16x8 At[4][2], B0[2][2], B1[2][2];
    const char* cA = (const char*)g.A + (size_t)cur.pm * tstep; const char* cB = (const char*)g.Bt + (size_t)cur.pn * tstep;
    S.a_ready(cur);
    if constexpr (SP2) {
        PG8_STAGE(PG8_SB(0, 0), cB, voffB); PG8_STAGE(PG8_SB(0, 1), cB + hstep, voffB); PG8_STAGE(PG8_SA(0, 0), cA, voffA); PG8_STAGE(PG8_SA(0, 1), cA + hstep, voffA);
        if (wr == 1) PG8_BAR;
        PG8_WAIT_V(2); PG8_BAR;
        PG8_STAGE(PG8_SB(1, 0), cB + kstep, voffB); PG8_STAGE(PG8_SA(1, 0), cA + kstep, voffA); PG8_STAGE(PG8_SB(1, 1), cB + hstep + kstep, voffB);
        PG8_WAIT_V(6); PG8_BAR;
    } else {
        PG8_STAGE(PG8_SB(0, 0), cB, voffB); PG8_STAGE(PG8_SA(0, 0), cA, voffA); PG8_STAGE(PG8_SB(0, 1), cB + hstep, voffB); PG8_STAGE(PG8_SA(0, 1), cA + hstep, voffA);
        if (wr == 1) PG8_BAR;
        PG8_WAIT_V(4); PG8_BAR;
        PG8_STAGE(PG8_SB(1, 0), cB + kstep, voffB); PG8_STAGE(PG8_SA(1, 0), cA + kstep, voffA); PG8_STAGE(PG8_SB(1, 1), cB + hstep + kstep, voffB);
        PG8_WAIT_V(6); PG8_BAR;
    }
    for (;;) {
        const bool has_next = S.next(ui + 1, nxt);
        const char* nA = has_next ? (const char*)g.A + (size_t)nxt.pm * tstep : cA; const char* nB = has_next ? (const char*)g.Bt + (size_t)nxt.pn * tstep : cB;
        for (int t = 0; t < nt; t += 2) {
            const bool last = (t == nt - 2);
            const char* a1 = cA + (size_t)(t + 1) * kstep;
            const char* a2 = last ? nA : cA + (size_t)(t + 2) * kstep; const char* b2 = last ? nB : cB + (size_t)(t + 2) * kstep;
            const char* a3 = a2 + kstep; const char* b3 = b2 + kstep;
            if (last && has_next) S.a_ready(nxt);
            if (last) E.pre(cur, wid, lane);
            if constexpr (SP2) {
            PG8_LDB(B0, 0, 0); PG8_LDB(B1, 0, 1); PG8_SCHED; PG8_LDA(At, 0, 0); PG8_STAGE(PG8_SA(1, 1), a1 + hstep, voffA);
            PG8_WAIT_V(8); PG8_WAIT_L(0); PG8_BAR; PG8_MMA(0, 0, At, B0); PG8_MMA(0, 1, At, B1); PG8_BAR; PG8_SCHED;
            PG8_LDA(At, 0, 1); PG8_STAGE(PG8_SB(0, 0), b2, voffB); PG8_STAGE(PG8_SB(0, 1), b2 + hstep, voffB); PG8_STAGE(PG8_SA(0, 0), a2, voffA);
            PG8_WAIT_V(8); PG8_WAIT_L(0); PG8_BAR; PG8_MMA(1, 0, At, B0); PG8_MMA(1, 1, At, B1); PG8_BAR; PG8_SCHED;
            PG8_LDB(B0, 1, 0); PG8_LDB(B1, 1, 1); PG8_SCHED; PG8_LDA(At, 1, 0); PG8_STAGE(PG8_SA(0, 1), a2 + hstep, voffA);
            PG8_WAIT_V(8); PG8_WAIT_L(0); PG8_BAR; PG8_MMA(0, 0, At, B0); PG8_MMA(0, 1, At, B1); PG8_BAR; PG8_SCHED;
            PG8_LDA(At, 1, 1); PG8_STAGE(PG8_SB(1, 0), b3, voffB); PG8_STAGE(PG8_SB(1, 1), b3 + hstep, voffB); PG8_STAGE(PG8_SA(1, 0), a3, voffA);
            PG8_WAIT_V(8); PG8_WAIT_L(0); PG8_BAR; PG8_MMA(1, 0, At, B0); PG8_MMA(1, 1, At, B1); PG8_BAR; PG8_SCHED;
            } else {
            PG8_LDB(B0, 0, 0); PG8_SCHED; PG8_LDA(At, 0, 0); PG8_STAGE(PG8_SA(1, 1), a1 + hstep, voffA);
            PG8_WAIT_L(8); PG8_BAR; PG8_WAIT_L(0); PG8_MMA(0, 0, At, B0); PG8_BAR; PG8_SCHED;
            PG8_LDB(B1, 0, 1); PG8_STAGE(PG8_SB(0, 0), b2, voffB);
            PG8_BAR; PG8_WAIT_L(0); PG8_MMA(0, 1, At, B1); PG8_BAR;
            PG8_LDA(At, 0, 1); PG8_STAGE(PG8_SA(0, 0), a2, voffA);
            PG8_BAR; PG8_WAIT_L(0); PG8_MMA(1, 0, At, B0); PG8_BAR; PG8_SCHED;
            PG8_STAGE(PG8_SB(0, 1), b2 + hstep, voffB);
            PG8_WAIT_V(6); PG8_BAR; PG8_MMA(1, 1, At, B1); PG8_BAR;
            PG8_LDB(B0, 1, 0); PG8_SCHED; PG8_LDA(At, 1, 0); PG8_STAGE(PG8_SA(0, 1), a2 + hstep, voffA);
            PG8_WAIT_L(8); PG8_BAR; PG8_WAIT_L(0); PG8_MMA(0, 0, At, B0); PG8_BAR; PG8_SCHED;
            PG8_LDB(B1, 1, 1); PG8_STAGE(PG8_SB(1, 0), b3, voffB);
            PG8_BAR; PG8_WAIT_L(0); PG8_MMA(0, 1, At, B1); PG8_BAR;
            PG8_LDA(At, 1, 1); PG8_STAGE(PG8_SA(1, 0), a3, voffA);
            PG8_BAR; PG8_WAIT_L(0); PG8_MMA(1, 0, At, B0); PG8_BAR; PG8_SCHED;
            PG8_STAGE(PG8_SB(1, 1), b3 + hstep, voffB);
            PG8_WAIT_V(6); PG8_BAR; PG8_MMA(1, 1, At, B1); PG8_BAR;
            }
        }
        if constexpr (ALIGN_EPI) { if (wr == 0) PG8_BAR; }
        if constexpr (!Epi::AFTER_DRAIN) { E(acc, cur, wr, wc, fr, fq); S.done(cur); }
        if (!has_next) break;
#pragma unroll
        for (int a = 0; a < 2; ++a)
#pragma unroll
            for (int b = 0; b < 2; ++b)
#pragma unroll
                for (int m = 0; m < 4; ++m)
#pragma unroll
                    for (int n = 0; n < 2; ++n) acc[a][b][m][n] = (f32x4){0.f, 0.f, 0.f, 0.f};
        cur = nxt; cA = nA; cB = nB; ++ui;
        if constexpr (ALIGN_EPI) { if (wr == 1) PG8_BAR; }
    }
    PG8_WAIT_V(0);
    if constexpr (!ALIGN_EPI) { if (wr == 0) PG8_BAR; }
    PG8_BAR;
    if constexpr (Epi::AFTER_DRAIN) { E.fused(acc, cur, wr, wc, fr, fq, lds, wid, lane); S.done(cur); }
#undef PG8_SA
#undef PG8_SB
#undef PG8_STAGE
#undef PG8_LDA
#undef PG8_LDB
#undef PG8_MMA
#undef PG8_WAIT_V
#undef PG8_WAIT_L
#undef PG8_BAR
#undef PG8_SCHED
}
}
#define GAS __attribute__((address_space(1)))
#define LAS __attribute__((address_space(3)))
typedef unsigned short bf16;
typedef unsigned v4u __attribute__((ext_vector_type(4)));
typedef float f32x4 __attribute__((ext_vector_type(4)));
typedef short bf16x8 __attribute__((ext_vector_type(8)));
typedef GAS unsigned gu32;
typedef GAS unsigned long long gu64;
#define RLX_AGENT __ATOMIC_RELAXED, __HIP_MEMORY_SCOPE_AGENT
#define LDS_WAIT() asm volatile("s_waitcnt lgkmcnt(0)" ::: "memory")
#define VM_WAIT() asm volatile("s_waitcnt vmcnt(0)" ::: "memory")
__device__ __forceinline__ unsigned long long rt() { return __builtin_amdgcn_s_memrealtime(); }
__device__ __forceinline__ unsigned f2bf(float f) { unsigned u = __builtin_bit_cast(unsigned, f); return (u + 0x7fffu + ((u >> 16) & 1u)) >> 16; }
__device__ __forceinline__ unsigned pk2(float lo, float hi) { return f2bf(lo) | (f2bf(hi) << 16); }

#define XB_TMO      128
#define XB_XCNT(j)  (256  + 64 * (j))
#define XB_XSUB(j)  (1280 + 64 * (j))
#define XB_XGEN(j)  (2304 + 64 * (j))
#define XB_TOP      3328
#define XB_TOPGEN   3392
#define XCD_BAR_WORDS 3456
#define XB_SPIN_CAP (1u << 18)

__device__ __forceinline__ unsigned xb_ld(unsigned* p)              { return __hip_atomic_load(p, __ATOMIC_RELAXED, __HIP_MEMORY_SCOPE_AGENT); }
__device__ __forceinline__ unsigned xb_add(unsigned* p, unsigned v) { return __hip_atomic_fetch_add(p, v, __ATOMIC_RELAXED, __HIP_MEMORY_SCOPE_AGENT); }
__device__ __forceinline__ unsigned xb_xcc_id() { return (unsigned)__builtin_amdgcn_s_getreg((3 << 11) | 20) & 0xFu; }
#define XB_SPIN(cond, bar) do { unsigned _sp = 0; while (cond) { __builtin_amdgcn_s_sleep(1); \
    if ((++_sp & 255u) == 0u) { if (xb_ld(&(bar)[XB_TMO])) break; if (_sp > XB_SPIN_CAP) { atomicAdd(&(bar)[XB_TMO], 1u); break; } } } } while (0)

struct XcdBarrier {
    unsigned* bar; unsigned x;
    volatile LAS unsigned* st;
};

__device__ __forceinline__ XcdBarrier xcd_barrier_post(unsigned* bar, volatile LAS unsigned* st) {
    XcdBarrier b; b.bar = bar; b.x = xb_xcc_id(); b.st = st;
    if (threadIdx.x == 0) (void)xb_add(&bar[XB_XCNT(b.x)], 1u);
    return b;
}
__device__ __forceinline__ void xcd_barrier_complete(unsigned* bar, unsigned x, unsigned& nloc, unsigned& nx) {
    const unsigned G = gridDim.x * gridDim.y * gridDim.z;
    unsigned sum, cnt, mine, sp = 0u;
    for (;;) {
        sum = 0u; cnt = 0u; mine = 0u;
#pragma unroll
        for (unsigned j = 0; j < 16; ++j) { const unsigned c = xb_ld(&bar[XB_XCNT(j)]); sum += c; cnt += (c > 0u) ? 1u : 0u; mine = (j == x) ? c : mine; }
        if (sum == G) break;
        __builtin_amdgcn_s_sleep(1);
        if ((++sp & 255u) == 0u) { if (xb_ld(&bar[XB_TMO])) break; if (sp > XB_SPIN_CAP) { atomicAdd(&bar[XB_TMO], 1u); break; } }
    }
    nloc = mine > 0u ? mine : 1u; nx = cnt > 0u ? cnt : 1u;
}

__device__ __forceinline__ void xcd_barrier(const XcdBarrier& b) {
    asm volatile("s_waitcnt vmcnt(0)" ::: "memory");
    __syncthreads();
    if (threadIdx.x == 0) {
        unsigned* bar = b.bar;
        __builtin_amdgcn_s_waitcnt(0);
        unsigned nloc = b.st[0], nx = b.st[1];
        if (nloc == 0u) { xcd_barrier_complete(bar, b.x, nloc, nx); b.st[0] = nloc; b.st[1] = nx; }
        const unsigned old = xb_add(&bar[XB_XSUB(b.x)], 1u);
        const unsigned gen = old / nloc;
        if (old + 1u == (gen + 1u) * nloc) {
            __builtin_amdgcn_fence(__ATOMIC_RELEASE, "agent");
            asm volatile("s_waitcnt vmcnt(0)" ::: "memory");
            const unsigned og = xb_add(&bar[XB_TOP], 1u);
            const unsigned tg = og / nx;
            if (og + 1u == (tg + 1u) * nx) xb_add(&bar[XB_TOPGEN], 1u);
            else XB_SPIN(xb_ld(&bar[XB_TOPGEN]) == tg, bar);
            __builtin_amdgcn_fence(__ATOMIC_ACQUIRE, "agent");
            xb_add(&bar[XB_XGEN(b.x)], 1u);
            asm volatile("s_waitcnt vmcnt(0)" ::: "memory");
        } else {
            XB_SPIN(xb_ld(&bar[XB_XGEN(b.x)]) == gen, bar);
            __builtin_amdgcn_fence(__ATOMIC_ACQUIRE, "agent");
            asm volatile("s_waitcnt vmcnt(0)" ::: "memory");
        }
    }
    __syncthreads();
}

constexpr int NWAVES = 8;
constexpr int BATCH = 8, SEQ = 2048, DM = 2048, M = BATCH * SEQ;
constexpr int NAH = 12, NMH = 4, ATTN_W = 1536, IN_W = 6664, IN_WP = 6912, DFF = 5632, UPW = 11264;
#ifndef MK_N_LAUNCHES
#define MK_N_LAUNCHES 1
#endif
#ifndef WGM_IN
#define WGM_IN 8
#endif
#ifndef WGM_OUT
#define WGM_OUT 4
#endif
#ifndef WGM_UP
#define WGM_UP 8
#endif
#ifndef WGM_DOWN
#define WGM_DOWN 4
#endif
constexpr int N_LAUNCHES = MK_N_LAUNCHES;
enum { PH_PRO = 0, PH_IN = 1, PH_PRE = 2, PH_MIX = 3, PH_OUT = 4, PH_UP = 5, PH_FIX = 6, PH_DOWN = 7 };
constexpr int PER_PHASE = 8;

constexpr size_t MiB = 1u << 20;
constexpr size_t WS_CTL = 0, CTL_ZERO_BYTES = 128 * 1024;
constexpr size_t WS_ROPE = 1 * MiB, WS_G = 2 * MiB, WS_SS = 2 * MiB + 512 * 1024;
constexpr size_t WS_WIN = 4 * MiB, WS_WOUT = 31 * MiB, WS_WUP = 39 * MiB, WS_WDN = 83 * MiB;
constexpr size_t WS_XN = 105 * MiB;
constexpr size_t WS_QB = 169 * MiB, WS_KB = 217 * MiB, WS_VB = 265 * MiB, WS_ML = 313 * MiB;
constexpr size_t WS_MIX = 377 * MiB;
constexpr size_t WS_RAW = 377 * MiB;
constexpr size_t WS_ACT = 169 * MiB;
constexpr size_t WS_MLC = 441 * MiB;
constexpr size_t WS_GA = 473 * MiB;
constexpr size_t WS_END = 475 * MiB;
static_assert(WS_WIN + (size_t)IN_WP * DM * 2 <= WS_WOUT && WS_WOUT + (size_t)DM * DM * 2 <= WS_WUP && WS_WUP + (size_t)UPW * DM * 2 <= WS_WDN && WS_WDN + (size_t)DM * DFF * 2 <= WS_XN, "weights map");
static_assert(WS_XN + (size_t)M * DM * 2 <= WS_QB && WS_ML + (size_t)M * 2048 * 2 <= WS_MIX && WS_MIX + (size_t)M * 2048 * 2 <= WS_MLC && WS_MLC + (size_t)M * 1024 * 2 <= WS_GA && WS_GA + (size_t)32 * 16 * 3 * 128 * 4 <= WS_END && WS_RAW + (size_t)256 * 4 * UPW * 4 <= WS_MLC && WS_ACT + (size_t)M * DFF * 2 <= WS_MIX, "activation map");
constexpr int CW_TMO = 0, CW_BAR = 4096, CW_QUEUE = 16384;

constexpr int RING_OFF = 0, RING_BYTES = 131072;
constexpr int SCR_OFF = RING_BYTES, SCR_BYTES = 24576;
constexpr int LDSCTL_OFF = SCR_OFF + SCR_BYTES, MISC_OFF = LDSCTL_OFF + 320;
constexpr int LDS_BYTES = 156672;
static_assert(MISC_OFF + 128 <= LDS_BYTES, "LDS map");

#define DI __device__ __forceinline__
typedef float f32x16 __attribute__((ext_vector_type(16)));
typedef short s16x4 __attribute__((ext_vector_type(4)));
typedef unsigned u32x2 __attribute__((ext_vector_type(2)));
#define MFMA32(a, b, c) __builtin_amdgcn_mfma_f32_32x32x16_bf16((a), (b), (c), 0, 0, 0)
constexpr float LOG2E = 1.4426950408889634f;

struct Frame {
    LAS unsigned char* lds; volatile LAS unsigned* MISC; gu32* ctl;
    int tid, lane, wave, vcu, G;
    float* out; unsigned char* ws;
};

DI unsigned swz_b(unsigned row) { return ((row & 3u) << 2) | ((row >> 2) & 3u); }
DI unsigned off_b(unsigned row, unsigned ch) { return 256u * row + 16u * (ch ^ swz_b(row)); }
DI bf16x8 lds_b128(LAS unsigned char* p) { return *(const LAS bf16x8*)p; }
DI LAS unsigned char* lp(unsigned a) { return (LAS unsigned char*)(size_t)a; }
typedef short v4i16_t __attribute__((ext_vector_type(4)));
DI s16x4 lds_tr(LAS unsigned char* p) { return __builtin_bit_cast(s16x4, __builtin_amdgcn_ds_read_tr16_b64_v4i16((LAS v4i16_t*)p)); }
DI int crow(int reg, int hh) { return (reg & 3) + 8 * (reg >> 2) + 4 * hh; }
typedef unsigned u32x4 __attribute__((ext_vector_type(4)));
typedef float f32x2_t __attribute__((ext_vector_type(2)));
typedef __bf16 bf16x2_t __attribute__((ext_vector_type(2)));
DI unsigned cvtpk(float lo, float hi) { f32x2_t v = {lo, hi}; bf16x2_t b = __builtin_convertvector(v, bf16x2_t); return __builtin_bit_cast(unsigned, b); }
DI bf16x8 pack8(float a0, float a1, float a2, float a3, float a4, float a5, float a6, float a7) {
    u32x4 p; p.x = cvtpk(a0, a1); p.y = cvtpk(a2, a3); p.z = cvtpk(a4, a5); p.w = cvtpk(a6, a7); return __builtin_bit_cast(bf16x8, p);
}
DI float bf_lo(unsigned w) { return __builtin_bit_cast(float, w << 16); }
DI float bf_hi(unsigned w) { return __builtin_bit_cast(float, w & 0xffff0000u); }

DI float wave_sum(float v) {
#pragma unroll
    for (int o = 1; o < 64; o <<= 1) v += __shfl_xor(v, o);
    return v;
}
template <int MAT> DI int colmap(int n) {
    if (MAT == 0) return n < 2 * ATTN_W ? (n & ~127) + ((n & 127) >> 1) + 64 * (n & 1) : (n < IN_W ? n : -1);
    if (MAT == 2) return DFF * ((n >> 7) & 1) + 128 * (n >> 8) + (n & 127);
    return n;
}
template <int MAT, bool SCALE, bool VEC> DI void transpose_items(const float* W, const float* gk, int K, int N, bf16* WT, LAS float* scr, int it0, int step, int it_end, int nblk, int lane) {
    if (it0 >= it_end) return;
    float cur[32], nxt[32];
    auto issue = [&](float (&r)[32], int item) {
        const int kb = item / nblk, nb = item % nblk, k0 = 64 * kb, n0 = 32 * nb;
        if (VEC) { const int q = lane & 7, kr = lane >> 3; const int col = colmap<MAT>(n0 + 4 * q);
#pragma unroll
            for (int i = 0; i < 8; ++i) { const f32x4 v = __builtin_nontemporal_load((const GAS f32x4*)(W + (size_t)(k0 + 8 * i + kr) * N + col)); r[4 * i] = v[0]; r[4 * i + 1] = v[1]; r[4 * i + 2] = v[2]; r[4 * i + 3] = v[3]; } }
        else { const int col = colmap<MAT>(n0 + (lane & 31));
#pragma unroll
            for (int i = 0; i < 32; ++i) r[i] = col >= 0 ? __builtin_nontemporal_load((const GAS float*)(W + (size_t)(k0 + 2 * i + (lane >> 5)) * N + col)) : 0.f; }
    };
    issue(cur, it0);
    for (int item = it0; item < it_end; item += step) {
        const bool has_next = item + step < it_end;
        if (has_next) issue(nxt, item + step);
        const int kb = item / nblk, nb = item % nblk, k0 = 64 * kb, n0 = 32 * nb;
        if (VEC) { const int q = lane & 7, kr = lane >> 3;
#pragma unroll
            for (int i = 0; i < 8; ++i)
#pragma unroll
                for (int j = 0; j < 4; ++j) scr[(8 * i + kr) * 33 + 4 * q + j] = cur[4 * i + j]; }
        else {
#pragma unroll
            for (int i = 0; i < 32; ++i) scr[(2 * i + (lane >> 5)) * 33 + (lane & 31)] = cur[i]; }
        const int c = lane & 7;
        f32x4 g0 = {1.f, 1.f, 1.f, 1.f}, g1v = g0;
        if (SCALE) { g0 = *(const GAS f32x4*)(gk + k0 + 8 * c); g1v = *(const GAS f32x4*)(gk + k0 + 8 * c + 4); }
        LDS_WAIT(); asm volatile("" ::: "memory");
#pragma unroll
        for (int j = 0; j < 4; ++j) { const int n = (lane >> 3) + 8 * j; const LAS float* sp = scr + (8 * c) * 33 + n;
            v4u o; o.x = cvtpk(sp[0 * 33] * g0[0], sp[1 * 33] * g0[1]); o.y = cvtpk(sp[2 * 33] * g0[2], sp[3 * 33] * g0[3]); o.z = cvtpk(sp[4 * 33] * g1v[0], sp[5 * 33] * g1v[1]); o.w = cvtpk(sp[6 * 33] * g1v[2], sp[7 * 33] * g1v[3]);
            if (VEC) __builtin_nontemporal_store(o, (GAS v4u*)(WT + (size_t)(n0 + n) * K + k0 + 8 * c)); else *(GAS v4u*)(WT + (size_t)(n0 + n) * K + k0 + 8 * c) = o; }
        LDS_WAIT(); asm volatile("" ::: "memory");
        if (has_next) {
#pragma unroll
            for (int i = 0; i < 32; ++i) cur[i] = nxt[i]; }
    }
}
DI void p0_prologue(Frame& F, const float* x, const float* g1, const float* w_in) {
    LAS float* scr = (LAS float*)(F.lds + RING_OFF + F.wave * 16384);
    const int gw = F.vcu * NWAVES + F.wave, NGW = F.G * NWAVES;
    constexpr int NB0 = IN_WP / 32, I0 = (DM / 64) * NB0;
    bf16* Win = (bf16*)(F.ws + WS_WIN);
    transpose_items<0, true, false>(w_in, g1, DM, IN_W, Win, scr, gw, NGW, I0, NB0, F.lane);
    {
        bf16* XN = (bf16*)(F.ws + WS_XN);
        f32x4 v[8], vn[8];
#pragma unroll
        for (int j = 0; j < 8; ++j) v[j] = __builtin_nontemporal_load((const GAS f32x4*)(x + (size_t)gw * DM) + F.lane + 64 * j);
        for (int m = gw; m < M; m += NGW) {
            const bool has_next = m + NGW < M;
            if (has_next) {
#pragma unroll
                for (int j = 0; j < 8; ++j) vn[j] = __builtin_nontemporal_load((const GAS f32x4*)(x + (size_t)(m + NGW) * DM) + F.lane + 64 * j); }
            float s = 0.f;
#pragma unroll
            for (int j = 0; j < 8; ++j) s += (v[j].x * v[j].x + v[j].y * v[j].y) + (v[j].z * v[j].z + v[j].w * v[j].w);
            const float rstd = 1.f / sqrtf(wave_sum(s) * (1.f / DM) + 1e-6f);
            GAS unsigned long long* o8 = (GAS unsigned long long*)(XN + (size_t)m * DM) + F.lane;
#pragma unroll
            for (int j = 0; j < 8; ++j) o8[64 * j] = (unsigned long long)cvtpk(v[j].x * rstd, v[j].y * rstd) | ((unsigned long long)cvtpk(v[j].z * rstd, v[j].w * rstd) << 32);
            if (has_next) {
#pragma unroll
                for (int j = 0; j < 8; ++j) v[j] = vn[j]; }
        }
    }
    {
        float* rope = (float*)(F.ws + WS_ROPE);
        for (int idx = gw * 64 + F.lane; idx < SEQ * 64; idx += NGW * 64) {
            const int t = idx >> 6, i = idx & 63; const double ang = (double)t * pow(10000.0, -(double)i / 64.0);
            rope[2 * idx] = (float)cos(ang); rope[2 * idx + 1] = (float)sin(ang);
        }
    }
}

DI void att_dma_tile(const unsigned char* gbase, const unsigned (&voff)[8], LAS unsigned char* ldst) {
#pragma unroll
    for (int it = 0; it < 8; ++it) __builtin_amdgcn_global_load_lds((const unsigned*)(gbase + voff[it]), (LAS unsigned*)(ldst + it * 1024), 16, 0, 0);
}
constexpr int ATT_LUT_BYTES = 10 * 2048;
DI void att_build_lut(LAS unsigned char* lut, int tid) {
    for (int idx = tid; idx < 10 * 64 * 8; idx += NWAVES * 64) {
        const int type = idx >> 9, rem = idx & 511, ln = rem >> 3, pair = rem & 7, q = ln & 31, hh = ln >> 5;
        const int d0 = type < 6 ? 32 * type : 32 * (type & 1);
        unsigned w = 0;
#pragma unroll
        for (int k = 0; k < 2; ++k) {
            const int e = 2 * pair + k, d = d0 + q - 4 * hh - ((e & 3) + 8 * (e >> 2));
            int c;
            if (type < 6) c = (d >= 0 && d <= 128 ? 1 : 0) + (d >= 0 && (d & 3) == 0 ? 1 : 0) + (d >= 0 && d <= 32 ? 1 : 0);
            else if (type < 8) c = (d >= 0 && d <= 31) ? 1 : 0;
            else c = (d >= 1 && d <= 32) ? 1 : 0;
            const unsigned bits = c == 0 ? 0xFF80u : (c == 1 ? 0x0000u : (c == 2 ? 0x3F80u : 0x3FCBu));
            w |= bits << (16 * k);
        }
        *(LAS unsigned*)(lut + type * 2048 + (pair >> 2) * 1024 + ln * 16 + (pair & 3) * 4) = w;
    }
}
DI void attn_unit(int b, int h, int r, int ib, const bf16* QB, const bf16* KB, const bf16* VB, bf16* MIX, LAS unsigned char* wl, LAS unsigned char* lut, int lane) {
    const int q = lane & 31, hh = lane >> 5, i0 = 32 * ib;
    const size_t rowb = (size_t)b * 2048;
    bf16x8 qf[8];
    { const bf16* qp = QB + (rowb + r * 512 + i0 + q) * 1536 + h * 128 + 8 * hh;
#pragma unroll
      for (int ks = 0; ks < 8; ++ks) qf[ks] = *(const GAS bf16x8*)(qp + 16 * ks); }
#pragma unroll
    for (int ks = 0; ks < 8; ++ks) asm volatile("" : "+v"(qf[ks]));
    f32x16 o[4];
#pragma unroll
    for (int c = 0; c < 4; ++c)
#pragma unroll
        for (int e = 0; e < 16; ++e) o[c][e] = 0.f;
    float mrun = -1e30f, lsum = 0.f;
    LAS unsigned char* Kt = wl; LAS unsigned char* Vt = wl + 8192;
    const int nt = (ib + 1) + (ib ? 6 : 3);
    auto tile_of = [&](int k, int& rc, int& j0, int& ty) {
        if (k <= ib) { rc = r; j0 = 32 * k; ty = ib - k < 5 ? ib - k : 5; }
        else { const int kk = k - (ib + 1); int far; if (ib) { rc = (r + 1 + (kk >> 1)) & 3; far = 1 - (kk & 1); } else { rc = (r + 1 + kk) & 3; far = 0; } j0 = i0 - 32 * far; ty = (r > rc ? 6 : 8) + far; } };
    unsigned voff[8];
#pragma unroll
    for (int it = 0; it < 8; ++it) { const unsigned row = 4 * it + (lane >> 4); voff[it] = row * 3072u + (((unsigned)lane & 15u) ^ swz_b(row)) * 16u; }
    const unsigned qi = (lane & 15) >> 2, pp = lane & 3, g16 = (lane >> 4) & 1;
    const unsigned swl = 16u * swz_b((unsigned)q), rowb_l = 256u * (unsigned)q;
    unsigned rk[8];
#pragma unroll
    for (int ks = 0; ks < 8; ++ks) rk[ks] = rowb_l + ((unsigned)(32 * ks + 16 * hh) ^ swl);
    unsigned tp[2];
#pragma unroll
    for (int t = 0; t < 2; ++t) tp[t] = 2048u * t + 1024u * hh + 256u * qi + 8u * (pp & 1) + 16u * ((2u * g16 + (pp >> 1)) ^ ((2u * t + hh) & 3u));
    const unsigned char* kbase = (const unsigned char*)(KB + rowb * 1536 + h * 128); const unsigned char* vbase = (const unsigned char*)(VB + rowb * 1536 + h * 128);
    { int rc, j0, ty; tile_of(0, rc, j0, ty);
      att_dma_tile(kbase + (size_t)(rc * 512 + j0) * 3072, voff, Kt);
      att_dma_tile(vbase + (size_t)(rc * 512 + j0) * 3072, voff, Vt); }
    for (int k = 0; k < nt; ++k) {
        int rc, j0, ty; tile_of(k, rc, j0, ty);
        const bool has_next = k + 1 < nt; int rcn = 0, j0n = 0, tyn = 0; if (has_next) tile_of(k + 1, rcn, j0n, tyn);
        const u32x4 bw0 = *(const LAS u32x4*)(lut + ty * 2048 + lane * 16), bw1 = *(const LAS u32x4*)(lut + ty * 2048 + 1024 + lane * 16);
        asm volatile("s_waitcnt vmcnt(8)" ::: "memory");
        bf16x8 kf[8];
#pragma unroll
        for (int ks = 0; ks < 8; ++ks) kf[ks] = lds_b128(Kt + rk[ks]);
        asm volatile("s_waitcnt lgkmcnt(0)" ::: "memory");
        if (has_next) att_dma_tile(kbase + (size_t)(rcn * 512 + j0n) * 3072, voff, Kt);
        f32x16 s;
#pragma unroll
        for (int e = 0; e < 16; ++e) s[e] = 0.f;
#pragma unroll
        for (int ks = 0; ks < 8; ++ks) s = MFMA32(kf[ks], qf[ks], s);
        s[0] += bf_lo(bw0.x); s[1] += bf_hi(bw0.x); s[2] += bf_lo(bw0.y); s[3] += bf_hi(bw0.y); s[4] += bf_lo(bw0.z); s[5] += bf_hi(bw0.z); s[6] += bf_lo(bw0.w); s[7] += bf_hi(bw0.w);
        s[8] += bf_lo(bw1.x); s[9] += bf_hi(bw1.x); s[10] += bf_lo(bw1.y); s[11] += bf_hi(bw1.y); s[12] += bf_lo(bw1.z); s[13] += bf_hi(bw1.z); s[14] += bf_lo(bw1.w); s[15] += bf_hi(bw1.w);
        float mx = fmaxf(fmaxf(fmaxf(s[0], s[1]), fmaxf(s[2], s[3])), fmaxf(fmaxf(s[4], s[5]), fmaxf(s[6], s[7])));
        mx = fmaxf(mx, fmaxf(fmaxf(fmaxf(s[8], s[9]), fmaxf(s[10], s[11])), fmaxf(fmaxf(s[12], s[13]), fmaxf(s[14], s[15]))));
        mx = fmaxf(mx, __shfl_xor(mx, 32));
        const float mnew = fmaxf(mrun, mx), alpha = __builtin_amdgcn_exp2f(mrun - mnew);
        float ps = 0.f;
#pragma unroll
        for (int e = 0; e < 16; ++e) { s[e] = __builtin_amdgcn_exp2f(s[e] - mnew); ps += s[e]; }
        lsum = lsum * alpha + ps;
        if (__any(mnew > mrun)) {
#pragma unroll
            for (int c = 0; c < 4; ++c)
#pragma unroll
                for (int e = 0; e < 16; ++e) o[c][e] *= alpha;
        }
        mrun = mnew;
        const bf16x8 pf0 = pack8(s[0], s[1], s[2], s[3], s[4], s[5], s[6], s[7]), pf1 = pack8(s[8], s[9], s[10], s[11], s[12], s[13], s[14], s[15]);
        if (has_next) asm volatile("s_waitcnt vmcnt(8)" ::: "memory"); else asm volatile("s_waitcnt vmcnt(0)" ::: "memory");
        bf16x8 vf[4][2];
#pragma unroll
        for (int c = 0; c < 4; ++c)
#pragma unroll
            for (int s2 = 0; s2 < 2; ++s2) {
                const unsigned xc = 64u * ((unsigned)c ^ qi);
                const s16x4 lo = lds_tr(Vt + 4096 * s2 + tp[0] + xc);
                const s16x4 hi = lds_tr(Vt + 4096 * s2 + tp[1] + xc);
                vf[c][s2] = __builtin_shufflevector(lo, hi, 0, 1, 2, 3, 4, 5, 6, 7);
            }
        asm volatile("s_waitcnt lgkmcnt(0)" ::: "memory");
        if (has_next) att_dma_tile(vbase + (size_t)(rcn * 512 + j0n) * 3072, voff, Vt);
#pragma unroll
        for (int c = 0; c < 4; ++c) { o[c] = MFMA32(vf[c][0], pf0, o[c]); o[c] = MFMA32(vf[c][1], pf1, o[c]); }
    }
    lsum += __shfl_xor(lsum, 32);
    const float inv = 1.0f / lsum;
#pragma unroll
    for (int c = 0; c < 4; ++c)
#pragma unroll
        for (int g = 0; g < 4; ++g) {
            u32x2 w; w.x = cvtpk(o[c][4 * g] * inv, o[c][4 * g + 1] * inv); w.y = cvtpk(o[c][4 * g + 2] * inv, o[c][4 * g + 3] * inv);
            *(LAS u32x2*)(Kt + rowb_l + ((unsigned)(16 * (4 * c + g)) ^ swl) + 8u * hh) = w;
        }
    asm volatile("s_waitcnt lgkmcnt(0)" ::: "memory");
    {
        unsigned char* ob = (unsigned char*)(MIX + ((size_t)b * 2048 + 4 * i0 + r) * 2048 + h * 128);
#pragma unroll
        for (int it = 0; it < 8; ++it) {
            const unsigned row = 4 * it + (lane >> 4), ch = lane & 15;
            const u32x4 v = *(const LAS u32x4*)(Kt + off_b(row, ch));
            *(GAS u32x4*)(ob + (size_t)row * 16384 + ch * 16) = v;
        }
    }
    asm volatile("s_waitcnt lgkmcnt(0)" ::: "memory");
}
constexpr int CV_NB1 = DM / 32, CV_NB2 = UPW / 32, CV_NB3 = DM / 32, CV_I1 = (DM / 64) * CV_NB1, CV_I2 = (DM / 64) * CV_NB2, CV_I3 = (DFF / 64) * CV_NB3;
constexpr int CV_EARLY = 0;
DI void convert_range(Frame& F, LAS float* scr, const float* w_out, const float* w_up, const float* g2, const float* w_down, int lo, int hi, int cw0, int cwn) {
    bf16* Wout = (bf16*)(F.ws + WS_WOUT); bf16* Wup = (bf16*)(F.ws + WS_WUP); bf16* Wdn = (bf16*)(F.ws + WS_WDN);
    auto clampi = [](int v, int a, int b) { return v < a ? a : (v > b ? b : v); };
    { const int a = clampi(lo, 0, CV_I1), b = clampi(hi, 0, CV_I1); if (b > a) transpose_items<1, false, true>(w_out, nullptr, DM, DM, Wout, scr, a + cw0, cwn, b, CV_NB1, F.lane); }
    { const int a = clampi(lo - CV_I1, 0, CV_I2), b = clampi(hi - CV_I1, 0, CV_I2); if (b > a) transpose_items<2, true, true>(w_up, g2, DM, UPW, Wup, scr, a + cw0, cwn, b, CV_NB2, F.lane); }
    { const int a = clampi(lo - CV_I1 - CV_I2, 0, CV_I3), b = clampi(hi - CV_I1 - CV_I2, 0, CV_I3); if (b > a) transpose_items<3, false, true>(w_down, nullptr, DFF, DM, Wdn, scr, a + cw0, cwn, b, CV_NB3, F.lane); }
}
constexpr int ML_SPLIT = 11;
constexpr int ML_WGS = 2 * BATCH * NMH;
DI void attn_phase(Frame& F, int qword0, const float* w_out, const float* w_up, const float* g2, const float* w_down, bool skip_conv) {
    const bf16* QB = (const bf16*)(F.ws + WS_QB); const bf16* KB = (const bf16*)(F.ws + WS_KB); const bf16* VB = (const bf16*)(F.ws + WS_VB); bf16* MIX = (bf16*)(F.ws + WS_MIX);
    LAS unsigned char* wl = F.lds + RING_OFF + F.wave * 16384; LAS unsigned char* lut = F.lds + SCR_OFF;
    att_build_lut(lut, F.tid);
    __syncthreads();
    constexpr int NCW = 3;
    if (F.wave >= NWAVES - NCW && !skip_conv)
        convert_range(F, (LAS float*)wl, w_out, w_up, g2, w_down, F.G == 256 ? CV_EARLY : 0, CV_I1 + CV_I2 + CV_I3, ((int)blockIdx.x - ML_WGS) * NCW + (F.wave - (NWAVES - NCW)), (F.G - ML_WGS) * NCW);
    int qsel = (int)(xb_xcc_id() & 7u);
    for (int tries = 0; tries < 8;) {
        unsigned u = 0; if (F.lane == 0) u = xb_add((unsigned*)(F.ctl + qword0 + 64 * qsel), 1u);
        u = (unsigned)__builtin_amdgcn_readfirstlane((int)u);
        if (u >= 768u) { qsel = (qsel + 1) & 7; ++tries; continue; }
        const int pair = u >> 4, ib = 15 - (u & 15), bh = qsel * 12 + (pair >> 2), r = pair & 3;
        attn_unit(bh / 12, bh % 12, r, ib, QB, KB, VB, MIX, wl, lut, F.lane);
    }
}

DI float scan_add64(float v, int lane) {
#pragma unroll
    for (int d = 1; d < 64; d <<= 1) { const float t = __shfl_up(v, d); if (lane >= d) v += t; }
    return v;
}
DI float scan_max64(float v, int lane) {
#pragma unroll
    for (int d = 1; d < 64; d <<= 1) { const float t = __shfl_up(v, d); if (lane >= d) v = fmaxf(v, t); }
    return v;
}
DI float silu_f(float y) { return y * __builtin_amdgcn_rcpf(1.0f + __builtin_amdgcn_exp2f(-LOG2E * y)); }
DI void mixer_prepass(Frame& F, const float* mcw, const float* mcb) {
    const bf16* ML = (const bf16*)(F.ws + WS_ML); bf16* MLC = (bf16*)(F.ws + WS_MLC); const float* G = (const float*)(F.ws + WS_G); float* GA = (float*)(F.ws + WS_GA);
    const int gw = F.vcu * NWAVES + F.wave, NGW = F.G * NWAVES;
    for (int it = gw; it < 32 * 16; it += NGW) {
        const int seq = it >> 4, ch = it & 15, b = seq >> 2, hm = seq & 3; const size_t mrow0 = (size_t)b * 2048 + ch * 128;
        const float gi0 = G[(mrow0 + F.lane) * 8 + hm], gf0 = G[(mrow0 + F.lane) * 8 + 4 + hm], gi1 = G[(mrow0 + 64 + F.lane) * 8 + hm], gf1 = G[(mrow0 + 64 + F.lane) * 8 + 4 + hm];
        const float lf0 = fminf(gf0, 0.f) - log1pf(expf(-fabsf(gf0))), lf1 = fminf(gf1, 0.f) - log1pf(expf(-fabsf(gf1)));
        const float b0 = scan_add64(lf0, F.lane); const float tot0 = __shfl(b0, 63); const float b1 = scan_add64(lf1, F.lane) + tot0;
        const float a0 = gi0 - b0, a1 = gi1 - b1;
        const float cm0 = scan_max64(a0, F.lane); const float M0 = __shfl(cm0, 63); const float cm1 = fmaxf(scan_max64(a1, F.lane), M0);
        float* o = GA + (size_t)it * 384;
        o[F.lane] = b0; o[64 + F.lane] = b1; o[128 + F.lane] = a0; o[192 + F.lane] = a1; o[256 + F.lane] = cm0; o[320 + F.lane] = cm1;
    }
    for (int it = gw * 64 + F.lane; it < (M / 4) * 128; it += NGW * 64) {
        const int c8 = it & 127, r4 = it >> 7, m0 = 4 * r4, t0 = m0 & 2047, ch0 = 8 * c8;
        u32x4 raw[7];
#pragma unroll
        for (int i = 0; i < 7; ++i) { u32x4 rv = *(const GAS u32x4*)(ML + (size_t)(m0 - 3 + i) * 2048 + ch0); if (t0 - 3 + i < 0) rv = (u32x4){0u, 0u, 0u, 0u}; raw[i] = rv; }
        float wt[5][8];
#pragma unroll
        for (int tap = 0; tap < 5; ++tap) { const float* wp = tap < 4 ? mcw + tap * 1024 + ch0 : mcb + ch0; const f32x4 a = *(const f32x4*)wp, bq = *(const f32x4*)(wp + 4);
            wt[tap][0] = a[0]; wt[tap][1] = a[1]; wt[tap][2] = a[2]; wt[tap][3] = a[3]; wt[tap][4] = bq[0]; wt[tap][5] = bq[1]; wt[tap][6] = bq[2]; wt[tap][7] = bq[3]; }
        const float osc = ch0 >= 512 ? 0.08838834764831845f : 1.0f;
#pragma unroll
        for (int rho = 0; rho < 4; ++rho) {
            float y[8];
#pragma unroll
            for (int j = 0; j < 8; ++j) y[j] = wt[4][j];
#pragma unroll
            for (int tap = 0; tap < 4; ++tap) { const u32x4 x = raw[rho + tap];
                y[0] += wt[tap][0] * bf_lo(x.x); y[1] += wt[tap][1] * bf_hi(x.x); y[2] += wt[tap][2] * bf_lo(x.y); y[3] += wt[tap][3] * bf_hi(x.y);
                y[4] += wt[tap][4] * bf_lo(x.z); y[5] += wt[tap][5] * bf_hi(x.z); y[6] += wt[tap][6] * bf_lo(x.w); y[7] += wt[tap][7] * bf_hi(x.w); }
#pragma unroll
            for (int j = 0; j < 8; ++j) y[j] = silu_f(y[j]) * osc;
            *(GAS bf16x8*)(MLC + (size_t)(m0 + rho) * 1024 + ch0) = pack8(y[0], y[1], y[2], y[3], y[4], y[5], y[6], y[7]);
        }
    }
}

constexpr int ML_Q = 0, ML_K = 32768, ML_V = 65536, ML_C = 98304;
constexpr int MS_A = 0, MS_U = 512, MS_WI = 1024, MS_WK = 1536, MS_EM = 2048, MS_NV = 2560, MS_GV = 3072, MS_CW = 3584, MS_NR = 8704, MS_RS = 12800, MS_SC = 13824;
DI void mlstm_seq(Frame& F, int b, int hm, const float* mng, int c0, int c1) {
    LAS unsigned char* L = F.lds + RING_OFF; LAS unsigned char* S = F.lds + SCR_OFF;
    LAS float* A_ = (LAS float*)(S + MS_A); LAS float* U_ = (LAS float*)(S + MS_U); LAS float* WI = (LAS float*)(S + MS_WI); LAS float* WK = (LAS float*)(S + MS_WK); LAS float* EM = (LAS float*)(S + MS_EM);
    LAS float* NV = (LAS float*)(S + MS_NV); LAS float* GV = (LAS float*)(S + MS_GV); LAS float* CW = (LAS float*)(S + MS_CW); LAS float* NR = (LAS float*)(S + MS_NR); LAS float* RS = (LAS float*)(S + MS_RS); LAS float* SC = (LAS float*)(S + MS_SC);
    const int w = F.wave;
    const bf16* ML = (const bf16*)(F.ws + WS_ML); const bf16* MLC = (const bf16*)(F.ws + WS_MLC); const float* GA = (const float*)(F.ws + WS_GA) + (size_t)(b * 4 + hm) * 16 * 384; bf16* MIX = (bf16*)(F.ws + WS_MIX);
    if (F.tid < 128) { GV[F.tid] = mng[hm * 128 + F.tid]; NV[F.tid] = 0.f; }
    for (int i = F.tid; i < 32768 / 16; i += 512) *(LAS u32x4*)(L + ML_C + 16 * i) = (u32x4){0u, 0u, 0u, 0u};
    f32x16 Cacc[2];
#pragma unroll
    for (int i = 0; i < 2; ++i)
#pragma unroll
        for (int e = 0; e < 16; ++e) Cacc[i][e] = 0.f;
    float mc = 0.f;
    const int tb = (w & 3) ^ (3 * (w >> 2)), eh = w >> 2;
    const int ebF = w >> 1, dbF0 = 2 * (w & 1);
#define ML_BAR() do { asm volatile("s_waitcnt lgkmcnt(0)" ::: "memory"); __builtin_amdgcn_s_barrier(); asm volatile("" ::: "memory"); } while (0)
#define ML_OPAQUE_TID(name) int name = F.tid; asm volatile("" : "+v"(name))
#define ML_THREAD_MAP(tidv) const int c16 = (tidv) & 15, rg = (tidv) >> 4; const unsigned rg16 = 16u * rg, c32 = 32u * c16; unsigned sa[4]; \
        _Pragma("unroll") for (int rho = 0; rho < 4; ++rho) sa[rho] = 1024u * rg + 256u * rho + 64u * (((unsigned)c16 >> 2) ^ (unsigned)rho) + 16u * (((unsigned)c16 & 3u) ^ ((unsigned)rg & 3u))
#define ML_LANE_MAP(tidv) const int lane = (tidv) & 63, hh = lane >> 5, l31 = lane & 31; const unsigned qi = (lane & 15) >> 2, pp = lane & 3, g16 = (lane >> 4) & 1; \
        const unsigned swl_ = 16u * swz_b((unsigned)l31), rowb_ = 256u * (unsigned)l31, hh8 = 8u * hh, hh16 = 16u * hh; unsigned tn[2], tp[2]; \
        _Pragma("unroll") for (int t = 0; t < 2; ++t) { tn[t] = 2048u * hh + 1024u * t + 256u * qi + 8u * (pp & 1) + 16u * ((2u * g16 + (pp >> 1)) ^ ((2u * hh + t) & 3u)); \
                                                       tp[t] = 2048u * t + 1024u * hh + 256u * qi + 8u * (pp & 1) + 16u * ((2u * g16 + (pp >> 1)) ^ ((2u * t + hh) & 3u)); }
#define SF(off) (*(LAS float*)(S + (off)))
#define SF4(off) (*(const LAS f32x4*)(S + (off)))
    u32x4 rq[4], rk_[4], rv4[4]; float pgt[6] = {0.f, 0.f, 0.f, 0.f, 0.f, 0.f};
    {
        const int c16 = F.tid & 15, rg = F.tid >> 4;
        const unsigned char* cq0 = (const unsigned char*)MLC + (size_t)b * 2048 * 2048 + 8192u * rg + 256u * hm + 16u * c16;
        const unsigned char* cv0 = (const unsigned char*)ML + (size_t)b * 2048 * 4096 + 16384u * rg + 2048 + 256u * hm + 16u * c16;
#pragma unroll
        for (int rho = 0; rho < 4; ++rho) { rk_[rho] = *(const GAS u32x4*)(cq0 + rho * 2048 + 1024); rv4[rho] = *(const GAS u32x4*)(cv0 + rho * 4096); }
        if (w == 0) {
#pragma unroll
            for (int i = 0; i < 6; ++i) pgt[i] = GA[64 * i + F.lane]; }
    }
    __syncthreads();
    for (int ch = 0; ch < c0; ++ch) {
        {
        ML_OPAQUE_TID(tidA); ML_THREAD_MAP(tidA);
#pragma unroll
        for (int rho = 0; rho < 4; ++rho) { *(LAS u32x4*)(lp(sa[rho]) + ML_K) = rk_[rho]; *(LAS u32x4*)lp(sa[rho] + ML_V) = rv4[rho]; }
        }
        if (w == 0) {
            ML_OPAQUE_TID(tidB); const int lane = tidB & 63; const unsigned l4 = 4u * lane;
            const float b1 = pgt[1], a0 = pgt[2], a1 = pgt[3], cm1 = pgt[5];
            const float Mall = __shfl(cm1, 63), blast = __shfl(b1, 63), mxa = fmaxf(mc, Mall);
            SF(MS_WK + l4) = __builtin_amdgcn_exp2f(LOG2E * (a0 - mxa)); SF(MS_WK + 256 + l4) = __builtin_amdgcn_exp2f(LOG2E * (a1 - mxa));
            if (lane == 0) SC[0] = __builtin_amdgcn_exp2f(LOG2E * (mc - mxa));
            mc = blast + mxa;
        }
        ML_BAR();
        {
            ML_OPAQUE_TID(tidP); const int c16 = tidP & 15, rg = tidP >> 4;
            int cn = ch + 1; asm volatile("" : "+s"(cn));
            const unsigned char* cq1 = (const unsigned char*)MLC + ((size_t)b * 2048 + cn * 128) * 2048 + 8192u * rg + 256u * hm + 16u * c16;
            const unsigned char* cv1 = (const unsigned char*)ML + ((size_t)b * 2048 + cn * 128) * 4096 + 16384u * rg + 2048 + 256u * hm + 16u * c16;
#pragma unroll
            for (int rho = 0; rho < 4; ++rho) { rk_[rho] = *(const GAS u32x4*)(cq1 + rho * 2048 + 1024); rv4[rho] = *(const GAS u32x4*)(cv1 + rho * 4096); }
            if (w == 0) { const float* ga1 = GA + cn * 384 + (tidP & 63);
#pragma unroll
                for (int i = 0; i < 6; ++i) pgt[i] = ga1[64 * i]; }
        }
        {
            ML_OPAQUE_TID(tidK); ML_THREAD_MAP(tidK); const int lane = tidK & 63;
            float ps[8] = {0.f, 0.f, 0.f, 0.f, 0.f, 0.f, 0.f, 0.f};
#pragma unroll
            for (int rho = 0; rho < 4; ++rho) {
                const float wk = SF(MS_WK + 4 * rho + rg16); const u32x4 kk = *(const LAS u32x4*)(lp(sa[rho]) + ML_K);
                const float v0 = bf_lo(kk.x) * wk, v1 = bf_hi(kk.x) * wk, v2 = bf_lo(kk.y) * wk, v3 = bf_hi(kk.y) * wk, v4 = bf_lo(kk.z) * wk, v5 = bf_hi(kk.z) * wk, v6 = bf_lo(kk.w) * wk, v7 = bf_hi(kk.w) * wk;
                ps[0] += v0; ps[1] += v1; ps[2] += v2; ps[3] += v3; ps[4] += v4; ps[5] += v5; ps[6] += v6; ps[7] += v7;
                *(LAS bf16x8*)(lp(sa[rho]) + ML_Q) = pack8(v0, v1, v2, v3, v4, v5, v6, v7);
            }
#pragma unroll
            for (int j = 0; j < 8; ++j) { ps[j] += __shfl_xor(ps[j], 16); ps[j] += __shfl_xor(ps[j], 32); }
            if ((lane >> 4) == 0) {
#pragma unroll
                for (int j = 0; j < 8; ++j) SF(MS_NR + 512 * w + 4 * j + c32) = ps[j];
            }
        }
        ML_BAR();
        {
        const float decay = SC[0];
        ML_OPAQUE_TID(tidF); const unsigned t4 = 4u * tidF;
        if (tidF < 128) { float a = 0.f;
#pragma unroll
            for (int ww = 0; ww < 8; ++ww) a += SF(MS_NR + 512 * ww + t4);
            SF(MS_NV + t4) = decay * SF(MS_NV + t4) + a; }
#pragma unroll
        for (int i = 0; i < 2; ++i)
#pragma unroll
            for (int e = 0; e < 16; ++e) Cacc[i][e] *= decay;
        ML_LANE_MAP(tidF);
        const unsigned xc_eF = 64u * ((unsigned)ebF ^ qi), xc_d0 = 64u * ((unsigned)dbF0 ^ qi), xc_d1 = 64u * ((unsigned)(dbF0 + 1) ^ qi);
        const unsigned aF0 = ML_V + tn[0] + xc_eF, aF1 = ML_V + tn[1] + xc_eF, aK00 = ML_Q + tn[0] + xc_d0, aK01 = ML_Q + tn[1] + xc_d0, aK10 = ML_Q + tn[0] + xc_d1, aK11 = ML_Q + tn[1] + xc_d1;
        bf16x8 af[8];
#pragma unroll
        for (int ks = 0; ks < 8; ++ks) { const s16x4 alo = lds_tr(lp(aF0) + 4096 * ks), ahi = lds_tr(lp(aF1) + 4096 * ks); af[ks] = __builtin_shufflevector(alo, ahi, 0, 1, 2, 3, 4, 5, 6, 7); }
#pragma unroll
        for (int i = 0; i < 2; ++i) {
            bf16x8 bk[8];
#pragma unroll
            for (int ks = 0; ks < 8; ++ks) { const s16x4 blo = lds_tr(lp(i ? aK10 : aK00) + 4096 * ks), bhi = lds_tr(lp(i ? aK11 : aK01) + 4096 * ks); bk[ks] = __builtin_shufflevector(blo, bhi, 0, 1, 2, 3, 4, 5, 6, 7); }
#pragma unroll
            for (int ks = 0; ks < 8; ++ks) Cacc[i] = MFMA32(af[ks], bk[ks], Cacc[i]);
        }
        }
        ML_BAR();
    }
    if (c0 > 0) {
        ML_OPAQUE_TID(tidW); ML_LANE_MAP(tidW);
#pragma unroll
        for (int i = 0; i < 2; ++i)
#pragma unroll
            for (int g = 0; g < 4; ++g) {
                u32x2 wv; wv.x = cvtpk(Cacc[i][4 * g], Cacc[i][4 * g + 1]); wv.y = cvtpk(Cacc[i][4 * g + 2], Cacc[i][4 * g + 3]);
                *(LAS u32x2*)lp(rowb_ + ((unsigned)(16 * (4 * ebF + g)) ^ swl_) + hh8 + ML_C + 8192u * (dbF0 + i)) = wv;
            }
    }
    {
        const int c16 = F.tid & 15, rg = F.tid >> 4;
        const unsigned char* cq0 = (const unsigned char*)MLC + ((size_t)b * 2048 + c0 * 128) * 2048 + 8192u * rg + 256u * hm + 16u * c16;
#pragma unroll
        for (int rho = 0; rho < 4; ++rho) rq[rho] = *(const GAS u32x4*)(cq0 + rho * 2048);
    }
    __syncthreads();
    for (int ch = c0; ch < c1; ++ch) {
        int t0 = ch * 128; asm volatile("" : "+s"(t0));
        const size_t mrow0 = (size_t)b * 2048 + t0;
        const unsigned char* cb0 = (const unsigned char*)ML + mrow0 * 4096;
        unsigned char* mb0 = (unsigned char*)MIX + mrow0 * 4096;
        {
        ML_OPAQUE_TID(tidA); ML_THREAD_MAP(tidA);
#pragma unroll
        for (int rho = 0; rho < 4; ++rho) { *(LAS u32x4*)(lp(sa[rho]) + ML_Q) = rq[rho]; *(LAS u32x4*)(lp(sa[rho]) + ML_K) = rk_[rho]; *(LAS u32x4*)lp(sa[rho] + ML_V) = rv4[rho]; }
        }
        __builtin_amdgcn_sched_barrier(0);
        if (w == 0) {
            ML_OPAQUE_TID(tidB); const int lane = tidB & 63; const unsigned l4 = 4u * lane;
            const float b0 = pgt[0], b1 = pgt[1], a0 = pgt[2], a1 = pgt[3], cm0 = pgt[4], cm1 = pgt[5];
            const float mx0 = fmaxf(mc, cm0), mx1 = fmaxf(mc, cm1);
            SF(MS_A + l4) = a0; SF(MS_A + 256 + l4) = a1; SF(MS_U + l4) = -mx0; SF(MS_U + 256 + l4) = -mx1;
            SF(MS_WI + l4) = __builtin_amdgcn_exp2f(LOG2E * (mc - mx0)); SF(MS_WI + 256 + l4) = __builtin_amdgcn_exp2f(LOG2E * (mc - mx1));
            SF(MS_EM + l4) = __builtin_amdgcn_exp2f(-LOG2E * (b0 + mx0)); SF(MS_EM + 256 + l4) = __builtin_amdgcn_exp2f(-LOG2E * (b1 + mx1));
            const float Mall = __shfl(cm1, 63), blast = __shfl(b1, 63), mxa = fmaxf(mc, Mall);
            SF(MS_WK + l4) = __builtin_amdgcn_exp2f(LOG2E * (a0 - mxa)); SF(MS_WK + 256 + l4) = __builtin_amdgcn_exp2f(LOG2E * (a1 - mxa));
            if (lane == 0) SC[0] = __builtin_amdgcn_exp2f(LOG2E * (mc - mxa));
            mc = blast + mxa;
        }
        ML_BAR();
        ML_OPAQUE_TID(tidC); ML_LANE_MAP(tidC);
        const unsigned tq4 = 4u * (32u * tb + l31);
        const unsigned voffO = 4096u * (32u * tb + l31) + 3072u + 256u * hm + 128u * eh + 8u * hh;
        unsigned rk[8];
#pragma unroll
        for (int ks = 0; ks < 8; ++ks) rk[ks] = rowb_ + ((unsigned)(32 * ks + 2 * hh8) ^ swl_);
        const unsigned xc_e0 = 64u * ((unsigned)(2 * eh) ^ qi), xc_e1 = 64u * ((unsigned)(2 * eh + 1) ^ qi);
        const unsigned aC00 = ML_C + tn[0] + xc_e0, aC01 = ML_C + tn[1] + xc_e0, aC10 = ML_C + tn[0] + xc_e1, aC11 = ML_C + tn[1] + xc_e1;
        const unsigned aV00 = ML_V + tp[0] + xc_e0, aV01 = ML_V + tp[1] + xc_e0, aV10 = ML_V + tp[0] + xc_e1, aV11 = ML_V + tp[1] + xc_e1;
        __builtin_amdgcn_sched_barrier(0);
        const int tq = 32 * tb + l31;
        const unsigned qoff = ML_Q + 8192u * tb;
        const float ut = SF(MS_U + tq4), wint = SF(MS_WI + tq4), emt = SF(MS_EM + tq4);
        bf16x8 qf[8];
#pragma unroll
        for (int ks = 0; ks < 8; ++ks) qf[ks] = lds_b128(lp(rk[ks] + qoff));
        f32x16 acc[2];
#pragma unroll
        for (int c = 0; c < 2; ++c) {
            __builtin_amdgcn_sched_barrier(0);
            bf16x8 cf[8];
#pragma unroll
            for (int ks = 0; ks < 8; ++ks) {
                const s16x4 lo = lds_tr(lp(c ? aC10 : aC00) + 4096 * ks);
                const s16x4 hi = lds_tr(lp(c ? aC11 : aC01) + 4096 * ks);
                cf[ks] = __builtin_shufflevector(lo, hi, 0, 1, 2, 3, 4, 5, 6, 7);
            }
#pragma unroll
            for (int e = 0; e < 16; ++e) acc[c][e] = 0.f;
#pragma unroll
            for (int ks = 0; ks < 8; ++ks) acc[c] = MFMA32(cf[ks], qf[ks], acc[c]);
#pragma unroll
            for (int e = 0; e < 16; ++e) acc[c][e] *= wint;
        }
        float qn = 0.f;
#pragma unroll
        for (int ks = 0; ks < 8; ++ks) { const f32x4 n0 = SF4(MS_NV + 64 * ks + 2 * hh16), n1 = SF4(MS_NV + 64 * ks + 16 + 2 * hh16); const u32x4 qq = __builtin_bit_cast(u32x4, qf[ks]);
            qn += bf_lo(qq.x) * n0[0] + bf_hi(qq.x) * n0[1] + bf_lo(qq.y) * n0[2] + bf_hi(qq.y) * n0[3] + bf_lo(qq.z) * n1[0] + bf_hi(qq.z) * n1[1] + bf_lo(qq.w) * n1[2] + bf_hi(qq.w) * n1[3]; }
        __builtin_amdgcn_sched_barrier(0);
        u32x4 og[4];
        { ML_OPAQUE_TID(tidO); const unsigned char* co = cb0 + 3072 + 256u * hm + 16384u * (tidO >> 4) + 16u * (tidO & 15);
#pragma unroll
          for (int rho = 0; rho < 4; ++rho) og[rho] = *(const GAS u32x4*)(co + rho * 4096); }
        float sumP = 0.f;
#pragma unroll
        for (int sb = 0; sb < 4; ++sb) {
            if (sb <= tb) {
                __builtin_amdgcn_sched_barrier(0);
                f32x16 s; bf16x8 kf[8];
#pragma unroll
                for (int e = 0; e < 16; ++e) s[e] = 0.f;
#pragma unroll
                for (int ks = 0; ks < 8; ++ks) kf[ks] = lds_b128(lp(rk[ks]) + ML_K + 8192 * sb);
#pragma unroll
                for (int ks = 0; ks < 8; ++ks) s = MFMA32(kf[ks], qf[ks], s);
#pragma unroll
                for (int g = 0; g < 4; ++g) { const f32x4 av = SF4(MS_A + 4 * (32 * sb + 8 * g) + hh16);
#pragma unroll
                    for (int j = 0; j < 4; ++j) { const int e = 4 * g + j; float p = s[e] * __builtin_amdgcn_exp2f(LOG2E * (ut + av[j])); if (sb == tb && crow(e, hh) > l31) p = 0.f; s[e] = p; sumP += p; } }
                const bf16x8 pf0 = pack8(s[0], s[1], s[2], s[3], s[4], s[5], s[6], s[7]), pf1 = pack8(s[8], s[9], s[10], s[11], s[12], s[13], s[14], s[15]);
                __builtin_amdgcn_sched_barrier(0);
                bf16x8 vf[2][2];
#pragma unroll
                for (int c = 0; c < 2; ++c)
#pragma unroll
                    for (int s2 = 0; s2 < 2; ++s2) {
                        const s16x4 lo = lds_tr(lp(c ? aV10 : aV00) + 8192 * sb + 4096 * s2);
                        const s16x4 hi = lds_tr(lp(c ? aV11 : aV01) + 8192 * sb + 4096 * s2);
                        vf[c][s2] = __builtin_shufflevector(lo, hi, 0, 1, 2, 3, 4, 5, 6, 7);
                    }
#pragma unroll
                for (int c = 0; c < 2; ++c) { acc[c] = MFMA32(vf[c][0], pf0, acc[c]); acc[c] = MFMA32(vf[c][1], pf1, acc[c]); }
            }
        }
        qn += __shfl_xor(qn, 32); sumP += __shfl_xor(sumP, 32);
        const float den = wint * qn + sumP, rden = 1.0f / fmaxf(fabsf(den), emt);
        __builtin_amdgcn_sched_barrier(0);
        ML_BAR();
#pragma unroll
        for (int c = 0; c < 2; ++c)
#pragma unroll
            for (int g = 0; g < 4; ++g) {
                u32x2 wv; wv.x = cvtpk(acc[c][4 * g] * rden, acc[c][4 * g + 1] * rden); wv.y = cvtpk(acc[c][4 * g + 2] * rden, acc[c][4 * g + 3] * rden);
                *(LAS u32x2*)lp(ML_Q + 8192u * tb + rowb_ + ((unsigned)(16 * (4 * (2 * eh + c) + g)) ^ swl_) + hh8) = wv;
            }
        ML_BAR();
        {
            ML_OPAQUE_TID(tidE); ML_THREAD_MAP(tidE);
            const f32x4 g0 = SF4(MS_GV + c32), g1v = SF4(MS_GV + 16 + c32);
            unsigned char* mo = mb0 + 3072 + 256u * hm + 16384u * rg + 16u * c16;
#pragma unroll
            for (int rho = 0; rho < 4; ++rho) {
                const u32x4 hv = *(const LAS u32x4*)(lp(sa[rho]) + ML_Q); const u32x4 ov = og[rho];
                float h[8] = {bf_lo(hv.x), bf_hi(hv.x), bf_lo(hv.y), bf_hi(hv.y), bf_lo(hv.z), bf_hi(hv.z), bf_lo(hv.w), bf_hi(hv.w)};
                const float o[8] = {bf_lo(ov.x), bf_hi(ov.x), bf_lo(ov.y), bf_hi(ov.y), bf_lo(ov.z), bf_hi(ov.z), bf_lo(ov.w), bf_hi(ov.w)};
                float ssq = 0.f;
#pragma unroll
                for (int j = 0; j < 8; ++j) { h[j] *= __builtin_amdgcn_rcpf(1.0f + __builtin_amdgcn_exp2f(-LOG2E * o[j])); ssq += h[j] * h[j]; }
                ssq += __shfl_xor(ssq, 1); ssq += __shfl_xor(ssq, 2); ssq += __shfl_xor(ssq, 4); ssq += __shfl_xor(ssq, 8);
                const float rstd = 1.0f / sqrtf(ssq * (1.0f / 128.0f) + 1e-6f);
                u32x4 wv; wv.x = cvtpk(h[0] * rstd * g0[0], h[1] * rstd * g0[1]); wv.y = cvtpk(h[2] * rstd * g0[2], h[3] * rstd * g0[3]); wv.z = cvtpk(h[4] * rstd * g1v[0], h[5] * rstd * g1v[1]); wv.w = cvtpk(h[6] * rstd * g1v[2], h[7] * rstd * g1v[3]);
                *(GAS u32x4*)(mo + rho * 4096) = wv;
            }
        }
        __builtin_amdgcn_sched_barrier(0);
        __builtin_amdgcn_sched_barrier(0);
        {
            ML_OPAQUE_TID(tidP); const int c16 = tidP & 15, rg = tidP >> 4;
            int cn1 = (ch + 1 < c1 ? ch + 1 : ch); asm volatile("" : "+s"(cn1));
            const unsigned char* cq1 = (const unsigned char*)MLC + ((size_t)b * 2048 + cn1 * 128) * 2048 + 8192u * rg + 256u * hm + 16u * c16;
            const unsigned char* cv1 = (const unsigned char*)ML + ((size_t)b * 2048 + cn1 * 128) * 4096 + 16384u * rg + 2048 + 256u * hm + 16u * c16;
#pragma unroll
            for (int rho = 0; rho < 4; ++rho) { rk_[rho] = *(const GAS u32x4*)(cq1 + rho * 2048 + 1024); rv4[rho] = *(const GAS u32x4*)(cv1 + rho * 4096); }
        }
        __builtin_amdgcn_sched_barrier(0);
        {
            ML_OPAQUE_TID(tidK); ML_THREAD_MAP(tidK); const int lane = tidK & 63;
            float ps[8] = {0.f, 0.f, 0.f, 0.f, 0.f, 0.f, 0.f, 0.f};
#pragma unroll
            for (int rho = 0; rho < 4; ++rho) {
                const float wk = SF(MS_WK + 4 * rho + rg16); const u32x4 kk = *(const LAS u32x4*)(lp(sa[rho]) + ML_K);
                const float v0 = bf_lo(kk.x) * wk, v1 = bf_hi(kk.x) * wk, v2 = bf_lo(kk.y) * wk, v3 = bf_hi(kk.y) * wk, v4 = bf_lo(kk.z) * wk, v5 = bf_hi(kk.z) * wk, v6 = bf_lo(kk.w) * wk, v7 = bf_hi(kk.w) * wk;
                ps[0] += v0; ps[1] += v1; ps[2] += v2; ps[3] += v3; ps[4] += v4; ps[5] += v5; ps[6] += v6; ps[7] += v7;
                *(LAS bf16x8*)(lp(sa[rho]) + ML_Q) = pack8(v0, v1, v2, v3, v4, v5, v6, v7);
            }
#pragma unroll
            for (int j = 0; j < 8; ++j) { ps[j] += __shfl_xor(ps[j], 16); ps[j] += __shfl_xor(ps[j], 32); }
            if ((lane >> 4) == 0) {
#pragma unroll
                for (int j = 0; j < 8; ++j) SF(MS_NR + 512 * w + 4 * j + c32) = ps[j];
            }
        }
        ML_BAR();
        {
            ML_OPAQUE_TID(tidP2); const int c16 = tidP2 & 15, rg = tidP2 >> 4;
            int cn1 = (ch + 1 < c1 ? ch + 1 : ch); asm volatile("" : "+s"(cn1));
            const unsigned char* cq1 = (const unsigned char*)MLC + ((size_t)b * 2048 + cn1 * 128) * 2048 + 8192u * rg + 256u * hm + 16u * c16;
#pragma unroll
            for (int rho = 0; rho < 4; ++rho) rq[rho] = *(const GAS u32x4*)(cq1 + rho * 2048);
            if (w == 0) { const float* ga1 = GA + cn1 * 384 + (tidP2 & 63);
#pragma unroll
                for (int i = 0; i < 6; ++i) pgt[i] = ga1[64 * i]; }
        }
        __builtin_amdgcn_sched_barrier(0);
        const float decay = SC[0];
        ML_OPAQUE_TID(tidF); const unsigned t4 = 4u * tidF;
        if (tidF < 128) { float a = 0.f;
#pragma unroll
            for (int ww = 0; ww < 8; ++ww) a += SF(MS_NR + 512 * ww + t4);
            SF(MS_NV + t4) = decay * SF(MS_NV + t4) + a; }
#pragma unroll
        for (int i = 0; i < 2; ++i)
#pragma unroll
            for (int e = 0; e < 16; ++e) Cacc[i][e] *= decay;
        {
        ML_LANE_MAP(tidF);
        const unsigned xc_eF = 64u * ((unsigned)ebF ^ qi), xc_d0 = 64u * ((unsigned)dbF0 ^ qi), xc_d1 = 64u * ((unsigned)(dbF0 + 1) ^ qi);
        const unsigned aF0 = ML_V + tn[0] + xc_eF, aF1 = ML_V + tn[1] + xc_eF, aK00 = ML_Q + tn[0] + xc_d0, aK01 = ML_Q + tn[1] + xc_d0, aK10 = ML_Q + tn[0] + xc_d1, aK11 = ML_Q + tn[1] + xc_d1;
        unsigned cwr[4];
#pragma unroll
        for (int g = 0; g < 4; ++g) cwr[g] = rowb_ + ((unsigned)(16 * (4 * ebF + g)) ^ swl_) + hh8;
        bf16x8 af[8];
#pragma unroll
        for (int ks = 0; ks < 8; ++ks) {
            const s16x4 alo = lds_tr(lp(aF0) + 4096 * ks);
            const s16x4 ahi = lds_tr(lp(aF1) + 4096 * ks);
            af[ks] = __builtin_shufflevector(alo, ahi, 0, 1, 2, 3, 4, 5, 6, 7);
        }
#pragma unroll
        for (int i = 0; i < 2; ++i) {
            bf16x8 bk[8];
#pragma unroll
            for (int ks = 0; ks < 8; ++ks) {
                const s16x4 blo = lds_tr(lp(i ? aK10 : aK00) + 4096 * ks);
                const s16x4 bhi = lds_tr(lp(i ? aK11 : aK01) + 4096 * ks);
                bk[ks] = __builtin_shufflevector(blo, bhi, 0, 1, 2, 3, 4, 5, 6, 7);
            }
#pragma unroll
            for (int ks = 0; ks < 8; ++ks) Cacc[i] = MFMA32(af[ks], bk[ks], Cacc[i]);
        }
#pragma unroll
        for (int i = 0; i < 2; ++i)
#pragma unroll
            for (int g = 0; g < 4; ++g) {
                u32x2 wv; wv.x = cvtpk(Cacc[i][4 * g], Cacc[i][4 * g + 1]); wv.y = cvtpk(Cacc[i][4 * g + 2], Cacc[i][4 * g + 3]);
                *(LAS u32x2*)lp(cwr[g] + ML_C + 8192u * (dbF0 + i)) = wv;
            }
        }
        ML_BAR();
    }
}

DI void ffn_fixup(Frame& F, const float* cw, const float* cb) {
    const float* RAWB = (const float*)(F.ws + WS_RAW); bf16* ACT = (bf16*)(F.ws + WS_ACT);
    const int gt = (F.vcu * NWAVES + F.wave) * 64 + F.lane, NT = F.G * NWAVES * 64;
    for (int it = gt; it < 256 * 2 * (DFF / 4); it += NT) {
        const int j4 = it % (DFF / 4), rs = it / (DFF / 4), rho = rs & 1, strip = rs >> 1, j = 4 * j4;
        const int pg = (j >> 7) * 256 + (j & 127);
        const bool first = (strip & 31) == 0;
        const float* own = RAWB + (size_t)strip * 4 * UPW; const float* prv = RAWB + (size_t)(strip - 1) * 4 * UPW;
        const f32x4 z = {0.f, 0.f, 0.f, 0.f};
        f32x4 gm2, gm1, g0, vm2, vm1, v0;
        if (rho == 0) { gm2 = first ? z : *(const f32x4*)(prv + 2 * UPW + pg); gm1 = first ? z : *(const f32x4*)(prv + 3 * UPW + pg); g0 = *(const f32x4*)(own + pg);
                        vm2 = first ? z : *(const f32x4*)(prv + 2 * UPW + pg + 128); vm1 = first ? z : *(const f32x4*)(prv + 3 * UPW + pg + 128); v0 = *(const f32x4*)(own + pg + 128); }
        else { gm2 = first ? z : *(const f32x4*)(prv + 3 * UPW + pg); gm1 = *(const f32x4*)(own + pg); g0 = *(const f32x4*)(own + UPW + pg);
               vm2 = first ? z : *(const f32x4*)(prv + 3 * UPW + pg + 128); vm1 = *(const f32x4*)(own + pg + 128); v0 = *(const f32x4*)(own + UPW + pg + 128); }
        const f32x4 yg = *(const f32x4*)(cb + j) + *(const f32x4*)(cw + j) * gm2 + *(const f32x4*)(cw + UPW + j) * gm1 + *(const f32x4*)(cw + 2 * UPW + j) * g0;
        const f32x4 yv = *(const f32x4*)(cb + DFF + j) + *(const f32x4*)(cw + DFF + j) * vm2 + *(const f32x4*)(cw + UPW + DFF + j) * vm1 + *(const f32x4*)(cw + 2 * UPW + DFF + j) * v0;
        u32x2 wv; wv.x = cvtpk(silu_f(yg[0]) * yv[0], silu_f(yg[1]) * yv[1]); wv.y = cvtpk(silu_f(yg[2]) * yv[2], silu_f(yg[3]) * yv[3]);
        *(GAS u32x2*)(ACT + (size_t)(64 * strip + rho) * DFF + j) = wv;
    }
}

struct Args { const float* in[16]; float* out; unsigned char* ws; int ph_lo, ph_hi, li, pad; };
__global__ void __launch_bounds__(NWAVES * 64, 2) fwd_kernel(Args args) {
    extern __shared__ __attribute__((aligned(16))) unsigned char lds[];
    Frame F;
    F.lds = (LAS unsigned char*)lds; F.MISC = (volatile LAS unsigned*)(F.lds + MISC_OFF);
    F.tid = threadIdx.x; F.lane = F.tid & 63; F.wave = __builtin_amdgcn_readfirstlane(F.tid >> 6);
    F.G = gridDim.x; { const int bx = blockIdx.x; F.vcu = (F.G % 8 == 0) ? (bx % 8) * (F.G / 8) + bx / 8 : bx; }
    F.ws = args.ws; F.ctl = (gu32*)(args.ws + WS_CTL); F.out = args.out;
    for (int u = F.tid; u < (LDS_BYTES - LDSCTL_OFF) / 4; u += NWAVES * 64) ((LAS unsigned*)(F.lds + LDSCTL_OFF))[u] = 0u;
    __syncthreads();
    XcdBarrier bar; bar.bar = (unsigned*)(F.ctl + CW_BAR) + args.li * XCD_BAR_WORDS; bar.x = 0; bar.st = nullptr;
    if (N_LAUNCHES != PER_PHASE) bar = xcd_barrier_post((unsigned*)(F.ctl + CW_BAR) + args.li * XCD_BAR_WORDS, F.MISC + 8);
#define GRID_BAR(seam) do { if (N_LAUNCHES == PER_PHASE) { if (F.tid == 0) __hip_atomic_store(F.ctl + CW_TMO, 0xBADBA0u | (unsigned)(seam), RLX_AGENT); } else { xcd_barrier(bar); } } while (0)
    const int lo = args.ph_lo, hi = args.ph_hi;
#define IN(k) (lo <= (k) && (k) < hi)
#define BOTH(k) (IN(k) && IN((k) + 1))
    PG8_LAS float* escr = (PG8_LAS float*)(F.lds + SCR_OFF);
    if (IN(PH_PRO)) { p0_prologue(F, args.in[0], args.in[1], args.in[2]); if (BOTH(PH_PRO)) GRID_BAR(PH_PRO); }
    if (IN(PH_IN)) {
        pg8::Gemm g{(const pg8::bf16_t*)(F.ws + WS_XN), (const pg8::bf16_t*)(F.ws + WS_WIN), M, IN_WP, DM}; pg8::StaticOrder S; S.init(M, IN_WP, F.G, (int)blockIdx.x, WGM_IN);
        pg8::Epi1 E{(pg8::bf16_t*)(F.ws + WS_QB), (pg8::bf16_t*)(F.ws + WS_KB), (pg8::bf16_t*)(F.ws + WS_VB), (pg8::bf16_t*)(F.ws + WS_ML), (float*)(F.ws + WS_G), (const float*)(F.ws + WS_ROPE), args.in[3], args.in[4], args.in[7], args.in[8], escr};
        pg8::gemm_phase<pg8::Epi1, pg8::StaticOrder, true, true>(F.lds + RING_OFF, g, S, E);
        { constexpr int IDLE0 = (M / 256) * (IN_WP / 256) % 256;
          if (F.G == 256 && (int)blockIdx.x >= IDLE0)
              convert_range(F, (LAS float*)(F.lds + RING_OFF + F.wave * 16384), args.in[10], args.in[12], args.in[11], args.in[15], 0, CV_EARLY, ((int)blockIdx.x - IDLE0) * NWAVES + F.wave, (256 - IDLE0) * NWAVES);
        }
        if (BOTH(PH_IN)) GRID_BAR(PH_IN);
    }
    if (IN(PH_PRE)) { mixer_prepass(F, args.in[5], args.in[6]); if (BOTH(PH_PRE)) GRID_BAR(PH_PRE); }
    if (IN(PH_MIX)) {
#ifndef PROBE_P2
#define PROBE_P2 0
#endif
#ifndef PROBE_LIGHT_UP
#define PROBE_LIGHT_UP 0
#endif
        const bool skip_ml = PROBE_P2 >= 2 && args.li == 1, skip_at = PROBE_P2 == 1 && args.li == 1;
        const bool is_ml = (int)blockIdx.x < ML_WGS;
        if (is_ml && !skip_ml) { const int seq = (int)blockIdx.x & 31, part = (int)blockIdx.x >> 5; mlstm_seq(F, seq >> 2, seq & 3, args.in[9], part ? ML_SPLIT : 0, part ? SEQ / 128 : ML_SPLIT); __syncthreads(); }
        if (!skip_at) attn_phase(F, CW_QUEUE + 1024 * args.li, args.in[10], args.in[12], args.in[11], args.in[15], is_ml || (PROBE_P2 == 3 && args.li == 1));
        if (BOTH(PH_MIX)) GRID_BAR(PH_MIX);
    }
    if (IN(PH_OUT)) {
        pg8::Gemm g{(const pg8::bf16_t*)(F.ws + WS_MIX), (const pg8::bf16_t*)(F.ws + WS_WOUT), M, DM, DM}; pg8::StaticOrder S; S.init(M, DM, F.G, (int)blockIdx.x, WGM_OUT);
        pg8::Epi3 E{args.in[0], (pg8::bf16_t*)(F.ws + WS_XN), (float*)(F.ws + WS_SS), escr};
        pg8::gemm_phase<pg8::Epi3, pg8::StaticOrder, true, true>(F.lds + RING_OFF, g, S, E);
        if (BOTH(PH_OUT)) GRID_BAR(PH_OUT);
    }
    if (IN(PH_UP)) {
        pg8::Gemm g{(const pg8::bf16_t*)(F.ws + WS_XN), (const pg8::bf16_t*)(F.ws + WS_WUP), M, UPW, DM}; pg8::StaticOrder S; S.init(M, UPW, F.G, (int)blockIdx.x, WGM_UP);
        pg8::Epi4 E{(pg8::bf16_t*)(F.ws + WS_ACT), (float*)(F.ws + WS_RAW), (const float*)(F.ws + WS_SS), args.in[13], args.in[14], escr, args.li == 0 ? PROBE_LIGHT_UP : 0};
        pg8::gemm_phase<pg8::Epi4, pg8::StaticOrder, true, true>(F.lds + RING_OFF, g, S, E);
        if (BOTH(PH_UP)) GRID_BAR(PH_UP);
    }
    if (IN(PH_FIX)) { ffn_fixup(F, args.in[13], args.in[14]); if (BOTH(PH_FIX)) GRID_BAR(PH_FIX); }
    if (IN(PH_DOWN)) {
        pg8::Gemm g{(const pg8::bf16_t*)(F.ws + WS_ACT), (const pg8::bf16_t*)(F.ws + WS_WDN), M, DM, DFF}; pg8::StaticOrder S; S.init(M, DM, F.G, (int)blockIdx.x, WGM_DOWN);
        pg8::Epi5 E{F.out, (const pg8::bf16_t*)(F.ws + WS_XN)};
        pg8::gemm_phase<pg8::Epi5, pg8::StaticOrder, true, true>(F.lds + RING_OFF, g, S, E);
    }
#undef IN
#undef BOTH
}

extern "C" void kernel_launch(void* const* d_in, const int* in_sizes, int n_in, void* d_out, int out_size, void* d_ws, size_t ws_size, hipStream_t stream) {
    static int grid = 0;
    if (grid == 0) {
        if (n_in != 16 || in_sizes[0] != M * DM || out_size != M * DM || ws_size < WS_END) { fprintf(stderr, "kernel_launch: unexpected shapes (n_in %d in0 %d out %d ws %zu)\n", n_in, n_in > 0 ? in_sizes[0] : -1, out_size, ws_size); grid = -1; return; }
        int dev = 0, cus = 0, per_cu = 0;
        if (hipGetDevice(&dev) != hipSuccess || hipDeviceGetAttribute(&cus, hipDeviceAttributeMultiprocessorCount, dev) != hipSuccess) { grid = -1; return; }
        if (hipFuncSetAttribute((const void*)fwd_kernel, hipFuncAttributeMaxDynamicSharedMemorySize, LDS_BYTES) != hipSuccess) { fprintf(stderr, "kernel_launch: hipFuncSetAttribute failed\n"); grid = -1; return; }
        if (hipOccupancyMaxActiveBlocksPerMultiprocessor(&per_cu, (const void*)fwd_kernel, NWAVES * 64, LDS_BYTES) != hipSuccess || per_cu < 1) fprintf(stderr, "kernel_launch: occupancy query reports %d blocks per CU\n", per_cu);
        (void)hipGetLastError();
        grid = cus;
    }
    if (grid < 0) return;
    if (hipMemsetAsync((char*)d_ws + WS_CTL, 0, CTL_ZERO_BYTES, stream) != hipSuccess) return;
    Args a{};
    for (int i = 0; i < 16; ++i) a.in[i] = (const float*)d_in[i];
    a.out = (float*)d_out; a.ws = (unsigned char*)d_ws;
#ifdef PROBE_REPEAT
    { const int k = PROBE_REPEAT; const int lo[3] = {0, k, k + 1}, hi[3] = {k + 1, k + 1, PER_PHASE};
      for (int li = 0; li < 3; ++li) { a.ph_lo = lo[li]; a.ph_hi = hi[li]; a.li = li; hipLaunchKernelGGL(fwd_kernel, dim3(grid), dim3(NWAVES * 64), LDS_BYTES, stream, a); } }
#else
    if (N_LAUNCHES == 1) { a.ph_lo = 0; a.ph_hi = PER_PHASE; a.li = 0; hipLaunchKernelGGL(fwd_kernel, dim3(grid), dim3(NWAVES * 64), LDS_BYTES, stream, a); }
    else for (int li = 0; li < PER_PHASE; ++li) { a.ph_lo = li; a.ph_hi = li + 1; a.li = 0; hipLaunchKernelGGL(fwd_kernel, dim3(grid), dim3(NWAVES * 64), LDS_BYTES, stream, a); }
#endif
}
```

```cpp
#include <hip/hip_runtime.h>
#include <cstdio>
#include <cstdint>
#include <cmath>
namespace pg8 {
#define PG8_LAS __attribute__((address_space(3)))
typedef unsigned short bf16_t;
typedef short bf16x8 __attribute__((ext_vector_type(8)));
typedef float f32x4 __attribute__((ext_vector_type(4)));
typedef unsigned u32x4 __attribute__((ext_vector_type(4)));
constexpr int BM = 256, BK = 64, HALF = 128, HTB = HALF * BK * 2  , STAGE_BYTES = 8 * HTB, NXCD = 8, WGM = 8;

__host__ __device__ __forceinline__ int lds_byte(int r, int c) { const int st = (r >> 4) * 2 + (c >> 5), rr = r & 15, cc = c & 31, ob = rr * 64 + cc * 2; return st * 1024 + (ob ^ (((ob >> 9) & 1) << 5)); }
__host__ __device__ __forceinline__ void stage_rc(int b, int& R, int& C) { const int st = b / 1024, sb = b % 1024, swz = sb ^ (((sb >> 9) & 1) << 5); R = (st >> 1) * 16 + swz / 64; C = (st & 1) * 32 + (swz % 64) / 2; }
__host__ __device__ __forceinline__ int perm32(int rho) { const int n = rho >> 4, i = rho & 15; return 8 * (i >> 2) + 4 * n + (i & 3); }

struct Unit { int pm, pn; };
struct Gemm { const bf16_t* A; const bf16_t* Bt; int M, N, K; };

struct StaticOrder {
    int nM, nN, nwg, G, c, wgm;
    __host__ __device__ void init(int M, int N, int G_, int c_, int wgm_ = WGM) { nM = M / BM; nN = N / BM; nwg = nM * nN; G = G_; c = c_; wgm = wgm_; }
    __host__ __device__ bool next(int i, Unit& u) const {
        const long L = (long)i * G + c; if (L >= nwg) return false;
        int wgid = (int)L; { const int q = nwg / NXCD, r = nwg % NXCD, xcd = wgid % NXCD, off = wgid / NXCD; wgid = (xcd < r ? xcd * (q + 1) : r * (q + 1) + (xcd - r) * q) + off; }
        const int nig = wgm * nN, gid = wgid / nig, fm = gid * wgm, gsz = (nM - fm) < wgm ? (nM - fm) : wgm;
        u.pm = fm + ((wgid % nig) % gsz); u.pn = (wgid % nig) / gsz; return true;
    }
    __device__ __forceinline__ void a_ready(const Unit&) const {}
    __device__ __forceinline__ void done(const Unit&) const {}
};

__device__ __forceinline__ unsigned cvt_pk_bf16(float lo, float hi) { unsigned r; asm volatile("v_cvt_pk_bf16_f32 %0, %1, %2" : "=v"(r) : "v"(lo), "v"(hi)); return r; }

typedef float f32x2 __attribute__((ext_vector_type(2)));
#define EPI_BAR() do { asm volatile("s_waitcnt lgkmcnt(0)" ::: "memory"); __builtin_amdgcn_s_barrier(); asm volatile("" ::: "memory"); } while (0)
constexpr float kEps = 1e-6f;

struct Epi1 {
    static constexpr bool PERM = true, AFTER_DRAIN = false, APERM = false;
    __device__ __forceinline__ void pre(const Unit&, int, int) const {}
    bf16_t *QB, *KB, *VB, *ML; float* G; const float* rope; const float *qg, *kg, *b_i, *b_f; PG8_LAS float* scr;
    __device__ __forceinline__ void operator()(const f32x4 (&acc)[2][2][4][2], const Unit& u, int wr, int wc, int fr, int fq) const {
        const int pn = u.pn;
        if (pn < 12) {
            const bool isq = pn < 6;
#pragma unroll
            for (int ai = 0; ai < 2; ++ai)
#pragma unroll
                for (int m = 0; m < 4; ++m)
#pragma unroll
                    for (int bj = 0; bj < 2; ++bj) {
                        const f32x4 a = acc[ai][bj][m][0], b = acc[ai][bj][m][1];
                        float s = (a[0] * a[0] + a[1] * a[1]) + (a[2] * a[2] + a[3] * a[3]) + (b[0] * b[0] + b[1] * b[1]) + (b[2] * b[2] + b[3] * b[3]);
                        s += __shfl_xor(s, 16); s += __shfl_xor(s, 32);
                        if (fq == 0) scr[((ai * HALF + wr * 64 + m * 16 + fr) * 2 + bj) * 4 + wc] = s;
                    }
            EPI_BAR();
            const float* gsrc = isq ? qg : kg; const float gscale = isq ? 0.08838834764831845f * 1.4426950408889634f : 1.0f;
            f32x4 gva, gvb;
#pragma unroll
            for (int e = 0; e < 4; ++e) { const int p = 32 * wc + 8 * fq + e; gva[e] = gsrc[(p >> 1) + 64 * (p & 1)] * gscale; gvb[e] = gsrc[((p + 4) >> 1) + 64 * (p & 1)] * gscale; }
            bf16_t* dst = isq ? QB : KB; const int head0 = (isq ? pn : pn - 6) * 2;
#pragma unroll
            for (int ai = 0; ai < 2; ++ai)
#pragma unroll
                for (int m = 0; m < 4; ++m) {
                    const int rl = ai * HALF + wr * 64 + m * 16 + fr, grow = u.pm * BM + rl, t = grow & 2047, bb = grow >> 11;
                    const size_t drow = (size_t)bb * 2048 + (size_t)(t & 3) * 512 + (t >> 2);
                    const f32x4 cs0 = *(const f32x4*)(rope + ((size_t)t * 64 + 16 * wc + 4 * fq) * 2), cs1 = *(const f32x4*)(rope + ((size_t)t * 64 + 16 * wc + 4 * fq) * 2 + 4);
#pragma unroll
                    for (int bj = 0; bj < 2; ++bj) {
                        const f32x4 pp = *(const PG8_LAS f32x4*)(scr + (rl * 2 + bj) * 4);
                        const float rstd = 1.0f / sqrtf(((pp[0] + pp[1]) + (pp[2] + pp[3])) * (1.0f / 128.0f) + kEps);
                        const f32x4 a = acc[ai][bj][m][0] * (gva * rstd), b = acc[ai][bj][m][1] * (gvb * rstd);
                        const f32x2 xe0 = {a[0], a[2]}, xo0 = {a[1], a[3]}, xe1 = {b[0], b[2]}, xo1 = {b[1], b[3]};
                        const f32x2 c0 = {cs0[0], cs0[2]}, s0 = {cs0[1], cs0[3]}, c1 = {cs1[0], cs1[2]}, s1 = {cs1[1], cs1[3]};
                        const f32x2 oe0 = xe0 * c0 - xo0 * s0, oo0 = xe0 * s0 + xo0 * c0, oe1 = xe1 * c1 - xo1 * s1, oo1 = xe1 * s1 + xo1 * c1;
                        u32x4 w;
                        w.x = cvt_pk_bf16(oe0[0], oo0[0]); w.y = cvt_pk_bf16(oe0[1], oo0[1]); w.z = cvt_pk_bf16(oe1[0], oo1[0]); w.w = cvt_pk_bf16(oe1[1], oo1[1]);
                        *(u32x4*)(dst + drow * 1536 + (head0 + bj) * 128 + 32 * wc + 8 * fq) = w;
                    }
                }
        } else if (pn < 26) {
            const bool isv = pn < 18;
#pragma unroll
            for (int ai = 0; ai < 2; ++ai)
#pragma unroll
                for (int m = 0; m < 4; ++m) {
                    const int rl = ai * HALF + wr * 64 + m * 16 + fr, grow = u.pm * BM + rl, t = grow & 2047, bb = grow >> 11;
                    bf16_t* rowp = isv ? VB + ((size_t)bb * 2048 + (size_t)(t & 3) * 512 + (t >> 2)) * 1536 + (pn - 12) * 256 : ML + (size_t)grow * 2048 + (pn - 18) * 256;
#pragma unroll
                    for (int bj = 0; bj < 2; ++bj) {
                        const f32x4 a = acc[ai][bj][m][0], b = acc[ai][bj][m][1];
                        u32x4 w; w.x = cvt_pk_bf16(a[0], a[1]); w.y = cvt_pk_bf16(a[2], a[3]); w.z = cvt_pk_bf16(b[0], b[1]); w.w = cvt_pk_bf16(b[2], b[3]);
                        *(u32x4*)(rowp + bj * HALF + 32 * wc + 8 * fq) = w;
                    }
                }
        } else {
            if (wc == 0 && fq == 0) {
                const f32x4 bi = *(const f32x4*)b_i, bf = *(const f32x4*)b_f;
#pragma unroll
                for (int ai = 0; ai < 2; ++ai)
#pragma unroll
                    for (int m = 0; m < 4; ++m) {
                        const int grow = u.pm * BM + ai * HALF + wr * 64 + m * 16 + fr;
                        *(f32x4*)(G + (size_t)grow * 8) = acc[ai][0][m][0] + bi; *(f32x4*)(G + (size_t)grow * 8 + 4) = acc[ai][0][m][1] + bf;
                    }
            }
        }
    }
};

struct Epi3 {
    static constexpr bool PERM = true, AFTER_DRAIN = false, APERM = false;
    __device__ __forceinline__ void pre(const Unit&, int, int) const {}
    const bf16_t* XN; const float* IR; bf16_t* X1; float* SS; PG8_LAS float* scr;
    __device__ __forceinline__ void operator()(const f32x4 (&acc)[2][2][4][2], const Unit& u, int wr, int wc, int fr, int fq) const {
        const int col0 = u.pn * BM + 32 * wc + 8 * fq;
#pragma unroll
        for (int ai = 0; ai < 2; ++ai)
#pragma unroll
            for (int m = 0; m < 4; ++m) {
                const int rl = ai * HALF + wr * 64 + m * 16 + fr; const size_t off = (size_t)(u.pm * BM + rl) * 2048 + col0;
                const float ir = IR[u.pm * BM + rl];
                float s = 0.f;
#pragma unroll
                for (int bj = 0; bj < 2; ++bj) {
                    const u32x4 xw = __builtin_nontemporal_load((const u32x4*)(XN + off + bj * HALF));
                    const f32x4 x0 = {__builtin_bit_cast(float, xw.x << 16), __builtin_bit_cast(float, xw.x & 0xffff0000u), __builtin_bit_cast(float, xw.y << 16), __builtin_bit_cast(float, xw.y & 0xffff0000u)};
                    const f32x4 x1 = {__builtin_bit_cast(float, xw.z << 16), __builtin_bit_cast(float, xw.z & 0xffff0000u), __builtin_bit_cast(float, xw.w << 16), __builtin_bit_cast(float, xw.w & 0xffff0000u)};
                    const f32x4 a = acc[ai][bj][m][0] + x0 * ir, b = acc[ai][bj][m][1] + x1 * ir;
                    s += (a[0] * a[0] + a[1] * a[1]) + (a[2] * a[2] + a[3] * a[3]) + (b[0] * b[0] + b[1] * b[1]) + (b[2] * b[2] + b[3] * b[3]);
                    u32x4 w; w.x = cvt_pk_bf16(a[0], a[1]); w.y = cvt_pk_bf16(a[2], a[3]); w.z = cvt_pk_bf16(b[0], b[1]); w.w = cvt_pk_bf16(b[2], b[3]);
                    *(u32x4*)(X1 + off + bj * HALF) = w;
                }
                s += __shfl_xor(s, 16); s += __shfl_xor(s, 32);
                if (fq == 0) scr[rl * 4 + wc] = s;
            }
        EPI_BAR();
        if (wc == 0 && fq == 0) {
#pragma unroll
            for (int ai = 0; ai < 2; ++ai)
#pragma unroll
                for (int m = 0; m < 4; ++m) {
                    const int rl = ai * HALF + wr * 64 + m * 16 + fr; const f32x4 pp = *(const PG8_LAS f32x4*)(scr + rl * 4);
                    SS[(size_t)(u.pm * BM + rl) * 8 + u.pn] = (pp[0] + pp[1]) + (pp[2] + pp[3]);
                }
        }
    }
};

__device__ __forceinline__ float dpp_shr1(float v) { return __builtin_bit_cast(float, __builtin_amdgcn_update_dpp(0, __builtin_bit_cast(int, v), 0x111, 0xf, 0xf, true)); }
struct Epi4 {
    static constexpr bool PERM = true, AFTER_DRAIN = false, APERM = true;
    bf16_t* ACT; float* RAWB; const float* SS; const float *cw, *cb; PG8_LAS float* scr; int light;
    __device__ __forceinline__ void pre(const Unit& u, int wid, int lane) const {
        __builtin_amdgcn_global_load_lds((const unsigned*)((const char*)(SS + (size_t)u.pm * BM * 8) + wid * 1024 + lane * 16), (PG8_LAS unsigned*)((PG8_LAS char*)scr + wid * 1024), 16, 0, 0);
        if (wid < 4) { const int seg = 2 * wid + (lane >> 5), q4 = seg >> 1, gv = seg & 1;
            const float* src = (q4 < 3 ? cw + q4 * 11264 : cb) + (gv ? 5632 : 0) + u.pn * 128 + 4 * (lane & 31);
            __builtin_amdgcn_global_load_lds((const unsigned*)src, (PG8_LAS unsigned*)((PG8_LAS char*)scr + 8192 + wid * 1024), 16, 0, 0); }
    }
    __device__ __forceinline__ void operator()(f32x4 (&acc)[2][2][4][2], const Unit& u, int wr, int wc, int fr, int fq) const {
        if (light == 1) return;
        const int j0 = u.pn * 128 + 32 * wc + 8 * fq;
#pragma unroll
        for (int ai = 0; ai < 2; ++ai)
#pragma unroll
            for (int m = 0; m < 4; ++m) {
                const PG8_LAS float* sp = scr + (ai * HALF + wr * 64 + 4 * fr + m) * 8; const f32x4 s0 = *(const PG8_LAS f32x4*)sp, s1 = *(const PG8_LAS f32x4*)(sp + 4);
                const float rstd = 1.0f / sqrtf((((s0[0] + s0[1]) + (s0[2] + s0[3])) + ((s1[0] + s1[1]) + (s1[2] + s1[3]))) * (1.0f / 2048.0f) + kEps);
#pragma unroll
                for (int bj = 0; bj < 2; ++bj) { acc[ai][bj][m][0] = acc[ai][bj][m][0] * rstd; acc[ai][bj][m][1] = acc[ai][bj][m][1] * rstd; }
            }
        if (fr == 0 && light != 2) {
#pragma unroll
            for (int ai = 0; ai < 2; ++ai)
#pragma unroll
                for (int mm = 0; mm < 2; ++mm)
#pragma unroll
                    for (int bj = 0; bj < 2; ++bj) { float* p = RAWB + ((size_t)(u.pm * 4 + ai * 2 + wr) * 4 + mm) * 11264 + u.pn * 256 + bj * HALF + 32 * wc + 8 * fq; *(f32x4*)p = acc[ai][bj][mm][0]; *(f32x4*)(p + 4) = acc[ai][bj][mm][1]; }
        }
        if (fr == 15 && light != 2) {
#pragma unroll
            for (int ai = 0; ai < 2; ++ai)
#pragma unroll
                for (int mm = 0; mm < 2; ++mm)
#pragma unroll
                    for (int bj = 0; bj < 2; ++bj) { float* p = RAWB + ((size_t)(u.pm * 4 + ai * 2 + wr) * 4 + 2 + mm) * 11264 + u.pn * 256 + bj * HALF + 32 * wc + 8 * fq; *(f32x4*)p = acc[ai][bj][2 + mm][0]; *(f32x4*)(p + 4) = acc[ai][bj][2 + mm][1]; }
        }
#pragma unroll
        for (int ai = 0; ai < 2; ++ai) {
            unsigned pk[4][4];
#pragma unroll
            for (int n = 0; n < 2; ++n) {
                const PG8_LAS float* wl = scr + 2048 + 32 * wc + 8 * fq + 4 * n;
                const f32x4 wg0 = *(const PG8_LAS f32x4*)wl, wg1 = *(const PG8_LAS f32x4*)(wl + 256), wg2 = *(const PG8_LAS f32x4*)(wl + 512), bg = *(const PG8_LAS f32x4*)(wl + 768);
                const f32x4 wv0 = *(const PG8_LAS f32x4*)(wl + 128), wv1 = *(const PG8_LAS f32x4*)(wl + 384), wv2 = *(const PG8_LAS f32x4*)(wl + 640), bv = *(const PG8_LAS f32x4*)(wl + 896);
                f32x4 ug[6], uv[6];
#pragma unroll
                for (int j = 0; j < 4; ++j) { ug[0][j] = dpp_shr1(acc[ai][0][2][n][j]); ug[1][j] = dpp_shr1(acc[ai][0][3][n][j]); uv[0][j] = dpp_shr1(acc[ai][1][2][n][j]); uv[1][j] = dpp_shr1(acc[ai][1][3][n][j]); }
#pragma unroll
                for (int m = 0; m < 4; ++m) { ug[2 + m] = acc[ai][0][m][n]; uv[2 + m] = acc[ai][1][m][n]; }
#pragma unroll
                for (int m = 0; m < 4; ++m) {
                    const f32x4 yg = bg + wg0 * ug[m] + wg1 * ug[m + 1] + wg2 * ug[m + 2];
                    const f32x4 yv = bv + wv0 * uv[m] + wv1 * uv[m + 1] + wv2 * uv[m + 2];
                    const f32x4 t = yg * -1.4426950408889634f;
                    f32x4 sg; sg[0] = __builtin_amdgcn_rcpf(1.0f + __builtin_amdgcn_exp2f(t[0])); sg[1] = __builtin_amdgcn_rcpf(1.0f + __builtin_amdgcn_exp2f(t[1])); sg[2] = __builtin_amdgcn_rcpf(1.0f + __builtin_amdgcn_exp2f(t[2])); sg[3] = __builtin_amdgcn_rcpf(1.0f + __builtin_amdgcn_exp2f(t[3]));
                    const f32x4 res = (yg * yv) * sg;
                    pk[m][2 * n] = cvt_pk_bf16(res[0], res[1]); pk[m][2 * n + 1] = cvt_pk_bf16(res[2], res[3]);
                }
            }
#pragma unroll
            for (int m = 0; m < 4; ++m) {
                if ((m < 2 && fr == 0) || (light == 2 && pk[m][0] != 0x12345678u)) continue;
                const int grow = u.pm * BM + ai * HALF + wr * 64 + 4 * fr + m;
                u32x4 w; w.x = pk[m][0]; w.y = pk[m][1]; w.z = pk[m][2]; w.w = pk[m][3];
                *(u32x4*)(ACT + (size_t)grow * 5632 + j0) = w;
            }
        }
    }
};

struct Epi5 {
    static constexpr bool PERM = true, AFTER_DRAIN = false, APERM = false;
    __device__ __forceinline__ void pre(const Unit&, int, int) const {}
    float* out; const bf16_t* X1;
    __device__ __forceinline__ void operator()(const f32x4 (&acc)[2][2][4][2], const Unit& u, int wr, int wc, int fr, int fq) const {
        const int col0 = u.pn * BM + 32 * wc + 8 * fq;
#pragma unroll
        for (int ai = 0; ai < 2; ++ai)
#pragma unroll
            for (int m = 0; m < 4; ++m) {
                const size_t off = (size_t)(u.pm * BM + ai * HALF + wr * 64 + m * 16 + fr) * 2048 + col0;
#pragma unroll
                for (int bj = 0; bj < 2; ++bj) {
                    const u32x4 w = __builtin_nontemporal_load((const u32x4*)(X1 + off + bj * HALF));
                    const f32x4 r0 = {__builtin_bit_cast(float, w.x << 16), __builtin_bit_cast(float, w.x & 0xffff0000u), __builtin_bit_cast(float, w.y << 16), __builtin_bit_cast(float, w.y & 0xffff0000u)};
                    const f32x4 r1 = {__builtin_bit_cast(float, w.z << 16), __builtin_bit_cast(float, w.z & 0xffff0000u), __builtin_bit_cast(float, w.w << 16), __builtin_bit_cast(float, w.w & 0xffff0000u)};
                    __builtin_nontemporal_store(acc[ai][bj][m][0] + r0, (f32x4*)(out + off + bj * HALF)); __builtin_nontemporal_store(acc[ai][bj][m][1] + r1, (f32x4*)(out + off + bj * HALF + 4));
                }
            }
    }
};
template <class Epi, class Sched, bool ALIGN_EPI = false, bool SP2 = false>
__device__ __forceinline__ void gemm_phase(PG8_LAS unsigned char* lds, const Gemm g, const Sched& S, const Epi& E) {
    const int tid = threadIdx.x, wid = __builtin_amdgcn_readfirstlane(tid >> 6), lane = tid & 63, wr = wid >> 2, wc = wid & 3, fr = lane & 15, fq = lane >> 4;
    const int K = g.K, nt = K / BK;
    unsigned voffA[2], voffB[2];
#pragma unroll
    for (int i = 0; i < 2; ++i) { int R, C; stage_rc(tid * 16 + i * 8192, R, C); const int Rb = Epi::PERM ? ((R & ~31) + perm32(R & 31)) : R;
        const int Ra = Epi::APERM ? ((R & ~63) + 4 * (R & 15) + ((R >> 4) & 3)) : R;
        voffA[i] = (unsigned)(Ra * K + C) * 2u; voffB[i] = (unsigned)(Rb * K + C) * 2u; }
    const size_t kstep = (size_t)(BK * 2);
    const size_t hstep = (size_t)HALF * K * 2;
    const size_t tstep = 2 * hstep;
    const unsigned ldsw = (unsigned)wid * 1024u;
    const int aoff = lds_byte(wr * 64 + fr, fq * 8), boff = lds_byte(wc * 32 + fr, fq * 8);
#define PG8_SA(b, h) (((b) * 2 + (h)) * HTB)
#define PG8_SB(b, h) ((4 + (b) * 2 + (h)) * HTB)
#define PG8_STAGE(bufoff, gbase, voff) do { _Pragma("unroll") for (int _i = 0; _i < 2; ++_i) \
        __builtin_amdgcn_global_load_lds((const unsigned*)((const char*)(gbase) + (voff)[_i]), (PG8_LAS unsigned*)(lds + (bufoff) + ldsw + _i * 8192), 16, 0, 0); } while (0)
#define PG8_LDA(dst, b, h) do { _Pragma("unroll") for (int m = 0; m < 4; ++m) _Pragma("unroll") for (int k = 0; k < 2; ++k) dst[m][k] = *(const PG8_LAS bf16x8*)(lds + PG8_SA(b, h) + aoff + m * 2048 + k * 1024); } while (0)
#define PG8_LDB(dst, b, h) do { _Pragma("unroll") for (int n = 0; n < 2; ++n) _Pragma("unroll") for (int k = 0; k < 2; ++k) dst[n][k] = *(const PG8_LAS bf16x8*)(lds + PG8_SB(b, h) + boff + n * 2048 + k * 1024); } while (0)
#define PG8_MMA(ai, bj, At, Bt) do { __builtin_amdgcn_s_setprio(1); _Pragma("unroll") for (int m = 0; m < 4; ++m) _Pragma("unroll") for (int n = 0; n < 2; ++n) _Pragma("unroll") for (int k = 0; k < 2; ++k) \
        acc[ai][bj][m][n] = __builtin_amdgcn_mfma_f32_16x16x32_bf16(Bt[n][k], At[m][k], acc[ai][bj][m][n], 0, 0, 0); __builtin_amdgcn_s_setprio(0); } while (0)
#define PG8_WAIT_V(n) asm volatile("s_waitcnt vmcnt(" #n ")" ::: "memory")
#define PG8_WAIT_L(n) asm volatile("s_waitcnt lgkmcnt(" #n ")" ::: "memory")
#define PG8_BAR __builtin_amdgcn_s_barrier()
#define PG8_SCHED __builtin_amdgcn_sched_barrier(0)
    Unit cur, nxt; int ui = 0;
    if (!S.next(0, cur)) return;
    f32x4 acc[2][2][4][2];
#pragma unroll
    for (int a = 0; a < 2; ++a)
#pragma unroll
        for (int b = 0; b < 2; ++b)
#pragma unroll
            for (int m = 0; m < 4; ++m)
#pragma unroll
                for (int n = 0; n < 2; ++n) acc[a][b][m][n] = (f32x4){0.f, 0.f, 0.f, 0.f};
    bf16x8 At[4][2], B0[2][2], B1[2][2];
    const char* cA = (const char*)g.A + (size_t)cur.pm * tstep; const char* cB = (const char*)g.Bt + (size_t)cur.pn * tstep;
    S.a_ready(cur);
    if constexpr (SP2) {
        PG8_STAGE(PG8_SB(0, 0), cB, voffB); PG8_STAGE(PG8_SB(0, 1), cB + hstep, voffB); PG8_STAGE(PG8_SA(0, 0), cA, voffA); PG8_STAGE(PG8_SA(0, 1), cA + hstep, voffA);
        if (wr == 1) PG8_BAR;
        PG8_WAIT_V(2); PG8_BAR;
        PG8_STAGE(PG8_SB(1, 0), cB + kstep, voffB); PG8_STAGE(PG8_SA(1, 0), cA + kstep, voffA); PG8_STAGE(PG8_SB(1, 1), cB + hstep + kstep, voffB);
        PG8_WAIT_V(6); PG8_BAR;
    } else {
        PG8_STAGE(PG8_SB(0, 0), cB, voffB); PG8_STAGE(PG8_SA(0, 0), cA, voffA); PG8_STAGE(PG8_SB(0, 1), cB + hstep, voffB); PG8_STAGE(PG8_SA(0, 1), cA + hstep, voffA);
        if (wr == 1) PG8_BAR;
        PG8_WAIT_V(4); PG8_BAR;
        PG8_STAGE(PG8_SB(1, 0), cB + kstep, voffB); PG8_STAGE(PG8_SA(1, 0), cA + kstep, voffA); PG8_STAGE(PG8_SB(1, 1), cB + hstep + kstep, voffB);
        PG8_WAIT_V(6); PG8_BAR;
    }
    for (;;) {
        const bool has_next = S.next(ui + 1, nxt);
        const char* nA = has_next ? (const char*)g.A + (size_t)nxt.pm * tstep : cA; const char* nB = has_next ? (const char*)g.Bt + (size_t)nxt.pn * tstep : cB;
        for (int t = 0; t < nt; t += 2) {
            const bool last = (t == nt - 2);
            const char* a1 = cA + (size_t)(t + 1) * kstep;
            const char* a2 = last ? nA : cA + (size_t)(t + 2) * kstep; const char* b2 = last ? nB : cB + (size_t)(t + 2) * kstep;
            const char* a3 = a2 + kstep; const char* b3 = b2 + kstep;
            if (last && has_next) S.a_ready(nxt);
            if (last) E.pre(cur, wid, lane);
            if constexpr (SP2) {
            PG8_LDB(B0, 0, 0); PG8_LDB(B1, 0, 1); PG8_SCHED; PG8_LDA(At, 0, 0); PG8_STAGE(PG8_SA(1, 1), a1 + hstep, voffA);
            PG8_WAIT_V(8); PG8_WAIT_L(0); PG8_BAR; PG8_MMA(0, 0, At, B0); PG8_MMA(0, 1, At, B1); PG8_BAR; PG8_SCHED;
            PG8_LDA(At, 0, 1); PG8_STAGE(PG8_SB(0, 0), b2, voffB); PG8_STAGE(PG8_SB(0, 1), b2 + hstep, voffB); PG8_STAGE(PG8_SA(0, 0), a2, voffA);
            PG8_WAIT_V(8); PG8_WAIT_L(0); PG8_BAR; PG8_MMA(1, 0, At, B0); PG8_MMA(1, 1, At, B1); PG8_BAR; PG8_SCHED;
            PG8_LDB(B0, 1, 0); PG8_LDB(B1, 1, 1); PG8_SCHED; PG8_LDA(At, 1, 0); PG8_STAGE(PG8_SA(0, 1), a2 + hstep, voffA);
            PG8_WAIT_V(8); PG8_WAIT_L(0); PG8_BAR; PG8_MMA(0, 0, At, B0); PG8_MMA(0, 1, At, B1); PG8_BAR; PG8_SCHED;
            PG8_LDA(At, 1, 1); PG8_STAGE(PG8_SB(1, 0), b3, voffB); PG8_STAGE(PG8_SB(1, 1), b3 + hstep, voffB); PG8_STAGE(PG8_SA(1, 0), a3, voffA);
            PG8_WAIT_V(8); PG8_WAIT_L(0); PG8_BAR; PG8_MMA(1, 0, At, B0); PG8_MMA(1, 1, At, B1); PG8_BAR; PG8_SCHED;
            } else {
            PG8_LDB(B0, 0, 0); PG8_SCHED; PG8_LDA(At, 0, 0); PG8_STAGE(PG8_SA(1, 1), a1 + hstep, voffA);
            PG8_WAIT_L(8); PG8_BAR; PG8_WAIT_L(0); PG8_MMA(0, 0, At, B0); PG8_BAR; PG8_SCHED;
            PG8_LDB(B1, 0, 1); PG8_STAGE(PG8_SB(0, 0), b2, voffB);
            PG8_BAR; PG8_WAIT_L(0); PG8_MMA(0, 1, At, B1); PG8_BAR;
            PG8_LDA(At, 0, 1); PG8_STAGE(PG8_SA(0, 0), a2, voffA);
            PG8_BAR; PG8_WAIT_L(0); PG8_MMA(1, 0, At, B0); PG8_BAR; PG8_SCHED;
            PG8_STAGE(PG8_SB(0, 1), b2 + hstep, voffB);
            PG8_WAIT_V(6); PG8_BAR; PG8_MMA(1, 1, At, B1); PG8_BAR;
            PG8_LDB(B0, 1, 0); PG8_SCHED; PG8_LDA(At, 1, 0); PG8_STAGE(PG8_SA(0, 1), a2 + hstep, voffA);
            PG8_WAIT_L(8); PG8_BAR; PG8_WAIT_L(0); PG8_MMA(0, 0, At, B0); PG8_BAR; PG8_SCHED;
            PG8_LDB(B1, 1, 1); PG8_STAGE(PG8_SB(1, 0), b3, voffB);
            PG8_BAR; PG8_WAIT_L(0); PG8_MMA(0, 1, At, B1); PG8_BAR;
            PG8_LDA(At, 1, 1); PG8_STAGE(PG8_SA(1, 0), a3, voffA);
            PG8_BAR; PG8_WAIT_L(0); PG8_MMA(1, 0, At, B0); PG8_BAR; PG8_SCHED;
            PG8_STAGE(PG8_SB(1, 1), b3 + hstep, voffB);
            PG8_WAIT_V(6); PG8_BAR; PG8_MMA(1, 1, At, B1); PG8_BAR;
            }
        }
        if constexpr (ALIGN_EPI) { if (wr == 0) PG8_BAR; }
        if constexpr (!Epi::AFTER_DRAIN) { E(acc, cur, wr, wc, fr, fq); S.done(cur); }
        if (!has_next) break;
#pragma unroll
        for (int a = 0; a < 2; ++a)
#pragma unroll
            for (int b = 0; b < 2; ++b)
#pragma unroll
                for (int m = 0; m < 4; ++m)
#pragma unroll
                    for (int n = 0; n < 2; ++n) acc[a][b][m][n] = (f32x4){0.f, 0.f, 0.f, 0.f};
        cur = nxt; cA = nA; cB = nB; ++ui;
        if constexpr (ALIGN_EPI) { if (wr == 1) PG8_BAR; }
    }
    PG8_WAIT_V(0);
    if constexpr (!ALIGN_EPI) { if (wr == 0) PG8_BAR; }
    PG8_BAR;
    if constexpr (Epi::AFTER_DRAIN) { E.fused(acc, cur, wr, wc, fr, fq, lds, wid, lane); S.done(cur); }
#undef PG8_SA
#undef PG8_SB
#undef PG8_STAGE
#undef PG8_LDA
#undef PG8_LDB
#undef PG8_MMA
#undef PG8_WAIT_V
#undef PG8_WAIT_L
#undef PG8_BAR
#undef PG8_SCHED
}
}
#define GAS __attribute__((address_space(1)))
#define LAS __attribute__((address_space(3)))
typedef unsigned short bf16;
typedef unsigned v4u __attribute__((ext_vector_type(4)));
typedef float f32x4 __attribute__((ext_vector_type(4)));
typedef short bf16x8 __attribute__((ext_vector_type(8)));
typedef GAS unsigned gu32;
typedef GAS unsigned long long gu64;
#define RLX_AGENT __ATOMIC_RELAXED, __HIP_MEMORY_SCOPE_AGENT
#define LDS_WAIT() asm volatile("s_waitcnt lgkmcnt(0)" ::: "memory")
#define VM_WAIT() asm volatile("s_waitcnt vmcnt(0)" ::: "memory")
__device__ __forceinline__ unsigned long long rt() { return __builtin_amdgcn_s_memrealtime(); }
__device__ __forceinline__ unsigned f2bf(float f) { unsigned u = __builtin_bit_cast(unsigned, f); return (u + 0x7fffu + ((u >> 16) & 1u)) >> 16; }
__device__ __forceinline__ unsigned pk2(float lo, float hi) { return f2bf(lo) | (f2bf(hi) << 16); }

#define XB_TMO      128
#define XB_XCNT(j)  (256  + 64 * (j))
#define XB_XSUB(j)  (1280 + 64 * (j))
#define XB_XGEN(j)  (2304 + 64 * (j))
#define XB_TOP      3328
#define XB_TOPGEN   3392
#define XCD_BAR_WORDS 3456
#define XB_SPIN_CAP (1u << 18)

__device__ __forceinline__ unsigned xb_ld(unsigned* p)              { return __hip_atomic_load(p, __ATOMIC_RELAXED, __HIP_MEMORY_SCOPE_AGENT); }
__device__ __forceinline__ unsigned xb_add(unsigned* p, unsigned v) { return __hip_atomic_fetch_add(p, v, __ATOMIC_RELAXED, __HIP_MEMORY_SCOPE_AGENT); }
__device__ __forceinline__ unsigned xb_xcc_id() { return (unsigned)__builtin_amdgcn_s_getreg((3 << 11) | 20) & 0xFu; }
#define XB_SPIN(cond, bar) do { unsigned _sp = 0; while (cond) { __builtin_amdgcn_s_sleep(1); \
    if ((++_sp & 255u) == 0u) { if (xb_ld(&(bar)[XB_TMO])) break; if (_sp > XB_SPIN_CAP) { atomicAdd(&(bar)[XB_TMO], 1u); break; } } } } while (0)

struct XcdBarrier {
    unsigned* bar; unsigned x;
    volatile LAS unsigned* st;
};

__device__ __forceinline__ XcdBarrier xcd_barrier_post(unsigned* bar, volatile LAS unsigned* st) {
    XcdBarrier b; b.bar = bar; b.x = xb_xcc_id(); b.st = st;
    if (threadIdx.x == 0) (void)xb_add(&bar[XB_XCNT(b.x)], 1u);
    return b;
}
__device__ __forceinline__ void xcd_barrier_complete(unsigned* bar, unsigned x, unsigned& nloc, unsigned& nx) {
    const unsigned G = gridDim.x * gridDim.y * gridDim.z;
    unsigned sum, cnt, mine, sp = 0u;
    for (;;) {
        sum = 0u; cnt = 0u; mine = 0u;
#pragma unroll
        for (unsigned j = 0; j < 16; ++j) { const unsigned c = xb_ld(&bar[XB_XCNT(j)]); sum += c; cnt += (c > 0u) ? 1u : 0u; mine = (j == x) ? c : mine; }
        if (sum == G) break;
        __builtin_amdgcn_s_sleep(1);
        if ((++sp & 255u) == 0u) { if (xb_ld(&bar[XB_TMO])) break; if (sp > XB_SPIN_CAP) { atomicAdd(&bar[XB_TMO], 1u); break; } }
    }
    nloc = mine > 0u ? mine : 1u; nx = cnt > 0u ? cnt : 1u;
}

__device__ __forceinline__ void xcd_barrier(const XcdBarrier& b) {
    asm volatile("s_waitcnt vmcnt(0)" ::: "memory");
    __syncthreads();
    if (threadIdx.x == 0) {
        unsigned* bar = b.bar;
        __builtin_amdgcn_s_waitcnt(0);
        unsigned nloc = b.st[0], nx = b.st[1];
        if (nloc == 0u) { xcd_barrier_complete(bar, b.x, nloc, nx); b.st[0] = nloc; b.st[1] = nx; }
        const unsigned old = xb_add(&bar[XB_XSUB(b.x)], 1u);
        const unsigned gen = old / nloc;
        if (old + 1u == (gen + 1u) * nloc) {
            __builtin_amdgcn_fence(__ATOMIC_RELEASE, "agent");
            asm volatile("s_waitcnt vmcnt(0)" ::: "memory");
            const unsigned og = xb_add(&bar[XB_TOP], 1u);
            const unsigned tg = og / nx;
            if (og + 1u == (tg + 1u) * nx) xb_add(&bar[XB_TOPGEN], 1u);
            else XB_SPIN(xb_ld(&bar[XB_TOPGEN]) == tg, bar);
            __builtin_amdgcn_fence(__ATOMIC_ACQUIRE, "agent");
            xb_add(&bar[XB_XGEN(b.x)], 1u);
            asm volatile("s_waitcnt vmcnt(0)" ::: "memory");
        } else {
            XB_SPIN(xb_ld(&bar[XB_XGEN(b.x)]) == gen, bar);
            __builtin_amdgcn_fence(__ATOMIC_ACQUIRE, "agent");
            asm volatile("s_waitcnt vmcnt(0)" ::: "memory");
        }
    }
    __syncthreads();
}

constexpr int NWAVES = 8;
constexpr int BATCH = 8, SEQ = 2048, DM = 2048, M = BATCH * SEQ;
constexpr int NAH = 12, NMH = 4, ATTN_W = 1536, IN_W = 6664, IN_WP = 6912, DFF = 5632, UPW = 11264;
#ifndef MK_N_LAUNCHES
#define MK_N_LAUNCHES 1
#endif
#ifndef WGM_IN
#define WGM_IN 8
#endif
#ifndef WGM_OUT
#define WGM_OUT 4
#endif
#ifndef WGM_UP
#define WGM_UP 8
#endif
#ifndef WGM_DOWN
#define WGM_DOWN 4
#endif
constexpr int N_LAUNCHES = MK_N_LAUNCHES;
enum { PH_PRO = 0, PH_IN = 1, PH_PRE = 2, PH_MIX = 3, PH_OUT = 4, PH_UP = 5, PH_FIX = 6, PH_DOWN = 7 };
constexpr int PER_PHASE = 8;

constexpr size_t MiB = 1u << 20;
constexpr size_t WS_CTL = 0, CTL_ZERO_BYTES = 128 * 1024;
constexpr size_t WS_ROPE = 1 * MiB, WS_G = 2 * MiB, WS_SS = 2 * MiB + 512 * 1024, WS_IR = 3 * MiB;
constexpr size_t WS_WIN = 4 * MiB, WS_WOUT = 31 * MiB, WS_WUP = 39 * MiB, WS_WDN = 83 * MiB;
constexpr size_t WS_XN = 105 * MiB;
constexpr size_t WS_QB = 169 * MiB, WS_KB = 217 * MiB, WS_VB = 265 * MiB, WS_ML = 313 * MiB;
constexpr size_t WS_MIX = 377 * MiB;
constexpr size_t WS_RAW = 377 * MiB;
constexpr size_t WS_ACT = 169 * MiB;
constexpr size_t WS_MLC = 441 * MiB;
constexpr size_t WS_GA = 473 * MiB;
constexpr size_t WS_X1 = 441 * MiB;
constexpr size_t WS_END = 505 * MiB;
static_assert(WS_WIN + (size_t)IN_WP * DM * 2 <= WS_WOUT && WS_WOUT + (size_t)DM * DM * 2 <= WS_WUP && WS_WUP + (size_t)UPW * DM * 2 <= WS_WDN && WS_WDN + (size_t)DM * DFF * 2 <= WS_XN, "weights map");
static_assert(WS_XN + (size_t)M * DM * 2 <= WS_QB && WS_ML + (size_t)M * 2048 * 2 <= WS_MIX && WS_MIX + (size_t)M * 2048 * 2 <= WS_MLC && WS_MLC + (size_t)M * 1024 * 2 <= WS_GA && WS_GA + (size_t)32 * 16 * 3 * 128 * 4 <= WS_END && WS_X1 + (size_t)M * DM * 2 <= WS_END && WS_RAW + (size_t)256 * 4 * UPW * 4 <= WS_MLC && WS_ACT + (size_t)M * DFF * 2 <= WS_MIX, "activation map");
constexpr int CW_TMO = 0, CW_BAR = 4096, CW_QUEUE = 16384;

constexpr int RING_OFF = 0, RING_BYTES = 131072;
constexpr int SCR_OFF = RING_BYTES, SCR_BYTES = 24576;
constexpr int LDSCTL_OFF = SCR_OFF + SCR_BYTES, MISC_OFF = LDSCTL_OFF + 320;
constexpr int LDS_BYTES = 156672;
static_assert(MISC_OFF + 128 <= LDS_BYTES, "LDS map");

#define DI __device__ __forceinline__
typedef float f32x16 __attribute__((ext_vector_type(16)));
typedef short s16x4 __attribute__((ext_vector_type(4)));
typedef unsigned u32x2 __attribute__((ext_vector_type(2)));
#define MFMA32(a, b, c) __builtin_amdgcn_mfma_f32_32x32x16_bf16((a), (b), (c), 0, 0, 0)
constexpr float LOG2E = 1.4426950408889634f;

struct Frame {
    LAS unsigned char* lds; volatile LAS unsigned* MISC; gu32* ctl;
    int tid, lane, wave, vcu, G;
    float* out; unsigned char* ws;
};

DI unsigned swz_b(unsigned row) { return ((row & 3u) << 2) | ((row >> 2) & 3u); }
DI unsigned off_b(unsigned row, unsigned ch) { return 256u * row + 16u * (ch ^ swz_b(row)); }
DI bf16x8 lds_b128(LAS unsigned char* p) { return *(const LAS bf16x8*)p; }
DI LAS unsigned char* lp(unsigned a) { return (LAS unsigned char*)(size_t)a; }
typedef short v4i16_t __attribute__((ext_vector_type(4)));
DI s16x4 lds_tr(LAS unsigned char* p) { return __builtin_bit_cast(s16x4, __builtin_amdgcn_ds_read_tr16_b64_v4i16((LAS v4i16_t*)p)); }
DI int crow(int reg, int hh) { return (reg & 3) + 8 * (reg >> 2) + 4 * hh; }
typedef unsigned u32x4 __attribute__((ext_vector_type(4)));
typedef float f32x2_t __attribute__((ext_vector_type(2)));
typedef __bf16 bf16x2_t __attribute__((ext_vector_type(2)));
DI unsigned cvtpk(float lo, float hi) { f32x2_t v = {lo, hi}; bf16x2_t b = __builtin_convertvector(v, bf16x2_t); return __builtin_bit_cast(unsigned, b); }
DI bf16x8 pack8(float a0, float a1, float a2, float a3, float a4, float a5, float a6, float a7) {
    u32x4 p; p.x = cvtpk(a0, a1); p.y = cvtpk(a2, a3); p.z = cvtpk(a4, a5); p.w = cvtpk(a6, a7); return __builtin_bit_cast(bf16x8, p);
}
DI float bf_lo(unsigned w) { return __builtin_bit_cast(float, w << 16); }
DI float bf_hi(unsigned w) { return __builtin_bit_cast(float, w & 0xffff0000u); }

DI float wave_sum(float v) {
#pragma unroll
    for (int o = 1; o < 64; o <<= 1) v += __shfl_xor(v, o);
    return v;
}
template <int MAT> DI int colmap(int n) {
    if (MAT == 0) return n < 2 * ATTN_W ? (n & ~127) + ((n & 127) >> 1) + 64 * (n & 1) : (n < IN_W ? n : -1);
    if (MAT == 2) return DFF * ((n >> 7) & 1) + 128 * (n >> 8) + (n & 127);
    return n;
}
template <int MAT, bool SCALE, bool VEC> DI void transpose_items(const float* W, const float* gk, int K, int N, bf16* WT, LAS float* scr, int it0, int step, int it_end, int nblk, int lane) {
    if (it0 >= it_end) return;
    float cur[32], nxt[32];
    auto issue = [&](float (&r)[32], int item) {
        const int kb = item / nblk, nb = item % nblk, k0 = 64 * kb, n0 = 32 * nb;
        if (VEC) { const int q = lane & 7, kr = lane >> 3; const int col = colmap<MAT>(n0 + 4 * q);
#pragma unroll
            for (int i = 0; i < 8; ++i) { const f32x4 v = __builtin_nontemporal_load((const GAS f32x4*)(W + (size_t)(k0 + 8 * i + kr) * N + col)); r[4 * i] = v[0]; r[4 * i + 1] = v[1]; r[4 * i + 2] = v[2]; r[4 * i + 3] = v[3]; } }
        else { const int col = colmap<MAT>(n0 + (lane & 31));
#pragma unroll
            for (int i = 0; i < 32; ++i) r[i] = col >= 0 ? __builtin_nontemporal_load((const GAS float*)(W + (size_t)(k0 + 2 * i + (lane >> 5)) * N + col)) : 0.f; }
    };
    issue(cur, it0);
    for (int item = it0; item < it_end; item += step) {
        const bool has_next = item + step < it_end;
        if (has_next) issue(nxt, item + step);
        const int kb = item / nblk, nb = item % nblk, k0 = 64 * kb, n0 = 32 * nb;
        if (VEC) { const int q = lane & 7, kr = lane >> 3;
#pragma unroll
            for (int i = 0; i < 8; ++i)
#pragma unroll
                for (int j = 0; j < 4; ++j) scr[(8 * i + kr) * 33 + 4 * q + j] = cur[4 * i + j]; }
        else {
#pragma unroll
            for (int i = 0; i < 32; ++i) scr[(2 * i + (lane >> 5)) * 33 + (lane & 31)] = cur[i]; }
        const int c = lane & 7;
        f32x4 g0 = {1.f, 1.f, 1.f, 1.f}, g1v = g0;
        if (SCALE) { g0 = *(const GAS f32x4*)(gk + k0 + 8 * c); g1v = *(const GAS f32x4*)(gk + k0 + 8 * c + 4); }
        LDS_WAIT(); asm volatile("" ::: "memory");
#pragma unroll
        for (int j = 0; j < 4; ++j) { const int n = (lane >> 3) + 8 * j; const LAS float* sp = scr + (8 * c) * 33 + n;
            v4u o; o.x = cvtpk(sp[0 * 33] * g0[0], sp[1 * 33] * g0[1]); o.y = cvtpk(sp[2 * 33] * g0[2], sp[3 * 33] * g0[3]); o.z = cvtpk(sp[4 * 33] * g1v[0], sp[5 * 33] * g1v[1]); o.w = cvtpk(sp[6 * 33] * g1v[2], sp[7 * 33] * g1v[3]);
            if (VEC) __builtin_nontemporal_store(o, (GAS v4u*)(WT + (size_t)(n0 + n) * K + k0 + 8 * c)); else *(GAS v4u*)(WT + (size_t)(n0 + n) * K + k0 + 8 * c) = o; }
        LDS_WAIT(); asm volatile("" ::: "memory");
        if (has_next) {
#pragma unroll
            for (int i = 0; i < 32; ++i) cur[i] = nxt[i]; }
    }
}
DI void p0_prologue(Frame& F, const float* x, const float* g1, const float* w_in) {
    LAS float* scr = (LAS float*)(F.lds + RING_OFF + F.wave * 16384);
    const int gw = F.vcu * NWAVES + F.wave, NGW = F.G * NWAVES;
    constexpr int NB0 = IN_WP / 32, I0 = (DM / 64) * NB0;
    bf16* Win = (bf16*)(F.ws + WS_WIN);
    transpose_items<0, true, false>(w_in, g1, DM, IN_W, Win, scr, gw, NGW, I0, NB0, F.lane);
    {
        bf16* XN = (bf16*)(F.ws + WS_XN);
        f32x4 v[8], vn[8];
#pragma unroll
        for (int j = 0; j < 8; ++j) v[j] = __builtin_nontemporal_load((const GAS f32x4*)(x + (size_t)gw * DM) + F.lane + 64 * j);
        for (int m = gw; m < M; m += NGW) {
            const bool has_next = m + NGW < M;
            if (has_next) {
#pragma unroll
                for (int j = 0; j < 8; ++j) vn[j] = __builtin_nontemporal_load((const GAS f32x4*)(x + (size_t)(m + NGW) * DM) + F.lane + 64 * j); }
            float s = 0.f;
#pragma unroll
            for (int j = 0; j < 8; ++j) s += (v[j].x * v[j].x + v[j].y * v[j].y) + (v[j].z * v[j].z + v[j].w * v[j].w);
            const float rms = sqrtf(wave_sum(s) * (1.f / DM) + 1e-6f), rstd = 1.f / rms;
            if (F.lane == 0) ((float*)(F.ws + WS_IR))[m] = rms;
            GAS unsigned long long* o8 = (GAS unsigned long long*)(XN + (size_t)m * DM) + F.lane;
#pragma unroll
            for (int j = 0; j < 8; ++j) o8[64 * j] = (unsigned long long)cvtpk(v[j].x * rstd, v[j].y * rstd) | ((unsigned long long)cvtpk(v[j].z * rstd, v[j].w * rstd) << 32);
            if (has_next) {
#pragma unroll
                for (int j = 0; j < 8; ++j) v[j] = vn[j]; }
        }
    }
    {
        float* rope = (float*)(F.ws + WS_ROPE);
        for (int idx = gw * 64 + F.lane; idx < SEQ * 64; idx += NGW * 64) {
            const int t = idx >> 6, i = idx & 63; const double ang = (double)t * pow(10000.0, -(double)i / 64.0);
            rope[2 * idx] = (float)cos(ang); rope[2 * idx + 1] = (float)sin(ang);
        }
    }
}

DI void att_dma_tile(const unsigned char* gbase, const unsigned (&voff)[8], LAS unsigned char* ldst) {
#pragma unroll
    for (int it = 0; it < 8; ++it) __builtin_amdgcn_global_load_lds((const unsigned*)(gbase + voff[it]), (LAS unsigned*)(ldst + it * 1024), 16, 0, 0);
}
constexpr int ATT_LUT_BYTES = 10 * 2048;
DI void att_build_lut(LAS unsigned char* lut, int tid) {
    for (int idx = tid; idx < 10 * 64 * 8; idx += NWAVES * 64) {
        const int type = idx >> 9, rem = idx & 511, ln = rem >> 3, pair = rem & 7, q = ln & 31, hh = ln >> 5;
        const int d0 = type < 6 ? 32 * type : 32 * (type & 1);
        unsigned w = 0;
#pragma unroll
        for (int k = 0; k < 2; ++k) {
            const int e = 2 * pair + k, d = d0 + q - 4 * hh - ((e & 3) + 8 * (e >> 2));
            int c;
            if (type < 6) c = (d >= 0 && d <= 128 ? 1 : 0) + (d >= 0 && (d & 3) == 0 ? 1 : 0) + (d >= 0 && d <= 32 ? 1 : 0);
            else if (type < 8) c = (d >= 0 && d <= 31) ? 1 : 0;
            else c = (d >= 1 && d <= 32) ? 1 : 0;
            const unsigned bits = c == 0 ? 0xFF80u : (c == 1 ? 0x0000u : (c == 2 ? 0x3F80u : 0x3FCBu));
            w |= bits << (16 * k);
        }
        *(LAS unsigned*)(lut + type * 2048 + (pair >> 2) * 1024 + ln * 16 + (pair & 3) * 4) = w;
    }
}
DI void attn_unit(int b, int h, int r, int ib, const bf16* QB, const bf16* KB, const bf16* VB, bf16* MIX, LAS unsigned char* wl, LAS unsigned char* lut, int lane) {
    const int q = lane & 31, hh = lane >> 5, i0 = 32 * ib;
    const size_t rowb = (size_t)b * 2048;
    bf16x8 qf[8];
    { const bf16* qp = QB + (rowb + r * 512 + i0 + q) * 1536 + h * 128 + 8 * hh;
#pragma unroll
      for (int ks = 0; ks < 8; ++ks) qf[ks] = *(const GAS bf16x8*)(qp + 16 * ks); }
#pragma unroll
    for (int ks = 0; ks < 8; ++ks) asm volatile("" : "+v"(qf[ks]));
    f32x16 o[4];
#pragma unroll
    for (int c = 0; c < 4; ++c)
#pragma unroll
        for (int e = 0; e < 16; ++e) o[c][e] = 0.f;
    float mrun = -1e30f, lsum = 0.f;
    LAS unsigned char* Kt = wl; LAS unsigned char* Vt = wl + 8192;
    const int nt = (ib + 1) + (ib ? 6 : 3);
    auto tile_of = [&](int k, int& rc, int& j0, int& ty) {
        if (k <= ib) { rc = r; j0 = 32 * k; ty = ib - k < 5 ? ib - k : 5; }
        else { const int kk = k - (ib + 1); int far; if (ib) { rc = (r + 1 + (kk >> 1)) & 3; far = 1 - (kk & 1); } else { rc = (r + 1 + kk) & 3; far = 0; } j0 = i0 - 32 * far; ty = (r > rc ? 6 : 8) + far; } };
    unsigned voff[8];
#pragma unroll
    for (int it = 0; it < 8; ++it) { const unsigned row = 4 * it + (lane >> 4); voff[it] = row * 3072u + (((unsigned)lane & 15u) ^ swz_b(row)) * 16u; }
    const unsigned qi = (lane & 15) >> 2, pp = lane & 3, g16 = (lane >> 4) & 1;
    const unsigned swl = 16u * swz_b((unsigned)q), rowb_l = 256u * (unsigned)q;
    unsigned rk[8];
#pragma unroll
    for (int ks = 0; ks < 8; ++ks) rk[ks] = rowb_l + ((unsigned)(32 * ks + 16 * hh) ^ swl);
    unsigned tp[2];
#pragma unroll
    for (int t = 0; t < 2; ++t) tp[t] = 2048u * t + 1024u * hh + 256u * qi + 8u * (pp & 1) + 16u * ((2u * g16 + (pp >> 1)) ^ ((2u * t + hh) & 3u));
    const unsigned char* kbase = (const unsigned char*)(KB + rowb * 1536 + h * 128); const unsigned char* vbase = (const unsigned char*)(VB + rowb * 1536 + h * 128);
    { int rc, j0, ty; tile_of(0, rc, j0, ty);
      att_dma_tile(kbase + (size_t)(rc * 512 + j0) * 3072, voff, Kt);
      att_dma_tile(vbase + (size_t)(rc * 512 + j0) * 3072, voff, Vt); }
    for (int k = 0; k < nt; ++k) {
        int rc, j0, ty; tile_of(k, rc, j0, ty);
        const bool has_next = k + 1 < nt; int rcn = 0, j0n = 0, tyn = 0; if (has_next) tile_of(k + 1, rcn, j0n, tyn);
        const u32x4 bw0 = *(const LAS u32x4*)(lut + ty * 2048 + lane * 16), bw1 = *(const LAS u32x4*)(lut + ty * 2048 + 1024 + lane * 16);
        asm volatile("s_waitcnt vmcnt(8)" ::: "memory");
        bf16x8 kf[8];
#pragma unroll
        for (int ks = 0; ks < 8; ++ks) kf[ks] = lds_b128(Kt + rk[ks]);
        asm volatile("s_waitcnt lgkmcnt(0)" ::: "memory");
        if (has_next) att_dma_tile(kbase + (size_t)(rcn * 512 + j0n) * 3072, voff, Kt);
        f32x16 s;
#pragma unroll
        for (int e = 0; e < 16; ++e) s[e] = 0.f;
#pragma unroll
        for (int ks = 0; ks < 8; ++ks) s = MFMA32(kf[ks], qf[ks], s);
        s[0] += bf_lo(bw0.x); s[1] += bf_hi(bw0.x); s[2] += bf_lo(bw0.y); s[3] += bf_hi(bw0.y); s[4] += bf_lo(bw0.z); s[5] += bf_hi(bw0.z); s[6] += bf_lo(bw0.w); s[7] += bf_hi(bw0.w);
        s[8] += bf_lo(bw1.x); s[9] += bf_hi(bw1.x); s[10] += bf_lo(bw1.y); s[11] += bf_hi(bw1.y); s[12] += bf_lo(bw1.z); s[13] += bf_hi(bw1.z); s[14] += bf_lo(bw1.w); s[15] += bf_hi(bw1.w);
        float mx = fmaxf(fmaxf(fmaxf(s[0], s[1]), fmaxf(s[2], s[3])), fmaxf(fmaxf(s[4], s[5]), fmaxf(s[6], s[7])));
        mx = fmaxf(mx, fmaxf(fmaxf(fmaxf(s[8], s[9]), fmaxf(s[10], s[11])), fmaxf(fmaxf(s[12], s[13]), fmaxf(s[14], s[15]))));
        mx = fmaxf(mx, __shfl_xor(mx, 32));
        const float mnew = fmaxf(mrun, mx), alpha = __builtin_amdgcn_exp2f(mrun - mnew);
        float ps = 0.f;
#pragma unroll
        for (int e = 0; e < 16; ++e) { s[e] = __builtin_amdgcn_exp2f(s[e] - mnew); ps += s[e]; }
        lsum = lsum * alpha + ps;
        if (__any(mnew > mrun)) {
#pragma unroll
            for (int c = 0; c < 4; ++c)
#pragma unroll
                for (int e = 0; e < 16; ++e) o[c][e] *= alpha;
        }
        mrun = mnew;
        const bf16x8 pf0 = pack8(s[0], s[1], s[2], s[3], s[4], s[5], s[6], s[7]), pf1 = pack8(s[8], s[9], s[10], s[11], s[12], s[13], s[14], s[15]);
        if (has_next) asm volatile("s_waitcnt vmcnt(8)" ::: "memory"); else asm volatile("s_waitcnt vmcnt(0)" ::: "memory");
        bf16x8 vf[4][2];
#pragma unroll
        for (int c = 0; c < 4; ++c)
#pragma unroll
            for (int s2 = 0; s2 < 2; ++s2) {
                const unsigned xc = 64u * ((unsigned)c ^ qi);
                const s16x4 lo = lds_tr(Vt + 4096 * s2 + tp[0] + xc);
                const s16x4 hi = lds_tr(Vt + 4096 * s2 + tp[1] + xc);
                vf[c][s2] = __builtin_shufflevector(lo, hi, 0, 1, 2, 3, 4, 5, 6, 7);
            }
        asm volatile("s_waitcnt lgkmcnt(0)" ::: "memory");
        if (has_next) att_dma_tile(vbase + (size_t)(rcn * 512 + j0n) * 3072, voff, Vt);
#pragma unroll
        for (int c = 0; c < 4; ++c) { o[c] = MFMA32(vf[c][0], pf0, o[c]); o[c] = MFMA32(vf[c][1], pf1, o[c]); }
    }
    lsum += __shfl_xor(lsum, 32);
    const float inv = 1.0f / lsum;
#pragma unroll
    for (int c = 0; c < 4; ++c)
#pragma unroll
        for (int g = 0; g < 4; ++g) {
            u32x2 w; w.x = cvtpk(o[c][4 * g] * inv, o[c][4 * g + 1] * inv); w.y = cvtpk(o[c][4 * g + 2] * inv, o[c][4 * g + 3] * inv);
            *(LAS u32x2*)(Kt + rowb_l + ((unsigned)(16 * (4 * c + g)) ^ swl) + 8u * hh) = w;
        }
    asm volatile("s_waitcnt lgkmcnt(0)" ::: "memory");
    {
        unsigned char* ob = (unsigned char*)(MIX + ((size_t)b * 2048 + 4 * i0 + r) * 2048 + h * 128);
#pragma unroll
        for (int it = 0; it < 8; ++it) {
            const unsigned row = 4 * it + (lane >> 4), ch = lane & 15;
            const u32x4 v = *(const LAS u32x4*)(Kt + off_b(row, ch));
            *(GAS u32x4*)(ob + (size_t)row * 16384 + ch * 16) = v;
        }
    }
    asm volatile("s_waitcnt lgkmcnt(0)" ::: "memory");
}
constexpr int CV_NB1 = DM / 32, CV_NB2 = UPW / 32, CV_NB3 = DM / 32, CV_I1 = (DM / 64) * CV_NB1, CV_I2 = (DM / 64) * CV_NB2, CV_I3 = (DFF / 64) * CV_NB3;
constexpr int CV_EARLY = 0;
DI void convert_range(Frame& F, LAS float* scr, const float* w_out, const float* w_up, const float* g2, const float* w_down, int lo, int hi, int cw0, int cwn) {
    bf16* Wout = (bf16*)(F.ws + WS_WOUT); bf16* Wup = (bf16*)(F.ws + WS_WUP); bf16* Wdn = (bf16*)(F.ws + WS_WDN);
    auto clampi = [](int v, int a, int b) { return v < a ? a : (v > b ? b : v); };
    { const int a = clampi(lo, 0, CV_I1), b = clampi(hi, 0, CV_I1); if (b > a) transpose_items<1, false, true>(w_out, nullptr, DM, DM, Wout, scr, a + cw0, cwn, b, CV_NB1, F.lane); }
    { const int a = clampi(lo - CV_I1, 0, CV_I2), b = clampi(hi - CV_I1, 0, CV_I2); if (b > a) transpose_items<2, true, true>(w_up, g2, DM, UPW, Wup, scr, a + cw0, cwn, b, CV_NB2, F.lane); }
    { const int a = clampi(lo - CV_I1 - CV_I2, 0, CV_I3), b = clampi(hi - CV_I1 - CV_I2, 0, CV_I3); if (b > a) transpose_items<3, false, true>(w_down, nullptr, DFF, DM, Wdn, scr, a + cw0, cwn, b, CV_NB3, F.lane); }
}
constexpr int ML_SPLIT = 11;
constexpr int ML_WGS = 2 * BATCH * NMH;
DI void attn_phase(Frame& F, int qword0, const float* w_out, const float* w_up, const float* g2, const float* w_down, bool skip_conv) {
    const bf16* QB = (const bf16*)(F.ws + WS_QB); const bf16* KB = (const bf16*)(F.ws + WS_KB); const bf16* VB = (const bf16*)(F.ws + WS_VB); bf16* MIX = (bf16*)(F.ws + WS_MIX);
    LAS unsigned char* wl = F.lds + RING_OFF + F.wave * 16384; LAS unsigned char* lut = F.lds + SCR_OFF;
    att_build_lut(lut, F.tid);
    __syncthreads();
    constexpr int NCW = 3;
    if (F.wave >= NWAVES - NCW && !skip_conv)
        convert_range(F, (LAS float*)wl, w_out, w_up, g2, w_down, F.G == 256 ? CV_EARLY : 0, CV_I1 + CV_I2 + CV_I3, ((int)blockIdx.x - ML_WGS) * NCW + (F.wave - (NWAVES - NCW)), (F.G - ML_WGS) * NCW);
    int qsel = (int)(xb_xcc_id() & 7u);
    for (int tries = 0; tries < 8;) {
        unsigned u = 0; if (F.lane == 0) u = xb_add((unsigned*)(F.ctl + qword0 + 64 * qsel), 1u);
        u = (unsigned)__builtin_amdgcn_readfirstlane((int)u);
        if (u >= 768u) { qsel = (qsel + 1) & 7; ++tries; continue; }
        const int pair = u >> 4, ib = 15 - (u & 15), bh = qsel * 12 + (pair >> 2), r = pair & 3;
        attn_unit(bh / 12, bh % 12, r, ib, QB, KB, VB, MIX, wl, lut, F.lane);
    }
}

DI float scan_add64(float v, int lane) {
#pragma unroll
    for (int d = 1; d < 64; d <<= 1) { const float t = __shfl_up(v, d); if (lane >= d) v += t; }
    return v;
}
DI float scan_max64(float v, int lane) {
#pragma unroll
    for (int d = 1; d < 64; d <<= 1) { const float t = __shfl_up(v, d); if (lane >= d) v = fmaxf(v, t); }
    return v;
}
DI float silu_f(float y) { return y * __builtin_amdgcn_rcpf(1.0f + __builtin_amdgcn_exp2f(-LOG2E * y)); }
DI void mixer_prepass(Frame& F, const float* mcw, const float* mcb) {
    const bf16* ML = (const bf16*)(F.ws + WS_ML); bf16* MLC = (bf16*)(F.ws + WS_MLC); const float* G = (const float*)(F.ws + WS_G); float* GA = (float*)(F.ws + WS_GA);
    const int gw = F.vcu * NWAVES + F.wave, NGW = F.G * NWAVES;
    for (int it = gw; it < 32 * 16; it += NGW) {
        const int seq = it >> 4, ch = it & 15, b = seq >> 2, hm = seq & 3; const size_t mrow0 = (size_t)b * 2048 + ch * 128;
        const float gi0 = G[(mrow0 + F.lane) * 8 + hm], gf0 = G[(mrow0 + F.lane) * 8 + 4 + hm], gi1 = G[(mrow0 + 64 + F.lane) * 8 + hm], gf1 = G[(mrow0 + 64 + F.lane) * 8 + 4 + hm];
        const float lf0 = fminf(gf0, 0.f) - log1pf(expf(-fabsf(gf0))), lf1 = fminf(gf1, 0.f) - log1pf(expf(-fabsf(gf1)));
        const float b0 = scan_add64(lf0, F.lane); const float tot0 = __shfl(b0, 63); const float b1 = scan_add64(lf1, F.lane) + tot0;
        const float a0 = gi0 - b0, a1 = gi1 - b1;
        const float cm0 = scan_max64(a0, F.lane); const float M0 = __shfl(cm0, 63); const float cm1 = fmaxf(scan_max64(a1, F.lane), M0);
        float* o = GA + (size_t)it * 384;
        o[F.lane] = b0; o[64 + F.lane] = b1; o[128 + F.lane] = a0; o[192 + F.lane] = a1; o[256 + F.lane] = cm0; o[320 + F.lane] = cm1;
    }
    for (int it = gw * 64 + F.lane; it < (M / 4) * 128; it += NGW * 64) {
        const int c8 = it & 127, r4 = it >> 7, m0 = 4 * r4, t0 = m0 & 2047, ch0 = 8 * c8;
        u32x4 raw[7];
#pragma unroll
        for (int i = 0; i < 7; ++i) { u32x4 rv = *(const GAS u32x4*)(ML + (size_t)(m0 - 3 + i) * 2048 + ch0); if (t0 - 3 + i < 0) rv = (u32x4){0u, 0u, 0u, 0u}; raw[i] = rv; }
        float wt[5][8];
#pragma unroll
        for (int tap = 0; tap < 5; ++tap) { const float* wp = tap < 4 ? mcw + tap * 1024 + ch0 : mcb + ch0; const f32x4 a = *(const f32x4*)wp, bq = *(const f32x4*)(wp + 4);
            wt[tap][0] = a[0]; wt[tap][1] = a[1]; wt[tap][2] = a[2]; wt[tap][3] = a[3]; wt[tap][4] = bq[0]; wt[tap][5] = bq[1]; wt[tap][6] = bq[2]; wt[tap][7] = bq[3]; }
        const float osc = ch0 >= 512 ? 0.08838834764831845f : 1.0f;
#pragma unroll
        for (int rho = 0; rho < 4; ++rho) {
            float y[8];
#pragma unroll
            for (int j = 0; j < 8; ++j) y[j] = wt[4][j];
#pragma unroll
            for (int tap = 0; tap < 4; ++tap) { const u32x4 x = raw[rho + tap];
                y[0] += wt[tap][0] * bf_lo(x.x); y[1] += wt[tap][1] * bf_hi(x.x); y[2] += wt[tap][2] * bf_lo(x.y); y[3] += wt[tap][3] * bf_hi(x.y);
                y[4] += wt[tap][4] * bf_lo(x.z); y[5] += wt[tap][5] * bf_hi(x.z); y[6] += wt[tap][6] * bf_lo(x.w); y[7] += wt[tap][7] * bf_hi(x.w); }
#pragma unroll
            for (int j = 0; j < 8; ++j) y[j] = silu_f(y[j]) * osc;
            *(GAS bf16x8*)(MLC + (size_t)(m0 + rho) * 1024 + ch0) = pack8(y[0], y[1], y[2], y[3], y[4], y[5], y[6], y[7]);
        }
    }
}

constexpr int ML_Q = 0, ML_K = 32768, ML_V = 65536, ML_C = 98304;
constexpr int MS_A = 0, MS_U = 512, MS_WI = 1024, MS_WK = 1536, MS_EM = 2048, MS_NV = 2560, MS_GV = 3072, MS_CW = 3584, MS_NR = 8704, MS_RS = 12800, MS_SC = 13824;
DI void mlstm_seq(Frame& F, int b, int hm, const float* mng, int c0, int c1) {
    LAS unsigned char* L = F.lds + RING_OFF; LAS unsigned char* S = F.lds + SCR_OFF;
    LAS float* A_ = (LAS float*)(S + MS_A); LAS float* U_ = (LAS float*)(S + MS_U); LAS float* WI = (LAS float*)(S + MS_WI); LAS float* WK = (LAS float*)(S + MS_WK); LAS float* EM = (LAS float*)(S + MS_EM);
    LAS float* NV = (LAS float*)(S + MS_NV); LAS float* GV = (LAS float*)(S + MS_GV); LAS float* CW = (LAS float*)(S + MS_CW); LAS float* NR = (LAS float*)(S + MS_NR); LAS float* RS = (LAS float*)(S + MS_RS); LAS float* SC = (LAS float*)(S + MS_SC);
    const int w = F.wave;
    const bf16* ML = (const bf16*)(F.ws + WS_ML); const bf16* MLC = (const bf16*)(F.ws + WS_MLC); const float* GA = (const float*)(F.ws + WS_GA) + (size_t)(b * 4 + hm) * 16 * 384; bf16* MIX = (bf16*)(F.ws + WS_MIX);
    if (F.tid < 128) { GV[F.tid] = mng[hm * 128 + F.tid]; NV[F.tid] = 0.f; }
    for (int i = F.tid; i < 32768 / 16; i += 512) *(LAS u32x4*)(L + ML_C + 16 * i) = (u32x4){0u, 0u, 0u, 0u};
    f32x16 Cacc[2];
#pragma unroll
    for (int i = 0; i < 2; ++i)
#pragma unroll
        for (int e = 0; e < 16; ++e) Cacc[i][e] = 0.f;
    float mc = 0.f;
    const int tb = (w & 3) ^ (3 * (w >> 2)), eh = w >> 2;
    const int ebF = w >> 1, dbF0 = 2 * (w & 1);
#define ML_BAR() do { asm volatile("s_waitcnt lgkmcnt(0)" ::: "memory"); __builtin_amdgcn_s_barrier(); asm volatile("" ::: "memory"); } while (0)
#define ML_OPAQUE_TID(name) int name = F.tid; asm volatile("" : "+v"(name))
#define ML_THREAD_MAP(tidv) const int c16 = (tidv) & 15, rg = (tidv) >> 4; const unsigned rg16 = 16u * rg, c32 = 32u * c16; unsigned sa[4]; \
        _Pragma("unroll") for (int rho = 0; rho < 4; ++rho) sa[rho] = 1024u * rg + 256u * rho + 64u * (((unsigned)c16 >> 2) ^ (unsigned)rho) + 16u * (((unsigned)c16 & 3u) ^ ((unsigned)rg & 3u))
#define ML_LANE_MAP(tidv) const int lane = (tidv) & 63, hh = lane >> 5, l31 = lane & 31; const unsigned qi = (lane & 15) >> 2, pp = lane & 3, g16 = (lane >> 4) & 1; \
        const unsigned swl_ = 16u * swz_b((unsigned)l31), rowb_ = 256u * (unsigned)l31, hh8 = 8u * hh, hh16 = 16u * hh; unsigned tn[2], tp[2]; \
        _Pragma("unroll") for (int t = 0; t < 2; ++t) { tn[t] = 2048u * hh + 1024u * t + 256u * qi + 8u * (pp & 1) + 16u * ((2u * g16 + (pp >> 1)) ^ ((2u * hh + t) & 3u)); \
                                                       tp[t] = 2048u * t + 1024u * hh + 256u * qi + 8u * (pp & 1) + 16u * ((2u * g16 + (pp >> 1)) ^ ((2u * t + hh) & 3u)); }
#define SF(off) (*(LAS float*)(S + (off)))
#define SF4(off) (*(const LAS f32x4*)(S + (off)))
    u32x4 rq[4], rk_[4], rv4[4]; float pgt[6] = {0.f, 0.f, 0.f, 0.f, 0.f, 0.f};
    {
        const int c16 = F.tid & 15, rg = F.tid >> 4;
        const unsigned char* cq0 = (const unsigned char*)MLC + (size_t)b * 2048 * 2048 + 8192u * rg + 256u * hm + 16u * c16;
        const unsigned char* cv0 = (const unsigned char*)ML + (size_t)b * 2048 * 4096 + 16384u * rg + 2048 + 256u * hm + 16u * c16;
#pragma unroll
        for (int rho = 0; rho < 4; ++rho) { rk_[rho] = *(const GAS u32x4*)(cq0 + rho * 2048 + 1024); rv4[rho] = *(const GAS u32x4*)(cv0 + rho * 4096); }
        if (w == 0) {
#pragma unroll
            for (int i = 0; i < 6; ++i) pgt[i] = GA[64 * i + F.lane]; }
    }
    __syncthreads();
    for (int ch = 0; ch < c0; ++ch) {
        {
        ML_OPAQUE_TID(tidA); ML_THREAD_MAP(tidA);
#pragma unroll
        for (int rho = 0; rho < 4; ++rho) { *(LAS u32x4*)(lp(sa[rho]) + ML_K) = rk_[rho]; *(LAS u32x4*)lp(sa[rho] + ML_V) = rv4[rho]; }
        }
        if (w == 0) {
            ML_OPAQUE_TID(tidB); const int lane = tidB & 63; const unsigned l4 = 4u * lane;
            const float b1 = pgt[1], a0 = pgt[2], a1 = pgt[3], cm1 = pgt[5];
            const float Mall = __shfl(cm1, 63), blast = __shfl(b1, 63), mxa = fmaxf(mc, Mall);
            SF(MS_WK + l4) = __builtin_amdgcn_exp2f(LOG2E * (a0 - mxa)); SF(MS_WK + 256 + l4) = __builtin_amdgcn_exp2f(LOG2E * (a1 - mxa));
            if (lane == 0) SC[0] = __builtin_amdgcn_exp2f(LOG2E * (mc - mxa));
            mc = blast + mxa;
        }
        ML_BAR();
        {
            ML_OPAQUE_TID(tidP); const int c16 = tidP & 15, rg = tidP >> 4;
            int cn = ch + 1; asm volatile("" : "+s"(cn));
            const unsigned char* cq1 = (const unsigned char*)MLC + ((size_t)b * 2048 + cn * 128) * 2048 + 8192u * rg + 256u * hm + 16u * c16;
            const unsigned char* cv1 = (const unsigned char*)ML + ((size_t)b * 2048 + cn * 128) * 4096 + 16384u * rg + 2048 + 256u * hm + 16u * c16;
#pragma unroll
            for (int rho = 0; rho < 4; ++rho) { rk_[rho] = *(const GAS u32x4*)(cq1 + rho * 2048 + 1024); rv4[rho] = *(const GAS u32x4*)(cv1 + rho * 4096); }
            if (w == 0) { const float* ga1 = GA + cn * 384 + (tidP & 63);
#pragma unroll
                for (int i = 0; i < 6; ++i) pgt[i] = ga1[64 * i]; }
        }
        {
            ML_OPAQUE_TID(tidK); ML_THREAD_MAP(tidK); const int lane = tidK & 63;
            float ps[8] = {0.f, 0.f, 0.f, 0.f, 0.f, 0.f, 0.f, 0.f};
#pragma unroll
            for (int rho = 0; rho < 4; ++rho) {
                const float wk = SF(MS_WK + 4 * rho + rg16); const u32x4 kk = *(const LAS u32x4*)(lp(sa[rho]) + ML_K);
                const float v0 = bf_lo(kk.x) * wk, v1 = bf_hi(kk.x) * wk, v2 = bf_lo(kk.y) * wk, v3 = bf_hi(kk.y) * wk, v4 = bf_lo(kk.z) * wk, v5 = bf_hi(kk.z) * wk, v6 = bf_lo(kk.w) * wk, v7 = bf_hi(kk.w) * wk;
                ps[0] += v0; ps[1] += v1; ps[2] += v2; ps[3] += v3; ps[4] += v4; ps[5] += v5; ps[6] += v6; ps[7] += v7;
                *(LAS bf16x8*)(lp(sa[rho]) + ML_Q) = pack8(v0, v1, v2, v3, v4, v5, v6, v7);
            }
#pragma unroll
            for (int j = 0; j < 8; ++j) { ps[j] += __shfl_xor(ps[j], 16); ps[j] += __shfl_xor(ps[j], 32); }
            if ((lane >> 4) == 0) {
#pragma unroll
                for (int j = 0; j < 8; ++j) SF(MS_NR + 512 * w + 4 * j + c32) = ps[j];
            }
        }
        ML_BAR();
        {
        const float decay = SC[0];
        ML_OPAQUE_TID(tidF); const unsigned t4 = 4u * tidF;
        if (tidF < 128) { float a = 0.f;
#pragma unroll
            for (int ww = 0; ww < 8; ++ww) a += SF(MS_NR + 512 * ww + t4);
            SF(MS_NV + t4) = decay * SF(MS_NV + t4) + a; }
#pragma unroll
        for (int i = 0; i < 2; ++i)
#pragma unroll
            for (int e = 0; e < 16; ++e) Cacc[i][e] *= decay;
        ML_LANE_MAP(tidF);
        const unsigned xc_eF = 64u * ((unsigned)ebF ^ qi), xc_d0 = 64u * ((unsigned)dbF0 ^ qi), xc_d1 = 64u * ((unsigned)(dbF0 + 1) ^ qi);
        const unsigned aF0 = ML_V + tn[0] + xc_eF, aF1 = ML_V + tn[1] + xc_eF, aK00 = ML_Q + tn[0] + xc_d0, aK01 = ML_Q + tn[1] + xc_d0, aK10 = ML_Q + tn[0] + xc_d1, aK11 = ML_Q + tn[1] + xc_d1;
        bf16x8 af[8];
#pragma unroll
        for (int ks = 0; ks < 8; ++ks) { const s16x4 alo = lds_tr(lp(aF0) + 4096 * ks), ahi = lds_tr(lp(aF1) + 4096 * ks); af[ks] = __builtin_shufflevector(alo, ahi, 0, 1, 2, 3, 4, 5, 6, 7); }
#pragma unroll
        for (int i = 0; i < 2; ++i) {
            bf16x8 bk[8];
#pragma unroll
            for (int ks = 0; ks < 8; ++ks) { const s16x4 blo = lds_tr(lp(i ? aK10 : aK00) + 4096 * ks), bhi = lds_tr(lp(i ? aK11 : aK01) + 4096 * ks); bk[ks] = __builtin_shufflevector(blo, bhi, 0, 1, 2, 3, 4, 5, 6, 7); }
#pragma unroll
            for (int ks = 0; ks < 8; ++ks) Cacc[i] = MFMA32(af[ks], bk[ks], Cacc[i]);
        }
        }
        ML_BAR();
    }
    if (c0 > 0) {
        ML_OPAQUE_TID(tidW); ML_LANE_MAP(tidW);
#pragma unroll
        for (int i = 0; i < 2; ++i)
#pragma unroll
            for (int g = 0; g < 4; ++g) {
                u32x2 wv; wv.x = cvtpk(Cacc[i][4 * g], Cacc[i][4 * g + 1]); wv.y = cvtpk(Cacc[i][4 * g + 2], Cacc[i][4 * g + 3]);
                *(LAS u32x2*)lp(rowb_ + ((unsigned)(16 * (4 * ebF + g)) ^ swl_) + hh8 + ML_C + 8192u * (dbF0 + i)) = wv;
            }
    }
    {
        const int c16 = F.tid & 15, rg = F.tid >> 4;
        const unsigned char* cq0 = (const unsigned char*)MLC + ((size_t)b * 2048 + c0 * 128) * 2048 + 8192u * rg + 256u * hm + 16u * c16;
#pragma unroll
        for (int rho = 0; rho < 4; ++rho) rq[rho] = *(const GAS u32x4*)(cq0 + rho * 2048);
    }
    __syncthreads();
    for (int ch = c0; ch < c1; ++ch) {
        int t0 = ch * 128; asm volatile("" : "+s"(t0));
        const size_t mrow0 = (size_t)b * 2048 + t0;
        const unsigned char* cb0 = (const unsigned char*)ML + mrow0 * 4096;
        unsigned char* mb0 = (unsigned char*)MIX + mrow0 * 4096;
        {
        ML_OPAQUE_TID(tidA); ML_THREAD_MAP(tidA);
#pragma unroll
        for (int rho = 0; rho < 4; ++rho) { *(LAS u32x4*)(lp(sa[rho]) + ML_Q) = rq[rho]; *(LAS u32x4*)(lp(sa[rho]) + ML_K) = rk_[rho]; *(LAS u32x4*)lp(sa[rho] + ML_V) = rv4[rho]; }
        }
        __builtin_amdgcn_sched_barrier(0);
        if (w == 0) {
            ML_OPAQUE_TID(tidB); const int lane = tidB & 63; const unsigned l4 = 4u * lane;
            const float b0 = pgt[0], b1 = pgt[1], a0 = pgt[2], a1 = pgt[3], cm0 = pgt[4], cm1 = pgt[5];
            const float mx0 = fmaxf(mc, cm0), mx1 = fmaxf(mc, cm1);
            SF(MS_A + l4) = a0; SF(MS_A + 256 + l4) = a1; SF(MS_U + l4) = -mx0; SF(MS_U + 256 + l4) = -mx1;
            SF(MS_WI + l4) = __builtin_amdgcn_exp2f(LOG2E * (mc - mx0)); SF(MS_WI + 256 + l4) = __builtin_amdgcn_exp2f(LOG2E * (mc - mx1));
            SF(MS_EM + l4) = __builtin_amdgcn_exp2f(-LOG2E * (b0 + mx0)); SF(MS_EM + 256 + l4) = __builtin_amdgcn_exp2f(-LOG2E * (b1 + mx1));
            const float Mall = __shfl(cm1, 63), blast = __shfl(b1, 63), mxa = fmaxf(mc, Mall);
            SF(MS_WK + l4) = __builtin_amdgcn_exp2f(LOG2E * (a0 - mxa)); SF(MS_WK + 256 + l4) = __builtin_amdgcn_exp2f(LOG2E * (a1 - mxa));
            if (lane == 0) SC[0] = __builtin_amdgcn_exp2f(LOG2E * (mc - mxa));
            mc = blast + mxa;
        }
        ML_BAR();
        ML_OPAQUE_TID(tidC); ML_LANE_MAP(tidC);
        const unsigned tq4 = 4u * (32u * tb + l31);
        const unsigned voffO = 4096u * (32u * tb + l31) + 3072u + 256u * hm + 128u * eh + 8u * hh;
        unsigned rk[8];
#pragma unroll
        for (int ks = 0; ks < 8; ++ks) rk[ks] = rowb_ + ((unsigned)(32 * ks + 2 * hh8) ^ swl_);
        const unsigned xc_e0 = 64u * ((unsigned)(2 * eh) ^ qi), xc_e1 = 64u * ((unsigned)(2 * eh + 1) ^ qi);
        const unsigned aC00 = ML_C + tn[0] + xc_e0, aC01 = ML_C + tn[1] + xc_e0, aC10 = ML_C + tn[0] + xc_e1, aC11 = ML_C + tn[1] + xc_e1;
        const unsigned aV00 = ML_V + tp[0] + xc_e0, aV01 = ML_V + tp[1] + xc_e0, aV10 = ML_V + tp[0] + xc_e1, aV11 = ML_V + tp[1] + xc_e1;
        __builtin_amdgcn_sched_barrier(0);
        const int tq = 32 * tb + l31;
        const unsigned qoff = ML_Q + 8192u * tb;
        const float ut = SF(MS_U + tq4), wint = SF(MS_WI + tq4), emt = SF(MS_EM + tq4);
        bf16x8 qf[8];
#pragma unroll
        for (int ks = 0; ks < 8; ++ks) qf[ks] = lds_b128(lp(rk[ks] + qoff));
        f32x16 acc[2];
#pragma unroll
        for (int c = 0; c < 2; ++c) {
            __builtin_amdgcn_sched_barrier(0);
            bf16x8 cf[8];
#pragma unroll
            for (int ks = 0; ks < 8; ++ks) {
                const s16x4 lo = lds_tr(lp(c ? aC10 : aC00) + 4096 * ks);
                const s16x4 hi = lds_tr(lp(c ? aC11 : aC01) + 4096 * ks);
                cf[ks] = __builtin_shufflevector(lo, hi, 0, 1, 2, 3, 4, 5, 6, 7);
            }
#pragma unroll
            for (int e = 0; e < 16; ++e) acc[c][e] = 0.f;
#pragma unroll
            for (int ks = 0; ks < 8; ++ks) acc[c] = MFMA32(cf[ks], qf[ks], acc[c]);
#pragma unroll
            for (int e = 0; e < 16; ++e) acc[c][e] *= wint;
        }
        float qn = 0.f;
#pragma unroll
        for (int ks = 0; ks < 8; ++ks) { const f32x4 n0 = SF4(MS_NV + 64 * ks + 2 * hh16), n1 = SF4(MS_NV + 64 * ks + 16 + 2 * hh16); const u32x4 qq = __builtin_bit_cast(u32x4, qf[ks]);
            qn += bf_lo(qq.x) * n0[0] + bf_hi(qq.x) * n0[1] + bf_lo(qq.y) * n0[2] + bf_hi(qq.y) * n0[3] + bf_lo(qq.z) * n1[0] + bf_hi(qq.z) * n1[1] + bf_lo(qq.w) * n1[2] + bf_hi(qq.w) * n1[3]; }
        __builtin_amdgcn_sched_barrier(0);
        u32x4 og[4];
        { ML_OPAQUE_TID(tidO); const unsigned char* co = cb0 + 3072 + 256u * hm + 16384u * (tidO >> 4) + 16u * (tidO & 15);
#pragma unroll
          for (int rho = 0; rho < 4; ++rho) og[rho] = *(const GAS u32x4*)(co + rho * 4096); }
        float sumP = 0.f;
#pragma unroll
        for (int sb = 0; sb < 4; ++sb) {
            if (sb <= tb) {
                __builtin_amdgcn_sched_barrier(0);
                f32x16 s; bf16x8 kf[8];
#pragma unroll
                for (int e = 0; e < 16; ++e) s[e] = 0.f;
#pragma unroll
                for (int ks = 0; ks < 8; ++ks) kf[ks] = lds_b128(lp(rk[ks]) + ML_K + 8192 * sb);
#pragma unroll
                for (int ks = 0; ks < 8; ++ks) s = MFMA32(kf[ks], qf[ks], s);
#pragma unroll
                for (int g = 0; g < 4; ++g) { const f32x4 av = SF4(MS_A + 4 * (32 * sb + 8 * g) + hh16);
#pragma unroll
                    for (int j = 0; j < 4; ++j) { const int e = 4 * g + j; float p = s[e] * __builtin_amdgcn_exp2f(LOG2E * (ut + av[j])); if (sb == tb && crow(e, hh) > l31) p = 0.f; s[e] = p; sumP += p; } }
                const bf16x8 pf0 = pack8(s[0], s[1], s[2], s[3], s[4], s[5], s[6], s[7]), pf1 = pack8(s[8], s[9], s[10], s[11], s[12], s[13], s[14], s[15]);
                __builtin_amdgcn_sched_barrier(0);
                bf16x8 vf[2][2];
#pragma unroll
                for (int c = 0; c < 2; ++c)
#pragma unroll
                    for (int s2 = 0; s2 < 2; ++s2) {
                        const s16x4 lo = lds_tr(lp(c ? aV10 : aV00) + 8192 * sb + 4096 * s2);
                        const s16x4 hi = lds_tr(lp(c ? aV11 : aV01) + 8192 * sb + 4096 * s2);
                        vf[c][s2] = __builtin_shufflevector(lo, hi, 0, 1, 2, 3, 4, 5, 6, 7);
                    }
#pragma unroll
                for (int c = 0; c < 2; ++c) { acc[c] = MFMA32(vf[c][0], pf0, acc[c]); acc[c] = MFMA32(vf[c][1], pf1, acc[c]); }
            }
        }
        qn += __shfl_xor(qn, 32); sumP += __shfl_xor(sumP, 32);
        const float den = wint * qn + sumP, rden = 1.0f / fmaxf(fabsf(den), emt);
        __builtin_amdgcn_sched_barrier(0);
        ML_BAR();
#pragma unroll
        for (int c = 0; c < 2; ++c)
#pragma unroll
            for (int g = 0; g < 4; ++g) {
                u32x2 wv; wv.x = cvtpk(acc[c][4 * g] * rden, acc[c][4 * g + 1] * rden); wv.y = cvtpk(acc[c][4 * g + 2] * rden, acc[c][4 * g + 3] * rden);
                *(LAS u32x2*)lp(ML_Q + 8192u * tb + rowb_ + ((unsigned)(16 * (4 * (2 * eh + c) + g)) ^ swl_) + hh8) = wv;
            }
        ML_BAR();
        {
            ML_OPAQUE_TID(tidE); ML_THREAD_MAP(tidE);
            const f32x4 g0 = SF4(MS_GV + c32), g1v = SF4(MS_GV + 16 + c32);
            unsigned char* mo = mb0 + 3072 + 256u * hm + 16384u * rg + 16u * c16;
#pragma unroll
            for (int rho = 0; rho < 4; ++rho) {
                const u32x4 hv = *(const LAS u32x4*)(lp(sa[rho]) + ML_Q); const u32x4 ov = og[rho];
                float h[8] = {bf_lo(hv.x), bf_hi(hv.x), bf_lo(hv.y), bf_hi(hv.y), bf_lo(hv.z), bf_hi(hv.z), bf_lo(hv.w), bf_hi(hv.w)};
                const float o[8] = {bf_lo(ov.x), bf_hi(ov.x), bf_lo(ov.y), bf_hi(ov.y), bf_lo(ov.z), bf_hi(ov.z), bf_lo(ov.w), bf_hi(ov.w)};
                float ssq = 0.f;
#pragma unroll
                for (int j = 0; j < 8; ++j) { h[j] *= __builtin_amdgcn_rcpf(1.0f + __builtin_amdgcn_exp2f(-LOG2E * o[j])); ssq += h[j] * h[j]; }
                ssq += __shfl_xor(ssq, 1); ssq += __shfl_xor(ssq, 2); ssq += __shfl_xor(ssq, 4); ssq += __shfl_xor(ssq, 8);
                const float rstd = 1.0f / sqrtf(ssq * (1.0f / 128.0f) + 1e-6f);
                u32x4 wv; wv.x = cvtpk(h[0] * rstd * g0[0], h[1] * rstd * g0[1]); wv.y = cvtpk(h[2] * rstd * g0[2], h[3] * rstd * g0[3]); wv.z = cvtpk(h[4] * rstd * g1v[0], h[5] * rstd * g1v[1]); wv.w = cvtpk(h[6] * rstd * g1v[2], h[7] * rstd * g1v[3]);
                *(GAS u32x4*)(mo + rho * 4096) = wv;
            }
        }
        __builtin_amdgcn_sched_barrier(0);
        __builtin_amdgcn_sched_barrier(0);
        {
            ML_OPAQUE_TID(tidP); const int c16 = tidP & 15, rg = tidP >> 4;
            int cn1 = (ch + 1 < c1 ? ch + 1 : ch); asm volatile("" : "+s"(cn1));
            const unsigned char* cq1 = (const unsigned char*)MLC + ((size_t)b * 2048 + cn1 * 128) * 2048 + 8192u * rg + 256u * hm + 16u * c16;
            const unsigned char* cv1 = (const unsigned char*)ML + ((size_t)b * 2048 + cn1 * 128) * 4096 + 16384u * rg + 2048 + 256u * hm + 16u * c16;
#pragma unroll
            for (int rho = 0; rho < 4; ++rho) { rk_[rho] = *(const GAS u32x4*)(cq1 + rho * 2048 + 1024); rv4[rho] = *(const GAS u32x4*)(cv1 + rho * 4096); }
        }
        __builtin_amdgcn_sched_barrier(0);
        {
            ML_OPAQUE_TID(tidK); ML_THREAD_MAP(tidK); const int lane = tidK & 63;
            float ps[8] = {0.f, 0.f, 0.f, 0.f, 0.f, 0.f, 0.f, 0.f};
#pragma unroll
            for (int rho = 0; rho < 4; ++rho) {
                const float wk = SF(MS_WK + 4 * rho + rg16); const u32x4 kk = *(const LAS u32x4*)(lp(sa[rho]) + ML_K);
                const float v0 = bf_lo(kk.x) * wk, v1 = bf_hi(kk.x) * wk, v2 = bf_lo(kk.y) * wk, v3 = bf_hi(kk.y) * wk, v4 = bf_lo(kk.z) * wk, v5 = bf_hi(kk.z) * wk, v6 = bf_lo(kk.w) * wk, v7 = bf_hi(kk.w) * wk;
                ps[0] += v0; ps[1] += v1; ps[2] += v2; ps[3] += v3; ps[4] += v4; ps[5] += v5; ps[6] += v6; ps[7] += v7;
                *(LAS bf16x8*)(lp(sa[rho]) + ML_Q) = pack8(v0, v1, v2, v3, v4, v5, v6, v7);
            }
#pragma unroll
            for (int j = 0; j < 8; ++j) { ps[j] += __shfl_xor(ps[j], 16); ps[j] += __shfl_xor(ps[j], 32); }
            if ((lane >> 4) == 0) {
#pragma unroll
                for (int j = 0; j < 8; ++j) SF(MS_NR + 512 * w + 4 * j + c32) = ps[j];
            }
        }
        ML_BAR();
        {
            ML_OPAQUE_TID(tidP2); const int c16 = tidP2 & 15, rg = tidP2 >> 4;
            int cn1 = (ch + 1 < c1 ? ch + 1 : ch); asm volatile("" : "+s"(cn1));
            const unsigned char* cq1 = (const unsigned char*)MLC + ((size_t)b * 2048 + cn1 * 128) * 2048 + 8192u * rg + 256u * hm + 16u * c16;
#pragma unroll
            for (int rho = 0; rho < 4; ++rho) rq[rho] = *(const GAS u32x4*)(cq1 + rho * 2048);
            if (w == 0) { const float* ga1 = GA + cn1 * 384 + (tidP2 & 63);
#pragma unroll
                for (int i = 0; i < 6; ++i) pgt[i] = ga1[64 * i]; }
        }
        __builtin_amdgcn_sched_barrier(0);
        const float decay = SC[0];
        ML_OPAQUE_TID(tidF); const unsigned t4 = 4u * tidF;
        if (tidF < 128) { float a = 0.f;
#pragma unroll
            for (int ww = 0; ww < 8; ++ww) a += SF(MS_NR + 512 * ww + t4);
            SF(MS_NV + t4) = decay * SF(MS_NV + t4) + a; }
#pragma unroll
        for (int i = 0; i < 2; ++i)
#pragma unroll
            for (int e = 0; e < 16; ++e) Cacc[i][e] *= decay;
        {
        ML_LANE_MAP(tidF);
        const unsigned xc_eF = 64u * ((unsigned)ebF ^ qi), xc_d0 = 64u * ((unsigned)dbF0 ^ qi), xc_d1 = 64u * ((unsigned)(dbF0 + 1) ^ qi);
        const unsigned aF0 = ML_V + tn[0] + xc_eF, aF1 = ML_V + tn[1] + xc_eF, aK00 = ML_Q + tn[0] + xc_d0, aK01 = ML_Q + tn[1] + xc_d0, aK10 = ML_Q + tn[0] + xc_d1, aK11 = ML_Q + tn[1] + xc_d1;
        unsigned cwr[4];
#pragma unroll
        for (int g = 0; g < 4; ++g) cwr[g] = rowb_ + ((unsigned)(16 * (4 * ebF + g)) ^ swl_) + hh8;
        bf16x8 af[8];
#pragma unroll
        for (int ks = 0; ks < 8; ++ks) {
            const s16x4 alo = lds_tr(lp(aF0) + 4096 * ks);
            const s16x4 ahi = lds_tr(lp(aF1) + 4096 * ks);
            af[ks] = __builtin_shufflevector(alo, ahi, 0, 1, 2, 3, 4, 5, 6, 7);
        }
#pragma unroll
        for (int i = 0; i < 2; ++i) {
            bf16x8 bk[8];
#pragma unroll
            for (int ks = 0; ks < 8; ++ks) {
                const s16x4 blo = lds_tr(lp(i ? aK10 : aK00) + 4096 * ks);
                const s16x4 bhi = lds_tr(lp(i ? aK11 : aK01) + 4096 * ks);
                bk[ks] = __builtin_shufflevector(blo, bhi, 0, 1, 2, 3, 4, 5, 6, 7);
            }
#pragma unroll
            for (int ks = 0; ks < 8; ++ks) Cacc[i] = MFMA32(af[ks], bk[ks], Cacc[i]);
        }
#pragma unroll
        for (int i = 0; i < 2; ++i)
#pragma unroll
            for (int g = 0; g < 4; ++g) {
                u32x2 wv; wv.x = cvtpk(Cacc[i][4 * g], Cacc[i][4 * g + 1]); wv.y = cvtpk(Cacc[i][4 * g + 2], Cacc[i][4 * g + 3]);
                *(LAS u32x2*)lp(cwr[g] + ML_C + 8192u * (dbF0 + i)) = wv;
            }
        }
        ML_BAR();
    }
}

DI void ffn_fixup(Frame& F, const float* cw, const float* cb) {
    const float* RAWB = (const float*)(F.ws + WS_RAW); bf16* ACT = (bf16*)(F.ws + WS_ACT);
    const int gt = (F.vcu * NWAVES + F.wave) * 64 + F.lane, NT = F.G * NWAVES * 64;
    for (int it = gt; it < 256 * 2 * (DFF / 4); it += NT) {
        const int j4 = it % (DFF / 4), rs = it / (DFF / 4), rho = rs & 1, strip = rs >> 1, j = 4 * j4;
        const int pg = (j >> 7) * 256 + (j & 127);
        const bool first = (strip & 31) == 0;
        const float* own = RAWB + (size_t)strip * 4 * UPW; const float* prv = RAWB + (size_t)(strip - 1) * 4 * UPW;
        const f32x4 z = {0.f, 0.f, 0.f, 0.f};
        f32x4 gm2, gm1, g0, vm2, vm1, v0;
        if (rho == 0) { gm2 = first ? z : *(const f32x4*)(prv + 2 * UPW + pg); gm1 = first ? z : *(const f32x4*)(prv + 3 * UPW + pg); g0 = *(const f32x4*)(own + pg);
                        vm2 = first ? z : *(const f32x4*)(prv + 2 * UPW + pg + 128); vm1 = first ? z : *(const f32x4*)(prv + 3 * UPW + pg + 128); v0 = *(const f32x4*)(own + pg + 128); }
        else { gm2 = first ? z : *(const f32x4*)(prv + 3 * UPW + pg); gm1 = *(const f32x4*)(own + pg); g0 = *(const f32x4*)(own + UPW + pg);
               vm2 = first ? z : *(const f32x4*)(prv + 3 * UPW + pg + 128); vm1 = *(const f32x4*)(own + pg + 128); v0 = *(const f32x4*)(own + UPW + pg + 128); }
        const f32x4 yg = *(const f32x4*)(cb + j) + *(const f32x4*)(cw + j) * gm2 + *(const f32x4*)(cw + UPW + j) * gm1 + *(const f32x4*)(cw + 2 * UPW + j) * g0;
        const f32x4 yv = *(const f32x4*)(cb + DFF + j) + *(const f32x4*)(cw + DFF + j) * vm2 + *(const f32x4*)(cw + UPW + DFF + j) * vm1 + *(const f32x4*)(cw + 2 * UPW + DFF + j) * v0;
        u32x2 wv; wv.x = cvtpk(silu_f(yg[0]) * yv[0], silu_f(yg[1]) * yv[1]); wv.y = cvtpk(silu_f(yg[2]) * yv[2], silu_f(yg[3]) * yv[3]);
        *(GAS u32x2*)(ACT + (size_t)(64 * strip + rho) * DFF + j) = wv;
    }
}

struct Args { const float* in[16]; float* out; unsigned char* ws; int ph_lo, ph_hi, li, pad; };
__global__ void __launch_bounds__(NWAVES * 64, 2) fwd_kernel(Args args) {
    extern __shared__ __attribute__((aligned(16))) unsigned char lds[];
    Frame F;
    F.lds = (LAS unsigned char*)lds; F.MISC = (volatile LAS unsigned*)(F.lds + MISC_OFF);
    F.tid = threadIdx.x; F.lane = F.tid & 63; F.wave = __builtin_amdgcn_readfirstlane(F.tid >> 6);
    F.G = gridDim.x; { const int bx = blockIdx.x; F.vcu = (F.G % 8 == 0) ? (bx % 8) * (F.G / 8) + bx / 8 : bx; }
    F.ws = args.ws; F.ctl = (gu32*)(args.ws + WS_CTL); F.out = args.out;
    for (int u = F.tid; u < (LDS_BYTES - LDSCTL_OFF) / 4; u += NWAVES * 64) ((LAS unsigned*)(F.lds + LDSCTL_OFF))[u] = 0u;
    __syncthreads();
    XcdBarrier bar; bar.bar = (unsigned*)(F.ctl + CW_BAR) + args.li * XCD_BAR_WORDS; bar.x = 0; bar.st = nullptr;
    if (N_LAUNCHES != PER_PHASE) bar = xcd_barrier_post((unsigned*)(F.ctl + CW_BAR) + args.li * XCD_BAR_WORDS, F.MISC + 8);
#define GRID_BAR(seam) do { if (N_LAUNCHES == PER_PHASE) { if (F.tid == 0) __hip_atomic_store(F.ctl + CW_TMO, 0xBADBA0u | (unsigned)(seam), RLX_AGENT); } else { xcd_barrier(bar); } } while (0)
    const int lo = args.ph_lo, hi = args.ph_hi;
#define IN(k) (lo <= (k) && (k) < hi)
#define BOTH(k) (IN(k) && IN((k) + 1))
    PG8_LAS float* escr = (PG8_LAS float*)(F.lds + SCR_OFF);
    if (IN(PH_PRO)) { p0_prologue(F, args.in[0], args.in[1], args.in[2]); if (BOTH(PH_PRO)) GRID_BAR(PH_PRO); }
    if (IN(PH_IN)) {
        pg8::Gemm g{(const pg8::bf16_t*)(F.ws + WS_XN), (const pg8::bf16_t*)(F.ws + WS_WIN), M, IN_WP, DM}; pg8::StaticOrder S; S.init(M, IN_WP, F.G, (int)blockIdx.x, WGM_IN);
        pg8::Epi1 E{(pg8::bf16_t*)(F.ws + WS_QB), (pg8::bf16_t*)(F.ws + WS_KB), (pg8::bf16_t*)(F.ws + WS_VB), (pg8::bf16_t*)(F.ws + WS_ML), (float*)(F.ws + WS_G), (const float*)(F.ws + WS_ROPE), args.in[3], args.in[4], args.in[7], args.in[8], escr};
        pg8::gemm_phase<pg8::Epi1, pg8::StaticOrder, true, true>(F.lds + RING_OFF, g, S, E);
        { constexpr int IDLE0 = (M / 256) * (IN_WP / 256) % 256;
          if (F.G == 256 && (int)blockIdx.x >= IDLE0)
              convert_range(F, (LAS float*)(F.lds + RING_OFF + F.wave * 16384), args.in[10], args.in[12], args.in[11], args.in[15], 0, CV_EARLY, ((int)blockIdx.x - IDLE0) * NWAVES + F.wave, (256 - IDLE0) * NWAVES);
        }
        if (BOTH(PH_IN)) GRID_BAR(PH_IN);
    }
    if (IN(PH_PRE)) { mixer_prepass(F, args.in[5], args.in[6]); if (BOTH(PH_PRE)) GRID_BAR(PH_PRE); }
    if (IN(PH_MIX)) {
#ifndef PROBE_P2
#define PROBE_P2 0
#endif
#ifndef PROBE_LIGHT_UP
#define PROBE_LIGHT_UP 0
#endif
        const bool skip_ml = PROBE_P2 >= 2 && args.li == 1, skip_at = PROBE_P2 == 1 && args.li == 1;
        const bool is_ml = (int)blockIdx.x < ML_WGS;
        if (is_ml && !skip_ml) { const int seq = (int)blockIdx.x & 31, part = (int)blockIdx.x >> 5; mlstm_seq(F, seq >> 2, seq & 3, args.in[9], part ? ML_SPLIT : 0, part ? SEQ / 128 : ML_SPLIT); __syncthreads(); }
        if (!skip_at) attn_phase(F, CW_QUEUE + 1024 * args.li, args.in[10], args.in[12], args.in[11], args.in[15], is_ml || (PROBE_P2 == 3 && args.li == 1));
        if (BOTH(PH_MIX)) GRID_BAR(PH_MIX);
    }
    if (IN(PH_OUT)) {
        pg8::Gemm g{(const pg8::bf16_t*)(F.ws + WS_MIX), (const pg8::bf16_t*)(F.ws + WS_WOUT), M, DM, DM}; pg8::StaticOrder S; S.init(M, DM, F.G, (int)blockIdx.x, WGM_OUT);
        pg8::Epi3 E{(const pg8::bf16_t*)(F.ws + WS_XN), (const float*)(F.ws + WS_IR), (pg8::bf16_t*)(F.ws + WS_X1), (float*)(F.ws + WS_SS), escr};
        pg8::gemm_phase<pg8::Epi3, pg8::StaticOrder, true, true>(F.lds + RING_OFF, g, S, E);
        if (BOTH(PH_OUT)) GRID_BAR(PH_OUT);
    }
    if (IN(PH_UP)) {
        pg8::Gemm g{(const pg8::bf16_t*)(F.ws + WS_X1), (const pg8::bf16_t*)(F.ws + WS_WUP), M, UPW, DM}; pg8::StaticOrder S; S.init(M, UPW, F.G, (int)blockIdx.x, WGM_UP);
        pg8::Epi4 E{(pg8::bf16_t*)(F.ws + WS_ACT), (float*)(F.ws + WS_RAW), (const float*)(F.ws + WS_SS), args.in[13], args.in[14], escr, args.li == 0 ? PROBE_LIGHT_UP : 0};
        pg8::gemm_phase<pg8::Epi4, pg8::StaticOrder, true, true>(F.lds + RING_OFF, g, S, E);
        if (BOTH(PH_UP)) GRID_BAR(PH_UP);
    }
    if (IN(PH_FIX)) { ffn_fixup(F, args.in[13], args.in[14]); if (BOTH(PH_FIX)) GRID_BAR(PH_FIX); }
    if (IN(PH_DOWN)) {
        pg8::Gemm g{(const pg8::bf16_t*)(F.ws + WS_ACT), (const pg8::bf16_t*)(F.ws + WS_WDN), M, DM, DFF}; pg8::StaticOrder S; S.init(M, DM, F.G, (int)blockIdx.x, WGM_DOWN);
        pg8::Epi5 E{F.out, (const pg8::bf16_t*)(F.ws + WS_X1)};
        pg8::gemm_phase<pg8::Epi5, pg8::StaticOrder, true, true>(F.lds + RING_OFF, g, S, E);
    }
#undef IN
#undef BOTH
}

extern "C" void kernel_launch(void* const* d_in, const int* in_sizes, int n_in, void* d_out, int out_size, void* d_ws, size_t ws_size, hipStream_t stream) {
    static int grid = 0;
    if (grid == 0) {
        if (n_in != 16 || in_sizes[0] != M * DM || out_size != M * DM || ws_size < WS_END) { fprintf(stderr, "kernel_launch: unexpected shapes (n_in %d in0 %d out %d ws %zu)\n", n_in, n_in > 0 ? in_sizes[0] : -1, out_size, ws_size); grid = -1; return; }
        int dev = 0, cus = 0, per_cu = 0;
        if (hipGetDevice(&dev) != hipSuccess || hipDeviceGetAttribute(&cus, hipDeviceAttributeMultiprocessorCount, dev) != hipSuccess) { grid = -1; return; }
        if (hipFuncSetAttribute((const void*)fwd_kernel, hipFuncAttributeMaxDynamicSharedMemorySize, LDS_BYTES) != hipSuccess) { fprintf(stderr, "kernel_launch: hipFuncSetAttribute failed\n"); grid = -1; return; }
        if (hipOccupancyMaxActiveBlocksPerMultiprocessor(&per_cu, (const void*)fwd_kernel, NWAVES * 64, LDS_BYTES) != hipSuccess || per_cu < 1) fprintf(stderr, "kernel_launch: occupancy query reports %d blocks per CU\n", per_cu);
        (void)hipGetLastError();
        grid = cus;
    }
    if (grid < 0) return;
    if (hipMemsetAsync((char*)d_ws + WS_CTL, 0, CTL_ZERO_BYTES, stream) != hipSuccess) return;
    Args a{};
    for (int i = 0; i < 16; ++i) a.in[i] = (const float*)d_in[i];
    a.out = (float*)d_out; a.ws = (unsigned char*)d_ws;
#ifdef PROBE_REPEAT
    { const int k = PROBE_REPEAT; const int lo[3] = {0, k, k + 1}, hi[3] = {k + 1, k + 1, PER_PHASE};
      for (int li = 0; li < 3; ++li) { a.ph_lo = lo[li]; a.ph_hi = hi[li]; a.li = li; hipLaunchKernelGGL(fwd_kernel, dim3(grid), dim3(NWAVES * 64), LDS_BYTES, stream, a); } }
#else
    if (N_LAUNCHES == 1) { a.ph_lo = 0; a.ph_hi = PER_PHASE; a.li = 0; hipLaunchKernelGGL(fwd_kernel, dim3(grid), dim3(NWAVES * 64), LDS_BYTES, stream, a); }
    else for (int li = 0; li < PER_PHASE; ++li) { a.ph_lo = li; a.ph_hi = li + 1; a.li = 0; hipLaunchKernelGGL(fwd_kernel, dim3(grid), dim3(NWAVES * 64), LDS_BYTES, stream, a); }
#endif
}
```

```cpp
#include <hip/hip_runtime.h>
#include <cstdio>
#include <cstdint>
#include <cmath>
namespace pg8 {
#define PG8_LAS __attribute__((address_space(3)))
typedef unsigned short bf16_t;
typedef short bf16x8 __attribute__((ext_vector_type(8)));
typedef float f32x4 __attribute__((ext_vector_type(4)));
typedef unsigned u32x4 __attribute__((ext_vector_type(4)));
constexpr int BM = 256, BK = 64, HALF = 128, HTB = HALF * BK * 2  , STAGE_BYTES = 8 * HTB, NXCD = 8, WGM = 8;

__host__ __device__ __forceinline__ int lds_byte(int r, int c) { const int st = (r >> 4) * 2 + (c >> 5), rr = r & 15, cc = c & 31, ob = rr * 64 + cc * 2; return st * 1024 + (ob ^ (((ob >> 9) & 1) << 5)); }
__host__ __device__ __forceinline__ void stage_rc(int b, int& R, int& C) { const int st = b / 1024, sb = b % 1024, swz = sb ^ (((sb >> 9) & 1) << 5); R = (st >> 1) * 16 + swz / 64; C = (st & 1) * 32 + (swz % 64) / 2; }
__host__ __device__ __forceinline__ int perm32(int rho) { const int n = rho >> 4, i = rho & 15; return 8 * (i >> 2) + 4 * n + (i & 3); }

struct Unit { int pm, pn; };
struct Gemm { const bf16_t* A; const bf16_t* Bt; int M, N, K; };

struct StaticOrder {
    int nM, nN, nwg, G, c, wgm;
    __host__ __device__ void init(int M, int N, int G_, int c_, int wgm_ = WGM) { nM = M / BM; nN = N / BM; nwg = nM * nN; G = G_; c = c_; wgm = wgm_; }
    __host__ __device__ bool next(int i, Unit& u) const {
        const long L = (long)i * G + c; if (L >= nwg) return false;
        int wgid = (int)L; { const int q = nwg / NXCD, r = nwg % NXCD, xcd = wgid % NXCD, off = wgid / NXCD; wgid = (xcd < r ? xcd * (q + 1) : r * (q + 1) + (xcd - r) * q) + off; }
        const int nig = wgm * nN, gid = wgid / nig, fm = gid * wgm, gsz = (nM - fm) < wgm ? (nM - fm) : wgm;
        u.pm = fm + ((wgid % nig) % gsz); u.pn = (wgid % nig) / gsz; return true;
    }
    __device__ __forceinline__ void a_ready(const Unit&) const {}
    __device__ __forceinline__ void done(const Unit&) const {}
};

__device__ __forceinline__ unsigned cvt_pk_bf16(float lo, float hi) { unsigned r; asm volatile("v_cvt_pk_bf16_f32 %0, %1, %2" : "=v"(r) : "v"(lo), "v"(hi)); return r; }

typedef float f32x2 __attribute__((ext_vector_type(2)));
#define EPI_BAR() do { asm volatile("s_waitcnt lgkmcnt(0)" ::: "memory"); __builtin_amdgcn_s_barrier(); asm volatile("" ::: "memory"); } while (0)
constexpr float kEps = 1e-6f;

struct Epi1 {
    static constexpr bool PERM = true, AFTER_DRAIN = false, APERM = false;
    __device__ __forceinline__ void pre(const Unit&, int, int) const {}
    bf16_t *QB, *KB, *VB, *ML; float* G; const float* rope; const float *qg, *kg, *b_i, *b_f; PG8_LAS float* scr;
    __device__ __forceinline__ void operator()(const f32x4 (&acc)[2][2][4][2], const Unit& u, int wr, int wc, int fr, int fq) const {
        const int pn = u.pn;
        if (pn < 12) {
            const bool isq = pn < 6;
#pragma unroll
            for (int ai = 0; ai < 2; ++ai)
#pragma unroll
                for (int m = 0; m < 4; ++m)
#pragma unroll
                    for (int bj = 0; bj < 2; ++bj) {
                        const f32x4 a = acc[ai][bj][m][0], b = acc[ai][bj][m][1];
                        float s = (a[0] * a[0] + a[1] * a[1]) + (a[2] * a[2] + a[3] * a[3]) + (b[0] * b[0] + b[1] * b[1]) + (b[2] * b[2] + b[3] * b[3]);
                        s += __shfl_xor(s, 16); s += __shfl_xor(s, 32);
                        if (fq == 0) scr[((ai * HALF + wr * 64 + m * 16 + fr) * 2 + bj) * 4 + wc] = s;
                    }
            EPI_BAR();
            const float* gsrc = isq ? qg : kg; const float gscale = isq ? 0.08838834764831845f * 1.4426950408889634f : 1.0f;
            f32x4 gva, gvb;
#pragma unroll
            for (int e = 0; e < 4; ++e) { const int p = 32 * wc + 8 * fq + e; gva[e] = gsrc[(p >> 1) + 64 * (p & 1)] * gscale; gvb[e] = gsrc[((p + 4) >> 1) + 64 * (p & 1)] * gscale; }
            bf16_t* dst = isq ? QB : KB; const int head0 = (isq ? pn : pn - 6) * 2;
#pragma unroll
            for (int ai = 0; ai < 2; ++ai)
#pragma unroll
                for (int m = 0; m < 4; ++m) {
                    const int rl = ai * HALF + wr * 64 + m * 16 + fr, grow = u.pm * BM + rl, t = grow & 2047, bb = grow >> 11;
                    const size_t drow = (size_t)bb * 2048 + (size_t)(t & 3) * 512 + (t >> 2);
                    const f32x4 cs0 = *(const f32x4*)(rope + ((size_t)t * 64 + 16 * wc + 4 * fq) * 2), cs1 = *(const f32x4*)(rope + ((size_t)t * 64 + 16 * wc + 4 * fq) * 2 + 4);
#pragma unroll
                    for (int bj = 0; bj < 2; ++bj) {
                        const f32x4 pp = *(const PG8_LAS f32x4*)(scr + (rl * 2 + bj) * 4);
                        const float rstd = 1.0f / sqrtf(((pp[0] + pp[1]) + (pp[2] + pp[3])) * (1.0f / 128.0f) + kEps);
                        const f32x4 a = acc[ai][bj][m][0] * (gva * rstd), b = acc[ai][bj][m][1] * (gvb * rstd);
                        const f32x2 xe0 = {a[0], a[2]}, xo0 = {a[1], a[3]}, xe1 = {b[0], b[2]}, xo1 = {b[1], b[3]};
                        const f32x2 c0 = {cs0[0], cs0[2]}, s0 = {cs0[1], cs0[3]}, c1 = {cs1[0], cs1[2]}, s1 = {cs1[1], cs1[3]};
                        const f32x2 oe0 = xe0 * c0 - xo0 * s0, oo0 = xe0 * s0 + xo0 * c0, oe1 = xe1 * c1 - xo1 * s1, oo1 = xe1 * s1 + xo1 * c1;
                        u32x4 w;
                        w.x = cvt_pk_bf16(oe0[0], oo0[0]); w.y = cvt_pk_bf16(oe0[1], oo0[1]); w.z = cvt_pk_bf16(oe1[0], oo1[0]); w.w = cvt_pk_bf16(oe1[1], oo1[1]);
                        *(u32x4*)(dst + drow * 1536 + (head0 + bj) * 128 + 32 * wc + 8 * fq) = w;
                    }
                }
        } else if (pn < 26) {
            const bool isv = pn < 18;
#pragma unroll
            for (int ai = 0; ai < 2; ++ai)
#pragma unroll
                for (int m = 0; m < 4; ++m) {
                    const int rl = ai * HALF + wr * 64 + m * 16 + fr, grow = u.pm * BM + rl, t = grow & 2047, bb = grow >> 11;
                    bf16_t* rowp = isv ? VB + ((size_t)bb * 2048 + (size_t)(t & 3) * 512 + (t >> 2)) * 1536 + (pn - 12) * 256 : ML + (size_t)grow * 2048 + (pn - 18) * 256;
#pragma unroll
                    for (int bj = 0; bj < 2; ++bj) {
                        const f32x4 a = acc[ai][bj][m][0], b = acc[ai][bj][m][1];
                        u32x4 w; w.x = cvt_pk_bf16(a[0], a[1]); w.y = cvt_pk_bf16(a[2], a[3]); w.z = cvt_pk_bf16(b[0], b[1]); w.w = cvt_pk_bf16(b[2], b[3]);
                        *(u32x4*)(rowp + bj * HALF + 32 * wc + 8 * fq) = w;
                    }
                }
        } else {
            if (wc == 0 && fq == 0) {
                const f32x4 bi = *(const f32x4*)b_i, bf = *(const f32x4*)b_f;
#pragma unroll
                for (int ai = 0; ai < 2; ++ai)
#pragma unroll
                    for (int m = 0; m < 4; ++m) {
                        const int grow = u.pm * BM + ai * HALF + wr * 64 + m * 16 + fr;
                        *(f32x4*)(G + (size_t)grow * 8) = acc[ai][0][m][0] + bi; *(f32x4*)(G + (size_t)grow * 8 + 4) = acc[ai][0][m][1] + bf;
                    }
            }
        }
    }
};

struct Epi3 {
    static constexpr bool PERM = true, AFTER_DRAIN = false, APERM = false;
    __device__ __forceinline__ void pre(const Unit&, int, int) const {}
    const bf16_t* XN; const float* IR; bf16_t* X1; float* SS; PG8_LAS float* scr;
    __device__ __forceinline__ void operator()(const f32x4 (&acc)[2][2][4][2], const Unit& u, int wr, int wc, int fr, int fq) const {
        const int col0 = u.pn * BM + 32 * wc + 8 * fq;
#pragma unroll
        for (int ai = 0; ai < 2; ++ai)
#pragma unroll
            for (int m = 0; m < 4; ++m) {
                const int rl = ai * HALF + wr * 64 + m * 16 + fr; const size_t off = (size_t)(u.pm * BM + rl) * 2048 + col0;
                const float ir = IR[u.pm * BM + rl];
                float s = 0.f;
#pragma unroll
                for (int bj = 0; bj < 2; ++bj) {
                    const u32x4 xw = __builtin_nontemporal_load((const u32x4*)(XN + off + bj * HALF));
                    const f32x4 x0 = {__builtin_bit_cast(float, xw.x << 16), __builtin_bit_cast(float, xw.x & 0xffff0000u), __builtin_bit_cast(float, xw.y << 16), __builtin_bit_cast(float, xw.y & 0xffff0000u)};
                    const f32x4 x1 = {__builtin_bit_cast(float, xw.z << 16), __builtin_bit_cast(float, xw.z & 0xffff0000u), __builtin_bit_cast(float, xw.w << 16), __builtin_bit_cast(float, xw.w & 0xffff0000u)};
                    const f32x4 a = acc[ai][bj][m][0] + x0 * ir, b = acc[ai][bj][m][1] + x1 * ir;
                    s += (a[0] * a[0] + a[1] * a[1]) + (a[2] * a[2] + a[3] * a[3]) + (b[0] * b[0] + b[1] * b[1]) + (b[2] * b[2] + b[3] * b[3]);
                    u32x4 w; w.x = cvt_pk_bf16(a[0], a[1]); w.y = cvt_pk_bf16(a[2], a[3]); w.z = cvt_pk_bf16(b[0], b[1]); w.w = cvt_pk_bf16(b[2], b[3]);
                    *(u32x4*)(X1 + off + bj * HALF) = w;
                }
                s += __shfl_xor(s, 16); s += __shfl_xor(s, 32);
                if (fq == 0) scr[rl * 4 + wc] = s;
            }
        EPI_BAR();
        if (wc == 0 && fq == 0) {
#pragma unroll
            for (int ai = 0; ai < 2; ++ai)
#pragma unroll
                for (int m = 0; m < 4; ++m) {
                    const int rl = ai * HALF + wr * 64 + m * 16 + fr; const f32x4 pp = *(const PG8_LAS f32x4*)(scr + rl * 4);
                    SS[(size_t)(u.pm * BM + rl) * 8 + u.pn] = (pp[0] + pp[1]) + (pp[2] + pp[3]);
                }
        }
    }
};

__device__ __forceinline__ float dpp_shr1(float v) { return __builtin_bit_cast(float, __builtin_amdgcn_update_dpp(0, __builtin_bit_cast(int, v), 0x111, 0xf, 0xf, true)); }
struct Epi4 {
    static constexpr bool PERM = true, AFTER_DRAIN = false, APERM = true;
    bf16_t* ACT; bf16_t* RAWB; const float* SS; const float *cw, *cb; PG8_LAS float* scr; int light;
    __device__ __forceinline__ void pre(const Unit& u, int wid, int lane) const {
        __builtin_amdgcn_global_load_lds((const unsigned*)((const char*)(SS + (size_t)u.pm * BM * 8) + wid * 1024 + lane * 16), (PG8_LAS unsigned*)((PG8_LAS char*)scr + wid * 1024), 16, 0, 0);
        if (wid < 4) { const int seg = 2 * wid + (lane >> 5), q4 = seg >> 1, gv = seg & 1;
            const float* src = (q4 < 3 ? cw + q4 * 11264 : cb) + (gv ? 5632 : 0) + u.pn * 128 + 4 * (lane & 31);
            __builtin_amdgcn_global_load_lds((const unsigned*)src, (PG8_LAS unsigned*)((PG8_LAS char*)scr + 8192 + wid * 1024), 16, 0, 0); }
    }
    __device__ __forceinline__ void operator()(f32x4 (&acc)[2][2][4][2], const Unit& u, int wr, int wc, int fr, int fq) const {
        if (light == 1) return;
        const int j0 = u.pn * 128 + 32 * wc + 8 * fq;
#pragma unroll
        for (int ai = 0; ai < 2; ++ai)
#pragma unroll
            for (int m = 0; m < 4; ++m) {
                const PG8_LAS float* sp = scr + (ai * HALF + wr * 64 + 4 * fr + m) * 8; const f32x4 s0 = *(const PG8_LAS f32x4*)sp, s1 = *(const PG8_LAS f32x4*)(sp + 4);
                const float rstd = 1.0f / sqrtf((((s0[0] + s0[1]) + (s0[2] + s0[3])) + ((s1[0] + s1[1]) + (s1[2] + s1[3]))) * (1.0f / 2048.0f) + kEps);
#pragma unroll
                for (int bj = 0; bj < 2; ++bj) { acc[ai][bj][m][0] = acc[ai][bj][m][0] * rstd; acc[ai][bj][m][1] = acc[ai][bj][m][1] * rstd; }
            }
        if (fr == 0 && light != 2) {
#pragma unroll
            for (int ai = 0; ai < 2; ++ai)
#pragma unroll
                for (int mm = 0; mm < 2; ++mm)
#pragma unroll
                    for (int bj = 0; bj < 2; ++bj) { bf16_t* p = RAWB + ((size_t)(u.pm * 4 + ai * 2 + wr) * 4 + mm) * 11264 + u.pn * 256 + bj * HALF + 32 * wc + 8 * fq; const f32x4 a = acc[ai][bj][mm][0], b = acc[ai][bj][mm][1];
                        u32x4 w; w.x = cvt_pk_bf16(a[0], a[1]); w.y = cvt_pk_bf16(a[2], a[3]); w.z = cvt_pk_bf16(b[0], b[1]); w.w = cvt_pk_bf16(b[2], b[3]); *(u32x4*)p = w; }
        }
        if (fr == 15 && light != 2) {
#pragma unroll
            for (int ai = 0; ai < 2; ++ai)
#pragma unroll
                for (int mm = 0; mm < 2; ++mm)
#pragma unroll
                    for (int bj = 0; bj < 2; ++bj) { bf16_t* p = RAWB + ((size_t)(u.pm * 4 + ai * 2 + wr) * 4 + 2 + mm) * 11264 + u.pn * 256 + bj * HALF + 32 * wc + 8 * fq; const f32x4 a = acc[ai][bj][2 + mm][0], b = acc[ai][bj][2 + mm][1];
                        u32x4 w; w.x = cvt_pk_bf16(a[0], a[1]); w.y = cvt_pk_bf16(a[2], a[3]); w.z = cvt_pk_bf16(b[0], b[1]); w.w = cvt_pk_bf16(b[2], b[3]); *(u32x4*)p = w; }
        }
#pragma unroll
        for (int ai = 0; ai < 2; ++ai) {
            unsigned pk[4][4];
#pragma unroll
            for (int n = 0; n < 2; ++n) {
                const PG8_LAS float* wl = scr + 2048 + 32 * wc + 8 * fq + 4 * n;
                const f32x4 wg0 = *(const PG8_LAS f32x4*)wl, wg1 = *(const PG8_LAS f32x4*)(wl + 256), wg2 = *(const PG8_LAS f32x4*)(wl + 512), bg = *(const PG8_LAS f32x4*)(wl + 768);
                const f32x4 wv0 = *(const PG8_LAS f32x4*)(wl + 128), wv1 = *(const PG8_LAS f32x4*)(wl + 384), wv2 = *(const PG8_LAS f32x4*)(wl + 640), bv = *(const PG8_LAS f32x4*)(wl + 896);
                f32x4 ug[6], uv[6];
#pragma unroll
                for (int j = 0; j < 4; ++j) { ug[0][j] = dpp_shr1(acc[ai][0][2][n][j]); ug[1][j] = dpp_shr1(acc[ai][0][3][n][j]); uv[0][j] = dpp_shr1(acc[ai][1][2][n][j]); uv[1][j] = dpp_shr1(acc[ai][1][3][n][j]); }
#pragma unroll
                for (int m = 0; m < 4; ++m) { ug[2 + m] = acc[ai][0][m][n]; uv[2 + m] = acc[ai][1][m][n]; }
#pragma unroll
                for (int m = 0; m < 4; ++m) {
                    const f32x4 yg = bg + wg0 * ug[m] + wg1 * ug[m + 1] + wg2 * ug[m + 2];
                    const f32x4 yv = bv + wv0 * uv[m] + wv1 * uv[m + 1] + wv2 * uv[m + 2];
                    const f32x4 t = yg * -1.4426950408889634f;
                    f32x4 sg; sg[0] = __builtin_amdgcn_rcpf(1.0f + __builtin_amdgcn_exp2f(t[0])); sg[1] = __builtin_amdgcn_rcpf(1.0f + __builtin_amdgcn_exp2f(t[1])); sg[2] = __builtin_amdgcn_rcpf(1.0f + __builtin_amdgcn_exp2f(t[2])); sg[3] = __builtin_amdgcn_rcpf(1.0f + __builtin_amdgcn_exp2f(t[3]));
                    const f32x4 res = (yg * yv) * sg;
                    pk[m][2 * n] = cvt_pk_bf16(res[0], res[1]); pk[m][2 * n + 1] = cvt_pk_bf16(res[2], res[3]);
                }
            }
#pragma unroll
            for (int m = 0; m < 4; ++m) {
                if ((m < 2 && fr == 0) || (light == 2 && pk[m][0] != 0x12345678u)) continue;
                const int grow = u.pm * BM + ai * HALF + wr * 64 + 4 * fr + m;
                u32x4 w; w.x = pk[m][0]; w.y = pk[m][1]; w.z = pk[m][2]; w.w = pk[m][3];
                *(u32x4*)(ACT + (size_t)grow * 5632 + j0) = w;
            }
        }
    }
};

struct Epi5 {
    static constexpr bool PERM = true, AFTER_DRAIN = false, APERM = false;
    __device__ __forceinline__ void pre(const Unit&, int, int) const {}
    float* out; const bf16_t* X1;
    __device__ __forceinline__ void operator()(const f32x4 (&acc)[2][2][4][2], const Unit& u, int wr, int wc, int fr, int fq) const {
        const int col0 = u.pn * BM + 32 * wc + 8 * fq;
#pragma unroll
        for (int ai = 0; ai < 2; ++ai)
#pragma unroll
            for (int m = 0; m < 4; ++m) {
                const size_t off = (size_t)(u.pm * BM + ai * HALF + wr * 64 + m * 16 + fr) * 2048 + col0;
#pragma unroll
                for (int bj = 0; bj < 2; ++bj) {
                    const u32x4 w = __builtin_nontemporal_load((const u32x4*)(X1 + off + bj * HALF));
                    const f32x4 r0 = {__builtin_bit_cast(float, w.x << 16), __builtin_bit_cast(float, w.x & 0xffff0000u), __builtin_bit_cast(float, w.y << 16), __builtin_bit_cast(float, w.y & 0xffff0000u)};
                    const f32x4 r1 = {__builtin_bit_cast(float, w.z << 16), __builtin_bit_cast(float, w.z & 0xffff0000u), __builtin_bit_cast(float, w.w << 16), __builtin_bit_cast(float, w.w & 0xffff0000u)};
                    __builtin_nontemporal_store(acc[ai][bj][m][0] + r0, (f32x4*)(out + off + bj * HALF)); __builtin_nontemporal_store(acc[ai][bj][m][1] + r1, (f32x4*)(out + off + bj * HALF + 4));
                }
            }
    }
};
template <class Epi, class Sched, bool ALIGN_EPI = false, bool SP2 = false>
__device__ __forceinline__ void gemm_phase(PG8_LAS unsigned char* lds, const Gemm g, const Sched& S, const Epi& E) {
    const int tid = threadIdx.x, wid = __builtin_amdgcn_readfirstlane(tid >> 6), lane = tid & 63, wr = wid >> 2, wc = wid & 3, fr = lane & 15, fq = lane >> 4;
    const int K = g.K, nt = K / BK;
    unsigned voffA[2], voffB[2];
#pragma unroll
    for (int i = 0; i < 2; ++i) { int R, C; stage_rc(tid * 16 + i * 8192, R, C); const int Rb = Epi::PERM ? ((R & ~31) + perm32(R & 31)) : R;
        const int Ra = Epi::APERM ? ((R & ~63) + 4 * (R & 15) + ((R >> 4) & 3)) : R;
        voffA[i] = (unsigned)(Ra * K + C) * 2u; voffB[i] = (unsigned)(Rb * K + C) * 2u; }
    const size_t kstep = (size_t)(BK * 2);
    const size_t hstep = (size_t)HALF * K * 2;
    const size_t tstep = 2 * hstep;
    const unsigned ldsw = (unsigned)wid * 1024u;
    const int aoff = lds_byte(wr * 64 + fr, fq * 8), boff = lds_byte(wc * 32 + fr, fq * 8);
#define PG8_SA(b, h) (((b) * 2 + (h)) * HTB)
#define PG8_SB(b, h) ((4 + (b) * 2 + (h)) * HTB)
#define PG8_STAGE(bufoff, gbase, voff) do { _Pragma("unroll") for (int _i = 0; _i < 2; ++_i) \
        __builtin_amdgcn_global_load_lds((const unsigned*)((const char*)(gbase) + (voff)[_i]), (PG8_LAS unsigned*)(lds + (bufoff) + ldsw + _i * 8192), 16, 0, 0); } while (0)
#define PG8_LDA(dst, b, h) do { _Pragma("unroll") for (int m = 0; m < 4; ++m) _Pragma("unroll") for (int k = 0; k < 2; ++k) dst[m][k] = *(const PG8_LAS bf16x8*)(lds + PG8_SA(b, h) + aoff + m * 2048 + k * 1024); } while (0)
#define PG8_LDB(dst, b, h) do { _Pragma("unroll") for (int n = 0; n < 2; ++n) _Pragma("unroll") for (int k = 0; k < 2; ++k) dst[n][k] = *(const PG8_LAS bf16x8*)(lds + PG8_SB(b, h) + boff + n * 2048 + k * 1024); } while (0)
#define PG8_MMA(ai, bj, At, Bt) do { __builtin_amdgcn_s_setprio(1); _Pragma("unroll") for (int m = 0; m < 4; ++m) _Pragma("unroll") for (int n = 0; n < 2; ++n) _Pragma("unroll") for (int k = 0; k < 2; ++k) \
        acc[ai][bj][m][n] = __builtin_amdgcn_mfma_f32_16x16x32_bf16(Bt[n][k], At[m][k], acc[ai][bj][m][n], 0, 0, 0); __builtin_amdgcn_s_setprio(0); } while (0)
#define PG8_WAIT_V(n) asm volatile("s_waitcnt vmcnt(" #n ")" ::: "memory")
#define PG8_WAIT_L(n) asm volatile("s_waitcnt lgkmcnt(" #n ")" ::: "memory")
#define PG8_BAR __builtin_amdgcn_s_barrier()
#define PG8_SCHED __builtin_amdgcn_sched_barrier(0)
    Unit cur, nxt; int ui = 0;
    if (!S.next(0, cur)) return;
    f32x4 acc[2][2][4][2];
#pragma unroll
    for (int a = 0; a < 2; ++a)
#pragma unroll
        for (int b = 0; b < 2; ++b)
#pragma unroll
            for (int m = 0; m < 4; ++m)
#pragma unroll
                for (int n = 0; n < 2; ++n) acc[a][b][m][n] = (f32x4){0.f, 0.f, 0.f, 0.f};
    bf16x8 At[4][2], B0[2][2], B1[2][2];
    const char* cA = (const char*)g.A + (size_t)cur.pm * tstep; const char* cB = (const char*)g.Bt + (size_t)cur.pn * tstep;
    S.a_ready(cur);
    if constexpr (SP2) {
        PG8_STAGE(PG8_SB(0, 0), cB, voffB); PG8_STAGE(PG8_SB(0, 1), cB + hstep, voffB); PG8_STAGE(PG8_SA(0, 0), cA, voffA); PG8_STAGE(PG8_SA(0, 1), cA + hstep, voffA);
        if (wr == 1) PG8_BAR;
        PG8_WAIT_V(2); PG8_BAR;
        PG8_STAGE(PG8_SB(1, 0), cB + kstep, voffB); PG8_STAGE(PG8_SA(1, 0), cA + kstep, voffA); PG8_STAGE(PG8_SB(1, 1), cB + hstep + kstep, voffB);
        PG8_WAIT_V(6); PG8_BAR;
    } else {
        PG8_STAGE(PG8_SB(0, 0), cB, voffB); PG8_STAGE(PG8_SA(0, 0), cA, voffA); PG8_STAGE(PG8_SB(0, 1), cB + hstep, voffB); PG8_STAGE(PG8_SA(0, 1), cA + hstep, voffA);
        if (wr == 1) PG8_BAR;
        PG8_WAIT_V(4); PG8_BAR;
        PG8_STAGE(PG8_SB(1, 0), cB + kstep, voffB); PG8_STAGE(PG8_SA(1, 0), cA + kstep, voffA); PG8_STAGE(PG8_SB(1, 1), cB + hstep + kstep, voffB);
        PG8_WAIT_V(6); PG8_BAR;
    }
    for (;;) {
        const bool has_next = S.next(ui + 1, nxt);
        const char* nA = has_next ? (const char*)g.A + (size_t)nxt.pm * tstep : cA; const char* nB = has_next ? (const char*)g.Bt + (size_t)nxt.pn * tstep : cB;
        for (int t = 0; t < nt; t += 2) {
            const bool last = (t == nt - 2);
            const char* a1 = cA + (size_t)(t + 1) * kstep;
            const char* a2 = last ? nA : cA + (size_t)(t + 2) * kstep; const char* b2 = last ? nB : cB + (size_t)(t + 2) * kstep;
            const char* a3 = a2 + kstep; const char* b3 = b2 + kstep;
            if (last && has_next) S.a_ready(nxt);
            if (last) E.pre(cur, wid, lane);
            if constexpr (SP2) {
            PG8_LDB(B0, 0, 0); PG8_LDB(B1, 0, 1); PG8_SCHED; PG8_LDA(At, 0, 0); PG8_STAGE(PG8_SA(1, 1), a1 + hstep, voffA);
            PG8_WAIT_V(8); PG8_WAIT_L(0); PG8_BAR; PG8_MMA(0, 0, At, B0); PG8_MMA(0, 1, At, B1); PG8_BAR; PG8_SCHED;
            PG8_LDA(At, 0, 1); PG8_STAGE(PG8_SB(0, 0), b2, voffB); PG8_STAGE(PG8_SB(0, 1), b2 + hstep, voffB); PG8_STAGE(PG8_SA(0, 0), a2, voffA);
            PG8_WAIT_V(8); PG8_WAIT_L(0); PG8_BAR; PG8_MMA(1, 0, At, B0); PG8_MMA(1, 1, At, B1); PG8_BAR; PG8_SCHED;
            PG8_LDB(B0, 1, 0); PG8_LDB(B1, 1, 1); PG8_SCHED; PG8_LDA(At, 1, 0); PG8_STAGE(PG8_SA(0, 1), a2 + hstep, voffA);
            PG8_WAIT_V(8); PG8_WAIT_L(0); PG8_BAR; PG8_MMA(0, 0, At, B0); PG8_MMA(0, 1, At, B1); PG8_BAR; PG8_SCHED;
            PG8_LDA(At, 1, 1); PG8_STAGE(PG8_SB(1, 0), b3, voffB); PG8_STAGE(PG8_SB(1, 1), b3 + hstep, voffB); PG8_STAGE(PG8_SA(1, 0), a3, voffA);
            PG8_WAIT_V(8); PG8_WAIT_L(0); PG8_BAR; PG8_MMA(1, 0, At, B0); PG8_MMA(1, 1, At, B1); PG8_BAR; PG8_SCHED;
            } else {
            PG8_LDB(B0, 0, 0); PG8_SCHED; PG8_LDA(At, 0, 0); PG8_STAGE(PG8_SA(1, 1), a1 + hstep, voffA);
            PG8_WAIT_L(8); PG8_BAR; PG8_WAIT_L(0); PG8_MMA(0, 0, At, B0); PG8_BAR; PG8_SCHED;
            PG8_LDB(B1, 0, 1); PG8_STAGE(PG8_SB(0, 0), b2, voffB);
            PG8_BAR; PG8_WAIT_L(0); PG8_MMA(0, 1, At, B1); PG8_BAR;
            PG8_LDA(At, 0, 1); PG8_STAGE(PG8_SA(0, 0), a2, voffA);
            PG8_BAR; PG8_WAIT_L(0); PG8_MMA(1, 0, At, B0); PG8_BAR; PG8_SCHED;
            PG8_STAGE(PG8_SB(0, 1), b2 + hstep, voffB);
            PG8_WAIT_V(6); PG8_BAR; PG8_MMA(1, 1, At, B1); PG8_BAR;
            PG8_LDB(B0, 1, 0); PG8_SCHED; PG8_LDA(At, 1, 0); PG8_STAGE(PG8_SA(0, 1), a2 + hstep, voffA);
            PG8_WAIT_L(8); PG8_BAR; PG8_WAIT_L(0); PG8_MMA(0, 0, At, B0); PG8_BAR; PG8_SCHED;
            PG8_LDB(B1, 1, 1); PG8_STAGE(PG8_SB(1, 0), b3, voffB);
            PG8_BAR; PG8_WAIT_L(0); PG8_MMA(0, 1, At, B1); PG8_BAR;
            PG8_LDA(At, 1, 1); PG8_STAGE(PG8_SA(1, 0), a3, voffA);
            PG8_BAR; PG8_WAIT_L(0); PG8_MMA(1, 0, At, B0); PG8_BAR; PG8_SCHED;
            PG8_STAGE(PG8_SB(1, 1), b3 + hstep, voffB);
            PG8_WAIT_V(6); PG8_BAR; PG8_MMA(1, 1, At, B1); PG8_BAR;
            }
        }
        if constexpr (ALIGN_EPI) { if (wr == 0) PG8_BAR; }
        if constexpr (!Epi::AFTER_DRAIN) { E(acc, cur, wr, wc, fr, fq); S.done(cur); }
        if (!has_next) break;
#pragma unroll
        for (int a = 0; a < 2; ++a)
#pragma unroll
            for (int b = 0; b < 2; ++b)
#pragma unroll
                for (int m = 0; m < 4; ++m)
#pragma unroll
                    for (int n = 0; n < 2; ++n) acc[a][b][m][n] = (f32x4){0.f, 0.f, 0.f, 0.f};
        cur = nxt; cA = nA; cB = nB; ++ui;
        if constexpr (ALIGN_EPI) { if (wr == 1) PG8_BAR; }
    }
    PG8_WAIT_V(0);
    if constexpr (!ALIGN_EPI) { if (wr == 0) PG8_BAR; }
    PG8_BAR;
    if constexpr (Epi::AFTER_DRAIN) { E.fused(acc, cur, wr, wc, fr, fq, lds, wid, lane); S.done(cur); }
#undef PG8_SA
#undef PG8_SB
#undef PG8_STAGE
#undef PG8_LDA
#undef PG8_LDB
#undef PG8_MMA
#undef PG8_WAIT_V
#undef PG8_WAIT_L
#undef PG8_BAR
#undef PG8_SCHED
}
}
#define GAS __attribute__((address_space(1)))
#define LAS __attribute__((address_space(3)))
typedef unsigned short bf16;
typedef unsigned v4u __attribute__((ext_vector_type(4)));
typedef float f32x4 __attribute__((ext_vector_type(4)));
typedef short bf16x8 __attribute__((ext_vector_type(8)));
typedef GAS unsigned gu32;
typedef GAS unsigned long long gu64;
#define RLX_AGENT __ATOMIC_RELAXED, __HIP_MEMORY_SCOPE_AGENT
#define LDS_WAIT() asm volatile("s_waitcnt lgkmcnt(0)" ::: "memory")
#define VM_WAIT() asm volatile("s_waitcnt vmcnt(0)" ::: "memory")
__device__ __forceinline__ unsigned long long rt() { return __builtin_amdgcn_s_memrealtime(); }
__device__ __forceinline__ unsigned f2bf(float f) { unsigned u = __builtin_bit_cast(unsigned, f); return (u + 0x7fffu + ((u >> 16) & 1u)) >> 16; }
__device__ __forceinline__ unsigned pk2(float lo, float hi) { return f2bf(lo) | (f2bf(hi) << 16); }

#define XB_TMO      128
#define XB_XCNT(j)  (256  + 64 * (j))
#define XB_XSUB(j)  (1280 + 64 * (j))
#define XB_XGEN(j)  (2304 + 64 * (j))
#define XB_TOP      3328
#define XB_TOPGEN   3392
#define XCD_BAR_WORDS 3456
#define XB_SPIN_CAP (1u << 18)

__device__ __forceinline__ unsigned xb_ld(unsigned* p)              { return __hip_atomic_load(p, __ATOMIC_RELAXED, __HIP_MEMORY_SCOPE_AGENT); }
__device__ __forceinline__ unsigned xb_add(unsigned* p, unsigned v) { return __hip_atomic_fetch_add(p, v, __ATOMIC_RELAXED, __HIP_MEMORY_SCOPE_AGENT); }
__device__ __forceinline__ unsigned xb_xcc_id() { return (unsigned)__builtin_amdgcn_s_getreg((3 << 11) | 20) & 0xFu; }
#define XB_SPIN(cond, bar) do { unsigned _sp = 0; while (cond) { __builtin_amdgcn_s_sleep(1); \
    if ((++_sp & 255u) == 0u) { if (xb_ld(&(bar)[XB_TMO])) break; if (_sp > XB_SPIN_CAP) { atomicAdd(&(bar)[XB_TMO], 1u); break; } } } } while (0)

struct XcdBarrier {
    unsigned* bar; unsigned x;
    volatile LAS unsigned* st;
};

__device__ __forceinline__ XcdBarrier xcd_barrier_post(unsigned* bar, volatile LAS unsigned* st) {
    XcdBarrier b; b.bar = bar; b.x = xb_xcc_id(); b.st = st;
    if (threadIdx.x == 0) (void)xb_add(&bar[XB_XCNT(b.x)], 1u);
    return b;
}
__device__ __forceinline__ void xcd_barrier_complete(unsigned* bar, unsigned x, unsigned& nloc, unsigned& nx) {
    const unsigned G = gridDim.x * gridDim.y * gridDim.z;
    unsigned sum, cnt, mine, sp = 0u;
    for (;;) {
        sum = 0u; cnt = 0u; mine = 0u;
#pragma unroll
        for (unsigned j = 0; j < 16; ++j) { const unsigned c = xb_ld(&bar[XB_XCNT(j)]); sum += c; cnt += (c > 0u) ? 1u : 0u; mine = (j == x) ? c : mine; }
        if (sum == G) break;
        __builtin_amdgcn_s_sleep(1);
        if ((++sp & 255u) == 0u) { if (xb_ld(&bar[XB_TMO])) break; if (sp > XB_SPIN_CAP) { atomicAdd(&bar[XB_TMO], 1u); break; } }
    }
    nloc = mine > 0u ? mine : 1u; nx = cnt > 0u ? cnt : 1u;
}

__device__ __forceinline__ void xcd_barrier(const XcdBarrier& b) {
    asm volatile("s_waitcnt vmcnt(0)" ::: "memory");
    __syncthreads();
    if (threadIdx.x == 0) {
        unsigned* bar = b.bar;
        __builtin_amdgcn_s_waitcnt(0);
        unsigned nloc = b.st[0], nx = b.st[1];
        if (nloc == 0u) { xcd_barrier_complete(bar, b.x, nloc, nx); b.st[0] = nloc; b.st[1] = nx; }
        const unsigned old = xb_add(&bar[XB_XSUB(b.x)], 1u);
        const unsigned gen = old / nloc;
        if (old + 1u == (gen + 1u) * nloc) {
            __builtin_amdgcn_fence(__ATOMIC_RELEASE, "agent");
            asm volatile("s_waitcnt vmcnt(0)" ::: "memory");
            const unsigned og = xb_add(&bar[XB_TOP], 1u);
            const unsigned tg = og / nx;
            if (og + 1u == (tg + 1u) * nx) xb_add(&bar[XB_TOPGEN], 1u);
            else XB_SPIN(xb_ld(&bar[XB_TOPGEN]) == tg, bar);
            __builtin_amdgcn_fence(__ATOMIC_ACQUIRE, "agent");
            xb_add(&bar[XB_XGEN(b.x)], 1u);
            asm volatile("s_waitcnt vmcnt(0)" ::: "memory");
        } else {
            XB_SPIN(xb_ld(&bar[XB_XGEN(b.x)]) == gen, bar);
            __builtin_amdgcn_fence(__ATOMIC_ACQUIRE, "agent");
            asm volatile("s_waitcnt vmcnt(0)" ::: "memory");
        }
    }
    __syncthreads();
}

constexpr int NWAVES = 8;
constexpr int BATCH = 8, SEQ = 2048, DM = 2048, M = BATCH * SEQ;
constexpr int NAH = 12, NMH = 4, ATTN_W = 1536, IN_W = 6664, IN_WP = 6912, DFF = 5632, UPW = 11264;
#ifndef MK_N_LAUNCHES
#define MK_N_LAUNCHES 1
#endif
#ifndef WGM_IN
#define WGM_IN 8
#endif
#ifndef WGM_OUT
#define WGM_OUT 4
#endif
#ifndef WGM_UP
#define WGM_UP 8
#endif
#ifndef WGM_DOWN
#define WGM_DOWN 4
#endif
constexpr int N_LAUNCHES = MK_N_LAUNCHES;
enum { PH_PRO = 0, PH_IN = 1, PH_PRE = 2, PH_MIX = 3, PH_OUT = 4, PH_UP = 5, PH_FIX = 6, PH_DOWN = 7 };
constexpr int PER_PHASE = 8;

constexpr size_t MiB = 1u << 20;
constexpr size_t WS_CTL = 0, CTL_ZERO_BYTES = 128 * 1024;
constexpr size_t WS_ROPE = 1 * MiB, WS_G = 2 * MiB, WS_SS = 2 * MiB + 512 * 1024, WS_IR = 3 * MiB;
constexpr size_t WS_WIN = 4 * MiB, WS_WOUT = 31 * MiB, WS_WUP = 39 * MiB, WS_WDN = 83 * MiB;
constexpr size_t WS_XN = 105 * MiB;
constexpr size_t WS_QB = 169 * MiB, WS_KB = 217 * MiB, WS_VB = 265 * MiB, WS_ML = 313 * MiB;
constexpr size_t WS_MIX = 377 * MiB;
constexpr size_t WS_RAW = 377 * MiB;
constexpr size_t WS_ACT = 169 * MiB;
constexpr size_t WS_MLC = 441 * MiB;
constexpr size_t WS_GA = 473 * MiB;
constexpr size_t WS_X1 = 441 * MiB;
constexpr size_t WS_END = 505 * MiB;
static_assert(WS_WIN + (size_t)IN_WP * DM * 2 <= WS_WOUT && WS_WOUT + (size_t)DM * DM * 2 <= WS_WUP && WS_WUP + (size_t)UPW * DM * 2 <= WS_WDN && WS_WDN + (size_t)DM * DFF * 2 <= WS_XN, "weights map");
static_assert(WS_XN + (size_t)M * DM * 2 <= WS_QB && WS_ML + (size_t)M * 2048 * 2 <= WS_MIX && WS_MIX + (size_t)M * 2048 * 2 <= WS_MLC && WS_MLC + (size_t)M * 1024 * 2 <= WS_GA && WS_GA + (size_t)32 * 16 * 3 * 128 * 4 <= WS_END && WS_X1 + (size_t)M * DM * 2 <= WS_END && WS_RAW + (size_t)256 * 4 * UPW * 4 <= WS_MLC && WS_ACT + (size_t)M * DFF * 2 <= WS_MIX, "activation map");
constexpr int CW_TMO = 0, CW_BAR = 4096, CW_QUEUE = 16384;

constexpr int RING_OFF = 0, RING_BYTES = 131072;
constexpr int SCR_OFF = RING_BYTES, SCR_BYTES = 24576;
constexpr int LDSCTL_OFF = SCR_OFF + SCR_BYTES, MISC_OFF = LDSCTL_OFF + 320;
constexpr int LDS_BYTES = 156672;
static_assert(MISC_OFF + 128 <= LDS_BYTES, "LDS map");

#define DI __device__ __forceinline__
typedef float f32x16 __attribute__((ext_vector_type(16)));
typedef short s16x4 __attribute__((ext_vector_type(4)));
typedef unsigned u32x2 __attribute__((ext_vector_type(2)));
#define MFMA32(a, b, c) __builtin_amdgcn_mfma_f32_32x32x16_bf16((a), (b), (c), 0, 0, 0)
constexpr float LOG2E = 1.4426950408889634f;

struct Frame {
    LAS unsigned char* lds; volatile LAS unsigned* MISC; gu32* ctl;
    int tid, lane, wave, vcu, G;
    float* out; unsigned char* ws;
};

DI unsigned swz_b(unsigned row) { return ((row & 3u) << 2) | ((row >> 2) & 3u); }
DI unsigned off_b(unsigned row, unsigned ch) { return 256u * row + 16u * (ch ^ swz_b(row)); }
DI bf16x8 lds_b128(LAS unsigned char* p) { return *(const LAS bf16x8*)p; }
DI LAS unsigned char* lp(unsigned a) { return (LAS unsigned char*)(size_t)a; }
typedef short v4i16_t __attribute__((ext_vector_type(4)));
DI s16x4 lds_tr(LAS unsigned char* p) { return __builtin_bit_cast(s16x4, __builtin_amdgcn_ds_read_tr16_b64_v4i16((LAS v4i16_t*)p)); }
DI int crow(int reg, int hh) { return (reg & 3) + 8 * (reg >> 2) + 4 * hh; }
typedef unsigned u32x4 __attribute__((ext_vector_type(4)));
typedef float f32x2_t __attribute__((ext_vector_type(2)));
typedef __bf16 bf16x2_t __attribute__((ext_vector_type(2)));
DI unsigned cvtpk(float lo, float hi) { f32x2_t v = {lo, hi}; bf16x2_t b = __builtin_convertvector(v, bf16x2_t); return __builtin_bit_cast(unsigned, b); }
DI bf16x8 pack8(float a0, float a1, float a2, float a3, float a4, float a5, float a6, float a7) {
    u32x4 p; p.x = cvtpk(a0, a1); p.y = cvtpk(a2, a3); p.z = cvtpk(a4, a5); p.w = cvtpk(a6, a7); return __builtin_bit_cast(bf16x8, p);
}
DI float bf_lo(unsigned w) { return __builtin_bit_cast(float, w << 16); }
DI float bf_hi(unsigned w) { return __builtin_bit_cast(float, w & 0xffff0000u); }

DI float wave_sum(float v) {
#pragma unroll
    for (int o = 1; o < 64; o <<= 1) v += __shfl_xor(v, o);
    return v;
}
template <int MAT> DI int colmap(int n) {
    if (MAT == 0) return n < 2 * ATTN_W ? (n & ~127) + ((n & 127) >> 1) + 64 * (n & 1) : (n < IN_W ? n : -1);
    if (MAT == 2) return DFF * ((n >> 7) & 1) + 128 * (n >> 8) + (n & 127);
    return n;
}
template <int MAT, bool SCALE, bool VEC> DI void transpose_items(const float* W, const float* gk, int K, int N, bf16* WT, LAS float* scr, int it0, int step, int it_end, int nblk, int lane) {
    if (it0 >= it_end) return;
    float cur[32], nxt[32];
    auto issue = [&](float (&r)[32], int item) {
        const int kb = item / nblk, nb = item % nblk, k0 = 64 * kb, n0 = 32 * nb;
        if (VEC) { const int q = lane & 7, kr = lane >> 3; const int col = colmap<MAT>(n0 + 4 * q);
#pragma unroll
            for (int i = 0; i < 8; ++i) { const f32x4 v = __builtin_nontemporal_load((const GAS f32x4*)(W + (size_t)(k0 + 8 * i + kr) * N + col)); r[4 * i] = v[0]; r[4 * i + 1] = v[1]; r[4 * i + 2] = v[2]; r[4 * i + 3] = v[3]; } }
        else { const int col = colmap<MAT>(n0 + (lane & 31));
#pragma unroll
            for (int i = 0; i < 32; ++i) r[i] = col >= 0 ? __builtin_nontemporal_load((const GAS float*)(W + (size_t)(k0 + 2 * i + (lane >> 5)) * N + col)) : 0.f; }
    };
    issue(cur, it0);
    for (int item = it0; item < it_end; item += step) {
        const bool has_next = item + step < it_end;
        if (has_next) issue(nxt, item + step);
        const int kb = item / nblk, nb = item % nblk, k0 = 64 * kb, n0 = 32 * nb;
        if (VEC) { const int q = lane & 7, kr = lane >> 3;
#pragma unroll
            for (int i = 0; i < 8; ++i)
#pragma unroll
                for (int j = 0; j < 4; ++j) scr[(8 * i + kr) * 33 + 4 * q + j] = cur[4 * i + j]; }
        else {
#pragma unroll
            for (int i = 0; i < 32; ++i) scr[(2 * i + (lane >> 5)) * 33 + (lane & 31)] = cur[i]; }
        const int c = lane & 7;
        f32x4 g0 = {1.f, 1.f, 1.f, 1.f}, g1v = g0;
        if (SCALE) { g0 = *(const GAS f32x4*)(gk + k0 + 8 * c); g1v = *(const GAS f32x4*)(gk + k0 + 8 * c + 4); }
        LDS_WAIT(); asm volatile("" ::: "memory");
#pragma unroll
        for (int j = 0; j < 4; ++j) { const int n = (lane >> 3) + 8 * j; const LAS float* sp = scr + (8 * c) * 33 + n;
            v4u o; o.x = cvtpk(sp[0 * 33] * g0[0], sp[1 * 33] * g0[1]); o.y = cvtpk(sp[2 * 33] * g0[2], sp[3 * 33] * g0[3]); o.z = cvtpk(sp[4 * 33] * g1v[0], sp[5 * 33] * g1v[1]); o.w = cvtpk(sp[6 * 33] * g1v[2], sp[7 * 33] * g1v[3]);
            if (VEC) __builtin_nontemporal_store(o, (GAS v4u*)(WT + (size_t)(n0 + n) * K + k0 + 8 * c)); else *(GAS v4u*)(WT + (size_t)(n0 + n) * K + k0 + 8 * c) = o; }
        LDS_WAIT(); asm volatile("" ::: "memory");
        if (has_next) {
#pragma unroll
            for (int i = 0; i < 32; ++i) cur[i] = nxt[i]; }
    }
}
DI void p0_prologue(Frame& F, const float* x, const float* g1, const float* w_in) {
    LAS float* scr = (LAS float*)(F.lds + RING_OFF + F.wave * 16384);
    const int gw = F.vcu * NWAVES + F.wave, NGW = F.G * NWAVES;
    constexpr int NB0 = IN_WP / 32, I0 = (DM / 64) * NB0;
    bf16* Win = (bf16*)(F.ws + WS_WIN);
    transpose_items<0, true, false>(w_in, g1, DM, IN_W, Win, scr, gw, NGW, I0, NB0, F.lane);
    {
        bf16* XN = (bf16*)(F.ws + WS_XN);
        f32x4 v[8], vn[8];
#pragma unroll
        for (int j = 0; j < 8; ++j) v[j] = __builtin_nontemporal_load((const GAS f32x4*)(x + (size_t)gw * DM) + F.lane + 64 * j);
        for (int m = gw; m < M; m += NGW) {
            const bool has_next = m + NGW < M;
            if (has_next) {
#pragma unroll
                for (int j = 0; j < 8; ++j) vn[j] = __builtin_nontemporal_load((const GAS f32x4*)(x + (size_t)(m + NGW) * DM) + F.lane + 64 * j); }
            float s = 0.f;
#pragma unroll
            for (int j = 0; j < 8; ++j) s += (v[j].x * v[j].x + v[j].y * v[j].y) + (v[j].z * v[j].z + v[j].w * v[j].w);
            const float rms = sqrtf(wave_sum(s) * (1.f / DM) + 1e-6f), rstd = 1.f / rms;
            if (F.lane == 0) ((float*)(F.ws + WS_IR))[m] = rms;
            GAS unsigned long long* o8 = (GAS unsigned long long*)(XN + (size_t)m * DM) + F.lane;
#pragma unroll
            for (int j = 0; j < 8; ++j) o8[64 * j] = (unsigned long long)cvtpk(v[j].x * rstd, v[j].y * rstd) | ((unsigned long long)cvtpk(v[j].z * rstd, v[j].w * rstd) << 32);
            if (has_next) {
#pragma unroll
                for (int j = 0; j < 8; ++j) v[j] = vn[j]; }
        }
    }
    {
        float* rope = (float*)(F.ws + WS_ROPE);
        for (int idx = gw * 64 + F.lane; idx < SEQ * 64; idx += NGW * 64) {
            const int t = idx >> 6, i = idx & 63; const double ang = (double)t * pow(10000.0, -(double)i / 64.0);
            rope[2 * idx] = (float)cos(ang); rope[2 * idx + 1] = (float)sin(ang);
        }
    }
}

DI void att_dma_tile(const unsigned char* gbase, const unsigned (&voff)[8], LAS unsigned char* ldst) {
#pragma unroll
    for (int it = 0; it < 8; ++it) __builtin_amdgcn_global_load_lds((const unsigned*)(gbase + voff[it]), (LAS unsigned*)(ldst + it * 1024), 16, 0, 0);
}
constexpr int ATT_LUT_BYTES = 10 * 2048;
DI void att_build_lut(LAS unsigned char* lut, int tid) {
    for (int idx = tid; idx < 10 * 64 * 8; idx += NWAVES * 64) {
        const int type = idx >> 9, rem = idx & 511, ln = rem >> 3, pair = rem & 7, q = ln & 31, hh = ln >> 5;
        const int d0 = type < 6 ? 32 * type : 32 * (type & 1);
        unsigned w = 0;
#pragma unroll
        for (int k = 0; k < 2; ++k) {
            const int e = 2 * pair + k, d = d0 + q - 4 * hh - ((e & 3) + 8 * (e >> 2));
            int c;
            if (type < 6) c = (d >= 0 && d <= 128 ? 1 : 0) + (d >= 0 && (d & 3) == 0 ? 1 : 0) + (d >= 0 && d <= 32 ? 1 : 0);
            else if (type < 8) c = (d >= 0 && d <= 31) ? 1 : 0;
            else c = (d >= 1 && d <= 32) ? 1 : 0;
            const unsigned bits = c == 0 ? 0xFF80u : (c == 1 ? 0x0000u : (c == 2 ? 0x3F80u : 0x3FCBu));
            w |= bits << (16 * k);
        }
        *(LAS unsigned*)(lut + type * 2048 + (pair >> 2) * 1024 + ln * 16 + (pair & 3) * 4) = w;
    }
}
DI void attn_unit(int b, int h, int r, int ib, const bf16* QB, const bf16* KB, const bf16* VB, bf16* MIX, LAS unsigned char* wl, LAS unsigned char* lut, int lane) {
    const int q = lane & 31, hh = lane >> 5, i0 = 32 * ib;
    const size_t rowb = (size_t)b * 2048;
    bf16x8 qf[8];
    { const bf16* qp = QB + (rowb + r * 512 + i0 + q) * 1536 + h * 128 + 8 * hh;
#pragma unroll
      for (int ks = 0; ks < 8; ++ks) qf[ks] = *(const GAS bf16x8*)(qp + 16 * ks); }
#pragma unroll
    for (int ks = 0; ks < 8; ++ks) asm volatile("" : "+v"(qf[ks]));
    f32x16 o[4];
#pragma unroll
    for (int c = 0; c < 4; ++c)
#pragma unroll
        for (int e = 0; e < 16; ++e) o[c][e] = 0.f;
    float mrun = -1e30f, lsum = 0.f;
    LAS unsigned char* Kt = wl; LAS unsigned char* Vt = wl + 8192;
    const int nt = (ib + 1) + (ib ? 6 : 3);
    auto tile_of = [&](int k, int& rc, int& j0, int& ty) {
        if (k <= ib) { rc = r; j0 = 32 * k; ty = ib - k < 5 ? ib - k : 5; }
        else { const int kk = k - (ib + 1); int far; if (ib) { rc = (r + 1 + (kk >> 1)) & 3; far = 1 - (kk & 1); } else { rc = (r + 1 + kk) & 3; far = 0; } j0 = i0 - 32 * far; ty = (r > rc ? 6 : 8) + far; } };
    unsigned voff[8];
#pragma unroll
    for (int it = 0; it < 8; ++it) { const unsigned row = 4 * it + (lane >> 4); voff[it] = row * 3072u + (((unsigned)lane & 15u) ^ swz_b(row)) * 16u; }
    const unsigned qi = (lane & 15) >> 2, pp = lane & 3, g16 = (lane >> 4) & 1;
    const unsigned swl = 16u * swz_b((unsigned)q), rowb_l = 256u * (unsigned)q;
    unsigned rk[8];
#pragma unroll
    for (int ks = 0; ks < 8; ++ks) rk[ks] = rowb_l + ((unsigned)(32 * ks + 16 * hh) ^ swl);
    unsigned tp[2];
#pragma unroll
    for (int t = 0; t < 2; ++t) tp[t] = 2048u * t + 1024u * hh + 256u * qi + 8u * (pp & 1) + 16u * ((2u * g16 + (pp >> 1)) ^ ((2u * t + hh) & 3u));
    const unsigned char* kbase = (const unsigned char*)(KB + rowb * 1536 + h * 128); const unsigned char* vbase = (const unsigned char*)(VB + rowb * 1536 + h * 128);
    { int rc, j0, ty; tile_of(0, rc, j0, ty);
      att_dma_tile(kbase + (size_t)(rc * 512 + j0) * 3072, voff, Kt);
      att_dma_tile(vbase + (size_t)(rc * 512 + j0) * 3072, voff, Vt); }
    for (int k = 0; k < nt; ++k) {
        int rc, j0, ty; tile_of(k, rc, j0, ty);
        const bool has_next = k + 1 < nt; int rcn = 0, j0n = 0, tyn = 0; if (has_next) tile_of(k + 1, rcn, j0n, tyn);
        const u32x4 bw0 = *(const LAS u32x4*)(lut + ty * 2048 + lane * 16), bw1 = *(const LAS u32x4*)(lut + ty * 2048 + 1024 + lane * 16);
        asm volatile("s_waitcnt vmcnt(8)" ::: "memory");
        bf16x8 kf[8];
#pragma unroll
        for (int ks = 0; ks < 8; ++ks) kf[ks] = lds_b128(Kt + rk[ks]);
        asm volatile("s_waitcnt lgkmcnt(0)" ::: "memory");
        if (has_next) att_dma_tile(kbase + (size_t)(rcn * 512 + j0n) * 3072, voff, Kt);
        f32x16 s;
#pragma unroll
        for (int e = 0; e < 16; ++e) s[e] = 0.f;
#pragma unroll
        for (int ks = 0; ks < 8; ++ks) s = MFMA32(kf[ks], qf[ks], s);
        s[0] += bf_lo(bw0.x); s[1] += bf_hi(bw0.x); s[2] += bf_lo(bw0.y); s[3] += bf_hi(bw0.y); s[4] += bf_lo(bw0.z); s[5] += bf_hi(bw0.z); s[6] += bf_lo(bw0.w); s[7] += bf_hi(bw0.w);
        s[8] += bf_lo(bw1.x); s[9] += bf_hi(bw1.x); s[10] += bf_lo(bw1.y); s[11] += bf_hi(bw1.y); s[12] += bf_lo(bw1.z); s[13] += bf_hi(bw1.z); s[14] += bf_lo(bw1.w); s[15] += bf_hi(bw1.w);
        float mx = fmaxf(fmaxf(fmaxf(s[0], s[1]), fmaxf(s[2], s[3])), fmaxf(fmaxf(s[4], s[5]), fmaxf(s[6], s[7])));
        mx = fmaxf(mx, fmaxf(fmaxf(fmaxf(s[8], s[9]), fmaxf(s[10], s[11])), fmaxf(fmaxf(s[12], s[13]), fmaxf(s[14], s[15]))));
        mx = fmaxf(mx, __shfl_xor(mx, 32));
        const float mnew = fmaxf(mrun, mx), alpha = __builtin_amdgcn_exp2f(mrun - mnew);
        float ps = 0.f;
#pragma unroll
        for (int e = 0; e < 16; ++e) { s[e] = __builtin_amdgcn_exp2f(s[e] - mnew); ps += s[e]; }
        lsum = lsum * alpha + ps;
        if (__any(mnew > mrun)) {
#pragma unroll
            for (int c = 0; c < 4; ++c)
#pragma unroll
                for (int e = 0; e < 16; ++e) o[c][e] *= alpha;
        }
        mrun = mnew;
        const bf16x8 pf0 = pack8(s[0], s[1], s[2], s[3], s[4], s[5], s[6], s[7]), pf1 = pack8(s[8], s[9], s[10], s[11], s[12], s[13], s[14], s[15]);
        if (has_next) asm volatile("s_waitcnt vmcnt(8)" ::: "memory"); else asm volatile("s_waitcnt vmcnt(0)" ::: "memory");
        bf16x8 vf[4][2];
#pragma unroll
        for (int c = 0; c < 4; ++c)
#pragma unroll
            for (int s2 = 0; s2 < 2; ++s2) {
                const unsigned xc = 64u * ((unsigned)c ^ qi);
                const s16x4 lo = lds_tr(Vt + 4096 * s2 + tp[0] + xc);
                const s16x4 hi = lds_tr(Vt + 4096 * s2 + tp[1] + xc);
                vf[c][s2] = __builtin_shufflevector(lo, hi, 0, 1, 2, 3, 4, 5, 6, 7);
            }
        asm volatile("s_waitcnt lgkmcnt(0)" ::: "memory");
        if (has_next) att_dma_tile(vbase + (size_t)(rcn * 512 + j0n) * 3072, voff, Vt);
#pragma unroll
        for (int c = 0; c < 4; ++c) { o[c] = MFMA32(vf[c][0], pf0, o[c]); o[c] = MFMA32(vf[c][1], pf1, o[c]); }
    }
    lsum += __shfl_xor(lsum, 32);
    const float inv = 1.0f / lsum;
#pragma unroll
    for (int c = 0; c < 4; ++c)
#pragma unroll
        for (int g = 0; g < 4; ++g) {
            u32x2 w; w.x = cvtpk(o[c][4 * g] * inv, o[c][4 * g + 1] * inv); w.y = cvtpk(o[c][4 * g + 2] * inv, o[c][4 * g + 3] * inv);
            *(LAS u32x2*)(Kt + rowb_l + ((unsigned)(16 * (4 * c + g)) ^ swl) + 8u * hh) = w;
        }
    asm volatile("s_waitcnt lgkmcnt(0)" ::: "memory");
    {
        unsigned char* ob = (unsigned char*)(MIX + ((size_t)b * 2048 + 4 * i0 + r) * 2048 + h * 128);
#pragma unroll
        for (int it = 0; it < 8; ++it) {
            const unsigned row = 4 * it + (lane >> 4), ch = lane & 15;
            const u32x4 v = *(const LAS u32x4*)(Kt + off_b(row, ch));
            *(GAS u32x4*)(ob + (size_t)row * 16384 + ch * 16) = v;
        }
    }
    asm volatile("s_waitcnt lgkmcnt(0)" ::: "memory");
}
constexpr int CV_NB1 = DM / 32, CV_NB2 = UPW / 32, CV_NB3 = DM / 32, CV_I1 = (DM / 64) * CV_NB1, CV_I2 = (DM / 64) * CV_NB2, CV_I3 = (DFF / 64) * CV_NB3;
constexpr int CV_EARLY = 0;
DI void convert_range(Frame& F, LAS float* scr, const float* w_out, const float* w_up, const float* g2, const float* w_down, int lo, int hi, int cw0, int cwn) {
    bf16* Wout = (bf16*)(F.ws + WS_WOUT); bf16* Wup = (bf16*)(F.ws + WS_WUP); bf16* Wdn = (bf16*)(F.ws + WS_WDN);
    auto clampi = [](int v, int a, int b) { return v < a ? a : (v > b ? b : v); };
    { const int a = clampi(lo, 0, CV_I1), b = clampi(hi, 0, CV_I1); if (b > a) transpose_items<1, false, true>(w_out, nullptr, DM, DM, Wout, scr, a + cw0, cwn, b, CV_NB1, F.lane); }
    { const int a = clampi(lo - CV_I1, 0, CV_I2), b = clampi(hi - CV_I1, 0, CV_I2); if (b > a) transpose_items<2, true, true>(w_up, g2, DM, UPW, Wup, scr, a + cw0, cwn, b, CV_NB2, F.lane); }
    { const int a = clampi(lo - CV_I1 - CV_I2, 0, CV_I3), b = clampi(hi - CV_I1 - CV_I2, 0, CV_I3); if (b > a) transpose_items<3, false, true>(w_down, nullptr, DFF, DM, Wdn, scr, a + cw0, cwn, b, CV_NB3, F.lane); }
}
constexpr int ML_SPLIT = 11;
constexpr int ML_WGS = 2 * BATCH * NMH;
DI void attn_phase(Frame& F, int qword0, const float* w_out, const float* w_up, const float* g2, const float* w_down, bool skip_conv) {
    const bf16* QB = (const bf16*)(F.ws + WS_QB); const bf16* KB = (const bf16*)(F.ws + WS_KB); const bf16* VB = (const bf16*)(F.ws + WS_VB); bf16* MIX = (bf16*)(F.ws + WS_MIX);
    LAS unsigned char* wl = F.lds + RING_OFF + F.wave * 16384; LAS unsigned char* lut = F.lds + SCR_OFF;
    att_build_lut(lut, F.tid);
    __syncthreads();
    constexpr int NCW = 3;
    if (F.wave >= NWAVES - NCW && !skip_conv)
        convert_range(F, (LAS float*)wl, w_out, w_up, g2, w_down, F.G == 256 ? CV_EARLY : 0, CV_I1 + CV_I2 + CV_I3, ((int)blockIdx.x - ML_WGS) * NCW + (F.wave - (NWAVES - NCW)), (F.G - ML_WGS) * NCW);
    int qsel = (int)(xb_xcc_id() & 7u);
    for (int tries = 0; tries < 8;) {
        unsigned u = 0; if (F.lane == 0) u = xb_add((unsigned*)(F.ctl + qword0 + 64 * qsel), 1u);
        u = (unsigned)__builtin_amdgcn_readfirstlane((int)u);
        if (u >= 768u) { qsel = (qsel + 1) & 7; ++tries; continue; }
        const int pair = u >> 4, ib = 15 - (u & 15), bh = qsel * 12 + (pair >> 2), r = pair & 3;
        attn_unit(bh / 12, bh % 12, r, ib, QB, KB, VB, MIX, wl, lut, F.lane);
    }
}

DI float scan_add64(float v, int lane) {
#pragma unroll
    for (int d = 1; d < 64; d <<= 1) { const float t = __shfl_up(v, d); if (lane >= d) v += t; }
    return v;
}
DI float scan_max64(float v, int lane) {
#pragma unroll
    for (int d = 1; d < 64; d <<= 1) { const float t = __shfl_up(v, d); if (lane >= d) v = fmaxf(v, t); }
    return v;
}
DI float silu_f(float y) { return y * __builtin_amdgcn_rcpf(1.0f + __builtin_amdgcn_exp2f(-LOG2E * y)); }
DI void mixer_prepass(Frame& F, const float* mcw, const float* mcb) {
    const bf16* ML = (const bf16*)(F.ws + WS_ML); bf16* MLC = (bf16*)(F.ws + WS_MLC); const float* G = (const float*)(F.ws + WS_G); float* GA = (float*)(F.ws + WS_GA);
    const int gw = F.vcu * NWAVES + F.wave, NGW = F.G * NWAVES;
    for (int it = gw; it < 32 * 16; it += NGW) {
        const int seq = it >> 4, ch = it & 15, b = seq >> 2, hm = seq & 3; const size_t mrow0 = (size_t)b * 2048 + ch * 128;
        const float gi0 = G[(mrow0 + F.lane) * 8 + hm], gf0 = G[(mrow0 + F.lane) * 8 + 4 + hm], gi1 = G[(mrow0 + 64 + F.lane) * 8 + hm], gf1 = G[(mrow0 + 64 + F.lane) * 8 + 4 + hm];
        const float lf0 = fminf(gf0, 0.f) - log1pf(expf(-fabsf(gf0))), lf1 = fminf(gf1, 0.f) - log1pf(expf(-fabsf(gf1)));
        const float b0 = scan_add64(lf0, F.lane); const float tot0 = __shfl(b0, 63); const float b1 = scan_add64(lf1, F.lane) + tot0;
        const float a0 = gi0 - b0, a1 = gi1 - b1;
        const float cm0 = scan_max64(a0, F.lane); const float M0 = __shfl(cm0, 63); const float cm1 = fmaxf(scan_max64(a1, F.lane), M0);
        float* o = GA + (size_t)it * 384;
        o[F.lane] = b0; o[64 + F.lane] = b1; o[128 + F.lane] = a0; o[192 + F.lane] = a1; o[256 + F.lane] = cm0; o[320 + F.lane] = cm1;
    }
    for (int it = gw * 64 + F.lane; it < (M / 4) * 128; it += NGW * 64) {
        const int c8 = it & 127, r4 = it >> 7, m0 = 4 * r4, t0 = m0 & 2047, ch0 = 8 * c8;
        u32x4 raw[7];
#pragma unroll
        for (int i = 0; i < 7; ++i) { u32x4 rv = *(const GAS u32x4*)(ML + (size_t)(m0 - 3 + i) * 2048 + ch0); if (t0 - 3 + i < 0) rv = (u32x4){0u, 0u, 0u, 0u}; raw[i] = rv; }
        float wt[5][8];
#pragma unroll
        for (int tap = 0; tap < 5; ++tap) { const float* wp = tap < 4 ? mcw + tap * 1024 + ch0 : mcb + ch0; const f32x4 a = *(const f32x4*)wp, bq = *(const f32x4*)(wp + 4);
            wt[tap][0] = a[0]; wt[tap][1] = a[1]; wt[tap][2] = a[2]; wt[tap][3] = a[3]; wt[tap][4] = bq[0]; wt[tap][5] = bq[1]; wt[tap][6] = bq[2]; wt[tap][7] = bq[3]; }
        const float osc = ch0 >= 512 ? 0.08838834764831845f : 1.0f;
#pragma unroll
        for (int rho = 0; rho < 4; ++rho) {
            float y[8];
#pragma unroll
            for (int j = 0; j < 8; ++j) y[j] = wt[4][j];
#pragma unroll
            for (int tap = 0; tap < 4; ++tap) { const u32x4 x = raw[rho + tap];
                y[0] += wt[tap][0] * bf_lo(x.x); y[1] += wt[tap][1] * bf_hi(x.x); y[2] += wt[tap][2] * bf_lo(x.y); y[3] += wt[tap][3] * bf_hi(x.y);
                y[4] += wt[tap][4] * bf_lo(x.z); y[5] += wt[tap][5] * bf_hi(x.z); y[6] += wt[tap][6] * bf_lo(x.w); y[7] += wt[tap][7] * bf_hi(x.w); }
#pragma unroll
            for (int j = 0; j < 8; ++j) y[j] = silu_f(y[j]) * osc;
            *(GAS bf16x8*)(MLC + (size_t)(m0 + rho) * 1024 + ch0) = pack8(y[0], y[1], y[2], y[3], y[4], y[5], y[6], y[7]);
        }
    }
}

constexpr int ML_Q = 0, ML_K = 32768, ML_V = 65536, ML_C = 98304;
constexpr int MS_A = 0, MS_U = 512, MS_WI = 1024, MS_WK = 1536, MS_EM = 2048, MS_NV = 2560, MS_GV = 3072, MS_CW = 3584, MS_NR = 8704, MS_RS = 12800, MS_SC = 13824;
DI void mlstm_seq(Frame& F, int b, int hm, const float* mng, int c0, int c1) {
    LAS unsigned char* L = F.lds + RING_OFF; LAS unsigned char* S = F.lds + SCR_OFF;
    LAS float* A_ = (LAS float*)(S + MS_A); LAS float* U_ = (LAS float*)(S + MS_U); LAS float* WI = (LAS float*)(S + MS_WI); LAS float* WK = (LAS float*)(S + MS_WK); LAS float* EM = (LAS float*)(S + MS_EM);
    LAS float* NV = (LAS float*)(S + MS_NV); LAS float* GV = (LAS float*)(S + MS_GV); LAS float* CW = (LAS float*)(S + MS_CW); LAS float* NR = (LAS float*)(S + MS_NR); LAS float* RS = (LAS float*)(S + MS_RS); LAS float* SC = (LAS float*)(S + MS_SC);
    const int w = F.wave;
    const bf16* ML = (const bf16*)(F.ws + WS_ML); const bf16* MLC = (const bf16*)(F.ws + WS_MLC); const float* GA = (const float*)(F.ws + WS_GA) + (size_t)(b * 4 + hm) * 16 * 384; bf16* MIX = (bf16*)(F.ws + WS_MIX);
    if (F.tid < 128) { GV[F.tid] = mng[hm * 128 + F.tid]; NV[F.tid] = 0.f; }
    for (int i = F.tid; i < 32768 / 16; i += 512) *(LAS u32x4*)(L + ML_C + 16 * i) = (u32x4){0u, 0u, 0u, 0u};
    f32x16 Cacc[2];
#pragma unroll
    for (int i = 0; i < 2; ++i)
#pragma unroll
        for (int e = 0; e < 16; ++e) Cacc[i][e] = 0.f;
    float mc = 0.f;
    const int tb = (w & 3) ^ (3 * (w >> 2)), eh = w >> 2;
    const int ebF = w >> 1, dbF0 = 2 * (w & 1);
#define ML_BAR() do { asm volatile("s_waitcnt lgkmcnt(0)" ::: "memory"); __builtin_amdgcn_s_barrier(); asm volatile("" ::: "memory"); } while (0)
#define ML_OPAQUE_TID(name) int name = F.tid; asm volatile("" : "+v"(name))
#define ML_THREAD_MAP(tidv) const int c16 = (tidv) & 15, rg = (tidv) >> 4; const unsigned rg16 = 16u * rg, c32 = 32u * c16; unsigned sa[4]; \
        _Pragma("unroll") for (int rho = 0; rho < 4; ++rho) sa[rho] = 1024u * rg + 256u * rho + 64u * (((unsigned)c16 >> 2) ^ (unsigned)rho) + 16u * (((unsigned)c16 & 3u) ^ ((unsigned)rg & 3u))
#define ML_LANE_MAP(tidv) const int lane = (tidv) & 63, hh = lane >> 5, l31 = lane & 31; const unsigned qi = (lane & 15) >> 2, pp = lane & 3, g16 = (lane >> 4) & 1; \
        const unsigned swl_ = 16u * swz_b((unsigned)l31), rowb_ = 256u * (unsigned)l31, hh8 = 8u * hh, hh16 = 16u * hh; unsigned tn[2], tp[2]; \
        _Pragma("unroll") for (int t = 0; t < 2; ++t) { tn[t] = 2048u * hh + 1024u * t + 256u * qi + 8u * (pp & 1) + 16u * ((2u * g16 + (pp >> 1)) ^ ((2u * hh + t) & 3u)); \
                                                       tp[t] = 2048u * t + 1024u * hh + 256u * qi + 8u * (pp & 1) + 16u * ((2u * g16 + (pp >> 1)) ^ ((2u * t + hh) & 3u)); }
#define SF(off) (*(LAS float*)(S + (off)))
#define SF4(off) (*(const LAS f32x4*)(S + (off)))
    u32x4 rq[4], rk_[4], rv4[4]; float pgt[6] = {0.f, 0.f, 0.f, 0.f, 0.f, 0.f};
    {
        const int c16 = F.tid & 15, rg = F.tid >> 4;
        const unsigned char* cq0 = (const unsigned char*)MLC + (size_t)b * 2048 * 2048 + 8192u * rg + 256u * hm + 16u * c16;
        const unsigned char* cv0 = (const unsigned char*)ML + (size_t)b * 2048 * 4096 + 16384u * rg + 2048 + 256u * hm + 16u * c16;
#pragma unroll
        for (int rho = 0; rho < 4; ++rho) { rk_[rho] = *(const GAS u32x4*)(cq0 + rho * 2048 + 1024); rv4[rho] = *(const GAS u32x4*)(cv0 + rho * 4096); }
        if (w == 0) {
#pragma unroll
            for (int i = 0; i < 6; ++i) pgt[i] = GA[64 * i + F.lane]; }
    }
    __syncthreads();
    for (int ch = 0; ch < c0; ++ch) {
        {
        ML_OPAQUE_TID(tidA); ML_THREAD_MAP(tidA);
#pragma unroll
        for (int rho = 0; rho < 4; ++rho) { *(LAS u32x4*)(lp(sa[rho]) + ML_K) = rk_[rho]; *(LAS u32x4*)lp(sa[rho] + ML_V) = rv4[rho]; }
        }
        if (w == 0) {
            ML_OPAQUE_TID(tidB); const int lane = tidB & 63; const unsigned l4 = 4u * lane;
            const float b1 = pgt[1], a0 = pgt[2], a1 = pgt[3], cm1 = pgt[5];
            const float Mall = __shfl(cm1, 63), blast = __shfl(b1, 63), mxa = fmaxf(mc, Mall);
            SF(MS_WK + l4) = __builtin_amdgcn_exp2f(LOG2E * (a0 - mxa)); SF(MS_WK + 256 + l4) = __builtin_amdgcn_exp2f(LOG2E * (a1 - mxa));
            if (lane == 0) SC[0] = __builtin_amdgcn_exp2f(LOG2E * (mc - mxa));
            mc = blast + mxa;
        }
        ML_BAR();
        {
            ML_OPAQUE_TID(tidP); const int c16 = tidP & 15, rg = tidP >> 4;
            int cn = ch + 1; asm volatile("" : "+s"(cn));
            const unsigned char* cq1 = (const unsigned char*)MLC + ((size_t)b * 2048 + cn * 128) * 2048 + 8192u * rg + 256u * hm + 16u * c16;
            const unsigned char* cv1 = (const unsigned char*)ML + ((size_t)b * 2048 + cn * 128) * 4096 + 16384u * rg + 2048 + 256u * hm + 16u * c16;
#pragma unroll
            for (int rho = 0; rho < 4; ++rho) { rk_[rho] = *(const GAS u32x4*)(cq1 + rho * 2048 + 1024); rv4[rho] = *(const GAS u32x4*)(cv1 + rho * 4096); }
            if (w == 0) { const float* ga1 = GA + cn * 384 + (tidP & 63);
#pragma unroll
                for (int i = 0; i < 6; ++i) pgt[i] = ga1[64 * i]; }
        }
        {
            ML_OPAQUE_TID(tidK); ML_THREAD_MAP(tidK); const int lane = tidK & 63;
            float ps[8] = {0.f, 0.f, 0.f, 0.f, 0.f, 0.f, 0.f, 0.f};
#pragma unroll
            for (int rho = 0; rho < 4; ++rho) {
                const float wk = SF(MS_WK + 4 * rho + rg16); const u32x4 kk = *(const LAS u32x4*)(lp(sa[rho]) + ML_K);
                const float v0 = bf_lo(kk.x) * wk, v1 = bf_hi(kk.x) * wk, v2 = bf_lo(kk.y) * wk, v3 = bf_hi(kk.y) * wk, v4 = bf_lo(kk.z) * wk, v5 = bf_hi(kk.z) * wk, v6 = bf_lo(kk.w) * wk, v7 = bf_hi(kk.w) * wk;
                ps[0] += v0; ps[1] += v1; ps[2] += v2; ps[3] += v3; ps[4] += v4; ps[5] += v5; ps[6] += v6; ps[7] += v7;
                *(LAS bf16x8*)(lp(sa[rho]) + ML_Q) = pack8(v0, v1, v2, v3, v4, v5, v6, v7);
            }
#pragma unroll
            for (int j = 0; j < 8; ++j) { ps[j] += __shfl_xor(ps[j], 16); ps[j] += __shfl_xor(ps[j], 32); }
            if ((lane >> 4) == 0) {
#pragma unroll
                for (int j = 0; j < 8; ++j) SF(MS_NR + 512 * w + 4 * j + c32) = ps[j];
            }
        }
        ML_BAR();
        {
        const float decay = SC[0];
        ML_OPAQUE_TID(tidF); const unsigned t4 = 4u * tidF;
        if (tidF < 128) { float a = 0.f;
#pragma unroll
            for (int ww = 0; ww < 8; ++ww) a += SF(MS_NR + 512 * ww + t4);
            SF(MS_NV + t4) = decay * SF(MS_NV + t4) + a; }
#pragma unroll
        for (int i = 0; i < 2; ++i)
#pragma unroll
            for (int e = 0; e < 16; ++e) Cacc[i][e] *= decay;
        ML_LANE_MAP(tidF);
        const unsigned xc_eF = 64u * ((unsigned)ebF ^ qi), xc_d0 = 64u * ((unsigned)dbF0 ^ qi), xc_d1 = 64u * ((unsigned)(dbF0 + 1) ^ qi);
        const unsigned aF0 = ML_V + tn[0] + xc_eF, aF1 = ML_V + tn[1] + xc_eF, aK00 = ML_Q + tn[0] + xc_d0, aK01 = ML_Q + tn[1] + xc_d0, aK10 = ML_Q + tn[0] + xc_d1, aK11 = ML_Q + tn[1] + xc_d1;
        bf16x8 af[8];
#pragma unroll
        for (int ks = 0; ks < 8; ++ks) { const s16x4 alo = lds_tr(lp(aF0) + 4096 * ks), ahi = lds_tr(lp(aF1) + 4096 * ks); af[ks] = __builtin_shufflevector(alo, ahi, 0, 1, 2, 3, 4, 5, 6, 7); }
#pragma unroll
        for (int i = 0; i < 2; ++i) {
            bf16x8 bk[8];
#pragma unroll
            for (int ks = 0; ks < 8; ++ks) { const s16x4 blo = lds_tr(lp(i ? aK10 : aK00) + 4096 * ks), bhi = lds_tr(lp(i ? aK11 : aK01) + 4096 * ks); bk[ks] = __builtin_shufflevector(blo, bhi, 0, 1, 2, 3, 4, 5, 6, 7); }
#pragma unroll
            for (int ks = 0; ks < 8; ++ks) Cacc[i] = MFMA32(af[ks], bk[ks], Cacc[i]);
        }
        }
        ML_BAR();
    }
    if (c0 > 0) {
        ML_OPAQUE_TID(tidW); ML_LANE_MAP(tidW);
#pragma unroll
        for (int i = 0; i < 2; ++i)
#pragma unroll
            for (int g = 0; g < 4; ++g) {
                u32x2 wv; wv.x = cvtpk(Cacc[i][4 * g], Cacc[i][4 * g + 1]); wv.y = cvtpk(Cacc[i][4 * g + 2], Cacc[i][4 * g + 3]);
                *(LAS u32x2*)lp(rowb_ + ((unsigned)(16 * (4 * ebF + g)) ^ swl_) + hh8 + ML_C + 8192u * (dbF0 + i)) = wv;
            }
    }
    {
        const int c16 = F.tid & 15, rg = F.tid >> 4;
        const unsigned char* cq0 = (const unsigned char*)MLC + ((size_t)b * 2048 + c0 * 128) * 2048 + 8192u * rg + 256u * hm + 16u * c16;
#pragma unroll
        for (int rho = 0; rho < 4; ++rho) rq[rho] = *(const GAS u32x4*)(cq0 + rho * 2048);
    }
    __syncthreads();
    for (int ch = c0; ch < c1; ++ch) {
        int t0 = ch * 128; asm volatile("" : "+s"(t0));
        const size_t mrow0 = (size_t)b * 2048 + t0;
        const unsigned char* cb0 = (const unsigned char*)ML + mrow0 * 4096;
        unsigned char* mb0 = (unsigned char*)MIX + mrow0 * 4096;
        {
        ML_OPAQUE_TID(tidA); ML_THREAD_MAP(tidA);
#pragma unroll
        for (int rho = 0; rho < 4; ++rho) { *(LAS u32x4*)(lp(sa[rho]) + ML_Q) = rq[rho]; *(LAS u32x4*)(lp(sa[rho]) + ML_K) = rk_[rho]; *(LAS u32x4*)lp(sa[rho] + ML_V) = rv4[rho]; }
        }
        __builtin_amdgcn_sched_barrier(0);
        if (w == 0) {
            ML_OPAQUE_TID(tidB); const int lane = tidB & 63; const unsigned l4 = 4u * lane;
            const float b0 = pgt[0], b1 = pgt[1], a0 = pgt[2], a1 = pgt[3], cm0 = pgt[4], cm1 = pgt[5];
            const float mx0 = fmaxf(mc, cm0), mx1 = fmaxf(mc, cm1);
            SF(MS_A + l4) = a0; SF(MS_A + 256 + l4) = a1; SF(MS_U + l4) = -mx0; SF(MS_U + 256 + l4) = -mx1;
            SF(MS_WI + l4) = __builtin_amdgcn_exp2f(LOG2E * (mc - mx0)); SF(MS_WI + 256 + l4) = __builtin_amdgcn_exp2f(LOG2E * (mc - mx1));
            SF(MS_EM + l4) = __builtin_amdgcn_exp2f(-LOG2E * (b0 + mx0)); SF(MS_EM + 256 + l4) = __builtin_amdgcn_exp2f(-LOG2E * (b1 + mx1));
            const float Mall = __shfl(cm1, 63), blast = __shfl(b1, 63), mxa = fmaxf(mc, Mall);
            SF(MS_WK + l4) = __builtin_amdgcn_exp2f(LOG2E * (a0 - mxa)); SF(MS_WK + 256 + l4) = __builtin_amdgcn_exp2f(LOG2E * (a1 - mxa));
            if (lane == 0) SC[0] = __builtin_amdgcn_exp2f(LOG2E * (mc - mxa));
            mc = blast + mxa;
        }
        ML_BAR();
        ML_OPAQUE_TID(tidC); ML_LANE_MAP(tidC);
        const unsigned tq4 = 4u * (32u * tb + l31);
        const unsigned voffO = 4096u * (32u * tb + l31) + 3072u + 256u * hm + 128u * eh + 8u * hh;
        unsigned rk[8];
#pragma unroll
        for (int ks = 0; ks < 8; ++ks) rk[ks] = rowb_ + ((unsigned)(32 * ks + 2 * hh8) ^ swl_);
        const unsigned xc_e0 = 64u * ((unsigned)(2 * eh) ^ qi), xc_e1 = 64u * ((unsigned)(2 * eh + 1) ^ qi);
        const unsigned aC00 = ML_C + tn[0] + xc_e0, aC01 = ML_C + tn[1] + xc_e0, aC10 = ML_C + tn[0] + xc_e1, aC11 = ML_C + tn[1] + xc_e1;
        const unsigned aV00 = ML_V + tp[0] + xc_e0, aV01 = ML_V + tp[1] + xc_e0, aV10 = ML_V + tp[0] + xc_e1, aV11 = ML_V + tp[1] + xc_e1;
        __builtin_amdgcn_sched_barrier(0);
        const int tq = 32 * tb + l31;
        const unsigned qoff = ML_Q + 8192u * tb;
        const float ut = SF(MS_U + tq4), wint = SF(MS_WI + tq4), emt = SF(MS_EM + tq4);
        bf16x8 qf[8];
#pragma unroll
        for (int ks = 0; ks < 8; ++ks) qf[ks] = lds_b128(lp(rk[ks] + qoff));
        f32x16 acc[2];
#pragma unroll
        for (int c = 0; c < 2; ++c) {
            __builtin_amdgcn_sched_barrier(0);
            bf16x8 cf[8];
#pragma unroll
            for (int ks = 0; ks < 8; ++ks) {
                const s16x4 lo = lds_tr(lp(c ? aC10 : aC00) + 4096 * ks);
                const s16x4 hi = lds_tr(lp(c ? aC11 : aC01) + 4096 * ks);
                cf[ks] = __builtin_shufflevector(lo, hi, 0, 1, 2, 3, 4, 5, 6, 7);
            }
#pragma unroll
            for (int e = 0; e < 16; ++e) acc[c][e] = 0.f;
#pragma unroll
            for (int ks = 0; ks < 8; ++ks) acc[c] = MFMA32(cf[ks], qf[ks], acc[c]);
#pragma unroll
            for (int e = 0; e < 16; ++e) acc[c][e] *= wint;
        }
        float qn = 0.f;
#pragma unroll
        for (int ks = 0; ks < 8; ++ks) { const f32x4 n0 = SF4(MS_NV + 64 * ks + 2 * hh16), n1 = SF4(MS_NV + 64 * ks + 16 + 2 * hh16); const u32x4 qq = __builtin_bit_cast(u32x4, qf[ks]);
            qn += bf_lo(qq.x) * n0[0] + bf_hi(qq.x) * n0[1] + bf_lo(qq.y) * n0[2] + bf_hi(qq.y) * n0[3] + bf_lo(qq.z) * n1[0] + bf_hi(qq.z) * n1[1] + bf_lo(qq.w) * n1[2] + bf_hi(qq.w) * n1[3]; }
        __builtin_amdgcn_sched_barrier(0);
        u32x4 og[4];
        { ML_OPAQUE_TID(tidO); const unsigned char* co = cb0 + 3072 + 256u * hm + 16384u * (tidO >> 4) + 16u * (tidO & 15);
#pragma unroll
          for (int rho = 0; rho < 4; ++rho) og[rho] = *(const GAS u32x4*)(co + rho * 4096); }
        float sumP = 0.f;
#pragma unroll
        for (int sb = 0; sb < 4; ++sb) {
            if (sb <= tb) {
                __builtin_amdgcn_sched_barrier(0);
                f32x16 s; bf16x8 kf[8];
#pragma unroll
                for (int e = 0; e < 16; ++e) s[e] = 0.f;
#pragma unroll
                for (int ks = 0; ks < 8; ++ks) kf[ks] = lds_b128(lp(rk[ks]) + ML_K + 8192 * sb);
#pragma unroll
                for (int ks = 0; ks < 8; ++ks) s = MFMA32(kf[ks], qf[ks], s);
#pragma unroll
                for (int g = 0; g < 4; ++g) { const f32x4 av = SF4(MS_A + 4 * (32 * sb + 8 * g) + hh16);
#pragma unroll
                    for (int j = 0; j < 4; ++j) { const int e = 4 * g + j; float p = s[e] * __builtin_amdgcn_exp2f(LOG2E * (ut + av[j])); if (sb == tb && crow(e, hh) > l31) p = 0.f; s[e] = p; sumP += p; } }
                const bf16x8 pf0 = pack8(s[0], s[1], s[2], s[3], s[4], s[5], s[6], s[7]), pf1 = pack8(s[8], s[9], s[10], s[11], s[12], s[13], s[14], s[15]);
                __builtin_amdgcn_sched_barrier(0);
                bf16x8 vf[2][2];
#pragma unroll
                for (int c = 0; c < 2; ++c)
#pragma unroll
                    for (int s2 = 0; s2 < 2; ++s2) {
                        const s16x4 lo = lds_tr(lp(c ? aV10 : aV00) + 8192 * sb + 4096 * s2);
                        const s16x4 hi = lds_tr(lp(c ? aV11 : aV01) + 8192 * sb + 4096 * s2);
                        vf[c][s2] = __builtin_shufflevector(lo, hi, 0, 1, 2, 3, 4, 5, 6, 7);
                    }
#pragma unroll
                for (int c = 0; c < 2; ++c) { acc[c] = MFMA32(vf[c][0], pf0, acc[c]); acc[c] = MFMA32(vf[c][1], pf1, acc[c]); }
            }
        }
        qn += __shfl_xor(qn, 32); sumP += __shfl_xor(sumP, 32);
        const float den = wint * qn + sumP, rden = 1.0f / fmaxf(fabsf(den), emt);
        __builtin_amdgcn_sched_barrier(0);
        ML_BAR();
#pragma unroll
        for (int c = 0; c < 2; ++c)
#pragma unroll
            for (int g = 0; g < 4; ++g) {
                u32x2 wv; wv.x = cvtpk(acc[c][4 * g] * rden, acc[c][4 * g + 1] * rden); wv.y = cvtpk(acc[c][4 * g + 2] * rden, acc[c][4 * g + 3] * rden);
                *(LAS u32x2*)lp(ML_Q + 8192u * tb + rowb_ + ((unsigned)(16 * (4 * (2 * eh + c) + g)) ^ swl_) + hh8) = wv;
            }
        ML_BAR();
        {
            ML_OPAQUE_TID(tidE); ML_THREAD_MAP(tidE);
            const f32x4 g0 = SF4(MS_GV + c32), g1v = SF4(MS_GV + 16 + c32);
            unsigned char* mo = mb0 + 3072 + 256u * hm + 16384u * rg + 16u * c16;
#pragma unroll
            for (int rho = 0; rho < 4; ++rho) {
                const u32x4 hv = *(const LAS u32x4*)(lp(sa[rho]) + ML_Q); const u32x4 ov = og[rho];
                float h[8] = {bf_lo(hv.x), bf_hi(hv.x), bf_lo(hv.y), bf_hi(hv.y), bf_lo(hv.z), bf_hi(hv.z), bf_lo(hv.w), bf_hi(hv.w)};
                const float o[8] = {bf_lo(ov.x), bf_hi(ov.x), bf_lo(ov.y), bf_hi(ov.y), bf_lo(ov.z), bf_hi(ov.z), bf_lo(ov.w), bf_hi(ov.w)};
                float ssq = 0.f;
#pragma unroll
                for (int j = 0; j < 8; ++j) { h[j] *= __builtin_amdgcn_rcpf(1.0f + __builtin_amdgcn_exp2f(-LOG2E * o[j])); ssq += h[j] * h[j]; }
                ssq += __shfl_xor(ssq, 1); ssq += __shfl_xor(ssq, 2); ssq += __shfl_xor(ssq, 4); ssq += __shfl_xor(ssq, 8);
                const float rstd = 1.0f / sqrtf(ssq * (1.0f / 128.0f) + 1e-6f);
                u32x4 wv; wv.x = cvtpk(h[0] * rstd * g0[0], h[1] * rstd * g0[1]); wv.y = cvtpk(h[2] * rstd * g0[2], h[3] * rstd * g0[3]); wv.z = cvtpk(h[4] * rstd * g1v[0], h[5] * rstd * g1v[1]); wv.w = cvtpk(h[6] * rstd * g1v[2], h[7] * rstd * g1v[3]);
                *(GAS u32x4*)(mo + rho * 4096) = wv;
            }
        }
        __builtin_amdgcn_sched_barrier(0);
        __builtin_amdgcn_sched_barrier(0);
        {
            ML_OPAQUE_TID(tidP); const int c16 = tidP & 15, rg = tidP >> 4;
            int cn1 = (ch + 1 < c1 ? ch + 1 : ch); asm volatile("" : "+s"(cn1));
            const unsigned char* cq1 = (const unsigned char*)MLC + ((size_t)b * 2048 + cn1 * 128) * 2048 + 8192u * rg + 256u * hm + 16u * c16;
            const unsigned char* cv1 = (const unsigned char*)ML + ((size_t)b * 2048 + cn1 * 128) * 4096 + 16384u * rg + 2048 + 256u * hm + 16u * c16;
#pragma unroll
            for (int rho = 0; rho < 4; ++rho) { rk_[rho] = *(const GAS u32x4*)(cq1 + rho * 2048 + 1024); rv4[rho] = *(const GAS u32x4*)(cv1 + rho * 4096); }
        }
        __builtin_amdgcn_sched_barrier(0);
        {
            ML_OPAQUE_TID(tidK); ML_THREAD_MAP(tidK); const int lane = tidK & 63;
            float ps[8] = {0.f, 0.f, 0.f, 0.f, 0.f, 0.f, 0.f, 0.f};
#pragma unroll
            for (int rho = 0; rho < 4; ++rho) {
                const float wk = SF(MS_WK + 4 * rho + rg16); const u32x4 kk = *(const LAS u32x4*)(lp(sa[rho]) + ML_K);
                const float v0 = bf_lo(kk.x) * wk, v1 = bf_hi(kk.x) * wk, v2 = bf_lo(kk.y) * wk, v3 = bf_hi(kk.y) * wk, v4 = bf_lo(kk.z) * wk, v5 = bf_hi(kk.z) * wk, v6 = bf_lo(kk.w) * wk, v7 = bf_hi(kk.w) * wk;
                ps[0] += v0; ps[1] += v1; ps[2] += v2; ps[3] += v3; ps[4] += v4; ps[5] += v5; ps[6] += v6; ps[7] += v7;
                *(LAS bf16x8*)(lp(sa[rho]) + ML_Q) = pack8(v0, v1, v2, v3, v4, v5, v6, v7);
            }
#pragma unroll
            for (int j = 0; j < 8; ++j) { ps[j] += __shfl_xor(ps[j], 16); ps[j] += __shfl_xor(ps[j], 32); }
            if ((lane >> 4) == 0) {
#pragma unroll
                for (int j = 0; j < 8; ++j) SF(MS_NR + 512 * w + 4 * j + c32) = ps[j];
            }
        }
        ML_BAR();
        {
            ML_OPAQUE_TID(tidP2); const int c16 = tidP2 & 15, rg = tidP2 >> 4;
            int cn1 = (ch + 1 < c1 ? ch + 1 : ch); asm volatile("" : "+s"(cn1));
            const unsigned char* cq1 = (const unsigned char*)MLC + ((size_t)b * 2048 + cn1 * 128) * 2048 + 8192u * rg + 256u * hm + 16u * c16;
#pragma unroll
            for (int rho = 0; rho < 4; ++rho) rq[rho] = *(const GAS u32x4*)(cq1 + rho * 2048);
            if (w == 0) { const float* ga1 = GA + cn1 * 384 + (tidP2 & 63);
#pragma unroll
                for (int i = 0; i < 6; ++i) pgt[i] = ga1[64 * i]; }
        }
        __builtin_amdgcn_sched_barrier(0);
        const float decay = SC[0];
        ML_OPAQUE_TID(tidF); const unsigned t4 = 4u * tidF;
        if (tidF < 128) { float a = 0.f;
#pragma unroll
            for (int ww = 0; ww < 8; ++ww) a += SF(MS_NR + 512 * ww + t4);
            SF(MS_NV + t4) = decay * SF(MS_NV + t4) + a; }
#pragma unroll
        for (int i = 0; i < 2; ++i)
#pragma unroll
            for (int e = 0; e < 16; ++e) Cacc[i][e] *= decay;
        {
        ML_LANE_MAP(tidF);
        const unsigned xc_eF = 64u * ((unsigned)ebF ^ qi), xc_d0 = 64u * ((unsigned)dbF0 ^ qi), xc_d1 = 64u * ((unsigned)(dbF0 + 1) ^ qi);
        const unsigned aF0 = ML_V + tn[0] + xc_eF, aF1 = ML_V + tn[1] + xc_eF, aK00 = ML_Q + tn[0] + xc_d0, aK01 = ML_Q + tn[1] + xc_d0, aK10 = ML_Q + tn[0] + xc_d1, aK11 = ML_Q + tn[1] + xc_d1;
        unsigned cwr[4];
#pragma unroll
        for (int g = 0; g < 4; ++g) cwr[g] = rowb_ + ((unsigned)(16 * (4 * ebF + g)) ^ swl_) + hh8;
        bf16x8 af[8];
#pragma unroll
        for (int ks = 0; ks < 8; ++ks) {
            const s16x4 alo = lds_tr(lp(aF0) + 4096 * ks);
            const s16x4 ahi = lds_tr(lp(aF1) + 4096 * ks);
            af[ks] = __builtin_shufflevector(alo, ahi, 0, 1, 2, 3, 4, 5, 6, 7);
        }
#pragma unroll
        for (int i = 0; i < 2; ++i) {
            bf16x8 bk[8];
#pragma unroll
            for (int ks = 0; ks < 8; ++ks) {
                const s16x4 blo = lds_tr(lp(i ? aK10 : aK00) + 4096 * ks);
                const s16x4 bhi = lds_tr(lp(i ? aK11 : aK01) + 4096 * ks);
                bk[ks] = __builtin_shufflevector(blo, bhi, 0, 1, 2, 3, 4, 5, 6, 7);
            }
#pragma unroll
            for (int ks = 0; ks < 8; ++ks) Cacc[i] = MFMA32(af[ks], bk[ks], Cacc[i]);
        }
#pragma unroll
        for (int i = 0; i < 2; ++i)
#pragma unroll
            for (int g = 0; g < 4; ++g) {
                u32x2 wv; wv.x = cvtpk(Cacc[i][4 * g], Cacc[i][4 * g + 1]); wv.y = cvtpk(Cacc[i][4 * g + 2], Cacc[i][4 * g + 3]);
                *(LAS u32x2*)lp(cwr[g] + ML_C + 8192u * (dbF0 + i)) = wv;
            }
        }
        ML_BAR();
    }
}

DI void ffn_fixup(Frame& F, const float* cw, const float* cb) {
    const bf16* RAWB = (const bf16*)(F.ws + WS_RAW); bf16* ACT = (bf16*)(F.ws + WS_ACT);
    const int gt = (F.vcu * NWAVES + F.wave) * 64 + F.lane, NT = F.G * NWAVES * 64;
    auto ld4 = [](const bf16* p) { const u32x2 w = *(const GAS u32x2*)p; return (f32x4){bf_lo(w.x), bf_hi(w.x), bf_lo(w.y), bf_hi(w.y)}; };
    for (int it = gt; it < 256 * 2 * (DFF / 4); it += NT) {
        const int j4 = it % (DFF / 4), rs = it / (DFF / 4), rho = rs & 1, strip = rs >> 1, j = 4 * j4;
        const int pg = (j >> 7) * 256 + (j & 127);
        const bool first = (strip & 31) == 0;
        const bf16* own = RAWB + (size_t)strip * 4 * UPW; const bf16* prv = RAWB + (size_t)(strip - 1) * 4 * UPW;
        const f32x4 z = {0.f, 0.f, 0.f, 0.f};
        f32x4 gm2, gm1, g0, vm2, vm1, v0;
        if (rho == 0) { gm2 = first ? z : ld4(prv + 2 * UPW + pg); gm1 = first ? z : ld4(prv + 3 * UPW + pg); g0 = ld4(own + pg);
                        vm2 = first ? z : ld4(prv + 2 * UPW + pg + 128); vm1 = first ? z : ld4(prv + 3 * UPW + pg + 128); v0 = ld4(own + pg + 128); }
        else { gm2 = first ? z : ld4(prv + 3 * UPW + pg); gm1 = ld4(own + pg); g0 = ld4(own + UPW + pg);
               vm2 = first ? z : ld4(prv + 3 * UPW + pg + 128); vm1 = ld4(own + pg + 128); v0 = ld4(own + UPW + pg + 128); }
        const f32x4 yg = *(const f32x4*)(cb + j) + *(const f32x4*)(cw + j) * gm2 + *(const f32x4*)(cw + UPW + j) * gm1 + *(const f32x4*)(cw + 2 * UPW + j) * g0;
        const f32x4 yv = *(const f32x4*)(cb + DFF + j) + *(const f32x4*)(cw + DFF + j) * vm2 + *(const f32x4*)(cw + UPW + DFF + j) * vm1 + *(const f32x4*)(cw + 2 * UPW + DFF + j) * v0;
        u32x2 wv; wv.x = cvtpk(silu_f(yg[0]) * yv[0], silu_f(yg[1]) * yv[1]); wv.y = cvtpk(silu_f(yg[2]) * yv[2], silu_f(yg[3]) * yv[3]);
        *(GAS u32x2*)(ACT + (size_t)(64 * strip + rho) * DFF + j) = wv;
    }
}

struct Args { const float* in[16]; float* out; unsigned char* ws; int ph_lo, ph_hi, li, pad; };
__global__ void __launch_bounds__(NWAVES * 64, 2) fwd_kernel(Args args) {
    extern __shared__ __attribute__((aligned(16))) unsigned char lds[];
    Frame F;
    F.lds = (LAS unsigned char*)lds; F.MISC = (volatile LAS unsigned*)(F.lds + MISC_OFF);
    F.tid = threadIdx.x; F.lane = F.tid & 63; F.wave = __builtin_amdgcn_readfirstlane(F.tid >> 6);
    F.G = gridDim.x; { const int bx = blockIdx.x; F.vcu = (F.G % 8 == 0) ? (bx % 8) * (F.G / 8) + bx / 8 : bx; }
    F.ws = args.ws; F.ctl = (gu32*)(args.ws + WS_CTL); F.out = args.out;
    for (int u = F.tid; u < (LDS_BYTES - LDSCTL_OFF) / 4; u += NWAVES * 64) ((LAS unsigned*)(F.lds + LDSCTL_OFF))[u] = 0u;
    __syncthreads();
    XcdBarrier bar; bar.bar = (unsigned*)(F.ctl + CW_BAR) + args.li * XCD_BAR_WORDS; bar.x = 0; bar.st = nullptr;
    if (N_LAUNCHES != PER_PHASE) bar = xcd_barrier_post((unsigned*)(F.ctl + CW_BAR) + args.li * XCD_BAR_WORDS, F.MISC + 8);
#define GRID_BAR(seam) do { if (N_LAUNCHES == PER_PHASE) { if (F.tid == 0) __hip_atomic_store(F.ctl + CW_TMO, 0xBADBA0u | (unsigned)(seam), RLX_AGENT); } else { xcd_barrier(bar); } } while (0)
    const int lo = args.ph_lo, hi = args.ph_hi;
#define IN(k) (lo <= (k) && (k) < hi)
#define BOTH(k) (IN(k) && IN((k) + 1))
    PG8_LAS float* escr = (PG8_LAS float*)(F.lds + SCR_OFF);
    if (IN(PH_PRO)) { p0_prologue(F, args.in[0], args.in[1], args.in[2]); if (BOTH(PH_PRO)) GRID_BAR(PH_PRO); }
    if (IN(PH_IN)) {
        pg8::Gemm g{(const pg8::bf16_t*)(F.ws + WS_XN), (const pg8::bf16_t*)(F.ws + WS_WIN), M, IN_WP, DM}; pg8::StaticOrder S; S.init(M, IN_WP, F.G, (int)blockIdx.x, WGM_IN);
        pg8::Epi1 E{(pg8::bf16_t*)(F.ws + WS_QB), (pg8::bf16_t*)(F.ws + WS_KB), (pg8::bf16_t*)(F.ws + WS_VB), (pg8::bf16_t*)(F.ws + WS_ML), (float*)(F.ws + WS_G), (const float*)(F.ws + WS_ROPE), args.in[3], args.in[4], args.in[7], args.in[8], escr};
        pg8::gemm_phase<pg8::Epi1, pg8::StaticOrder, true, true>(F.lds + RING_OFF, g, S, E);
        { constexpr int IDLE0 = (M / 256) * (IN_WP / 256) % 256;
          if (F.G == 256 && (int)blockIdx.x >= IDLE0)
              convert_range(F, (LAS float*)(F.lds + RING_OFF + F.wave * 16384), args.in[10], args.in[12], args.in[11], args.in[15], 0, CV_EARLY, ((int)blockIdx.x - IDLE0) * NWAVES + F.wave, (256 - IDLE0) * NWAVES);
        }
        if (BOTH(PH_IN)) GRID_BAR(PH_IN);
    }
    if (IN(PH_PRE)) { mixer_prepass(F, args.in[5], args.in[6]); if (BOTH(PH_PRE)) GRID_BAR(PH_PRE); }
    if (IN(PH_MIX)) {
#ifndef PROBE_P2
#define PROBE_P2 0
#endif
#ifndef PROBE_LIGHT_UP
#define PROBE_LIGHT_UP 0
#endif
        const bool skip_ml = PROBE_P2 >= 2 && args.li == 1, skip_at = PROBE_P2 == 1 && args.li == 1;
        const bool is_ml = (int)blockIdx.x < ML_WGS;
        if (is_ml && !skip_ml) { const int seq = (int)blockIdx.x & 31, part = (int)blockIdx.x >> 5; mlstm_seq(F, seq >> 2, seq & 3, args.in[9], part ? ML_SPLIT : 0, part ? SEQ / 128 : ML_SPLIT); __syncthreads(); }
        if (!skip_at) attn_phase(F, CW_QUEUE + 1024 * args.li, args.in[10], args.in[12], args.in[11], args.in[15], is_ml || (PROBE_P2 == 3 && args.li == 1));
        if (BOTH(PH_MIX)) GRID_BAR(PH_MIX);
    }
    if (IN(PH_OUT)) {
        pg8::Gemm g{(const pg8::bf16_t*)(F.ws + WS_MIX), (const pg8::bf16_t*)(F.ws + WS_WOUT), M, DM, DM}; pg8::StaticOrder S; S.init(M, DM, F.G, (int)blockIdx.x, WGM_OUT);
        pg8::Epi3 E{(const pg8::bf16_t*)(F.ws + WS_XN), (const float*)(F.ws + WS_IR), (pg8::bf16_t*)(F.ws + WS_X1), (float*)(F.ws + WS_SS), escr};
        pg8::gemm_phase<pg8::Epi3, pg8::StaticOrder, true, true>(F.lds + RING_OFF, g, S, E);
        if (BOTH(PH_OUT)) GRID_BAR(PH_OUT);
    }
    if (IN(PH_UP)) {
        pg8::Gemm g{(const pg8::bf16_t*)(F.ws + WS_X1), (const pg8::bf16_t*)(F.ws + WS_WUP), M, UPW, DM}; pg8::StaticOrder S; S.init(M, UPW, F.G, (int)blockIdx.x, WGM_UP);
        pg8::Epi4 E{(pg8::bf16_t*)(F.ws + WS_ACT), (pg8::bf16_t*)(F.ws + WS_RAW), (const float*)(F.ws + WS_SS), args.in[13], args.in[14], escr, args.li == 0 ? PROBE_LIGHT_UP : 0};
        pg8::gemm_phase<pg8::Epi4, pg8::StaticOrder, true, true>(F.lds + RING_OFF, g, S, E);
        if (BOTH(PH_UP)) GRID_BAR(PH_UP);
    }
    if (IN(PH_FIX)) { ffn_fixup(F, args.in[13], args.in[14]); if (BOTH(PH_FIX)) GRID_BAR(PH_FIX); }
    if (IN(PH_DOWN)) {
        pg8::Gemm g{(const pg8::bf16_t*)(F.ws + WS_ACT), (const pg8::bf16_t*)(F.ws + WS_WDN), M, DM, DFF}; pg8::StaticOrder S; S.init(M, DM, F.G, (int)blockIdx.x, WGM_DOWN);
        pg8::Epi5 E{F.out, (const pg8::bf16_t*)(F.ws + WS_X1)};
        pg8::gemm_phase<pg8::Epi5, pg8::StaticOrder, true, true>(F.lds + RING_OFF, g, S, E);
    }
#undef IN
#undef BOTH
}

extern "C" void kernel_launch(void* const* d_in, const int* in_sizes, int n_in, void* d_out, int out_size, void* d_ws, size_t ws_size, hipStream_t stream) {
    static int grid = 0;
    if (grid == 0) {
        if (n_in != 16 || in_sizes[0] != M * DM || out_size != M * DM || ws_size < WS_END) { fprintf(stderr, "kernel_launch: unexpected shapes (n_in %d in0 %d out %d ws %zu)\n", n_in, n_in > 0 ? in_sizes[0] : -1, out_size, ws_size); grid = -1; return; }
        int dev = 0, cus = 0, per_cu = 0;
        if (hipGetDevice(&dev) != hipSuccess || hipDeviceGetAttribute(&cus, hipDeviceAttributeMultiprocessorCount, dev) != hipSuccess) { grid = -1; return; }
        if (hipFuncSetAttribute((const void*)fwd_kernel, hipFuncAttributeMaxDynamicSharedMemorySize, LDS_BYTES) != hipSuccess) { fprintf(stderr, "kernel_launch: hipFuncSetAttribute failed\n"); grid = -1; return; }
        if (hipOccupancyMaxActiveBlocksPerMultiprocessor(&per_cu, (const void*)fwd_kernel, NWAVES * 64, LDS_BYTES) != hipSuccess || per_cu < 1) fprintf(stderr, "kernel_launch: occupancy query reports %d blocks per CU\n", per_cu);
        (void)hipGetLastError();
        grid = cus;
    }
    if (grid < 0) return;
    if (hipMemsetAsync((char*)d_ws + WS_CTL, 0, CTL_ZERO_BYTES, stream) != hipSuccess) return;
    Args a{};
    for (int i = 0; i < 16; ++i) a.in[i] = (const float*)d_in[i];
    a.out = (float*)d_out; a.ws = (unsigned char*)d_ws;
#ifdef PROBE_REPEAT
    { const int k = PROBE_REPEAT; const int lo[3] = {0, k, k + 1}, hi[3] = {k + 1, k + 1, PER_PHASE};
      for (int li = 0; li < 3; ++li) { a.ph_lo = lo[li]; a.ph_hi = hi[li]; a.li = li; hipLaunchKernelGGL(fwd_kernel, dim3(grid), dim3(NWAVES * 64), LDS_BYTES, stream, a); } }
#else
    if (N_LAUNCHES == 1) { a.ph_lo = 0; a.ph_hi = PER_PHASE; a.li = 0; hipLaunchKernelGGL(fwd_kernel, dim3(grid), dim3(NWAVES * 64), LDS_BYTES, stream, a); }
    else for (int li = 0; li < PER_PHASE; ++li) { a.ph_lo = li; a.ph_hi = li + 1; a.li = 0; hipLaunchKernelGGL(fwd_kernel, dim3(grid), dim3(NWAVES * 64), LDS_BYTES, stream, a); }
#endif
}
```

```cpp
#include <hip/hip_runtime.h>
#include <cstdio>
#include <cstdint>
#include <cmath>
namespace pg8 {
#define PG8_LAS __attribute__((address_space(3)))
typedef unsigned short bf16_t;
typedef short bf16x8 __attribute__((ext_vector_type(8)));
typedef float f32x4 __attribute__((ext_vector_type(4)));
typedef unsigned u32x4 __attribute__((ext_vector_type(4)));
constexpr int BM = 256, BK = 64, HALF = 128, HTB = HALF * BK * 2  , STAGE_BYTES = 8 * HTB, NXCD = 8, WGM = 8;

__host__ __device__ __forceinline__ int lds_byte(int r, int c) { const int st = (r >> 4) * 2 + (c >> 5), rr = r & 15, cc = c & 31, ob = rr * 64 + cc * 2; return st * 1024 + (ob ^ (((ob >> 9) & 1) << 5)); }
__host__ __device__ __forceinline__ void stage_rc(int b, int& R, int& C) { const int st = b / 1024, sb = b % 1024, swz = sb ^ (((sb >> 9) & 1) << 5); R = (st >> 1) * 16 + swz / 64; C = (st & 1) * 32 + (swz % 64) / 2; }
__host__ __device__ __forceinline__ int perm32(int rho) { const int n = rho >> 4, i = rho & 15; return 8 * (i >> 2) + 4 * n + (i & 3); }

struct Unit { int pm, pn; };
struct Gemm { const bf16_t* A; const bf16_t* Bt; int M, N, K; };

struct StaticOrder {
    int nM, nN, nwg, G, c, wgm;
    __host__ __device__ void init(int M, int N, int G_, int c_, int wgm_ = WGM) { nM = M / BM; nN = N / BM; nwg = nM * nN; G = G_; c = c_; wgm = wgm_; }
    __host__ __device__ bool next(int i, Unit& u) const {
        const long L = (long)i * G + c; if (L >= nwg) return false;
        int wgid = (int)L; { const int q = nwg / NXCD, r = nwg % NXCD, xcd = wgid % NXCD, off = wgid / NXCD; wgid = (xcd < r ? xcd * (q + 1) : r * (q + 1) + (xcd - r) * q) + off; }
        const int nig = wgm * nN, gid = wgid / nig, fm = gid * wgm, gsz = (nM - fm) < wgm ? (nM - fm) : wgm;
        u.pm = fm + ((wgid % nig) % gsz); u.pn = (wgid % nig) / gsz; return true;
    }
    __device__ __forceinline__ void a_ready(const Unit&) const {}
    __device__ __forceinline__ void done(const Unit&) const {}
};

__device__ __forceinline__ unsigned cvt_pk_bf16(float lo, float hi) { unsigned r; asm volatile("v_cvt_pk_bf16_f32 %0, %1, %2" : "=v"(r) : "v"(lo), "v"(hi)); return r; }

typedef float f32x2 __attribute__((ext_vector_type(2)));
#define EPI_BAR() do { asm volatile("s_waitcnt lgkmcnt(0)" ::: "memory"); __builtin_amdgcn_s_barrier(); asm volatile("" ::: "memory"); } while (0)
constexpr float kEps = 1e-6f;

struct Epi1 {
    static constexpr bool PERM = true, AFTER_DRAIN = false, APERM = false;
    __device__ __forceinline__ void pre(const Unit&, int, int) const {}
    bf16_t *QB, *KB, *VB, *ML; float* G; const float* rope; const float *qg, *kg, *b_i, *b_f; PG8_LAS float* scr;
    __device__ __forceinline__ void operator()(const f32x4 (&acc)[2][2][4][2], const Unit& u, int wr, int wc, int fr, int fq) const {
        const int pn = u.pn;
        if (pn < 12) {
            const bool isq = pn < 6;
#pragma unroll
            for (int ai = 0; ai < 2; ++ai)
#pragma unroll
                for (int m = 0; m < 4; ++m)
#pragma unroll
                    for (int bj = 0; bj < 2; ++bj) {
                        const f32x4 a = acc[ai][bj][m][0], b = acc[ai][bj][m][1];
                        float s = (a[0] * a[0] + a[1] * a[1]) + (a[2] * a[2] + a[3] * a[3]) + (b[0] * b[0] + b[1] * b[1]) + (b[2] * b[2] + b[3] * b[3]);
                        s += __shfl_xor(s, 16); s += __shfl_xor(s, 32);
                        if (fq == 0) scr[((ai * HALF + wr * 64 + m * 16 + fr) * 2 + bj) * 4 + wc] = s;
                    }
            EPI_BAR();
            const float* gsrc = isq ? qg : kg; const float gscale = isq ? 0.08838834764831845f * 1.4426950408889634f : 1.0f;
            f32x4 gva, gvb;
#pragma unroll
            for (int e = 0; e < 4; ++e) { const int p = 32 * wc + 8 * fq + e; gva[e] = gsrc[(p >> 1) + 64 * (p & 1)] * gscale; gvb[e] = gsrc[((p + 4) >> 1) + 64 * (p & 1)] * gscale; }
            bf16_t* dst = isq ? QB : KB; const int head0 = (isq ? pn : pn - 6) * 2;
#pragma unroll
            for (int ai = 0; ai < 2; ++ai)
#pragma unroll
                for (int m = 0; m < 4; ++m) {
                    const int rl = ai * HALF + wr * 64 + m * 16 + fr, grow = u.pm * BM + rl, t = grow & 2047, bb = grow >> 11;
                    const size_t drow = (size_t)bb * 2048 + (size_t)(t & 3) * 512 + (t >> 2);
                    const f32x4 cs0 = *(const f32x4*)(rope + ((size_t)t * 64 + 16 * wc + 4 * fq) * 2), cs1 = *(const f32x4*)(rope + ((size_t)t * 64 + 16 * wc + 4 * fq) * 2 + 4);
#pragma unroll
                    for (int bj = 0; bj < 2; ++bj) {
                        const f32x4 pp = *(const PG8_LAS f32x4*)(scr + (rl * 2 + bj) * 4);
                        const float rstd = 1.0f / sqrtf(((pp[0] + pp[1]) + (pp[2] + pp[3])) * (1.0f / 128.0f) + kEps);
                        const f32x4 a = acc[ai][bj][m][0] * (gva * rstd), b = acc[ai][bj][m][1] * (gvb * rstd);
                        const f32x2 xe0 = {a[0], a[2]}, xo0 = {a[1], a[3]}, xe1 = {b[0], b[2]}, xo1 = {b[1], b[3]};
                        const f32x2 c0 = {cs0[0], cs0[2]}, s0 = {cs0[1], cs0[3]}, c1 = {cs1[0], cs1[2]}, s1 = {cs1[1], cs1[3]};
                        const f32x2 oe0 = xe0 * c0 - xo0 * s0, oo0 = xe0 * s0 + xo0 * c0, oe1 = xe1 * c1 - xo1 * s1, oo1 = xe1 * s1 + xo1 * c1;
                        u32x4 w;
                        w.x = cvt_pk_bf16(oe0[0], oo0[0]); w.y = cvt_pk_bf16(oe0[1], oo0[1]); w.z = cvt_pk_bf16(oe1[0], oo1[0]); w.w = cvt_pk_bf16(oe1[1], oo1[1]);
                        *(u32x4*)(dst + drow * 1536 + (head0 + bj) * 128 + 32 * wc + 8 * fq) = w;
                    }
                }
        } else if (pn < 26) {
            const bool isv = pn < 18;
#pragma unroll
            for (int ai = 0; ai < 2; ++ai)
#pragma unroll
                for (int m = 0; m < 4; ++m) {
                    const int rl = ai * HALF + wr * 64 + m * 16 + fr, grow = u.pm * BM + rl, t = grow & 2047, bb = grow >> 11;
                    bf16_t* rowp = isv ? VB + ((size_t)bb * 2048 + (size_t)(t & 3) * 512 + (t >> 2)) * 1536 + (pn - 12) * 256 : ML + (size_t)grow * 2048 + (pn - 18) * 256;
#pragma unroll
                    for (int bj = 0; bj < 2; ++bj) {
                        const f32x4 a = acc[ai][bj][m][0], b = acc[ai][bj][m][1];
                        u32x4 w; w.x = cvt_pk_bf16(a[0], a[1]); w.y = cvt_pk_bf16(a[2], a[3]); w.z = cvt_pk_bf16(b[0], b[1]); w.w = cvt_pk_bf16(b[2], b[3]);
                        *(u32x4*)(rowp + bj * HALF + 32 * wc + 8 * fq) = w;
                    }
                }
        } else {
            if (wc == 0 && fq == 0) {
                const f32x4 bi = *(const f32x4*)b_i, bf = *(const f32x4*)b_f;
#pragma unroll
                for (int ai = 0; ai < 2; ++ai)
#pragma unroll
                    for (int m = 0; m < 4; ++m) {
                        const int grow = u.pm * BM + ai * HALF + wr * 64 + m * 16 + fr;
                        *(f32x4*)(G + (size_t)grow * 8) = acc[ai][0][m][0] + bi; *(f32x4*)(G + (size_t)grow * 8 + 4) = acc[ai][0][m][1] + bf;
                    }
            }
        }
    }
};

struct Epi3 {
    static constexpr bool PERM = true, AFTER_DRAIN = false, APERM = false;
    __device__ __forceinline__ void pre(const Unit&, int, int) const {}
    const bf16_t* XN; const float* IR; bf16_t* X1; float* SS; PG8_LAS float* scr;
    __device__ __forceinline__ void operator()(const f32x4 (&acc)[2][2][4][2], const Unit& u, int wr, int wc, int fr, int fq) const {
        const int col0 = u.pn * BM + 32 * wc + 8 * fq;
#pragma unroll
        for (int ai = 0; ai < 2; ++ai)
#pragma unroll
            for (int m = 0; m < 4; ++m) {
                const int rl = ai * HALF + wr * 64 + m * 16 + fr; const size_t off = (size_t)(u.pm * BM + rl) * 2048 + col0;
                const float ir = IR[u.pm * BM + rl];
                float s = 0.f;
#pragma unroll
                for (int bj = 0; bj < 2; ++bj) {
                    const u32x4 xw = __builtin_nontemporal_load((const u32x4*)(XN + off + bj * HALF));
                    const f32x4 x0 = {__builtin_bit_cast(float, xw.x << 16), __builtin_bit_cast(float, xw.x & 0xffff0000u), __builtin_bit_cast(float, xw.y << 16), __builtin_bit_cast(float, xw.y & 0xffff0000u)};
                    const f32x4 x1 = {__builtin_bit_cast(float, xw.z << 16), __builtin_bit_cast(float, xw.z & 0xffff0000u), __builtin_bit_cast(float, xw.w << 16), __builtin_bit_cast(float, xw.w & 0xffff0000u)};
                    const f32x4 a = acc[ai][bj][m][0] + x0 * ir, b = acc[ai][bj][m][1] + x1 * ir;
                    s += (a[0] * a[0] + a[1] * a[1]) + (a[2] * a[2] + a[3] * a[3]) + (b[0] * b[0] + b[1] * b[1]) + (b[2] * b[2] + b[3] * b[3]);
                    u32x4 w; w.x = cvt_pk_bf16(a[0], a[1]); w.y = cvt_pk_bf16(a[2], a[3]); w.z = cvt_pk_bf16(b[0], b[1]); w.w = cvt_pk_bf16(b[2], b[3]);
                    *(u32x4*)(X1 + off + bj * HALF) = w;
                }
                s += __shfl_xor(s, 16); s += __shfl_xor(s, 32);
                if (fq == 0) scr[rl * 4 + wc] = s;
            }
        EPI_BAR();
        if (wc == 0 && fq == 0) {
#pragma unroll
            for (int ai = 0; ai < 2; ++ai)
#pragma unroll
                for (int m = 0; m < 4; ++m) {
                    const int rl = ai * HALF + wr * 64 + m * 16 + fr; const f32x4 pp = *(const PG8_LAS f32x4*)(scr + rl * 4);
                    SS[(size_t)(u.pm * BM + rl) * 8 + u.pn] = (pp[0] + pp[1]) + (pp[2] + pp[3]);
                }
        }
    }
};

__device__ __forceinline__ float dpp_shr1(float v) { return __builtin_bit_cast(float, __builtin_amdgcn_update_dpp(0, __builtin_bit_cast(int, v), 0x111, 0xf, 0xf, true)); }
struct Epi4 {
    static constexpr bool PERM = true, AFTER_DRAIN = false, APERM = true;
    bf16_t* ACT; bf16_t* RAWB; const float* SS; const float *cw, *cb; PG8_LAS float* scr; int light;
    __device__ __forceinline__ void pre(const Unit& u, int wid, int lane) const {
        __builtin_amdgcn_global_load_lds((const unsigned*)((const char*)(SS + (size_t)u.pm * BM * 8) + wid * 1024 + lane * 16), (PG8_LAS unsigned*)((PG8_LAS char*)scr + wid * 1024), 16, 0, 0);
        if (wid < 4) { const int seg = 2 * wid + (lane >> 5), q4 = seg >> 1, gv = seg & 1;
            const float* src = (q4 < 3 ? cw + q4 * 11264 : cb) + (gv ? 5632 : 0) + u.pn * 128 + 4 * (lane & 31);
            __builtin_amdgcn_global_load_lds((const unsigned*)src, (PG8_LAS unsigned*)((PG8_LAS char*)scr + 8192 + wid * 1024), 16, 0, 0); }
    }
    __device__ __forceinline__ void operator()(f32x4 (&acc)[2][2][4][2], const Unit& u, int wr, int wc, int fr, int fq) const {
        if (light == 1) return;
        const int j0 = u.pn * 128 + 32 * wc + 8 * fq;
#pragma unroll
        for (int ai = 0; ai < 2; ++ai)
#pragma unroll
            for (int m = 0; m < 4; ++m) {
                const PG8_LAS float* sp = scr + (ai * HALF + wr * 64 + 4 * fr + m) * 8; const f32x4 s0 = *(const PG8_LAS f32x4*)sp, s1 = *(const PG8_LAS f32x4*)(sp + 4);
                const float rstd = 1.0f / sqrtf((((s0[0] + s0[1]) + (s0[2] + s0[3])) + ((s1[0] + s1[1]) + (s1[2] + s1[3]))) * (1.0f / 2048.0f) + kEps);
#pragma unroll
                for (int bj = 0; bj < 2; ++bj) { acc[ai][bj][m][0] = acc[ai][bj][m][0] * rstd; acc[ai][bj][m][1] = acc[ai][bj][m][1] * rstd; }
            }
        if (fr == 0 && light != 2) {
#pragma unroll
            for (int ai = 0; ai < 2; ++ai)
#pragma unroll
                for (int mm = 0; mm < 2; ++mm)
#pragma unroll
                    for (int bj = 0; bj < 2; ++bj) { bf16_t* p = RAWB + ((size_t)(u.pm * 4 + ai * 2 + wr) * 4 + mm) * 11264 + u.pn * 256 + bj * HALF + 32 * wc + 8 * fq; const f32x4 a = acc[ai][bj][mm][0], b = acc[ai][bj][mm][1];
                        u32x4 w; w.x = cvt_pk_bf16(a[0], a[1]); w.y = cvt_pk_bf16(a[2], a[3]); w.z = cvt_pk_bf16(b[0], b[1]); w.w = cvt_pk_bf16(b[2], b[3]); *(u32x4*)p = w; }
        }
        if (fr == 15 && light != 2) {
#pragma unroll
            for (int ai = 0; ai < 2; ++ai)
#pragma unroll
                for (int mm = 0; mm < 2; ++mm)
#pragma unroll
                    for (int bj = 0; bj < 2; ++bj) { bf16_t* p = RAWB + ((size_t)(u.pm * 4 + ai * 2 + wr) * 4 + 2 + mm) * 11264 + u.pn * 256 + bj * HALF + 32 * wc + 8 * fq; const f32x4 a = acc[ai][bj][2 + mm][0], b = acc[ai][bj][2 + mm][1];
                        u32x4 w; w.x = cvt_pk_bf16(a[0], a[1]); w.y = cvt_pk_bf16(a[2], a[3]); w.z = cvt_pk_bf16(b[0], b[1]); w.w = cvt_pk_bf16(b[2], b[3]); *(u32x4*)p = w; }
        }
#pragma unroll
        for (int ai = 0; ai < 2; ++ai) {
            unsigned pk[4][4];
#pragma unroll
            for (int n = 0; n < 2; ++n) {
                const PG8_LAS float* wl = scr + 2048 + 32 * wc + 8 * fq + 4 * n;
                const f32x4 wg0 = *(const PG8_LAS f32x4*)wl, wg1 = *(const PG8_LAS f32x4*)(wl + 256), wg2 = *(const PG8_LAS f32x4*)(wl + 512), bg = *(const PG8_LAS f32x4*)(wl + 768);
                const f32x4 wv0 = *(const PG8_LAS f32x4*)(wl + 128), wv1 = *(const PG8_LAS f32x4*)(wl + 384), wv2 = *(const PG8_LAS f32x4*)(wl + 640), bv = *(const PG8_LAS f32x4*)(wl + 896);
                f32x4 ug[6], uv[6];
#pragma unroll
                for (int j = 0; j < 4; ++j) { ug[0][j] = dpp_shr1(acc[ai][0][2][n][j]); ug[1][j] = dpp_shr1(acc[ai][0][3][n][j]); uv[0][j] = dpp_shr1(acc[ai][1][2][n][j]); uv[1][j] = dpp_shr1(acc[ai][1][3][n][j]); }
#pragma unroll
                for (int m = 0; m < 4; ++m) { ug[2 + m] = acc[ai][0][m][n]; uv[2 + m] = acc[ai][1][m][n]; }
#pragma unroll
                for (int m = 0; m < 4; ++m) {
                    const f32x4 yg = bg + wg0 * ug[m] + wg1 * ug[m + 1] + wg2 * ug[m + 2];
                    const f32x4 yv = bv + wv0 * uv[m] + wv1 * uv[m + 1] + wv2 * uv[m + 2];
                    const f32x4 t = yg * -1.4426950408889634f;
                    f32x4 sg; sg[0] = __builtin_amdgcn_rcpf(1.0f + __builtin_amdgcn_exp2f(t[0])); sg[1] = __builtin_amdgcn_rcpf(1.0f + __builtin_amdgcn_exp2f(t[1])); sg[2] = __builtin_amdgcn_rcpf(1.0f + __builtin_amdgcn_exp2f(t[2])); sg[3] = __builtin_amdgcn_rcpf(1.0f + __builtin_amdgcn_exp2f(t[3]));
                    const f32x4 res = (yg * yv) * sg;
                    pk[m][2 * n] = cvt_pk_bf16(res[0], res[1]); pk[m][2 * n + 1] = cvt_pk_bf16(res[2], res[3]);
                }
            }
#pragma unroll
            for (int m = 0; m < 4; ++m) {
                if ((m < 2 && fr == 0) || (light == 2 && pk[m][0] != 0x12345678u)) continue;
                const int grow = u.pm * BM + ai * HALF + wr * 64 + 4 * fr + m;
                u32x4 w; w.x = pk[m][0]; w.y = pk[m][1]; w.z = pk[m][2]; w.w = pk[m][3];
                *(u32x4*)(ACT + (size_t)grow * 5632 + j0) = w;
            }
        }
    }
};

struct Epi5 {
    static constexpr bool PERM = true, AFTER_DRAIN = false, APERM = false;
    __device__ __forceinline__ void pre(const Unit&, int, int) const {}
    float* out; const bf16_t* X1;
    __device__ __forceinline__ void operator()(const f32x4 (&acc)[2][2][4][2], const Unit& u, int wr, int wc, int fr, int fq) const {
        const int col0 = u.pn * BM + 32 * wc + 8 * fq;
#pragma unroll
        for (int ai = 0; ai < 2; ++ai)
#pragma unroll
            for (int m = 0; m < 4; ++m) {
                const size_t off = (size_t)(u.pm * BM + ai * HALF + wr * 64 + m * 16 + fr) * 2048 + col0;
#pragma unroll
                for (int bj = 0; bj < 2; ++bj) {
                    const u32x4 w = __builtin_nontemporal_load((const u32x4*)(X1 + off + bj * HALF));
                    const f32x4 r0 = {__builtin_bit_cast(float, w.x << 16), __builtin_bit_cast(float, w.x & 0xffff0000u), __builtin_bit_cast(float, w.y << 16), __builtin_bit_cast(float, w.y & 0xffff0000u)};
                    const f32x4 r1 = {__builtin_bit_cast(float, w.z << 16), __builtin_bit_cast(float, w.z & 0xffff0000u), __builtin_bit_cast(float, w.w << 16), __builtin_bit_cast(float, w.w & 0xffff0000u)};
                    __builtin_nontemporal_store(acc[ai][bj][m][0] + r0, (f32x4*)(out + off + bj * HALF)); __builtin_nontemporal_store(acc[ai][bj][m][1] + r1, (f32x4*)(out + off + bj * HALF + 4));
                }
            }
    }
};
template <class Epi, class Sched, bool ALIGN_EPI = false, bool SP2 = false>
__device__ __forceinline__ void gemm_phase(PG8_LAS unsigned char* lds, const Gemm g, const Sched& S, const Epi& E) {
    const int tid = threadIdx.x, wid = __builtin_amdgcn_readfirstlane(tid >> 6), lane = tid & 63, wr = wid >> 2, wc = wid & 3, fr = lane & 15, fq = lane >> 4;
    const int K = g.K, nt = K / BK;
    unsigned voffA[2], voffB[2];
#pragma unroll
    for (int i = 0; i < 2; ++i) { int R, C; stage_rc(tid * 16 + i * 8192, R, C); const int Rb = Epi::PERM ? ((R & ~31) + perm32(R & 31)) : R;
        const int Ra = Epi::APERM ? ((R & ~63) + 4 * (R & 15) + ((R >> 4) & 3)) : R;
        voffA[i] = (unsigned)(Ra * K + C) * 2u; voffB[i] = (unsigned)(Rb * K + C) * 2u; }
    const size_t kstep = (size_t)(BK * 2);
    const size_t hstep = (size_t)HALF * K * 2;
    const size_t tstep = 2 * hstep;
    const unsigned ldsw = (unsigned)wid * 1024u;
    const int aoff = lds_byte(wr * 64 + fr, fq * 8), boff = lds_byte(wc * 32 + fr, fq * 8);
#define PG8_SA(b, h) (((b) * 2 + (h)) * HTB)
#define PG8_SB(b, h) ((4 + (b) * 2 + (h)) * HTB)
#define PG8_STAGE(bufoff, gbase, voff) do { _Pragma("unroll") for (int _i = 0; _i < 2; ++_i) \
        __builtin_amdgcn_global_load_lds((const unsigned*)((const char*)(gbase) + (voff)[_i]), (PG8_LAS unsigned*)(lds + (bufoff) + ldsw + _i * 8192), 16, 0, 0); } while (0)
#define PG8_LDA(dst, b, h) do { _Pragma("unroll") for (int m = 0; m < 4; ++m) _Pragma("unroll") for (int k = 0; k < 2; ++k) dst[m][k] = *(const PG8_LAS bf16x8*)(lds + PG8_SA(b, h) + aoff + m * 2048 + k * 1024); } while (0)
#define PG8_LDB(dst, b, h) do { _Pragma("unroll") for (int n = 0; n < 2; ++n) _Pragma("unroll") for (int k = 0; k < 2; ++k) dst[n][k] = *(const PG8_LAS bf16x8*)(lds + PG8_SB(b, h) + boff + n * 2048 + k * 1024); } while (0)
#define PG8_MMA(ai, bj, At, Bt) do { __builtin_amdgcn_s_setprio(1); _Pragma("unroll") for (int m = 0; m < 4; ++m) _Pragma("unroll") for (int n = 0; n < 2; ++n) _Pragma("unroll") for (int k = 0; k < 2; ++k) \
        acc[ai][bj][m][n] = __builtin_amdgcn_mfma_f32_16x16x32_bf16(Bt[n][k], At[m][k], acc[ai][bj][m][n], 0, 0, 0); __builtin_amdgcn_s_setprio(0); } while (0)
#define PG8_WAIT_V(n) asm volatile("s_waitcnt vmcnt(" #n ")" ::: "memory")
#define PG8_WAIT_L(n) asm volatile("s_waitcnt lgkmcnt(" #n ")" ::: "memory")
#define PG8_BAR __builtin_amdgcn_s_barrier()
#define PG8_SCHED __builtin_amdgcn_sched_barrier(0)
    Unit cur, nxt; int ui = 0;
    if (!S.next(0, cur)) return;
    f32x4 acc[2][2][4][2];
#pragma unroll
    for (int a = 0; a < 2; ++a)
#pragma unroll
        for (int b = 0; b < 2; ++b)
#pragma unroll
            for (int m = 0; m < 4; ++m)
#pragma unroll
                for (int n = 0; n < 2; ++n) acc[a][b][m][n] = (f32x4){0.f, 0.f, 0.f, 0.f};
    bf16x8 At[4][2], B0[2][2], B1[2][2];
    const char* cA = (const char*)g.A + (size_t)cur.pm * tstep; const char* cB = (const char*)g.Bt + (size_t)cur.pn * tstep;
    S.a_ready(cur);
    if constexpr (SP2) {
        PG8_STAGE(PG8_SB(0, 0), cB, voffB); PG8_STAGE(PG8_SB(0, 1), cB + hstep, voffB); PG8_STAGE(PG8_SA(0, 0), cA, voffA); PG8_STAGE(PG8_SA(0, 1), cA + hstep, voffA);
        if (wr == 1) PG8_BAR;
        PG8_WAIT_V(2); PG8_BAR;
        PG8_STAGE(PG8_SB(1, 0), cB + kstep, voffB); PG8_STAGE(PG8_SA(1, 0), cA + kstep, voffA); PG8_STAGE(PG8_SB(1, 1), cB + hstep + kstep, voffB);
        PG8_WAIT_V(6); PG8_BAR;
    } else {
        PG8_STAGE(PG8_SB(0, 0), cB, voffB); PG8_STAGE(PG8_SA(0, 0), cA, voffA); PG8_STAGE(PG8_SB(0, 1), cB + hstep, voffB); PG8_STAGE(PG8_SA(0, 1), cA + hstep, voffA);
        if (wr == 1) PG8_BAR;
        PG8_WAIT_V(4); PG8_BAR;
        PG8_STAGE(PG8_SB(1, 0), cB + kstep, voffB); PG8_STAGE(PG8_SA(1, 0), cA + kstep, voffA); PG8_STAGE(PG8_SB(1, 1), cB + hstep + kstep, voffB);
        PG8_WAIT_V(6); PG8_BAR;
    }
    for (;;) {
        const bool has_next = S.next(ui + 1, nxt);
        const char* nA = has_next ? (const char*)g.A + (size_t)nxt.pm * tstep : cA; const char* nB = has_next ? (const char*)g.Bt + (size_t)nxt.pn * tstep : cB;
        for (int t = 0; t < nt; t += 2) {
            const bool last = (t == nt - 2);
            const char* a1 = cA + (size_t)(t + 1) * kstep;
            const char* a2 = last ? nA : cA + (size_t)(t + 2) * kstep; const char* b2 = last ? nB : cB + (size_t)(t + 2) * kstep;
            const char* a3 = a2 + kstep; const char* b3 = b2 + kstep;
            if (last && has_next) S.a_ready(nxt);
            if (last) E.pre(cur, wid, lane);
            if constexpr (SP2) {
            PG8_LDB(B0, 0, 0); PG8_LDB(B1, 0, 1); PG8_SCHED; PG8_LDA(At, 0, 0); PG8_STAGE(PG8_SA(1, 1), a1 + hstep, voffA);
            PG8_WAIT_V(8); PG8_WAIT_L(0); PG8_BAR; PG8_MMA(0, 0, At, B0); PG8_MMA(0, 1, At, B1); PG8_BAR; PG8_SCHED;
            PG8_LDA(At, 0, 1); PG8_STAGE(PG8_SB(0, 0), b2, voffB); PG8_STAGE(PG8_SB(0, 1), b2 + hstep, voffB); PG8_STAGE(PG8_SA(0, 0), a2, voffA);
            PG8_WAIT_V(8); PG8_WAIT_L(0); PG8_BAR; PG8_MMA(1, 0, At, B0); PG8_MMA(1, 1, At, B1); PG8_BAR; PG8_SCHED;
            PG8_LDB(B0, 1, 0); PG8_LDB(B1, 1, 1); PG8_SCHED; PG8_LDA(At, 1, 0); PG8_STAGE(PG8_SA(0, 1), a2 + hstep, voffA);
            PG8_WAIT_V(8); PG8_WAIT_L(0); PG8_BAR; PG8_MMA(0, 0, At, B0); PG8_MMA(0, 1, At, B1); PG8_BAR; PG8_SCHED;
            PG8_LDA(At, 1, 1); PG8_STAGE(PG8_SB(1, 0), b3, voffB); PG8_STAGE(PG8_SB(1, 1), b3 + hstep, voffB); PG8_STAGE(PG8_SA(1, 0), a3, voffA);
            PG8_WAIT_V(8); PG8_WAIT_L(0); PG8_BAR; PG8_MMA(1, 0, At, B0); PG8_MMA(1, 1, At, B1); PG8_BAR; PG8_SCHED;
            } else {
            PG8_LDB(B0, 0, 0); PG8_SCHED; PG8_LDA(At, 0, 0); PG8_STAGE(PG8_SA(1, 1), a1 + hstep, voffA);
            PG8_WAIT_L(8); PG8_BAR; PG8_WAIT_L(0); PG8_MMA(0, 0, At, B0); PG8_BAR; PG8_SCHED;
            PG8_LDB(B1, 0, 1); PG8_STAGE(PG8_SB(0, 0), b2, voffB);
            PG8_BAR; PG8_WAIT_L(0); PG8_MMA(0, 1, At, B1); PG8_BAR;
            PG8_LDA(At, 0, 1); PG8_STAGE(PG8_SA(0, 0), a2, voffA);
            PG8_BAR; PG8_WAIT_L(0); PG8_MMA(1, 0, At, B0); PG8_BAR; PG8_SCHED;
            PG8_STAGE(PG8_SB(0, 1), b2 + hstep, voffB);
            PG8_WAIT_V(6); PG8_BAR; PG8_MMA(1, 1, At, B1); PG8_BAR;
            PG8_LDB(B0, 1, 0); PG8_SCHED; PG8_LDA(At, 1, 0); PG8_STAGE(PG8_SA(0, 1), a2 + hstep, voffA);
            PG8_WAIT_L(8); PG8_BAR; PG8_WAIT_L(0); PG8_MMA(0, 0, At, B0); PG8_BAR; PG8_SCHED;
            PG8_LDB(B1, 1, 1); PG8_STAGE(PG8_SB(1, 0), b3, voffB);
            PG8_BAR; PG8_WAIT_L(0); PG8_MMA(0, 1, At, B1); PG8_BAR;
            PG8_LDA(At, 1, 1); PG8_STAGE(PG8_SA(1, 0), a3, voffA);
            PG8_BAR; PG8_WAIT_L(0); PG8_MMA(1, 0, At, B0); PG8_BAR; PG8_SCHED;
            PG8_STAGE(PG8_SB(1, 1), b3 + hstep, voffB);
            PG8_WAIT_V(6); PG8_BAR; PG8_MMA(1, 1, At, B1); PG8_BAR;
            }
        }
        if constexpr (ALIGN_EPI) { if (wr == 0) PG8_BAR; }
        if constexpr (!Epi::AFTER_DRAIN) { E(acc, cur, wr, wc, fr, fq); S.done(cur); }
        if (!has_next) break;
#pragma unroll
        for (int a = 0; a < 2; ++a)
#pragma unroll
            for (int b = 0; b < 2; ++b)
#pragma unroll
                for (int m = 0; m < 4; ++m)
#pragma unroll
                    for (int n = 0; n < 2; ++n) acc[a][b][m][n] = (f32x4){0.f, 0.f, 0.f, 0.f};
        cur = nxt; cA = nA; cB = nB; ++ui;
        if constexpr (ALIGN_EPI) { if (wr == 1) PG8_BAR; }
    }
    PG8_WAIT_V(0);
    if constexpr (!ALIGN_EPI) { if (wr == 0) PG8_BAR; }
    PG8_BAR;
    if constexpr (Epi::AFTER_DRAIN) { E.fused(acc, cur, wr, wc, fr, fq, lds, wid, lane); S.done(cur); }
#undef PG8_SA
#undef PG8_SB
#undef PG8_STAGE
#undef PG8_LDA
#undef PG8_LDB
#undef PG8_MMA
#undef PG8_WAIT_V
#undef PG8_WAIT_L
#undef PG8_BAR
#undef PG8_SCHED
}
}
#define GAS __attribute__((address_space(1)))
#define LAS __attribute__((address_space(3)))
typedef unsigned short bf16;
typedef unsigned v4u __attribute__((ext_vector_type(4)));
typedef float f32x4 __attribute__((ext_vector_type(4)));
typedef short bf16x8 __attribute__((ext_vector_type(8)));
typedef GAS unsigned gu32;
typedef GAS unsigned long long gu64;
#define RLX_AGENT __ATOMIC_RELAXED, __HIP_MEMORY_SCOPE_AGENT
#define LDS_WAIT() asm volatile("s_waitcnt lgkmcnt(0)" ::: "memory")
#define VM_WAIT() asm volatile("s_waitcnt vmcnt(0)" ::: "memory")
__device__ __forceinline__ unsigned long long rt() { return __builtin_amdgcn_s_memrealtime(); }
__device__ __forceinline__ unsigned f2bf(float f) { unsigned u = __builtin_bit_cast(unsigned, f); return (u + 0x7fffu + ((u >> 16) & 1u)) >> 16; }
__device__ __forceinline__ unsigned pk2(float lo, float hi) { return f2bf(lo) | (f2bf(hi) << 16); }

#define XB_TMO      128
#define XB_XCNT(j)  (256  + 64 * (j))
#define XB_XSUB(j)  (1280 + 64 * (j))
#define XB_XGEN(j)  (2304 + 64 * (j))
#define XB_TOP      3328
#define XB_TOPGEN   3392
#define XCD_BAR_WORDS 3456
#define XB_SPIN_CAP (1u << 18)

__device__ __forceinline__ unsigned xb_ld(unsigned* p)              { return __hip_atomic_load(p, __ATOMIC_RELAXED, __HIP_MEMORY_SCOPE_AGENT); }
__device__ __forceinline__ unsigned xb_add(unsigned* p, unsigned v) { return __hip_atomic_fetch_add(p, v, __ATOMIC_RELAXED, __HIP_MEMORY_SCOPE_AGENT); }
__device__ __forceinline__ unsigned xb_xcc_id() { return (unsigned)__builtin_amdgcn_s_getreg((3 << 11) | 20) & 0xFu; }
#define XB_SPIN(cond, bar) do { unsigned _sp = 0; while (cond) { __builtin_amdgcn_s_sleep(1); \
    if ((++_sp & 255u) == 0u) { if (xb_ld(&(bar)[XB_TMO])) break; if (_sp > XB_SPIN_CAP) { atomicAdd(&(bar)[XB_TMO], 1u); break; } } } } while (0)

struct XcdBarrier {
    unsigned* bar; unsigned x;
    volatile LAS unsigned* st;
};

__device__ __forceinline__ XcdBarrier xcd_barrier_post(unsigned* bar, volatile LAS unsigned* st) {
    XcdBarrier b; b.bar = bar; b.x = xb_xcc_id(); b.st = st;
    if (threadIdx.x == 0) (void)xb_add(&bar[XB_XCNT(b.x)], 1u);
    return b;
}
__device__ __forceinline__ void xcd_barrier_complete(unsigned* bar, unsigned x, unsigned& nloc, unsigned& nx) {
    const unsigned G = gridDim.x * gridDim.y * gridDim.z;
    unsigned sum, cnt, mine, sp = 0u;
    for (;;) {
        sum = 0u; cnt = 0u; mine = 0u;
#pragma unroll
        for (unsigned j = 0; j < 16; ++j) { const unsigned c = xb_ld(&bar[XB_XCNT(j)]); sum += c; cnt += (c > 0u) ? 1u : 0u; mine = (j == x) ? c : mine; }
        if (sum == G) break;
        __builtin_amdgcn_s_sleep(1);
        if ((++sp & 255u) == 0u) { if (xb_ld(&bar[XB_TMO])) break; if (sp > XB_SPIN_CAP) { atomicAdd(&bar[XB_TMO], 1u); break; } }
    }
    nloc = mine > 0u ? mine : 1u; nx = cnt > 0u ? cnt : 1u;
}

__device__ __forceinline__ void xcd_barrier(const XcdBarrier& b) {
    asm volatile("s_waitcnt vmcnt(0)" ::: "memory");
    __syncthreads();
    if (threadIdx.x == 0) {
        unsigned* bar = b.bar;
        __builtin_amdgcn_s_waitcnt(0);
        unsigned nloc = b.st[0], nx = b.st[1];
        if (nloc == 0u) { xcd_barrier_complete(bar, b.x, nloc, nx); b.st[0] = nloc; b.st[1] = nx; }
        const unsigned old = xb_add(&bar[XB_XSUB(b.x)], 1u);
        const unsigned gen = old / nloc;
        if (old + 1u == (gen + 1u) * nloc) {
            __builtin_amdgcn_fence(__ATOMIC_RELEASE, "agent");
            asm volatile("s_waitcnt vmcnt(0)" ::: "memory");
            const unsigned og = xb_add(&bar[XB_TOP], 1u);
            const unsigned tg = og / nx;
            if (og + 1u == (tg + 1u) * nx) xb_add(&bar[XB_TOPGEN], 1u);
            else XB_SPIN(xb_ld(&bar[XB_TOPGEN]) == tg, bar);
            __builtin_amdgcn_fence(__ATOMIC_ACQUIRE, "agent");
            xb_add(&bar[XB_XGEN(b.x)], 1u);
            asm volatile("s_waitcnt vmcnt(0)" ::: "memory");
        } else {
            XB_SPIN(xb_ld(&bar[XB_XGEN(b.x)]) == gen, bar);
            __builtin_amdgcn_fence(__ATOMIC_ACQUIRE, "agent");
            asm volatile("s_waitcnt vmcnt(0)" ::: "memory");
        }
    }
    __syncthreads();
}
constexpr int ATT_NSLOT0 = 23, ATT_NSLOT1 = 15, ATT_STAGES = 6, ATT_LAND = 1;
constexpr int ATT_BLK0[8] = {15, 14, 13, 12, 8, 9, 10, 11}, ATT_BLK1[8] = {7, 6, 5, 4, 0, 1, 2, 3};
__device__ const unsigned short ATT_SCHED[38][12] = {
    {0x8001, 0x8403, 0x8805, 0x0000, 0x0000, 0x0000, 0x0000, 0x0000, 0x0000, 0x0000, 0x0000, 0x0000},
    {0x8c00, 0x9004, 0x9406, 0x8001, 0x8001, 0x8001, 0x8001, 0x8805, 0x8805, 0x8805, 0x8805, 0x0000},
    {0x0000, 0x0000, 0x0000, 0x8805, 0x8805, 0x8805, 0x8805, 0x8001, 0x8001, 0x8001, 0x8001, 0x0000},
    {0x8008, 0x8807, 0x0000, 0x8403, 0x8403, 0x8403, 0x8403, 0x8403, 0x8403, 0x8403, 0x8403, 0x0000},
    {0x8402, 0x0000, 0x0000, 0x9004, 0x9004, 0x9004, 0x9004, 0x9004, 0x9004, 0x9004, 0x9004, 0x0000},
    {0x9009, 0x0000, 0x0000, 0x8c00, 0x8c00, 0x8c00, 0x8c00, 0x8c00, 0x8c00, 0x8c00, 0x8c00, 0x0000},
    {0x8c0a, 0x0000, 0x0000, 0x9406, 0x9406, 0x9406, 0x9406, 0x9406, 0x9406, 0x9406, 0x9406, 0x0000},
    {0x940b, 0x0000, 0x0000, 0x8807, 0x8807, 0x8807, 0x8807, 0x8008, 0x8008, 0x8008, 0x8008, 0x0000},
    {0x0000, 0x0000, 0x0000, 0x8008, 0x8008, 0x8008, 0x8008, 0x8807, 0x8807, 0x8807, 0x8807, 0x0000},
    {0x800c, 0x8908, 0x0000, 0x8c0a, 0x8c0a, 0x8c0a, 0x8c0a, 0x8402, 0x8402, 0x8c0a, 0x940b, 0x0000},
    {0x0000, 0x0000, 0x0000, 0x8402, 0x8402, 0x8402, 0x8402, 0x8908, 0x8908, 0x8402, 0x8c0a, 0x0000},
    {0x8e09, 0x8a08, 0x0000, 0x940b, 0x940b, 0x940b, 0x940b, 0x0000, 0x9009, 0x9009, 0x8402, 0x0000},
    {0x870a, 0x9708, 0x0000, 0x9009, 0x9009, 0x9009, 0x9009, 0x8a08, 0x8e09, 0x8e09, 0x9009, 0x0000},
    {0x900d, 0x8d0b, 0x0000, 0x800c, 0x800c, 0x800c, 0x800c, 0x9708, 0x8a08, 0x870a, 0x870a, 0x0000},
    {0x830e, 0x890c, 0x8709, 0x900d, 0x900d, 0x900d, 0x8d0b, 0x0000, 0x9708, 0x0000, 0x8d0b, 0x0000},
    {0x940e, 0x920a, 0x8f0c, 0x830e, 0x830e, 0x890c, 0x890c, 0x0000, 0x8709, 0x8709, 0x0000, 0x0000},
    {0x820e, 0x8a0b, 0x8509, 0x940e, 0x940e, 0x8f0c, 0x8f0c, 0x0000, 0x0000, 0x920a, 0x920a, 0x0000},
    {0x950e, 0x920c, 0x8d0a, 0x820e, 0x820e, 0x0000, 0x8a0b, 0x0000, 0xc509, 0x8509, 0x8a0b, 0x0000},
    {0x820d, 0x8b0b, 0x860f, 0x950e, 0x950e, 0x920c, 0x920c, 0x0000, 0x0000, 0xcd0a, 0x8d0a, 0x0000},
    {0x950d, 0x9307, 0x8d0f, 0x860f, 0x820d, 0x820d, 0xcb0b, 0x0000, 0x0000, 0x0000, 0xcb0b, 0x0000},
    {0x830d, 0x880f, 0x8607, 0x8d0f, 0x950d, 0x950d, 0x0000, 0x9307, 0x0000, 0x0000, 0x0000, 0x0000},
    {0x9507, 0x930f, 0x0000, 0x880f, 0xc30d, 0xc30d, 0x0000, 0x8607, 0x0000, 0x0000, 0x0000, 0x0000},
    {0x0000, 0x0000, 0x0000, 0xd30f, 0x0000, 0x0000, 0x0000, 0xd507, 0x0000, 0x0000, 0x0000, 0x0000},
    {0x8000, 0x8401, 0x8802, 0x0000, 0x0000, 0x0000, 0x0000, 0x0000, 0x0000, 0x0000, 0x0000, 0x0000},
    {0x8d00, 0x9003, 0x9404, 0x8802, 0x8802, 0x8802, 0x8802, 0x8000, 0x8401, 0x8802, 0x8802, 0x0000},
    {0x8a00, 0x0000, 0x0000, 0x9404, 0x9404, 0x9404, 0x9404, 0x8d00, 0x8d00, 0x8401, 0x9003, 0x0000},
    {0x8f02, 0x9700, 0x0000, 0x9003, 0x9003, 0x9003, 0x9003, 0x8a00, 0x8a00, 0x8000, 0x8401, 0x0000},
    {0x9102, 0x8805, 0x0000, 0x8401, 0x8401, 0x8401, 0x8401, 0xd700, 0x9700, 0x8f02, 0x8f02, 0x0000},
    {0x8701, 0x8f04, 0x9506, 0x8805, 0x8805, 0x8805, 0x8000, 0x0000, 0x8000, 0x9102, 0x9102, 0x0000},
    {0x9203, 0x8901, 0x0000, 0x9506, 0x9506, 0x8f04, 0x8f04, 0x0000, 0x8701, 0x8701, 0x8000, 0x0000},
    {0x8606, 0x8d04, 0x9602, 0x8000, 0x8000, 0x8000, 0x9203, 0x0000, 0x8901, 0x8901, 0x9203, 0x0000},
    {0x8306, 0x9204, 0x8a01, 0x8606, 0x8606, 0x8d04, 0x8d04, 0x0000, 0x0000, 0x9602, 0x9602, 0x0000},
    {0x8406, 0x8f03, 0x9705, 0x8306, 0x8306, 0x9204, 0x9204, 0x0000, 0xca01, 0xca01, 0x0000, 0x0000},
    {0x8103, 0x9105, 0x8807, 0x8406, 0x9705, 0x9705, 0x8f03, 0x0000, 0x0000, 0x0000, 0x8f03, 0x0000},
    {0x8e05, 0x9707, 0x0000, 0x8807, 0x8406, 0x9105, 0xc103, 0x0000, 0x0000, 0x0000, 0xc103, 0x0000},
    {0x8507, 0x8207, 0x0000, 0x9707, 0x9105, 0xce05, 0x0000, 0x0000, 0x0000, 0x0000, 0x0000, 0x0000},
    {0x0000, 0x0000, 0x0000, 0x8207, 0xce05, 0x0000, 0x0000, 0x0000, 0x0000, 0x0000, 0x0000, 0x0000},
    {0x0000, 0x0000, 0x0000, 0xc507, 0x0000, 0x0000, 0x0000, 0x0000, 0x0000, 0x0000, 0x0000, 0x0000},
};

constexpr int NWAVES = 8;
constexpr int BATCH = 8, SEQ = 2048, DM = 2048, M = BATCH * SEQ;
constexpr int NAH = 12, NMH = 4, ATTN_W = 1536, IN_W = 6664, IN_WP = 6912, DFF = 5632, UPW = 11264;
#ifndef MK_N_LAUNCHES
#define MK_N_LAUNCHES 1
#endif
#ifndef WGM_IN
#define WGM_IN 8
#endif
#ifndef WGM_OUT
#define WGM_OUT 4
#endif
#ifndef WGM_UP
#define WGM_UP 8
#endif
#ifndef WGM_DOWN
#define WGM_DOWN 4
#endif
constexpr int N_LAUNCHES = MK_N_LAUNCHES;
enum { PH_PRO = 0, PH_IN = 1, PH_PRE = 2, PH_MIX = 3, PH_OUT = 4, PH_UP = 5, PH_FIX = 6, PH_DOWN = 7 };
constexpr int PER_PHASE = 8;

constexpr size_t MiB = 1u << 20;
constexpr size_t WS_CTL = 0, CTL_ZERO_BYTES = 128 * 1024;
constexpr size_t WS_ROPE = 1 * MiB, WS_G = 2 * MiB, WS_SS = 2 * MiB + 512 * 1024, WS_IR = 3 * MiB;
constexpr size_t WS_WIN = 4 * MiB, WS_WOUT = 31 * MiB, WS_WUP = 39 * MiB, WS_WDN = 83 * MiB;
constexpr size_t WS_XN = 105 * MiB;
constexpr size_t WS_QB = 169 * MiB, WS_KB = 217 * MiB, WS_VB = 265 * MiB, WS_ML = 313 * MiB;
constexpr size_t WS_MIX = 377 * MiB;
constexpr size_t WS_RAW = 377 * MiB;
constexpr size_t WS_ACT = 169 * MiB;
constexpr size_t WS_MLC = 441 * MiB;
constexpr size_t WS_GA = 473 * MiB;
constexpr size_t WS_X1 = 441 * MiB;
constexpr size_t WS_END = 505 * MiB;
static_assert(WS_WIN + (size_t)IN_WP * DM * 2 <= WS_WOUT && WS_WOUT + (size_t)DM * DM * 2 <= WS_WUP && WS_WUP + (size_t)UPW * DM * 2 <= WS_WDN && WS_WDN + (size_t)DM * DFF * 2 <= WS_XN, "weights map");
static_assert(WS_XN + (size_t)M * DM * 2 <= WS_QB && WS_ML + (size_t)M * 2048 * 2 <= WS_MIX && WS_MIX + (size_t)M * 2048 * 2 <= WS_MLC && WS_MLC + (size_t)M * 1024 * 2 <= WS_GA && WS_GA + (size_t)32 * 16 * 3 * 128 * 4 <= WS_END && WS_X1 + (size_t)M * DM * 2 <= WS_END && WS_RAW + (size_t)256 * 4 * UPW * 4 <= WS_MLC && WS_ACT + (size_t)M * DFF * 2 <= WS_MIX, "activation map");
constexpr int CW_TMO = 0, CW_BAR = 4096, CW_QUEUE = 16384;

constexpr int RING_OFF = 0, RING_BYTES = 131072;
constexpr int SCR_OFF = RING_BYTES, SCR_BYTES = 24576;
constexpr int LDSCTL_OFF = SCR_OFF + SCR_BYTES, MISC_OFF = LDSCTL_OFF + 320;
constexpr int LDS_BYTES = 156672;
static_assert(MISC_OFF + 128 <= LDS_BYTES, "LDS map");

#define DI __device__ __forceinline__
typedef float f32x16 __attribute__((ext_vector_type(16)));
typedef short s16x4 __attribute__((ext_vector_type(4)));
typedef unsigned u32x2 __attribute__((ext_vector_type(2)));
#define MFMA32(a, b, c) __builtin_amdgcn_mfma_f32_32x32x16_bf16((a), (b), (c), 0, 0, 0)
constexpr float LOG2E = 1.4426950408889634f;

struct Frame {
    LAS unsigned char* lds; volatile LAS unsigned* MISC; gu32* ctl;
    int tid, lane, wave, vcu, G;
    float* out; unsigned char* ws;
};

DI unsigned swz_b(unsigned row) { return ((row & 3u) << 2) | ((row >> 2) & 3u); }
DI unsigned off_b(unsigned row, unsigned ch) { return 256u * row + 16u * (ch ^ swz_b(row)); }
DI bf16x8 lds_b128(LAS unsigned char* p) { return *(const LAS bf16x8*)p; }
DI LAS unsigned char* lp(unsigned a) { return (LAS unsigned char*)(size_t)a; }
typedef short v4i16_t __attribute__((ext_vector_type(4)));
DI s16x4 lds_tr(LAS unsigned char* p) { return __builtin_bit_cast(s16x4, __builtin_amdgcn_ds_read_tr16_b64_v4i16((LAS v4i16_t*)p)); }
DI int crow(int reg, int hh) { return (reg & 3) + 8 * (reg >> 2) + 4 * hh; }
typedef unsigned u32x4 __attribute__((ext_vector_type(4)));
typedef float f32x2_t __attribute__((ext_vector_type(2)));
typedef __bf16 bf16x2_t __attribute__((ext_vector_type(2)));
DI unsigned cvtpk(float lo, float hi) { f32x2_t v = {lo, hi}; bf16x2_t b = __builtin_convertvector(v, bf16x2_t); return __builtin_bit_cast(unsigned, b); }
DI bf16x8 pack8(float a0, float a1, float a2, float a3, float a4, float a5, float a6, float a7) {
    u32x4 p; p.x = cvtpk(a0, a1); p.y = cvtpk(a2, a3); p.z = cvtpk(a4, a5); p.w = cvtpk(a6, a7); return __builtin_bit_cast(bf16x8, p);
}
DI float bf_lo(unsigned w) { return __builtin_bit_cast(float, w << 16); }
DI float bf_hi(unsigned w) { return __builtin_bit_cast(float, w & 0xffff0000u); }

DI float wave_sum(float v) {
#pragma unroll
    for (int o = 1; o < 64; o <<= 1) v += __shfl_xor(v, o);
    return v;
}
template <int MAT> DI int colmap(int n) {
    if (MAT == 0) return n < 2 * ATTN_W ? (n & ~127) + ((n & 127) >> 1) + 64 * (n & 1) : (n < IN_W ? n : -1);
    if (MAT == 2) return DFF * ((n >> 7) & 1) + 128 * (n >> 8) + (n & 127);
    return n;
}
template <int MAT, bool SCALE, bool VEC> DI void transpose_items(const float* W, const float* gk, int K, int N, bf16* WT, LAS float* scr, int it0, int step, int it_end, int nblk, int lane) {
    if (it0 >= it_end) return;
    float cur[32], nxt[32];
    auto issue = [&](float (&r)[32], int item) {
        const int kb = item / nblk, nb = item % nblk, k0 = 64 * kb, n0 = 32 * nb;
        if (VEC) { const int q = lane & 7, kr = lane >> 3; const int col = colmap<MAT>(n0 + 4 * q);
#pragma unroll
            for (int i = 0; i < 8; ++i) { const f32x4 v = __builtin_nontemporal_load((const GAS f32x4*)(W + (size_t)(k0 + 8 * i + kr) * N + col)); r[4 * i] = v[0]; r[4 * i + 1] = v[1]; r[4 * i + 2] = v[2]; r[4 * i + 3] = v[3]; } }
        else { const int col = colmap<MAT>(n0 + (lane & 31));
#pragma unroll
            for (int i = 0; i < 32; ++i) r[i] = col >= 0 ? __builtin_nontemporal_load((const GAS float*)(W + (size_t)(k0 + 2 * i + (lane >> 5)) * N + col)) : 0.f; }
    };
    issue(cur, it0);
    for (int item = it0; item < it_end; item += step) {
        const bool has_next = item + step < it_end;
        if (has_next) issue(nxt, item + step);
        const int kb = item / nblk, nb = item % nblk, k0 = 64 * kb, n0 = 32 * nb;
        if (VEC) { const int q = lane & 7, kr = lane >> 3;
#pragma unroll
            for (int i = 0; i < 8; ++i)
#pragma unroll
                for (int j = 0; j < 4; ++j) scr[(8 * i + kr) * 33 + 4 * q + j] = cur[4 * i + j]; }
        else {
#pragma unroll
            for (int i = 0; i < 32; ++i) scr[(2 * i + (lane >> 5)) * 33 + (lane & 31)] = cur[i]; }
        const int c = lane & 7;
        f32x4 g0 = {1.f, 1.f, 1.f, 1.f}, g1v = g0;
        if (SCALE) { g0 = *(const GAS f32x4*)(gk + k0 + 8 * c); g1v = *(const GAS f32x4*)(gk + k0 + 8 * c + 4); }
        LDS_WAIT(); asm volatile("" ::: "memory");
#pragma unroll
        for (int j = 0; j < 4; ++j) { const int n = (lane >> 3) + 8 * j; const LAS float* sp = scr + (8 * c) * 33 + n;
            v4u o; o.x = cvtpk(sp[0 * 33] * g0[0], sp[1 * 33] * g0[1]); o.y = cvtpk(sp[2 * 33] * g0[2], sp[3 * 33] * g0[3]); o.z = cvtpk(sp[4 * 33] * g1v[0], sp[5 * 33] * g1v[1]); o.w = cvtpk(sp[6 * 33] * g1v[2], sp[7 * 33] * g1v[3]);
            if (VEC) __builtin_nontemporal_store(o, (GAS v4u*)(WT + (size_t)(n0 + n) * K + k0 + 8 * c)); else *(GAS v4u*)(WT + (size_t)(n0 + n) * K + k0 + 8 * c) = o; }
        LDS_WAIT(); asm volatile("" ::: "memory");
        if (has_next) {
#pragma unroll
            for (int i = 0; i < 32; ++i) cur[i] = nxt[i]; }
    }
}
DI void p0_prologue(Frame& F, const float* x, const float* g1, const float* w_in) {
    LAS float* scr = (LAS float*)(F.lds + RING_OFF + F.wave * 16384);
    const int gw = F.vcu * NWAVES + F.wave, NGW = F.G * NWAVES;
    constexpr int NB0 = IN_WP / 32, I0 = (DM / 64) * NB0;
    bf16* Win = (bf16*)(F.ws + WS_WIN);
    transpose_items<0, true, false>(w_in, g1, DM, IN_W, Win, scr, gw, NGW, I0, NB0, F.lane);
    {
        bf16* XN = (bf16*)(F.ws + WS_XN);
        f32x4 v[8], vn[8];
#pragma unroll
        for (int j = 0; j < 8; ++j) v[j] = __builtin_nontemporal_load((const GAS f32x4*)(x + (size_t)gw * DM) + F.lane + 64 * j);
        for (int m = gw; m < M; m += NGW) {
            const bool has_next = m + NGW < M;
            if (has_next) {
#pragma unroll
                for (int j = 0; j < 8; ++j) vn[j] = __builtin_nontemporal_load((const GAS f32x4*)(x + (size_t)(m + NGW) * DM) + F.lane + 64 * j); }
            float s = 0.f;
#pragma unroll
            for (int j = 0; j < 8; ++j) s += (v[j].x * v[j].x + v[j].y * v[j].y) + (v[j].z * v[j].z + v[j].w * v[j].w);
            const float rms = sqrtf(wave_sum(s) * (1.f / DM) + 1e-6f), rstd = 1.f / rms;
            if (F.lane == 0) ((float*)(F.ws + WS_IR))[m] = rms;
            GAS unsigned long long* o8 = (GAS unsigned long long*)(XN + (size_t)m * DM) + F.lane;
#pragma unroll
            for (int j = 0; j < 8; ++j) o8[64 * j] = (unsigned long long)cvtpk(v[j].x * rstd, v[j].y * rstd) | ((unsigned long long)cvtpk(v[j].z * rstd, v[j].w * rstd) << 32);
            if (has_next) {
#pragma unroll
                for (int j = 0; j < 8; ++j) v[j] = vn[j]; }
        }
    }
    {
        float* rope = (float*)(F.ws + WS_ROPE);
        for (int idx = gw * 64 + F.lane; idx < SEQ * 64; idx += NGW * 64) {
            const int t = idx >> 6, i = idx & 63; const double ang = (double)t * pow(10000.0, -(double)i / 64.0);
            rope[2 * idx] = (float)cos(ang); rope[2 * idx + 1] = (float)sin(ang);
        }
    }
}

DI void xhalf_swap(float& a, float& b) { asm("s_nop 1\n\tv_permlane32_swap_b32 %0, %1" : "+v"(a), "+v"(b)); }
DI float xhalf_max(float x) { float a = x, b = x; xhalf_swap(a, b); return fmaxf(a, b); }
DI float xhalf_sum(float x) { float a = x, b = x; xhalf_swap(a, b); return a + b; }
DI void att_dma_tile(const unsigned char* gbase, const unsigned (&voff)[8], LAS unsigned char* ldst) {
#pragma unroll
    for (int it = 0; it < 8; ++it) __builtin_amdgcn_global_load_lds((const unsigned*)(gbase + voff[it]), (LAS unsigned*)(ldst + it * 1024), 16, 0, 0);
}
constexpr int ATT_LUT_BYTES = 10 * 2048;
DI void att_build_lut(LAS unsigned char* lut, int tid) {
    for (int idx = tid; idx < 10 * 64 * 8; idx += NWAVES * 64) {
        const int type = idx >> 9, rem = idx & 511, ln = rem >> 3, pair = rem & 7, q = ln & 31, hh = ln >> 5;
        const int d0 = type < 6 ? 32 * type : 32 * (type & 1);
        unsigned w = 0;
#pragma unroll
        for (int k = 0; k < 2; ++k) {
            const int e = 2 * pair + k, d = d0 + q - 4 * hh - ((e & 3) + 8 * (e >> 2));
            int c;
            if (type < 6) c = (d >= 0 && d <= 128 ? 1 : 0) + (d >= 0 && (d & 3) == 0 ? 1 : 0) + (d >= 0 && d <= 32 ? 1 : 0);
            else if (type < 8) c = (d >= 0 && d <= 31) ? 1 : 0;
            else c = (d >= 1 && d <= 32) ? 1 : 0;
            const unsigned bits = c == 0 ? 0xFF80u : (c == 1 ? 0x0000u : (c == 2 ? 0x3F80u : 0x3FCBu));
            w |= bits << (16 * k);
        }
        *(LAS unsigned*)(lut + type * 2048 + (pair >> 2) * 1024 + ln * 16 + (pair & 3) * 4) = w;
    }
}
constexpr int AT_RING = RING_OFF, AT_STAGE = 16384, AT_OUT = RING_OFF + ATT_STAGES * AT_STAGE, AT_TAB = SCR_OFF + ATT_LUT_BYTES;
static_assert(AT_OUT + NWAVES * 4096 <= RING_OFF + RING_BYTES && AT_TAB + (ATT_NSLOT0 + ATT_NSLOT1) * 24 <= SCR_OFF + SCR_BYTES, "attention LDS map");
DI void attn_items(Frame& F, int qword0, const bf16* QB, const bf16* KB, const bf16* VB, bf16* MIX) {
    const int lane = F.lane, w = F.wave;
    const int q = lane & 31, hh = lane >> 5;
    LAS unsigned char* lut = F.lds + SCR_OFF;
    LAS unsigned char* ring = F.lds + AT_RING;
    const unsigned prow = 4u * (unsigned)w + ((unsigned)lane >> 4), pvoff = prow * 3072u + (((unsigned)lane & 15u) ^ swz_b(prow)) * 16u;
    const unsigned qi = (lane & 15) >> 2, pp = lane & 3, g16 = (lane >> 4) & 1;
    const unsigned swl = 16u * swz_b((unsigned)q), rowb_l = 256u * (unsigned)q;
    unsigned tp[2];
#pragma unroll
    for (int t = 0; t < 2; ++t) tp[t] = 2048u * t + 1024u * hh + 256u * qi + 8u * (pp & 1) + 16u * ((2u * g16 + (pp >> 1)) ^ ((2u * t + hh) & 3u));
    int qsel = (int)(xb_xcc_id() & 7u), tries = 0;
    auto fetch = [&]() -> unsigned {
        while (tries < 8) {
            const unsigned u = xb_add((unsigned*)(F.ctl + qword0 + 64 * qsel), 1u);
            if (u < 96u) return ((unsigned)qsel << 8) | u;
            qsel = (qsel + 1) & 7; ++tries;
        }
        return 0xFFFFFFFFu; };
    auto load_tile = [&](unsigned le, int r, const unsigned char* kbase, const unsigned char* vbase) {
        const unsigned st = (le >> 10) & 7u, kind = (le >> 8) & 3u, k = le & 15u; const unsigned rc = (unsigned)(r + kind) & 3u;
        const size_t goff = (size_t)(rc * 512u + 32u * k) * 3072u;
        LAS unsigned char* dst = ring + st * AT_STAGE + w * 1024;
        __builtin_amdgcn_global_load_lds((const unsigned*)(kbase + goff + pvoff), (LAS unsigned*)dst, 16, 0, 0);
        __builtin_amdgcn_global_load_lds((const unsigned*)(vbase + goff + pvoff), (LAS unsigned*)(dst + 8192), 16, 0, 0); };
    auto load_row = [&](unsigned ev, int r, const unsigned char* kbase, const unsigned char* vbase) {
#pragma unroll
        for (int j = 0; j < 3; ++j) { const unsigned le = (unsigned)__builtin_amdgcn_readlane((int)ev, j); if (le & 0x8000u) load_tile(le, r, kbase, vbase); } };
#define AT_SLOT_END() do { asm volatile("s_waitcnt vmcnt(0)\n\ts_waitcnt lgkmcnt(0)" ::: "memory"); __builtin_amdgcn_s_barrier(); asm volatile("" ::: "memory"); } while (0)
    if (F.tid == 0) F.MISC[4] = fetch();
    __syncthreads();
    unsigned code = F.MISC[4];
    if (code == 0xFFFFFFFFu) return;
    bf16x8 qf[8];
    int b, h, r, pass, ib; const LAS unsigned short* tab; int nslot; const unsigned char* kbase; const unsigned char* vbase;
    auto decode = [&](unsigned c) { const int u = (int)(c & 255u), qs = (int)(c >> 8); pass = u >= 48 ? 1 : 0; const int idx = u - 48 * pass; b = qs; h = idx >> 2; r = idx & 3;
        ib = pass ? ATT_BLK1[w] : ATT_BLK0[w]; tab = (const LAS unsigned short*)(F.lds + AT_TAB) + (pass ? ATT_NSLOT0 * 12 : 0); nslot = pass ? ATT_NSLOT1 : ATT_NSLOT0;
        kbase = (const unsigned char*)(KB + (size_t)b * 2048 * 1536 + h * 128); vbase = (const unsigned char*)(VB + (size_t)b * 2048 * 1536 + h * 128); };
    auto load_q = [&]() { const bf16* qp = QB + ((size_t)b * 2048 + r * 512 + 32 * ib + q) * 1536 + h * 128 + 8 * hh;
#pragma unroll
        for (int ks = 0; ks < 8; ++ks) asm volatile("global_load_dwordx4 %0, %1, off" : "=&v"(qf[ks]) : "v"(qp + 16 * ks) : "memory"); };
    decode(code);
    f32x16 o[4]; float mrun = -1e30f, lsum = 0.f;
    int ob_ = 0, oh = 0, orr = 0, oib = 0; bool have_prev = false;
    auto finalize = [&]() {
            lsum = xhalf_sum(lsum);
            const float inv = 1.0f / lsum;
            LAS unsigned char* og = F.lds + AT_OUT + w * 4096;
            unsigned char* ob = (unsigned char*)(MIX + ((size_t)ob_ * 2048 + 4 * 32 * oib + orr) * 2048 + oh * 128);
#pragma unroll
            for (int hf = 0; hf < 2; ++hf) {
#pragma unroll
                for (int cl = 0; cl < 2; ++cl)
#pragma unroll
                    for (int g = 0; g < 4; ++g) {
                        const int c = 2 * hf + cl;
                        u32x2 wv; wv.x = cvtpk(o[c][4 * g] * inv, o[c][4 * g + 1] * inv); wv.y = cvtpk(o[c][4 * g + 2] * inv, o[c][4 * g + 3] * inv);
                        *(LAS u32x2*)(og + 128u * (unsigned)q + 16u * ((unsigned)(4 * cl + g) ^ ((unsigned)q & 7u)) + 8u * hh) = wv;
                    }
                asm volatile("s_waitcnt lgkmcnt(0)" ::: "memory");
#pragma unroll
                for (int it = 0; it < 4; ++it) {
                    const unsigned row = 8 * it + (lane >> 3), ch = lane & 7;
                    const u32x4 v = *(const LAS u32x4*)(og + 128u * row + 16u * (ch ^ (row & 7u)));
                    *(GAS u32x4*)(ob + (size_t)row * 16384 + hf * 128 + ch * 16) = v;
                }
                asm volatile("s_waitcnt lgkmcnt(0)" ::: "memory");
            }
    };
    for (;;) {
        load_row(tab[lane < 12 ? lane : 11], r, kbase, vbase);
        if (have_prev) finalize();
        load_q();
        AT_SLOT_END();
        unsigned nxt = 0xFFFFFFFFu; if (F.tid == 0) nxt = fetch();
#pragma unroll
        for (int c = 0; c < 4; ++c)
#pragma unroll
            for (int e = 0; e < 16; ++e) o[c][e] = 0.f;
        mrun = -1e30f; lsum = 0.f;
        unsigned evn = tab[12 + (lane < 12 ? lane : 11)];
        for (int u = 1; u < nslot; ++u) {
            const unsigned ev = evn; evn = tab[(u + 1) * 12 + (lane < 12 ? lane : 11)];
            const unsigned ce = (unsigned)__builtin_amdgcn_readlane((int)ev, 3 + w);
            load_row(ev, r, kbase, vbase);
            if (ce & 0x8000u) {
                const unsigned st = (ce >> 10) & 7u, kind = (ce >> 8) & 3u, k = ce & 15u; const int d = ib - (int)k;
                const unsigned rc = (unsigned)(r + kind) & 3u;
                const int ty = kind == 0 ? (d < 5 ? d : 5) : ((unsigned)r > rc ? 6 : 8) + d;
                LAS unsigned char* Kt = ring + st * AT_STAGE; LAS unsigned char* Vt = Kt + 8192;
                const u32x4 bw0 = *(const LAS u32x4*)(lut + ty * 2048 + lane * 16), bw1 = *(const LAS u32x4*)(lut + ty * 2048 + 1024 + lane * 16);
                bf16x8 kf[8];
#pragma unroll
                for (int ks = 0; ks < 8; ++ks) kf[ks] = lds_b128(Kt + rowb_l + ((unsigned)(32 * ks + 16 * hh) ^ swl));
                f32x16 s;
#pragma unroll
                for (int e = 0; e < 16; ++e) s[e] = 0.f;
#pragma unroll
                for (int ks = 0; ks < 8; ++ks) s = MFMA32(kf[ks], qf[ks], s);
                s16x4 vlo[4][2], vhi[4][2];
#pragma unroll
                for (int c = 0; c < 4; ++c) {
                    const unsigned xc = 64u * ((unsigned)c ^ qi), a0 = (unsigned)(size_t)Vt + tp[0] + xc, a1 = (unsigned)(size_t)Vt + tp[1] + xc;
                    asm volatile("ds_read_b64_tr_b16 %0, %1" : "=&v"(vlo[c][0]) : "v"(a0) : "memory");
                    asm volatile("ds_read_b64_tr_b16 %0, %1" : "=&v"(vhi[c][0]) : "v"(a1) : "memory");
                    asm volatile("ds_read_b64_tr_b16 %0, %1 offset:4096" : "=&v"(vlo[c][1]) : "v"(a0) : "memory");
                    asm volatile("ds_read_b64_tr_b16 %0, %1 offset:4096" : "=&v"(vhi[c][1]) : "v"(a1) : "memory");
                }
                s[0] += bf_lo(bw0.x); s[1] += bf_hi(bw0.x); s[2] += bf_lo(bw0.y); s[3] += bf_hi(bw0.y); s[4] += bf_lo(bw0.z); s[5] += bf_hi(bw0.z); s[6] += bf_lo(bw0.w); s[7] += bf_hi(bw0.w);
                s[8] += bf_lo(bw1.x); s[9] += bf_hi(bw1.x); s[10] += bf_lo(bw1.y); s[11] += bf_hi(bw1.y); s[12] += bf_lo(bw1.z); s[13] += bf_hi(bw1.z); s[14] += bf_lo(bw1.w); s[15] += bf_hi(bw1.w);
                float mx = fmaxf(fmaxf(fmaxf(s[0], s[1]), fmaxf(s[2], s[3])), fmaxf(fmaxf(s[4], s[5]), fmaxf(s[6], s[7])));
                mx = fmaxf(mx, fmaxf(fmaxf(fmaxf(s[8], s[9]), fmaxf(s[10], s[11])), fmaxf(fmaxf(s[12], s[13]), fmaxf(s[14], s[15]))));
                mx = xhalf_max(mx);
                const float mnew = fmaxf(mrun, mx), alpha = __builtin_amdgcn_exp2f(mrun - mnew);
                float ps = 0.f;
#pragma unroll
                for (int e = 0; e < 16; ++e) { s[e] = __builtin_amdgcn_exp2f(s[e] - mnew); ps += s[e]; }
                lsum = lsum * alpha + ps;
                if (__any(mnew > mrun)) {
#pragma unroll
                    for (int c = 0; c < 4; ++c)
#pragma unroll
                        for (int e = 0; e < 16; ++e) o[c][e] *= alpha;
                }
                mrun = mnew;
                const bf16x8 pf0 = pack8(s[0], s[1], s[2], s[3], s[4], s[5], s[6], s[7]), pf1 = pack8(s[8], s[9], s[10], s[11], s[12], s[13], s[14], s[15]);
                asm volatile("s_waitcnt lgkmcnt(0)" ::: "memory");
                __builtin_amdgcn_sched_barrier(0);
#pragma unroll
                for (int c = 0; c < 4; ++c) {
                    o[c] = MFMA32(__builtin_shufflevector(vlo[c][0], vhi[c][0], 0, 1, 2, 3, 4, 5, 6, 7), pf0, o[c]);
                    o[c] = MFMA32(__builtin_shufflevector(vlo[c][1], vhi[c][1], 0, 1, 2, 3, 4, 5, 6, 7), pf1, o[c]);
                }
            }
            if (u == nslot - 1 && F.tid == 0) F.MISC[4] = nxt;
            AT_SLOT_END();
        }
        const unsigned code_n = F.MISC[4];
        ob_ = b; oh = h; orr = r; oib = ib; have_prev = true;
        if (code_n == 0xFFFFFFFFu) break;
        decode(code_n);
    }
    finalize();
#undef AT_SLOT_END
}
constexpr int CV_NB1 = DM / 32, CV_NB2 = UPW / 32, CV_NB3 = DM / 32, CV_I1 = (DM / 64) * CV_NB1, CV_I2 = (DM / 64) * CV_NB2, CV_I3 = (DFF / 64) * CV_NB3;
constexpr int CV_EARLY = 0;
DI void convert_range(Frame& F, LAS float* scr, const float* w_out, const float* w_up, const float* g2, const float* w_down, int lo, int hi, int cw0, int cwn) {
    bf16* Wout = (bf16*)(F.ws + WS_WOUT); bf16* Wup = (bf16*)(F.ws + WS_WUP); bf16* Wdn = (bf16*)(F.ws + WS_WDN);
    auto clampi = [](int v, int a, int b) { return v < a ? a : (v > b ? b : v); };
    { const int a = clampi(lo, 0, CV_I1), b = clampi(hi, 0, CV_I1); if (b > a) transpose_items<1, false, true>(w_out, nullptr, DM, DM, Wout, scr, a + cw0, cwn, b, CV_NB1, F.lane); }
    { const int a = clampi(lo - CV_I1, 0, CV_I2), b = clampi(hi - CV_I1, 0, CV_I2); if (b > a) transpose_items<2, true, true>(w_up, g2, DM, UPW, Wup, scr, a + cw0, cwn, b, CV_NB2, F.lane); }
    { const int a = clampi(lo - CV_I1 - CV_I2, 0, CV_I3), b = clampi(hi - CV_I1 - CV_I2, 0, CV_I3); if (b > a) transpose_items<3, false, true>(w_down, nullptr, DFF, DM, Wdn, scr, a + cw0, cwn, b, CV_NB3, F.lane); }
}
constexpr int ML_SPLIT = 11;
constexpr int ML_WGS = 2 * BATCH * NMH;
DI void attn_phase(Frame& F, int qword0, const float* w_out, const float* w_up, const float* g2, const float* w_down, bool skip_conv) {
    const bf16* QB = (const bf16*)(F.ws + WS_QB); const bf16* KB = (const bf16*)(F.ws + WS_KB); const bf16* VB = (const bf16*)(F.ws + WS_VB); bf16* MIX = (bf16*)(F.ws + WS_MIX);
    if (!skip_conv)
        convert_range(F, (LAS float*)(F.lds + RING_OFF + F.wave * 16384), w_out, w_up, g2, w_down, F.G == 256 ? CV_EARLY : 0, CV_I1 + CV_I2 + CV_I3, ((int)blockIdx.x - ML_WGS) * NWAVES + F.wave, (F.G - ML_WGS) * NWAVES);
    __syncthreads();
    att_build_lut(F.lds + SCR_OFF, F.tid);
    for (int i = F.tid; i < (ATT_NSLOT0 + ATT_NSLOT1) * 12; i += NWAVES * 64) ((LAS unsigned short*)(F.lds + AT_TAB))[i] = ATT_SCHED[i / 12][i % 12];
    __syncthreads();
    attn_items(F, qword0, QB, KB, VB, MIX);
}

DI float scan_add64(float v, int lane) {
#pragma unroll
    for (int d = 1; d < 64; d <<= 1) { const float t = __shfl_up(v, d); if (lane >= d) v += t; }
    return v;
}
DI float scan_max64(float v, int lane) {
#pragma unroll
    for (int d = 1; d < 64; d <<= 1) { const float t = __shfl_up(v, d); if (lane >= d) v = fmaxf(v, t); }
    return v;
}
DI float silu_f(float y) { return y * __builtin_amdgcn_rcpf(1.0f + __builtin_amdgcn_exp2f(-LOG2E * y)); }
DI void mixer_prepass(Frame& F, const float* mcw, const float* mcb) {
    const bf16* ML = (const bf16*)(F.ws + WS_ML); bf16* MLC = (bf16*)(F.ws + WS_MLC); const float* G = (const float*)(F.ws + WS_G); float* GA = (float*)(F.ws + WS_GA);
    const int gw = F.vcu * NWAVES + F.wave, NGW = F.G * NWAVES;
    for (int it = gw; it < 32 * 16; it += NGW) {
        const int seq = it >> 4, ch = it & 15, b = seq >> 2, hm = seq & 3; const size_t mrow0 = (size_t)b * 2048 + ch * 128;
        const float gi0 = G[(mrow0 + F.lane) * 8 + hm], gf0 = G[(mrow0 + F.lane) * 8 + 4 + hm], gi1 = G[(mrow0 + 64 + F.lane) * 8 + hm], gf1 = G[(mrow0 + 64 + F.lane) * 8 + 4 + hm];
        const float lf0 = fminf(gf0, 0.f) - log1pf(expf(-fabsf(gf0))), lf1 = fminf(gf1, 0.f) - log1pf(expf(-fabsf(gf1)));
        const float b0 = scan_add64(lf0, F.lane); const float tot0 = __shfl(b0, 63); const float b1 = scan_add64(lf1, F.lane) + tot0;
        const float a0 = gi0 - b0, a1 = gi1 - b1;
        const float cm0 = scan_max64(a0, F.lane); const float M0 = __shfl(cm0, 63); const float cm1 = fmaxf(scan_max64(a1, F.lane), M0);
        float* o = GA + (size_t)it * 384;
        o[F.lane] = b0; o[64 + F.lane] = b1; o[128 + F.lane] = a0; o[192 + F.lane] = a1; o[256 + F.lane] = cm0; o[320 + F.lane] = cm1;
    }
    for (int it = gw * 64 + F.lane; it < (M / 4) * 128; it += NGW * 64) {
        const int c8 = it & 127, r4 = it >> 7, m0 = 4 * r4, t0 = m0 & 2047, ch0 = 8 * c8;
        u32x4 raw[7];
#pragma unroll
        for (int i = 0; i < 7; ++i) { u32x4 rv = *(const GAS u32x4*)(ML + (size_t)(m0 - 3 + i) * 2048 + ch0); if (t0 - 3 + i < 0) rv = (u32x4){0u, 0u, 0u, 0u}; raw[i] = rv; }
        float wt[5][8];
#pragma unroll
        for (int tap = 0; tap < 5; ++tap) { const float* wp = tap < 4 ? mcw + tap * 1024 + ch0 : mcb + ch0; const f32x4 a = *(const f32x4*)wp, bq = *(const f32x4*)(wp + 4);
            wt[tap][0] = a[0]; wt[tap][1] = a[1]; wt[tap][2] = a[2]; wt[tap][3] = a[3]; wt[tap][4] = bq[0]; wt[tap][5] = bq[1]; wt[tap][6] = bq[2]; wt[tap][7] = bq[3]; }
        const float osc = ch0 >= 512 ? 0.08838834764831845f : 1.0f;
#pragma unroll
        for (int rho = 0; rho < 4; ++rho) {
            float y[8];
#pragma unroll
            for (int j = 0; j < 8; ++j) y[j] = wt[4][j];
#pragma unroll
            for (int tap = 0; tap < 4; ++tap) { const u32x4 x = raw[rho + tap];
                y[0] += wt[tap][0] * bf_lo(x.x); y[1] += wt[tap][1] * bf_hi(x.x); y[2] += wt[tap][2] * bf_lo(x.y); y[3] += wt[tap][3] * bf_hi(x.y);
                y[4] += wt[tap][4] * bf_lo(x.z); y[5] += wt[tap][5] * bf_hi(x.z); y[6] += wt[tap][6] * bf_lo(x.w); y[7] += wt[tap][7] * bf_hi(x.w); }
#pragma unroll
            for (int j = 0; j < 8; ++j) y[j] = silu_f(y[j]) * osc;
            *(GAS bf16x8*)(MLC + (size_t)(m0 + rho) * 1024 + ch0) = pack8(y[0], y[1], y[2], y[3], y[4], y[5], y[6], y[7]);
        }
    }
}

constexpr int ML_Q = 0, ML_K = 32768, ML_V = 65536, ML_C = 98304;
constexpr int MS_A = 0, MS_U = 512, MS_WI = 1024, MS_WK = 1536, MS_EM = 2048, MS_NV = 2560, MS_GV = 3072, MS_CW = 3584, MS_NR = 8704, MS_RS = 12800, MS_SC = 13824;
DI void mlstm_seq(Frame& F, int b, int hm, const float* mng, int c0, int c1) {
    LAS unsigned char* L = F.lds + RING_OFF; LAS unsigned char* S = F.lds + SCR_OFF;
    LAS float* A_ = (LAS float*)(S + MS_A); LAS float* U_ = (LAS float*)(S + MS_U); LAS float* WI = (LAS float*)(S + MS_WI); LAS float* WK = (LAS float*)(S + MS_WK); LAS float* EM = (LAS float*)(S + MS_EM);
    LAS float* NV = (LAS float*)(S + MS_NV); LAS float* GV = (LAS float*)(S + MS_GV); LAS float* CW = (LAS float*)(S + MS_CW); LAS float* NR = (LAS float*)(S + MS_NR); LAS float* RS = (LAS float*)(S + MS_RS); LAS float* SC = (LAS float*)(S + MS_SC);
    const int w = F.wave;
    const bf16* ML = (const bf16*)(F.ws + WS_ML); const bf16* MLC = (const bf16*)(F.ws + WS_MLC); const float* GA = (const float*)(F.ws + WS_GA) + (size_t)(b * 4 + hm) * 16 * 384; bf16* MIX = (bf16*)(F.ws + WS_MIX);
    if (F.tid < 128) { GV[F.tid] = mng[hm * 128 + F.tid]; NV[F.tid] = 0.f; }
    for (int i = F.tid; i < 32768 / 16; i += 512) *(LAS u32x4*)(L + ML_C + 16 * i) = (u32x4){0u, 0u, 0u, 0u};
    f32x16 Cacc[2];
#pragma unroll
    for (int i = 0; i < 2; ++i)
#pragma unroll
        for (int e = 0; e < 16; ++e) Cacc[i][e] = 0.f;
    float mc = 0.f;
    const int tb = (w & 3) ^ (3 * (w >> 2)), eh = w >> 2;
    const int ebF = w >> 1, dbF0 = 2 * (w & 1);
#define ML_BAR() do { asm volatile("s_waitcnt lgkmcnt(0)" ::: "memory"); __builtin_amdgcn_s_barrier(); asm volatile("" ::: "memory"); } while (0)
#define ML_OPAQUE_TID(name) int name = F.tid; asm volatile("" : "+v"(name))
#define ML_THREAD_MAP(tidv) const int c16 = (tidv) & 15, rg = (tidv) >> 4; const unsigned rg16 = 16u * rg, c32 = 32u * c16; unsigned sa[4]; \
        _Pragma("unroll") for (int rho = 0; rho < 4; ++rho) sa[rho] = 1024u * rg + 256u * rho + 64u * (((unsigned)c16 >> 2) ^ (unsigned)rho) + 16u * (((unsigned)c16 & 3u) ^ ((unsigned)rg & 3u))
#define ML_LANE_MAP(tidv) const int lane = (tidv) & 63, hh = lane >> 5, l31 = lane & 31; const unsigned qi = (lane & 15) >> 2, pp = lane & 3, g16 = (lane >> 4) & 1; \
        const unsigned swl_ = 16u * swz_b((unsigned)l31), rowb_ = 256u * (unsigned)l31, hh8 = 8u * hh, hh16 = 16u * hh; unsigned tn[2], tp[2]; \
        _Pragma("unroll") for (int t = 0; t < 2; ++t) { tn[t] = 2048u * hh + 1024u * t + 256u * qi + 8u * (pp & 1) + 16u * ((2u * g16 + (pp >> 1)) ^ ((2u * hh + t) & 3u)); \
                                                       tp[t] = 2048u * t + 1024u * hh + 256u * qi + 8u * (pp & 1) + 16u * ((2u * g16 + (pp >> 1)) ^ ((2u * t + hh) & 3u)); }
#define SF(off) (*(LAS float*)(S + (off)))
#define SF4(off) (*(const LAS f32x4*)(S + (off)))
    u32x4 rq[4], rk_[4], rv4[4]; float pgt[6] = {0.f, 0.f, 0.f, 0.f, 0.f, 0.f};
    {
        const int c16 = F.tid & 15, rg = F.tid >> 4;
        const unsigned char* cq0 = (const unsigned char*)MLC + (size_t)b * 2048 * 2048 + 8192u * rg + 256u * hm + 16u * c16;
        const unsigned char* cv0 = (const unsigned char*)ML + (size_t)b * 2048 * 4096 + 16384u * rg + 2048 + 256u * hm + 16u * c16;
#pragma unroll
        for (int rho = 0; rho < 4; ++rho) { rk_[rho] = *(const GAS u32x4*)(cq0 + rho * 2048 + 1024); rv4[rho] = *(const GAS u32x4*)(cv0 + rho * 4096); }
        if (w == 0) {
#pragma unroll
            for (int i = 0; i < 6; ++i) pgt[i] = GA[64 * i + F.lane]; }
    }
    __syncthreads();
    for (int ch = 0; ch < c0; ++ch) {
        {
        ML_OPAQUE_TID(tidA); ML_THREAD_MAP(tidA);
#pragma unroll
        for (int rho = 0; rho < 4; ++rho) { *(LAS u32x4*)(lp(sa[rho]) + ML_K) = rk_[rho]; *(LAS u32x4*)lp(sa[rho] + ML_V) = rv4[rho]; }
        }
        if (w == 0) {
            ML_OPAQUE_TID(tidB); const int lane = tidB & 63; const unsigned l4 = 4u * lane;
            const float b1 = pgt[1], a0 = pgt[2], a1 = pgt[3], cm1 = pgt[5];
            const float Mall = __shfl(cm1, 63), blast = __shfl(b1, 63), mxa = fmaxf(mc, Mall);
            SF(MS_WK + l4) = __builtin_amdgcn_exp2f(LOG2E * (a0 - mxa)); SF(MS_WK + 256 + l4) = __builtin_amdgcn_exp2f(LOG2E * (a1 - mxa));
            if (lane == 0) SC[0] = __builtin_amdgcn_exp2f(LOG2E * (mc - mxa));
            mc = blast + mxa;
        }
        ML_BAR();
        {
            ML_OPAQUE_TID(tidP); const int c16 = tidP & 15, rg = tidP >> 4;
            int cn = ch + 1; asm volatile("" : "+s"(cn));
            const unsigned char* cq1 = (const unsigned char*)MLC + ((size_t)b * 2048 + cn * 128) * 2048 + 8192u * rg + 256u * hm + 16u * c16;
            const unsigned char* cv1 = (const unsigned char*)ML + ((size_t)b * 2048 + cn * 128) * 4096 + 16384u * rg + 2048 + 256u * hm + 16u * c16;
#pragma unroll
            for (int rho = 0; rho < 4; ++rho) { rk_[rho] = *(const GAS u32x4*)(cq1 + rho * 2048 + 1024); rv4[rho] = *(const GAS u32x4*)(cv1 + rho * 4096); }
            if (w == 0) { const float* ga1 = GA + cn * 384 + (tidP & 63);
#pragma unroll
                for (int i = 0; i < 6; ++i) pgt[i] = ga1[64 * i]; }
        }
        {
            ML_OPAQUE_TID(tidK); ML_THREAD_MAP(tidK); const int lane = tidK & 63;
            float ps[8] = {0.f, 0.f, 0.f, 0.f, 0.f, 0.f, 0.f, 0.f};
#pragma unroll
            for (int rho = 0; rho < 4; ++rho) {
                const float wk = SF(MS_WK + 4 * rho + rg16); const u32x4 kk = *(const LAS u32x4*)(lp(sa[rho]) + ML_K);
                const float v0 = bf_lo(kk.x) * wk, v1 = bf_hi(kk.x) * wk, v2 = bf_lo(kk.y) * wk, v3 = bf_hi(kk.y) * wk, v4 = bf_lo(kk.z) * wk, v5 = bf_hi(kk.z) * wk, v6 = bf_lo(kk.w) * wk, v7 = bf_hi(kk.w) * wk;
                ps[0] += v0; ps[1] += v1; ps[2] += v2; ps[3] += v3; ps[4] += v4; ps[5] += v5; ps[6] += v6; ps[7] += v7;
                *(LAS bf16x8*)(lp(sa[rho]) + ML_Q) = pack8(v0, v1, v2, v3, v4, v5, v6, v7);
            }
#pragma unroll
            for (int j = 0; j < 8; ++j) { ps[j] += __shfl_xor(ps[j], 16); ps[j] += __shfl_xor(ps[j], 32); }
            if ((lane >> 4) == 0) {
#pragma unroll
                for (int j = 0; j < 8; ++j) SF(MS_NR + 512 * w + 4 * j + c32) = ps[j];
            }
        }
        ML_BAR();
        {
        const float decay = SC[0];
        ML_OPAQUE_TID(tidF); const unsigned t4 = 4u * tidF;
        if (tidF < 128) { float a = 0.f;
#pragma unroll
            for (int ww = 0; ww < 8; ++ww) a += SF(MS_NR + 512 * ww + t4);
            SF(MS_NV + t4) = decay * SF(MS_NV + t4) + a; }
#pragma unroll
        for (int i = 0; i < 2; ++i)
#pragma unroll
            for (int e = 0; e < 16; ++e) Cacc[i][e] *= decay;
        ML_LANE_MAP(tidF);
        const unsigned xc_eF = 64u * ((unsigned)ebF ^ qi), xc_d0 = 64u * ((unsigned)dbF0 ^ qi), xc_d1 = 64u * ((unsigned)(dbF0 + 1) ^ qi);
        const unsigned aF0 = ML_V + tn[0] + xc_eF, aF1 = ML_V + tn[1] + xc_eF, aK00 = ML_Q + tn[0] + xc_d0, aK01 = ML_Q + tn[1] + xc_d0, aK10 = ML_Q + tn[0] + xc_d1, aK11 = ML_Q + tn[1] + xc_d1;
        bf16x8 af[8];
#pragma unroll
        for (int ks = 0; ks < 8; ++ks) { const s16x4 alo = lds_tr(lp(aF0) + 4096 * ks), ahi = lds_tr(lp(aF1) + 4096 * ks); af[ks] = __builtin_shufflevector(alo, ahi, 0, 1, 2, 3, 4, 5, 6, 7); }
#pragma unroll
        for (int i = 0; i < 2; ++i) {
            bf16x8 bk[8];
#pragma unroll
            for (int ks = 0; ks < 8; ++ks) { const s16x4 blo = lds_tr(lp(i ? aK10 : aK00) + 4096 * ks), bhi = lds_tr(lp(i ? aK11 : aK01) + 4096 * ks); bk[ks] = __builtin_shufflevector(blo, bhi, 0, 1, 2, 3, 4, 5, 6, 7); }
#pragma unroll
            for (int ks = 0; ks < 8; ++ks) Cacc[i] = MFMA32(af[ks], bk[ks], Cacc[i]);
        }
        }
        ML_BAR();
    }
    if (c0 > 0) {
        ML_OPAQUE_TID(tidW); ML_LANE_MAP(tidW);
#pragma unroll
        for (int i = 0; i < 2; ++i)
#pragma unroll
            for (int g = 0; g < 4; ++g) {
                u32x2 wv; wv.x = cvtpk(Cacc[i][4 * g], Cacc[i][4 * g + 1]); wv.y = cvtpk(Cacc[i][4 * g + 2], Cacc[i][4 * g + 3]);
                *(LAS u32x2*)lp(rowb_ + ((unsigned)(16 * (4 * ebF + g)) ^ swl_) + hh8 + ML_C + 8192u * (dbF0 + i)) = wv;
            }
    }
    {
        const int c16 = F.tid & 15, rg = F.tid >> 4;
        const unsigned char* cq0 = (const unsigned char*)MLC + ((size_t)b * 2048 + c0 * 128) * 2048 + 8192u * rg + 256u * hm + 16u * c16;
#pragma unroll
        for (int rho = 0; rho < 4; ++rho) rq[rho] = *(const GAS u32x4*)(cq0 + rho * 2048);
    }
    __syncthreads();
    for (int ch = c0; ch < c1; ++ch) {
        int t0 = ch * 128; asm volatile("" : "+s"(t0));
        const size_t mrow0 = (size_t)b * 2048 + t0;
        const unsigned char* cb0 = (const unsigned char*)ML + mrow0 * 4096;
        unsigned char* mb0 = (unsigned char*)MIX + mrow0 * 4096;
        {
        ML_OPAQUE_TID(tidA); ML_THREAD_MAP(tidA);
#pragma unroll
        for (int rho = 0; rho < 4; ++rho) { *(LAS u32x4*)(lp(sa[rho]) + ML_Q) = rq[rho]; *(LAS u32x4*)(lp(sa[rho]) + ML_K) = rk_[rho]; *(LAS u32x4*)lp(sa[rho] + ML_V) = rv4[rho]; }
        }
        __builtin_amdgcn_sched_barrier(0);
        if (w == 0) {
            ML_OPAQUE_TID(tidB); const int lane = tidB & 63; const unsigned l4 = 4u * lane;
            const float b0 = pgt[0], b1 = pgt[1], a0 = pgt[2], a1 = pgt[3], cm0 = pgt[4], cm1 = pgt[5];
            const float mx0 = fmaxf(mc, cm0), mx1 = fmaxf(mc, cm1);
            SF(MS_A + l4) = a0; SF(MS_A + 256 + l4) = a1; SF(MS_U + l4) = -mx0; SF(MS_U + 256 + l4) = -mx1;
            SF(MS_WI + l4) = __builtin_amdgcn_exp2f(LOG2E * (mc - mx0)); SF(MS_WI + 256 + l4) = __builtin_amdgcn_exp2f(LOG2E * (mc - mx1));
            SF(MS_EM + l4) = __builtin_amdgcn_exp2f(-LOG2E * (b0 + mx0)); SF(MS_EM + 256 + l4) = __builtin_amdgcn_exp2f(-LOG2E * (b1 + mx1));
            const float Mall = __shfl(cm1, 63), blast = __shfl(b1, 63), mxa = fmaxf(mc, Mall);
            SF(MS_WK + l4) = __builtin_amdgcn_exp2f(LOG2E * (a0 - mxa)); SF(MS_WK + 256 + l4) = __builtin_amdgcn_exp2f(LOG2E * (a1 - mxa));
            if (lane == 0) SC[0] = __builtin_amdgcn_exp2f(LOG2E * (mc - mxa));
            mc = blast + mxa;
        }
        ML_BAR();
        ML_OPAQUE_TID(tidC); ML_LANE_MAP(tidC);
        const unsigned tq4 = 4u * (32u * tb + l31);
        const unsigned voffO = 4096u * (32u * tb + l31) + 3072u + 256u * hm + 128u * eh + 8u * hh;
        unsigned rk[8];
#pragma unroll
        for (int ks = 0; ks < 8; ++ks) rk[ks] = rowb_ + ((unsigned)(32 * ks + 2 * hh8) ^ swl_);
        const unsigned xc_e0 = 64u * ((unsigned)(2 * eh) ^ qi), xc_e1 = 64u * ((unsigned)(2 * eh + 1) ^ qi);
        const unsigned aC00 = ML_C + tn[0] + xc_e0, aC01 = ML_C + tn[1] + xc_e0, aC10 = ML_C + tn[0] + xc_e1, aC11 = ML_C + tn[1] + xc_e1;
        const unsigned aV00 = ML_V + tp[0] + xc_e0, aV01 = ML_V + tp[1] + xc_e0, aV10 = ML_V + tp[0] + xc_e1, aV11 = ML_V + tp[1] + xc_e1;
        __builtin_amdgcn_sched_barrier(0);
        const int tq = 32 * tb + l31;
        const unsigned qoff = ML_Q + 8192u * tb;
        const float ut = SF(MS_U + tq4), wint = SF(MS_WI + tq4), emt = SF(MS_EM + tq4);
        bf16x8 qf[8];
#pragma unroll
        for (int ks = 0; ks < 8; ++ks) qf[ks] = lds_b128(lp(rk[ks] + qoff));
        f32x16 acc[2];
#pragma unroll
        for (int c = 0; c < 2; ++c) {
            __builtin_amdgcn_sched_barrier(0);
            bf16x8 cf[8];
#pragma unroll
            for (int ks = 0; ks < 8; ++ks) {
                const s16x4 lo = lds_tr(lp(c ? aC10 : aC00) + 4096 * ks);
                const s16x4 hi = lds_tr(lp(c ? aC11 : aC01) + 4096 * ks);
                cf[ks] = __builtin_shufflevector(lo, hi, 0, 1, 2, 3, 4, 5, 6, 7);
            }
#pragma unroll
            for (int e = 0; e < 16; ++e) acc[c][e] = 0.f;
#pragma unroll
            for (int ks = 0; ks < 8; ++ks) acc[c] = MFMA32(cf[ks], qf[ks], acc[c]);
#pragma unroll
            for (int e = 0; e < 16; ++e) acc[c][e] *= wint;
        }
        float qn = 0.f;
#pragma unroll
        for (int ks = 0; ks < 8; ++ks) { const f32x4 n0 = SF4(MS_NV + 64 * ks + 2 * hh16), n1 = SF4(MS_NV + 64 * ks + 16 + 2 * hh16); const u32x4 qq = __builtin_bit_cast(u32x4, qf[ks]);
            qn += bf_lo(qq.x) * n0[0] + bf_hi(qq.x) * n0[1] + bf_lo(qq.y) * n0[2] + bf_hi(qq.y) * n0[3] + bf_lo(qq.z) * n1[0] + bf_hi(qq.z) * n1[1] + bf_lo(qq.w) * n1[2] + bf_hi(qq.w) * n1[3]; }
        __builtin_amdgcn_sched_barrier(0);
        u32x4 og[4];
        { ML_OPAQUE_TID(tidO); const unsigned char* co = cb0 + 3072 + 256u * hm + 16384u * (tidO >> 4) + 16u * (tidO & 15);
#pragma unroll
          for (int rho = 0; rho < 4; ++rho) og[rho] = *(const GAS u32x4*)(co + rho * 4096); }
        float sumP = 0.f;
#pragma unroll
        for (int sb = 0; sb < 4; ++sb) {
            if (sb <= tb) {
                __builtin_amdgcn_sched_barrier(0);
                f32x16 s; bf16x8 kf[8];
#pragma unroll
                for (int e = 0; e < 16; ++e) s[e] = 0.f;
#pragma unroll
                for (int ks = 0; ks < 8; ++ks) kf[ks] = lds_b128(lp(rk[ks]) + ML_K + 8192 * sb);
#pragma unroll
                for (int ks = 0; ks < 8; ++ks) s = MFMA32(kf[ks], qf[ks], s);
#pragma unroll
                for (int g = 0; g < 4; ++g) { const f32x4 av = SF4(MS_A + 4 * (32 * sb + 8 * g) + hh16);
#pragma unroll
                    for (int j = 0; j < 4; ++j) { const int e = 4 * g + j; float p = s[e] * __builtin_amdgcn_exp2f(LOG2E * (ut + av[j])); if (sb == tb && crow(e, hh) > l31) p = 0.f; s[e] = p; sumP += p; } }
                const bf16x8 pf0 = pack8(s[0], s[1], s[2], s[3], s[4], s[5], s[6], s[7]), pf1 = pack8(s[8], s[9], s[10], s[11], s[12], s[13], s[14], s[15]);
                __builtin_amdgcn_sched_barrier(0);
                bf16x8 vf[2][2];
#pragma unroll
                for (int c = 0; c < 2; ++c)
#pragma unroll
                    for (int s2 = 0; s2 < 2; ++s2) {
                        const s16x4 lo = lds_tr(lp(c ? aV10 : aV00) + 8192 * sb + 4096 * s2);
                        const s16x4 hi = lds_tr(lp(c ? aV11 : aV01) + 8192 * sb + 4096 * s2);
                        vf[c][s2] = __builtin_shufflevector(lo, hi, 0, 1, 2, 3, 4, 5, 6, 7);
                    }
#pragma unroll
                for (int c = 0; c < 2; ++c) { acc[c] = MFMA32(vf[c][0], pf0, acc[c]); acc[c] = MFMA32(vf[c][1], pf1, acc[c]); }
            }
        }
        qn += __shfl_xor(qn, 32); sumP += __shfl_xor(sumP, 32);
        const float den = wint * qn + sumP, rden = 1.0f / fmaxf(fabsf(den), emt);
        __builtin_amdgcn_sched_barrier(0);
        ML_BAR();
#pragma unroll
        for (int c = 0; c < 2; ++c)
#pragma unroll
            for (int g = 0; g < 4; ++g) {
                u32x2 wv; wv.x = cvtpk(acc[c][4 * g] * rden, acc[c][4 * g + 1] * rden); wv.y = cvtpk(acc[c][4 * g + 2] * rden, acc[c][4 * g + 3] * rden);
                *(LAS u32x2*)lp(ML_Q + 8192u * tb + rowb_ + ((unsigned)(16 * (4 * (2 * eh + c) + g)) ^ swl_) + hh8) = wv;
            }
        ML_BAR();
        {
            ML_OPAQUE_TID(tidE); ML_THREAD_MAP(tidE);
            const f32x4 g0 = SF4(MS_GV + c32), g1v = SF4(MS_GV + 16 + c32);
            unsigned char* mo = mb0 + 3072 + 256u * hm + 16384u * rg + 16u * c16;
#pragma unroll
            for (int rho = 0; rho < 4; ++rho) {
                const u32x4 hv = *(const LAS u32x4*)(lp(sa[rho]) + ML_Q); const u32x4 ov = og[rho];
                float h[8] = {bf_lo(hv.x), bf_hi(hv.x), bf_lo(hv.y), bf_hi(hv.y), bf_lo(hv.z), bf_hi(hv.z), bf_lo(hv.w), bf_hi(hv.w)};
                const float o[8] = {bf_lo(ov.x), bf_hi(ov.x), bf_lo(ov.y), bf_hi(ov.y), bf_lo(ov.z), bf_hi(ov.z), bf_lo(ov.w), bf_hi(ov.w)};
                float ssq = 0.f;
#pragma unroll
                for (int j = 0; j < 8; ++j) { h[j] *= __builtin_amdgcn_rcpf(1.0f + __builtin_amdgcn_exp2f(-LOG2E * o[j])); ssq += h[j] * h[j]; }
                ssq += __shfl_xor(ssq, 1); ssq += __shfl_xor(ssq, 2); ssq += __shfl_xor(ssq, 4); ssq += __shfl_xor(ssq, 8);
                const float rstd = 1.0f / sqrtf(ssq * (1.0f / 128.0f) + 1e-6f);
                u32x4 wv; wv.x = cvtpk(h[0] * rstd * g0[0], h[1] * rstd * g0[1]); wv.y = cvtpk(h[2] * rstd * g0[2], h[3] * rstd * g0[3]); wv.z = cvtpk(h[4] * rstd * g1v[0], h[5] * rstd * g1v[1]); wv.w = cvtpk(h[6] * rstd * g1v[2], h[7] * rstd * g1v[3]);
                *(GAS u32x4*)(mo + rho * 4096) = wv;
            }
        }
        __builtin_amdgcn_sched_barrier(0);
        __builtin_amdgcn_sched_barrier(0);
        {
            ML_OPAQUE_TID(tidP); const int c16 = tidP & 15, rg = tidP >> 4;
            int cn1 = (ch + 1 < c1 ? ch + 1 : ch); asm volatile("" : "+s"(cn1));
            const unsigned char* cq1 = (const unsigned char*)MLC + ((size_t)b * 2048 + cn1 * 128) * 2048 + 8192u * rg + 256u * hm + 16u * c16;
            const unsigned char* cv1 = (const unsigned char*)ML + ((size_t)b * 2048 + cn1 * 128) * 4096 + 16384u * rg + 2048 + 256u * hm + 16u * c16;
#pragma unroll
            for (int rho = 0; rho < 4; ++rho) { rk_[rho] = *(const GAS u32x4*)(cq1 + rho * 2048 + 1024); rv4[rho] = *(const GAS u32x4*)(cv1 + rho * 4096); }
        }
        __builtin_amdgcn_sched_barrier(0);
        {
            ML_OPAQUE_TID(tidK); ML_THREAD_MAP(tidK); const int lane = tidK & 63;
            float ps[8] = {0.f, 0.f, 0.f, 0.f, 0.f, 0.f, 0.f, 0.f};
#pragma unroll
            for (int rho = 0; rho < 4; ++rho) {
                const float wk = SF(MS_WK + 4 * rho + rg16); const u32x4 kk = *(const LAS u32x4*)(lp(sa[rho]) + ML_K);
                const float v0 = bf_lo(kk.x) * wk, v1 = bf_hi(kk.x) * wk, v2 = bf_lo(kk.y) * wk, v3 = bf_hi(kk.y) * wk, v4 = bf_lo(kk.z) * wk, v5 = bf_hi(kk.z) * wk, v6 = bf_lo(kk.w) * wk, v7 = bf_hi(kk.w) * wk;
                ps[0] += v0; ps[1] += v1; ps[2] += v2; ps[3] += v3; ps[4] += v4; ps[5] += v5; ps[6] += v6; ps[7] += v7;
                *(LAS bf16x8*)(lp(sa[rho]) + ML_Q) = pack8(v0, v1, v2, v3, v4, v5, v6, v7);
            }
#pragma unroll
            for (int j = 0; j < 8; ++j) { ps[j] += __shfl_xor(ps[j], 16); ps[j] += __shfl_xor(ps[j], 32); }
            if ((lane >> 4) == 0) {
#pragma unroll
                for (int j = 0; j < 8; ++j) SF(MS_NR + 512 * w + 4 * j + c32) = ps[j];
            }
        }
        ML_BAR();
        {
            ML_OPAQUE_TID(tidP2); const int c16 = tidP2 & 15, rg = tidP2 >> 4;
            int cn1 = (ch + 1 < c1 ? ch + 1 : ch); asm volatile("" : "+s"(cn1));
            const unsigned char* cq1 = (const unsigned char*)MLC + ((size_t)b * 2048 + cn1 * 128) * 2048 + 8192u * rg + 256u * hm + 16u * c16;
#pragma unroll
            for (int rho = 0; rho < 4; ++rho) rq[rho] = *(const GAS u32x4*)(cq1 + rho * 2048);
            if (w == 0) { const float* ga1 = GA + cn1 * 384 + (tidP2 & 63);
#pragma unroll
                for (int i = 0; i < 6; ++i) pgt[i] = ga1[64 * i]; }
        }
        __builtin_amdgcn_sched_barrier(0);
        const float decay = SC[0];
        ML_OPAQUE_TID(tidF); const unsigned t4 = 4u * tidF;
        if (tidF < 128) { float a = 0.f;
#pragma unroll
            for (int ww = 0; ww < 8; ++ww) a += SF(MS_NR + 512 * ww + t4);
            SF(MS_NV + t4) = decay * SF(MS_NV + t4) + a; }
#pragma unroll
        for (int i = 0; i < 2; ++i)
#pragma unroll
            for (int e = 0; e < 16; ++e) Cacc[i][e] *= decay;
        {
        ML_LANE_MAP(tidF);
        const unsigned xc_eF = 64u * ((unsigned)ebF ^ qi), xc_d0 = 64u * ((unsigned)dbF0 ^ qi), xc_d1 = 64u * ((unsigned)(dbF0 + 1) ^ qi);
        const unsigned aF0 = ML_V + tn[0] + xc_eF, aF1 = ML_V + tn[1] + xc_eF, aK00 = ML_Q + tn[0] + xc_d0, aK01 = ML_Q + tn[1] + xc_d0, aK10 = ML_Q + tn[0] + xc_d1, aK11 = ML_Q + tn[1] + xc_d1;
        unsigned cwr[4];
#pragma unroll
        for (int g = 0; g < 4; ++g) cwr[g] = rowb_ + ((unsigned)(16 * (4 * ebF + g)) ^ swl_) + hh8;
        bf16x8 af[8];
#pragma unroll
        for (int ks = 0; ks < 8; ++ks) {
            const s16x4 alo = lds_tr(lp(aF0) + 4096 * ks);
            const s16x4 ahi = lds_tr(lp(aF1) + 4096 * ks);
            af[ks] = __builtin_shufflevector(alo, ahi, 0, 1, 2, 3, 4, 5, 6, 7);
        }
#pragma unroll
        for (int i = 0; i < 2; ++i) {
            bf16x8 bk[8];
#pragma unroll
            for (int ks = 0; ks < 8; ++ks) {
                const s16x4 blo = lds_tr(lp(i ? aK10 : aK00) + 4096 * ks);
                const s16x4 bhi = lds_tr(lp(i ? aK11 : aK01) + 4096 * ks);
                bk[ks] = __builtin_shufflevector(blo, bhi, 0, 1, 2, 3, 4, 5, 6, 7);
            }
#pragma unroll
            for (int ks = 0; ks < 8; ++ks) Cacc[i] = MFMA32(af[ks], bk[ks], Cacc[i]);
        }
#pragma unroll
        for (int i = 0; i < 2; ++i)
#pragma unroll
            for (int g = 0; g < 4; ++g) {
                u32x2 wv; wv.x = cvtpk(Cacc[i][4 * g], Cacc[i][4 * g + 1]); wv.y = cvtpk(Cacc[i][4 * g + 2], Cacc[i][4 * g + 3]);
                *(LAS u32x2*)lp(cwr[g] + ML_C + 8192u * (dbF0 + i)) = wv;
            }
        }
        ML_BAR();
    }
}

DI void ffn_fixup(Frame& F, const float* cw, const float* cb) {
    const bf16* RAWB = (const bf16*)(F.ws + WS_RAW); bf16* ACT = (bf16*)(F.ws + WS_ACT);
    const int gt = (F.vcu * NWAVES + F.wave) * 64 + F.lane, NT = F.G * NWAVES * 64;
    auto ld4 = [](const bf16* p) { const u32x2 w = *(const GAS u32x2*)p; return (f32x4){bf_lo(w.x), bf_hi(w.x), bf_lo(w.y), bf_hi(w.y)}; };
    for (int it = gt; it < 256 * 2 * (DFF / 4); it += NT) {
        const int j4 = it % (DFF / 4), rs = it / (DFF / 4), rho = rs & 1, strip = rs >> 1, j = 4 * j4;
        const int pg = (j >> 7) * 256 + (j & 127);
        const bool first = (strip & 31) == 0;
        const bf16* own = RAWB + (size_t)strip * 4 * UPW; const bf16* prv = RAWB + (size_t)(strip - 1) * 4 * UPW;
        const f32x4 z = {0.f, 0.f, 0.f, 0.f};
        f32x4 gm2, gm1, g0, vm2, vm1, v0;
        if (rho == 0) { gm2 = first ? z : ld4(prv + 2 * UPW + pg); gm1 = first ? z : ld4(prv + 3 * UPW + pg); g0 = ld4(own + pg);
                        vm2 = first ? z : ld4(prv + 2 * UPW + pg + 128); vm1 = first ? z : ld4(prv + 3 * UPW + pg + 128); v0 = ld4(own + pg + 128); }
        else { gm2 = first ? z : ld4(prv + 3 * UPW + pg); gm1 = ld4(own + pg); g0 = ld4(own + UPW + pg);
               vm2 = first ? z : ld4(prv + 3 * UPW + pg + 128); vm1 = ld4(own + pg + 128); v0 = ld4(own + UPW + pg + 128); }
        const f32x4 yg = *(const f32x4*)(cb + j) + *(const f32x4*)(cw + j) * gm2 + *(const f32x4*)(cw + UPW + j) * gm1 + *(const f32x4*)(cw + 2 * UPW + j) * g0;
        const f32x4 yv = *(const f32x4*)(cb + DFF + j) + *(const f32x4*)(cw + DFF + j) * vm2 + *(const f32x4*)(cw + UPW + DFF + j) * vm1 + *(const f32x4*)(cw + 2 * UPW + DFF + j) * v0;
        u32x2 wv; wv.x = cvtpk(silu_f(yg[0]) * yv[0], silu_f(yg[1]) * yv[1]); wv.y = cvtpk(silu_f(yg[2]) * yv[2], silu_f(yg[3]) * yv[3]);
        *(GAS u32x2*)(ACT + (size_t)(64 * strip + rho) * DFF + j) = wv;
    }
}

struct Args { const float* in[16]; float* out; unsigned char* ws; int ph_lo, ph_hi, li, pad; };
__global__ void __launch_bounds__(NWAVES * 64, 2) fwd_kernel(Args args) {
    extern __shared__ __attribute__((aligned(16))) unsigned char lds[];
    Frame F;
    F.lds = (LAS unsigned char*)lds; F.MISC = (volatile LAS unsigned*)(F.lds + MISC_OFF);
    F.tid = threadIdx.x; F.lane = F.tid & 63; F.wave = __builtin_amdgcn_readfirstlane(F.tid >> 6);
    F.G = gridDim.x; { const int bx = blockIdx.x; F.vcu = (F.G % 8 == 0) ? (bx % 8) * (F.G / 8) + bx / 8 : bx; }
    F.ws = args.ws; F.ctl = (gu32*)(args.ws + WS_CTL); F.out = args.out;
    for (int u = F.tid; u < (LDS_BYTES - LDSCTL_OFF) / 4; u += NWAVES * 64) ((LAS unsigned*)(F.lds + LDSCTL_OFF))[u] = 0u;
    __syncthreads();
    XcdBarrier bar; bar.bar = (unsigned*)(F.ctl + CW_BAR) + args.li * XCD_BAR_WORDS; bar.x = 0; bar.st = nullptr;
    if (N_LAUNCHES != PER_PHASE) bar = xcd_barrier_post((unsigned*)(F.ctl + CW_BAR) + args.li * XCD_BAR_WORDS, F.MISC + 8);
#define GRID_BAR(seam) do { if (N_LAUNCHES == PER_PHASE) { if (F.tid == 0) __hip_atomic_store(F.ctl + CW_TMO, 0xBADBA0u | (unsigned)(seam), RLX_AGENT); } else { xcd_barrier(bar); } } while (0)
    const int lo = args.ph_lo, hi = args.ph_hi;
#define IN(k) (lo <= (k) && (k) < hi)
#define BOTH(k) (IN(k) && IN((k) + 1))
    PG8_LAS float* escr = (PG8_LAS float*)(F.lds + SCR_OFF);
    if (IN(PH_PRO)) { p0_prologue(F, args.in[0], args.in[1], args.in[2]); if (BOTH(PH_PRO)) GRID_BAR(PH_PRO); }
    if (IN(PH_IN)) {
        pg8::Gemm g{(const pg8::bf16_t*)(F.ws + WS_XN), (const pg8::bf16_t*)(F.ws + WS_WIN), M, IN_WP, DM}; pg8::StaticOrder S; S.init(M, IN_WP, F.G, (int)blockIdx.x, WGM_IN);
        pg8::Epi1 E{(pg8::bf16_t*)(F.ws + WS_QB), (pg8::bf16_t*)(F.ws + WS_KB), (pg8::bf16_t*)(F.ws + WS_VB), (pg8::bf16_t*)(F.ws + WS_ML), (float*)(F.ws + WS_G), (const float*)(F.ws + WS_ROPE), args.in[3], args.in[4], args.in[7], args.in[8], escr};
        pg8::gemm_phase<pg8::Epi1, pg8::StaticOrder, true, true>(F.lds + RING_OFF, g, S, E);
        { constexpr int IDLE0 = (M / 256) * (IN_WP / 256) % 256;
          if (F.G == 256 && (int)blockIdx.x >= IDLE0)
              convert_range(F, (LAS float*)(F.lds + RING_OFF + F.wave * 16384), args.in[10], args.in[12], args.in[11], args.in[15], 0, CV_EARLY, ((int)blockIdx.x - IDLE0) * NWAVES + F.wave, (256 - IDLE0) * NWAVES);
        }
        if (BOTH(PH_IN)) GRID_BAR(PH_IN);
    }
    if (IN(PH_PRE)) { mixer_prepass(F, args.in[5], args.in[6]); if (BOTH(PH_PRE)) GRID_BAR(PH_PRE); }
    if (IN(PH_MIX)) {
#ifndef PROBE_P2
#define PROBE_P2 0
#endif
#ifndef PROBE_LIGHT_UP
#define PROBE_LIGHT_UP 0
#endif
        const bool skip_ml = PROBE_P2 >= 2 && args.li == 1, skip_at = PROBE_P2 == 1 && args.li == 1;
        const bool is_ml = (int)blockIdx.x < ML_WGS;
        if (is_ml && !skip_ml) { const int seq = (int)blockIdx.x & 31, part = (int)blockIdx.x >> 5; mlstm_seq(F, seq >> 2, seq & 3, args.in[9], part ? ML_SPLIT : 0, part ? SEQ / 128 : ML_SPLIT); __syncthreads(); }
        if (!skip_at) attn_phase(F, CW_QUEUE + 1024 * args.li, args.in[10], args.in[12], args.in[11], args.in[15], is_ml || (PROBE_P2 == 3 && args.li == 1));
        if (BOTH(PH_MIX)) GRID_BAR(PH_MIX);
    }
    if (IN(PH_OUT)) {
        pg8::Gemm g{(const pg8::bf16_t*)(F.ws + WS_MIX), (const pg8::bf16_t*)(F.ws + WS_WOUT), M, DM, DM}; pg8::StaticOrder S; S.init(M, DM, F.G, (int)blockIdx.x, WGM_OUT);
        pg8::Epi3 E{(const pg8::bf16_t*)(F.ws + WS_XN), (const float*)(F.ws + WS_IR), (pg8::bf16_t*)(F.ws + WS_X1), (float*)(F.ws + WS_SS), escr};
        pg8::gemm_phase<pg8::Epi3, pg8::StaticOrder, true, true>(F.lds + RING_OFF, g, S, E);
        if (BOTH(PH_OUT)) GRID_BAR(PH_OUT);
    }
    if (IN(PH_UP)) {
        pg8::Gemm g{(const pg8::bf16_t*)(F.ws + WS_X1), (const pg8::bf16_t*)(F.ws + WS_WUP), M, UPW, DM}; pg8::StaticOrder S; S.init(M, UPW, F.G, (int)blockIdx.x, WGM_UP);
        pg8::Epi4 E{(pg8::bf16_t*)(F.ws + WS_ACT), (pg8::bf16_t*)(F.ws + WS_RAW), (const float*)(F.ws + WS_SS), args.in[13], args.in[14], escr, args.li == 0 ? PROBE_LIGHT_UP : 0};
        pg8::gemm_phase<pg8::Epi4, pg8::StaticOrder, true, true>(F.lds + RING_OFF, g, S, E);
        if (BOTH(PH_UP)) GRID_BAR(PH_UP);
    }
    if (IN(PH_FIX)) { ffn_fixup(F, args.in[13], args.in[14]); if (BOTH(PH_FIX)) GRID_BAR(PH_FIX); }
    if (IN(PH_DOWN)) {
        pg8::Gemm g{(const pg8::bf16_t*)(F.ws + WS_ACT), (const pg8::bf16_t*)(F.ws + WS_WDN), M, DM, DFF}; pg8::StaticOrder S; S.init(M, DM, F.G, (int)blockIdx.x, WGM_DOWN);
        pg8::Epi5 E{F.out, (const pg8::bf16_t*)(F.ws + WS_X1)};
        pg8::gemm_phase<pg8::Epi5, pg8::StaticOrder, true, true>(F.lds + RING_OFF, g, S, E);
    }
#undef IN
#undef BOTH
}

extern "C" void kernel_launch(void* const* d_in, const int* in_sizes, int n_in, void* d_out, int out_size, void* d_ws, size_t ws_size, hipStream_t stream) {
    static int grid = 0;
    if (grid == 0) {
        if (n_in != 16 || in_sizes[0] != M * DM || out_size != M * DM || ws_size < WS_END) { fprintf(stderr, "kernel_launch: unexpected shapes (n_in %d in0 %d out %d ws %zu)\n", n_in, n_in > 0 ? in_sizes[0] : -1, out_size, ws_size); grid = -1; return; }
        int dev = 0, cus = 0, per_cu = 0;
        if (hipGetDevice(&dev) != hipSuccess || hipDeviceGetAttribute(&cus, hipDeviceAttributeMultiprocessorCount, dev) != hipSuccess) { grid = -1; return; }
        if (hipFuncSetAttribute((const void*)fwd_kernel, hipFuncAttributeMaxDynamicSharedMemorySize, LDS_BYTES) != hipSuccess) { fprintf(stderr, "kernel_launch: hipFuncSetAttribute failed\n"); grid = -1; return; }
        if (hipOccupancyMaxActiveBlocksPerMultiprocessor(&per_cu, (const void*)fwd_kernel, NWAVES * 64, LDS_BYTES) != hipSuccess || per_cu < 1) fprintf(stderr, "kernel_launch: occupancy query reports %d blocks per CU\n", per_cu);
        (void)hipGetLastError();
        grid = cus;
    }
    if (grid < 0) return;
    if (hipMemsetAsync((char*)d_ws + WS_CTL, 0, CTL_ZERO_BYTES, stream) != hipSuccess) return;
    Args a{};
    for (int i = 0; i < 16; ++i) a.in[i] = (const float*)d_in[i];
    a.out = (float*)d_out; a.ws = (unsigned char*)d_ws;
#ifdef PROBE_REPEAT
    { const int k = PROBE_REPEAT; const int lo[3] = {0, k, k + 1}, hi[3] = {k + 1, k + 1, PER_PHASE};
      for (int li = 0; li < 3; ++li) { a.ph_lo = lo[li]; a.ph_hi = hi[li]; a.li = li; hipLaunchKernelGGL(fwd_kernel, dim3(grid), dim3(NWAVES * 64), LDS_BYTES, stream, a); } }
#else
    if (N_LAUNCHES == 1) { a.ph_lo = 0; a.ph_hi = PER_PHASE; a.li = 0; hipLaunchKernelGGL(fwd_kernel, dim3(grid), dim3(NWAVES * 64), LDS_BYTES, stream, a); }
    else for (int li = 0; li < PER_PHASE; ++li) { a.ph_lo = li; a.ph_hi = li + 1; a.li = 0; hipLaunchKernelGGL(fwd_kernel, dim3(grid), dim3(NWAVES * 64), LDS_BYTES, stream, a); }
#endif
}
```

```cpp
#include <hip/hip_runtime.h>
#include <cstdio>
#include <cstdint>
#include <cmath>
namespace pg8 {
#define PG8_LAS __attribute__((address_space(3)))
typedef unsigned short bf16_t;
typedef short bf16x8 __attribute__((ext_vector_type(8)));
typedef float f32x4 __attribute__((ext_vector_type(4)));
typedef unsigned u32x4 __attribute__((ext_vector_type(4)));
constexpr int BM = 256, BK = 64, HALF = 128, HTB = HALF * BK * 2  , STAGE_BYTES = 8 * HTB, NXCD = 8, WGM = 8;

__host__ __device__ __forceinline__ int lds_byte(int r, int c) { const int st = (r >> 4) * 2 + (c >> 5), rr = r & 15, cc = c & 31, ob = rr * 64 + cc * 2; return st * 1024 + (ob ^ (((ob >> 9) & 1) << 5)); }
__host__ __device__ __forceinline__ void stage_rc(int b, int& R, int& C) { const int st = b / 1024, sb = b % 1024, swz = sb ^ (((sb >> 9) & 1) << 5); R = (st >> 1) * 16 + swz / 64; C = (st & 1) * 32 + (swz % 64) / 2; }
__host__ __device__ __forceinline__ int perm32(int rho) { const int n = rho >> 4, i = rho & 15; return 8 * (i >> 2) + 4 * n + (i & 3); }

struct Unit { int pm, pn; };
struct Gemm { const bf16_t* A; const bf16_t* Bt; int M, N, K; };

struct StaticOrder {
    int nM, nN, nwg, G, c, wgm;
    __host__ __device__ void init(int M, int N, int G_, int c_, int wgm_ = WGM) { nM = M / BM; nN = N / BM; nwg = nM * nN; G = G_; c = c_; wgm = wgm_; }
    __host__ __device__ bool next(int i, Unit& u) const {
        const long L = (long)i * G + c; if (L >= nwg) return false;
        int wgid = (int)L; { const int q = nwg / NXCD, r = nwg % NXCD, xcd = wgid % NXCD, off = wgid / NXCD; wgid = (xcd < r ? xcd * (q + 1) : r * (q + 1) + (xcd - r) * q) + off; }
        const int nig = wgm * nN, gid = wgid / nig, fm = gid * wgm, gsz = (nM - fm) < wgm ? (nM - fm) : wgm;
        u.pm = fm + ((wgid % nig) % gsz); u.pn = (wgid % nig) / gsz; return true;
    }
    __device__ __forceinline__ void a_ready(const Unit&) const {}
    __device__ __forceinline__ void done(const Unit&) const {}
};

__device__ __forceinline__ unsigned cvt_pk_bf16(float lo, float hi) { unsigned r; asm volatile("v_cvt_pk_bf16_f32 %0, %1, %2" : "=v"(r) : "v"(lo), "v"(hi)); return r; }

typedef float f32x2 __attribute__((ext_vector_type(2)));
#define EPI_BAR() do { asm volatile("s_waitcnt lgkmcnt(0)" ::: "memory"); __builtin_amdgcn_s_barrier(); asm volatile("" ::: "memory"); } while (0)
constexpr float kEps = 1e-6f;

struct Epi1 {
    static constexpr bool PERM = true, AFTER_DRAIN = false, APERM = false;
    __device__ __forceinline__ void pre(const Unit&, int, int) const {}
    bf16_t *QB, *KB, *VB, *ML; float* G; const float* rope; const float *qg, *kg, *b_i, *b_f; PG8_LAS float* scr;
    __device__ __forceinline__ void operator()(const f32x4 (&acc)[2][2][4][2], const Unit& u, int wr, int wc, int fr, int fq) const {
        const int pn = u.pn;
        if (pn < 12) {
            const bool isq = pn < 6;
#pragma unroll
            for (int ai = 0; ai < 2; ++ai)
#pragma unroll
                for (int m = 0; m < 4; ++m)
#pragma unroll
                    for (int bj = 0; bj < 2; ++bj) {
                        const f32x4 a = acc[ai][bj][m][0], b = acc[ai][bj][m][1];
                        float s = (a[0] * a[0] + a[1] * a[1]) + (a[2] * a[2] + a[3] * a[3]) + (b[0] * b[0] + b[1] * b[1]) + (b[2] * b[2] + b[3] * b[3]);
                        s += __shfl_xor(s, 16); s += __shfl_xor(s, 32);
                        if (fq == 0) scr[((ai * HALF + wr * 64 + m * 16 + fr) * 2 + bj) * 4 + wc] = s;
                    }
            EPI_BAR();
            const float* gsrc = isq ? qg : kg; const float gscale = isq ? 0.08838834764831845f * 1.4426950408889634f : 1.0f;
            f32x4 gva, gvb;
#pragma unroll
            for (int e = 0; e < 4; ++e) { const int p = 32 * wc + 8 * fq + e; gva[e] = gsrc[(p >> 1) + 64 * (p & 1)] * gscale; gvb[e] = gsrc[((p + 4) >> 1) + 64 * (p & 1)] * gscale; }
            bf16_t* dst = isq ? QB : KB; const int head0 = (isq ? pn : pn - 6) * 2;
#pragma unroll
            for (int ai = 0; ai < 2; ++ai)
#pragma unroll
                for (int m = 0; m < 4; ++m) {
                    const int rl = ai * HALF + wr * 64 + m * 16 + fr, grow = u.pm * BM + rl, t = grow & 2047, bb = grow >> 11;
                    const size_t drow = (size_t)bb * 2048 + (size_t)(t & 3) * 512 + (t >> 2);
                    const f32x4 cs0 = *(const f32x4*)(rope + ((size_t)t * 64 + 16 * wc + 4 * fq) * 2), cs1 = *(const f32x4*)(rope + ((size_t)t * 64 + 16 * wc + 4 * fq) * 2 + 4);
#pragma unroll
                    for (int bj = 0; bj < 2; ++bj) {
                        const f32x4 pp = *(const PG8_LAS f32x4*)(scr + (rl * 2 + bj) * 4);
                        const float rstd = 1.0f / sqrtf(((pp[0] + pp[1]) + (pp[2] + pp[3])) * (1.0f / 128.0f) + kEps);
                        const f32x4 a = acc[ai][bj][m][0] * (gva * rstd), b = acc[ai][bj][m][1] * (gvb * rstd);
                        const f32x2 xe0 = {a[0], a[2]}, xo0 = {a[1], a[3]}, xe1 = {b[0], b[2]}, xo1 = {b[1], b[3]};
                        const f32x2 c0 = {cs0[0], cs0[2]}, s0 = {cs0[1], cs0[3]}, c1 = {cs1[0], cs1[2]}, s1 = {cs1[1], cs1[3]};
                        const f32x2 oe0 = xe0 * c0 - xo0 * s0, oo0 = xe0 * s0 + xo0 * c0, oe1 = xe1 * c1 - xo1 * s1, oo1 = xe1 * s1 + xo1 * c1;
                        u32x4 w;
                        w.x = cvt_pk_bf16(oe0[0], oo0[0]); w.y = cvt_pk_bf16(oe0[1], oo0[1]); w.z = cvt_pk_bf16(oe1[0], oo1[0]); w.w = cvt_pk_bf16(oe1[1], oo1[1]);
                        *(u32x4*)(dst + drow * 1536 + (head0 + bj) * 128 + 32 * wc + 8 * fq) = w;
                    }
                }
        } else if (pn < 26) {
            const bool isv = pn < 18;
#pragma unroll
            for (int ai = 0; ai < 2; ++ai)
#pragma unroll
                for (int m = 0; m < 4; ++m) {
                    const int rl = ai * HALF + wr * 64 + m * 16 + fr, grow = u.pm * BM + rl, t = grow & 2047, bb = grow >> 11;
                    bf16_t* rowp = isv ? VB + ((size_t)bb * 2048 + (size_t)(t & 3) * 512 + (t >> 2)) * 1536 + (pn - 12) * 256 : ML + (size_t)grow * 2048 + (pn - 18) * 256;
#pragma unroll
                    for (int bj = 0; bj < 2; ++bj) {
                        const f32x4 a = acc[ai][bj][m][0], b = acc[ai][bj][m][1];
                        u32x4 w; w.x = cvt_pk_bf16(a[0], a[1]); w.y = cvt_pk_bf16(a[2], a[3]); w.z = cvt_pk_bf16(b[0], b[1]); w.w = cvt_pk_bf16(b[2], b[3]);
                        *(u32x4*)(rowp + bj * HALF + 32 * wc + 8 * fq) = w;
                    }
                }
        } else {
            if (wc == 0 && fq == 0) {
                const f32x4 bi = *(const f32x4*)b_i, bf = *(const f32x4*)b_f;
#pragma unroll
                for (int ai = 0; ai < 2; ++ai)
#pragma unroll
                    for (int m = 0; m < 4; ++m) {
                        const int grow = u.pm * BM + ai * HALF + wr * 64 + m * 16 + fr;
                        *(f32x4*)(G + (size_t)grow * 8) = acc[ai][0][m][0] + bi; *(f32x4*)(G + (size_t)grow * 8 + 4) = acc[ai][0][m][1] + bf;
                    }
            }
        }
    }
};

struct Epi3 {
    static constexpr bool PERM = true, AFTER_DRAIN = false, APERM = false;
    __device__ __forceinline__ void pre(const Unit&, int, int) const {}
    const bf16_t* XN; const float* IR; bf16_t* X1; float* SS; PG8_LAS float* scr;
    __device__ __forceinline__ void operator()(const f32x4 (&acc)[2][2][4][2], const Unit& u, int wr, int wc, int fr, int fq) const {
        const int col0 = u.pn * BM + 32 * wc + 8 * fq;
#pragma unroll
        for (int ai = 0; ai < 2; ++ai)
#pragma unroll
            for (int m = 0; m < 4; ++m) {
                const int rl = ai * HALF + wr * 64 + m * 16 + fr; const size_t off = (size_t)(u.pm * BM + rl) * 2048 + col0;
                const float ir = IR[u.pm * BM + rl];
                float s = 0.f;
#pragma unroll
                for (int bj = 0; bj < 2; ++bj) {
                    const u32x4 xw = __builtin_nontemporal_load((const u32x4*)(XN + off + bj * HALF));
                    const f32x4 x0 = {__builtin_bit_cast(float, xw.x << 16), __builtin_bit_cast(float, xw.x & 0xffff0000u), __builtin_bit_cast(float, xw.y << 16), __builtin_bit_cast(float, xw.y & 0xffff0000u)};
                    const f32x4 x1 = {__builtin_bit_cast(float, xw.z << 16), __builtin_bit_cast(float, xw.z & 0xffff0000u), __builtin_bit_cast(float, xw.w << 16), __builtin_bit_cast(float, xw.w & 0xffff0000u)};
                    const f32x4 a = acc[ai][bj][m][0] + x0 * ir, b = acc[ai][bj][m][1] + x1 * ir;
                    s += (a[0] * a[0] + a[1] * a[1]) + (a[2] * a[2] + a[3] * a[3]) + (b[0] * b[0] + b[1] * b[1]) + (b[2] * b[2] + b[3] * b[3]);
                    u32x4 w; w.x = cvt_pk_bf16(a[0], a[1]); w.y = cvt_pk_bf16(a[2], a[3]); w.z = cvt_pk_bf16(b[0], b[1]); w.w = cvt_pk_bf16(b[2], b[3]);
                    *(u32x4*)(X1 + off + bj * HALF) = w;
                }
                s += __shfl_xor(s, 16); s += __shfl_xor(s, 32);
                if (fq == 0) scr[rl * 4 + wc] = s;
            }
        EPI_BAR();
        if (wc == 0 && fq == 0) {
#pragma unroll
            for (int ai = 0; ai < 2; ++ai)
#pragma unroll
                for (int m = 0; m < 4; ++m) {
                    const int rl = ai * HALF + wr * 64 + m * 16 + fr; const f32x4 pp = *(const PG8_LAS f32x4*)(scr + rl * 4);
                    SS[(size_t)(u.pm * BM + rl) * 8 + u.pn] = (pp[0] + pp[1]) + (pp[2] + pp[3]);
                }
        }
    }
};

__device__ __forceinline__ float dpp_shr1(float v) { return __builtin_bit_cast(float, __builtin_amdgcn_update_dpp(0, __builtin_bit_cast(int, v), 0x111, 0xf, 0xf, true)); }
struct Epi4 {
    static constexpr bool PERM = true, AFTER_DRAIN = false, APERM = true;
    bf16_t* ACT; bf16_t* RAWB; const float* SS; const float *cw, *cb; PG8_LAS float* scr; int light;
    __device__ __forceinline__ void pre(const Unit& u, int wid, int lane) const {
        __builtin_amdgcn_global_load_lds((const unsigned*)((const char*)(SS + (size_t)u.pm * BM * 8) + wid * 1024 + lane * 16), (PG8_LAS unsigned*)((PG8_LAS char*)scr + wid * 1024), 16, 0, 0);
        if (wid < 4) { const int seg = 2 * wid + (lane >> 5), q4 = seg >> 1, gv = seg & 1;
            const float* src = (q4 < 3 ? cw + q4 * 11264 : cb) + (gv ? 5632 : 0) + u.pn * 128 + 4 * (lane & 31);
            __builtin_amdgcn_global_load_lds((const unsigned*)src, (PG8_LAS unsigned*)((PG8_LAS char*)scr + 8192 + wid * 1024), 16, 0, 0); }
    }
    __device__ __forceinline__ void operator()(f32x4 (&acc)[2][2][4][2], const Unit& u, int wr, int wc, int fr, int fq) const {
        if (light == 1) return;
        const int j0 = u.pn * 128 + 32 * wc + 8 * fq;
#pragma unroll
        for (int ai = 0; ai < 2; ++ai)
#pragma unroll
            for (int m = 0; m < 4; ++m) {
                const PG8_LAS float* sp = scr + (ai * HALF + wr * 64 + 4 * fr + m) * 8; const f32x4 s0 = *(const PG8_LAS f32x4*)sp, s1 = *(const PG8_LAS f32x4*)(sp + 4);
                const float rstd = 1.0f / sqrtf((((s0[0] + s0[1]) + (s0[2] + s0[3])) + ((s1[0] + s1[1]) + (s1[2] + s1[3]))) * (1.0f / 2048.0f) + kEps);
#pragma unroll
                for (int bj = 0; bj < 2; ++bj) { acc[ai][bj][m][0] = acc[ai][bj][m][0] * rstd; acc[ai][bj][m][1] = acc[ai][bj][m][1] * rstd; }
            }
        if (fr == 0 && light != 2) {
#pragma unroll
            for (int ai = 0; ai < 2; ++ai)
#pragma unroll
                for (int mm = 0; mm < 2; ++mm)
#pragma unroll
                    for (int bj = 0; bj < 2; ++bj) { bf16_t* p = RAWB + ((size_t)(u.pm * 4 + ai * 2 + wr) * 4 + mm) * 11264 + u.pn * 256 + bj * HALF + 32 * wc + 8 * fq; const f32x4 a = acc[ai][bj][mm][0], b = acc[ai][bj][mm][1];
                        u32x4 w; w.x = cvt_pk_bf16(a[0], a[1]); w.y = cvt_pk_bf16(a[2], a[3]); w.z = cvt_pk_bf16(b[0], b[1]); w.w = cvt_pk_bf16(b[2], b[3]); *(u32x4*)p = w; }
        }
        if (fr == 15 && light != 2) {
#pragma unroll
            for (int ai = 0; ai < 2; ++ai)
#pragma unroll
                for (int mm = 0; mm < 2; ++mm)
#pragma unroll
                    for (int bj = 0; bj < 2; ++bj) { bf16_t* p = RAWB + ((size_t)(u.pm * 4 + ai * 2 + wr) * 4 + 2 + mm) * 11264 + u.pn * 256 + bj * HALF + 32 * wc + 8 * fq; const f32x4 a = acc[ai][bj][2 + mm][0], b = acc[ai][bj][2 + mm][1];
                        u32x4 w; w.x = cvt_pk_bf16(a[0], a[1]); w.y = cvt_pk_bf16(a[2], a[3]); w.z = cvt_pk_bf16(b[0], b[1]); w.w = cvt_pk_bf16(b[2], b[3]); *(u32x4*)p = w; }
        }
#pragma unroll
        for (int ai = 0; ai < 2; ++ai) {
            unsigned pk[4][4];
#pragma unroll
            for (int n = 0; n < 2; ++n) {
                const PG8_LAS float* wl = scr + 2048 + 32 * wc + 8 * fq + 4 * n;
                const f32x4 wg0 = *(const PG8_LAS f32x4*)wl, wg1 = *(const PG8_LAS f32x4*)(wl + 256), wg2 = *(const PG8_LAS f32x4*)(wl + 512), bg = *(const PG8_LAS f32x4*)(wl + 768);
                const f32x4 wv0 = *(const PG8_LAS f32x4*)(wl + 128), wv1 = *(const PG8_LAS f32x4*)(wl + 384), wv2 = *(const PG8_LAS f32x4*)(wl + 640), bv = *(const PG8_LAS f32x4*)(wl + 896);
                f32x4 ug[6], uv[6];
#pragma unroll
                for (int j = 0; j < 4; ++j) { ug[0][j] = dpp_shr1(acc[ai][0][2][n][j]); ug[1][j] = dpp_shr1(acc[ai][0][3][n][j]); uv[0][j] = dpp_shr1(acc[ai][1][2][n][j]); uv[1][j] = dpp_shr1(acc[ai][1][3][n][j]); }
#pragma unroll
                for (int m = 0; m < 4; ++m) { ug[2 + m] = acc[ai][0][m][n]; uv[2 + m] = acc[ai][1][m][n]; }
#pragma unroll
                for (int m = 0; m < 4; ++m) {
                    const f32x4 yg = bg + wg0 * ug[m] + wg1 * ug[m + 1] + wg2 * ug[m + 2];
                    const f32x4 yv = bv + wv0 * uv[m] + wv1 * uv[m + 1] + wv2 * uv[m + 2];
                    const f32x4 t = yg * -1.4426950408889634f;
                    f32x4 sg; sg[0] = __builtin_amdgcn_rcpf(1.0f + __builtin_amdgcn_exp2f(t[0])); sg[1] = __builtin_amdgcn_rcpf(1.0f + __builtin_amdgcn_exp2f(t[1])); sg[2] = __builtin_amdgcn_rcpf(1.0f + __builtin_amdgcn_exp2f(t[2])); sg[3] = __builtin_amdgcn_rcpf(1.0f + __builtin_amdgcn_exp2f(t[3]));
                    const f32x4 res = (yg * yv) * sg;
                    pk[m][2 * n] = cvt_pk_bf16(res[0], res[1]); pk[m][2 * n + 1] = cvt_pk_bf16(res[2], res[3]);
                }
            }
#pragma unroll
            for (int m = 0; m < 4; ++m) {
                if ((m < 2 && fr == 0) || (light == 2 && pk[m][0] != 0x12345678u)) continue;
                const int grow = u.pm * BM + ai * HALF + wr * 64 + 4 * fr + m;
                u32x4 w; w.x = pk[m][0]; w.y = pk[m][1]; w.z = pk[m][2]; w.w = pk[m][3];
                *(u32x4*)(ACT + (size_t)grow * 5632 + j0) = w;
            }
        }
    }
};

struct Epi5 {
    static constexpr bool PERM = true, AFTER_DRAIN = false, APERM = false;
    __device__ __forceinline__ void pre(const Unit&, int, int) const {}
    float* out; const bf16_t* X1;
    __device__ __forceinline__ void operator()(const f32x4 (&acc)[2][2][4][2], const Unit& u, int wr, int wc, int fr, int fq) const {
        const int col0 = u.pn * BM + 32 * wc + 8 * fq;
#pragma unroll
        for (int ai = 0; ai < 2; ++ai)
#pragma unroll
            for (int m = 0; m < 4; ++m) {
                const size_t off = (size_t)(u.pm * BM + ai * HALF + wr * 64 + m * 16 + fr) * 2048 + col0;
#pragma unroll
                for (int bj = 0; bj < 2; ++bj) {
                    const u32x4 w = __builtin_nontemporal_load((const u32x4*)(X1 + off + bj * HALF));
                    const f32x4 r0 = {__builtin_bit_cast(float, w.x << 16), __builtin_bit_cast(float, w.x & 0xffff0000u), __builtin_bit_cast(float, w.y << 16), __builtin_bit_cast(float, w.y & 0xffff0000u)};
                    const f32x4 r1 = {__builtin_bit_cast(float, w.z << 16), __builtin_bit_cast(float, w.z & 0xffff0000u), __builtin_bit_cast(float, w.w << 16), __builtin_bit_cast(float, w.w & 0xffff0000u)};
                    __builtin_nontemporal_store(acc[ai][bj][m][0] + r0, (f32x4*)(out + off + bj * HALF)); __builtin_nontemporal_store(acc[ai][bj][m][1] + r1, (f32x4*)(out + off + bj * HALF + 4));
                }
            }
    }
};
template <class Epi, class Sched, bool ALIGN_EPI = false, bool SP2 = false>
__device__ __forceinline__ void gemm_phase(PG8_LAS unsigned char* lds, const Gemm g, const Sched& S, const Epi& E) {
    const int tid = threadIdx.x, wid = __builtin_amdgcn_readfirstlane(tid >> 6), lane = tid & 63, wr = wid >> 2, wc = wid & 3, fr = lane & 15, fq = lane >> 4;
    const int K = g.K, nt = K / BK;
    unsigned voffA[2], voffB[2];
#pragma unroll
    for (int i = 0; i < 2; ++i) { int R, C; stage_rc(tid * 16 + i * 8192, R, C); const int Rb = Epi::PERM ? ((R & ~31) + perm32(R & 31)) : R;
        const int Ra = Epi::APERM ? ((R & ~63) + 4 * (R & 15) + ((R >> 4) & 3)) : R;
        voffA[i] = (unsigned)(Ra * K + C) * 2u; voffB[i] = (unsigned)(Rb * K + C) * 2u; }
    const size_t kstep = (size_t)(BK * 2);
    const size_t hstep = (size_t)HALF * K * 2;
    const size_t tstep = 2 * hstep;
    const unsigned ldsw = (unsigned)wid * 1024u;
    const int aoff = lds_byte(wr * 64 + fr, fq * 8), boff = lds_byte(wc * 32 + fr, fq * 8);
#define PG8_SA(b, h) (((b) * 2 + (h)) * HTB)
#define PG8_SB(b, h) ((4 + (b) * 2 + (h)) * HTB)
#define PG8_STAGE(bufoff, gbase, voff) do { _Pragma("unroll") for (int _i = 0; _i < 2; ++_i) \
        __builtin_amdgcn_global_load_lds((const unsigned*)((const char*)(gbase) + (voff)[_i]), (PG8_LAS unsigned*)(lds + (bufoff) + ldsw + _i * 8192), 16, 0, 0); } while (0)
#define PG8_LDA(dst, b, h) do { _Pragma("unroll") for (int m = 0; m < 4; ++m) _Pragma("unroll") for (int k = 0; k < 2; ++k) dst[m][k] = *(const PG8_LAS bf16x8*)(lds + PG8_SA(b, h) + aoff + m * 2048 + k * 1024); } while (0)
#define PG8_LDB(dst, b, h) do { _Pragma("unroll") for (int n = 0; n < 2; ++n) _Pragma("unroll") for (int k = 0; k < 2; ++k) dst[n][k] = *(const PG8_LAS bf16x8*)(lds + PG8_SB(b, h) + boff + n * 2048 + k * 1024); } while (0)
#define PG8_MMA(ai, bj, At, Bt) do { __builtin_amdgcn_s_setprio(1); _Pragma("unroll") for (int m = 0; m < 4; ++m) _Pragma("unroll") for (int n = 0; n < 2; ++n) _Pragma("unroll") for (int k = 0; k < 2; ++k) \
        acc[ai][bj][m][n] = __builtin_amdgcn_mfma_f32_16x16x32_bf16(Bt[n][k], At[m][k], acc[ai][bj][m][n], 0, 0, 0); __builtin_amdgcn_s_setprio(0); } while (0)
#define PG8_WAIT_V(n) asm volatile("s_waitcnt vmcnt(" #n ")" ::: "memory")
#define PG8_WAIT_L(n) asm volatile("s_waitcnt lgkmcnt(" #n ")" ::: "memory")
#define PG8_BAR __builtin_amdgcn_s_barrier()
#define PG8_SCHED __builtin_amdgcn_sched_barrier(0)
    Unit cur, nxt; int ui = 0;
    if (!S.next(0, cur)) return;
    f32x4 acc[2][2][4][2];
#pragma unroll
    for (int a = 0; a < 2; ++a)
#pragma unroll
        for (int b = 0; b < 2; ++b)
#pragma unroll
            for (int m = 0; m < 4; ++m)
#pragma unroll
                for (int n = 0; n < 2; ++n) acc[a][b][m][n] = (f32x4){0.f, 0.f, 0.f, 0.f};
    bf16x8 At[4][2], B0[2][2], B1[2][2];
    const char* cA = (const char*)g.A + (size_t)cur.pm * tstep; const char* cB = (const char*)g.Bt + (size_t)cur.pn * tstep;
    S.a_ready(cur);
    if constexpr (SP2) {
        PG8_STAGE(PG8_SB(0, 0), cB, voffB); PG8_STAGE(PG8_SB(0, 1), cB + hstep, voffB); PG8_STAGE(PG8_SA(0, 0), cA, voffA); PG8_STAGE(PG8_SA(0, 1), cA + hstep, voffA);
        if (wr == 1) PG8_BAR;
        PG8_WAIT_V(2); PG8_BAR;
        PG8_STAGE(PG8_SB(1, 0), cB + kstep, voffB); PG8_STAGE(PG8_SA(1, 0), cA + kstep, voffA); PG8_STAGE(PG8_SB(1, 1), cB + hstep + kstep, voffB);
        PG8_WAIT_V(6); PG8_BAR;
    } else {
        PG8_STAGE(PG8_SB(0, 0), cB, voffB); PG8_STAGE(PG8_SA(0, 0), cA, voffA); PG8_STAGE(PG8_SB(0, 1), cB + hstep, voffB); PG8_STAGE(PG8_SA(0, 1), cA + hstep, voffA);
        if (wr == 1) PG8_BAR;
        PG8_WAIT_V(4); PG8_BAR;
        PG8_STAGE(PG8_SB(1, 0), cB + kstep, voffB); PG8_STAGE(PG8_SA(1, 0), cA + kstep, voffA); PG8_STAGE(PG8_SB(1, 1), cB + hstep + kstep, voffB);
        PG8_WAIT_V(6); PG8_BAR;
    }
    for (;;) {
        const bool has_next = S.next(ui + 1, nxt);
        const char* nA = has_next ? (const char*)g.A + (size_t)nxt.pm * tstep : cA; const char* nB = has_next ? (const char*)g.Bt + (size_t)nxt.pn * tstep : cB;
        for (int t = 0; t < nt; t += 2) {
            const bool last = (t == nt - 2);
            const char* a1 = cA + (size_t)(t + 1) * kstep;
            const char* a2 = last ? nA : cA + (size_t)(t + 2) * kstep; const char* b2 = last ? nB : cB + (size_t)(t + 2) * kstep;
            const char* a3 = a2 + kstep; const char* b3 = b2 + kstep;
            if (last && has_next) S.a_ready(nxt);
            if (last) E.pre(cur, wid, lane);
            if constexpr (SP2) {
            PG8_LDB(B0, 0, 0); PG8_LDB(B1, 0, 1); PG8_SCHED; PG8_LDA(At, 0, 0); PG8_STAGE(PG8_SA(1, 1), a1 + hstep, voffA);
            PG8_WAIT_V(8); PG8_WAIT_L(0); PG8_BAR; PG8_MMA(0, 0, At, B0); PG8_MMA(0, 1, At, B1); PG8_BAR; PG8_SCHED;
            PG8_LDA(At, 0, 1); PG8_STAGE(PG8_SB(0, 0), b2, voffB); PG8_STAGE(PG8_SB(0, 1), b2 + hstep, voffB); PG8_STAGE(PG8_SA(0, 0), a2, voffA);
            PG8_WAIT_V(8); PG8_WAIT_L(0); PG8_BAR; PG8_MMA(1, 0, At, B0); PG8_MMA(1, 1, At, B1); PG8_BAR; PG8_SCHED;
            PG8_LDB(B0, 1, 0); PG8_LDB(B1, 1, 1); PG8_SCHED; PG8_LDA(At, 1, 0); PG8_STAGE(PG8_SA(0, 1), a2 + hstep, voffA);
            PG8_WAIT_V(8); PG8_WAIT_L(0); PG8_BAR; PG8_MMA(0, 0, At, B0); PG8_MMA(0, 1, At, B1); PG8_BAR; PG8_SCHED;
            PG8_LDA(At, 1, 1); PG8_STAGE(PG8_SB(1, 0), b3, voffB); PG8_STAGE(PG8_SB(1, 1), b3 + hstep, voffB); PG8_STAGE(PG8_SA(1, 0), a3, voffA);
            PG8_WAIT_V(8); PG8_WAIT_L(0); PG8_BAR; PG8_MMA(1, 0, At, B0); PG8_MMA(1, 1, At, B1); PG8_BAR; PG8_SCHED;
            } else {
            PG8_LDB(B0, 0, 0); PG8_SCHED; PG8_LDA(At, 0, 0); PG8_STAGE(PG8_SA(1, 1), a1 + hstep, voffA);
            PG8_WAIT_L(8); PG8_BAR; PG8_WAIT_L(0); PG8_MMA(0, 0, At, B0); PG8_BAR; PG8_SCHED;
            PG8_LDB(B1, 0, 1); PG8_STAGE(PG8_SB(0, 0), b2, voffB);
            PG8_BAR; PG8_WAIT_L(0); PG8_MMA(0, 1, At, B1); PG8_BAR;
            PG8_LDA(At, 0, 1); PG8_STAGE(PG8_SA(0, 0), a2, voffA);
            PG8_BAR; PG8_WAIT_L(0); PG8_MMA(1, 0, At, B0); PG8_BAR; PG8_SCHED;
            PG8_STAGE(PG8_SB(0, 1), b2 + hstep, voffB);
            PG8_WAIT_V(6); PG8_BAR; PG8_MMA(1, 1, At, B1); PG8_BAR;
            PG8_LDB(B0, 1, 0); PG8_SCHED; PG8_LDA(At, 1, 0); PG8_STAGE(PG8_SA(0, 1), a2 + hstep, voffA);
            PG8_WAIT_L(8); PG8_BAR; PG8_WAIT_L(0); PG8_MMA(0, 0, At, B0); PG8_BAR; PG8_SCHED;
            PG8_LDB(B1, 1, 1); PG8_STAGE(PG8_SB(1, 0), b3, voffB);
            PG8_BAR; PG8_WAIT_L(0); PG8_MMA(0, 1, At, B1); PG8_BAR;
            PG8_LDA(At, 1, 1); PG8_STAGE(PG8_SA(1, 0), a3, voffA);
            PG8_BAR; PG8_WAIT_L(0); PG8_MMA(1, 0, At, B0); PG8_BAR; PG8_SCHED;
            PG8_STAGE(PG8_SB(1, 1), b3 + hstep, voffB);
            PG8_WAIT_V(6); PG8_BAR; PG8_MMA(1, 1, At, B1); PG8_BAR;
            }
        }
        if constexpr (ALIGN_EPI) { if (wr == 0) PG8_BAR; }
        if constexpr (!Epi::AFTER_DRAIN) { E(acc, cur, wr, wc, fr, fq); S.done(cur); }
        if (!has_next) break;
#pragma unroll
        for (int a = 0; a < 2; ++a)
#pragma unroll
            for (int b = 0; b < 2; ++b)
#pragma unroll
                for (int m = 0; m < 4; ++m)
#pragma unroll
                    for (int n = 0; n < 2; ++n) acc[a][b][m][n] = (f32x4){0.f, 0.f, 0.f, 0.f};
        cur = nxt; cA = nA; cB = nB; ++ui;
        if constexpr (ALIGN_EPI) { if (wr == 1) PG8_BAR; }
    }
    PG8_WAIT_V(0);
    if constexpr (!ALIGN_EPI) { if (wr == 0) PG8_BAR; }
    PG8_BAR;
    if constexpr (Epi::AFTER_DRAIN) { E.fused(acc, cur, wr, wc, fr, fq, lds, wid, lane); S.done(cur); }
#undef PG8_SA
#undef PG8_SB
#undef PG8_STAGE
#undef PG8_LDA
#undef PG8_LDB
#undef PG8_MMA
#undef PG8_WAIT_V
#undef PG8_WAIT_L
#undef PG8_BAR
#undef PG8_SCHED
}
}
#define GAS __attribute__((address_space(1)))
#define LAS __attribute__((address_space(3)))
typedef unsigned short bf16;
typedef unsigned v4u __attribute__((ext_vector_type(4)));
typedef float f32x4 __attribute__((ext_vector_type(4)));
typedef short bf16x8 __attribute__((ext_vector_type(8)));
typedef GAS unsigned gu32;
typedef GAS unsigned long long gu64;
#define RLX_AGENT __ATOMIC_RELAXED, __HIP_MEMORY_SCOPE_AGENT
#define LDS_WAIT() asm volatile("s_waitcnt lgkmcnt(0)" ::: "memory")
#define VM_WAIT() asm volatile("s_waitcnt vmcnt(0)" ::: "memory")
__device__ __forceinline__ unsigned long long rt() { return __builtin_amdgcn_s_memrealtime(); }
__device__ __forceinline__ unsigned f2bf(float f) { unsigned u = __builtin_bit_cast(unsigned, f); return (u + 0x7fffu + ((u >> 16) & 1u)) >> 16; }
__device__ __forceinline__ unsigned pk2(float lo, float hi) { return f2bf(lo) | (f2bf(hi) << 16); }

#define XB_TMO      128
#define XB_XCNT(j)  (256  + 64 * (j))
#define XB_XSUB(j)  (1280 + 64 * (j))
#define XB_XGEN(j)  (2304 + 64 * (j))
#define XB_TOP      3328
#define XB_TOPGEN   3392
#define XCD_BAR_WORDS 3456
#define XB_SPIN_CAP (1u << 18)

__device__ __forceinline__ unsigned xb_ld(unsigned* p)              { return __hip_atomic_load(p, __ATOMIC_RELAXED, __HIP_MEMORY_SCOPE_AGENT); }
__device__ __forceinline__ unsigned xb_add(unsigned* p, unsigned v) { return __hip_atomic_fetch_add(p, v, __ATOMIC_RELAXED, __HIP_MEMORY_SCOPE_AGENT); }
__device__ __forceinline__ unsigned xb_xcc_id() { return (unsigned)__builtin_amdgcn_s_getreg((3 << 11) | 20) & 0xFu; }
#define XB_SPIN(cond, bar) do { unsigned _sp = 0; while (cond) { __builtin_amdgcn_s_sleep(1); \
    if ((++_sp & 255u) == 0u) { if (xb_ld(&(bar)[XB_TMO])) break; if (_sp > XB_SPIN_CAP) { atomicAdd(&(bar)[XB_TMO], 1u); break; } } } } while (0)

struct XcdBarrier {
    unsigned* bar; unsigned x;
    volatile LAS unsigned* st;
};

__device__ __forceinline__ XcdBarrier xcd_barrier_post(unsigned* bar, volatile LAS unsigned* st) {
    XcdBarrier b; b.bar = bar; b.x = xb_xcc_id(); b.st = st;
    if (threadIdx.x == 0) (void)xb_add(&bar[XB_XCNT(b.x)], 1u);
    return b;
}
__device__ __forceinline__ void xcd_barrier_complete(unsigned* bar, unsigned x, unsigned& nloc, unsigned& nx) {
    const unsigned G = gridDim.x * gridDim.y * gridDim.z;
    unsigned sum, cnt, mine, sp = 0u;
    for (;;) {
        sum = 0u; cnt = 0u; mine = 0u;
#pragma unroll
        for (unsigned j = 0; j < 16; ++j) { const unsigned c = xb_ld(&bar[XB_XCNT(j)]); sum += c; cnt += (c > 0u) ? 1u : 0u; mine = (j == x) ? c : mine; }
        if (sum == G) break;
        __builtin_amdgcn_s_sleep(1);
        if ((++sp & 255u) == 0u) { if (xb_ld(&bar[XB_TMO])) break; if (sp > XB_SPIN_CAP) { atomicAdd(&bar[XB_TMO], 1u); break; } }
    }
    nloc = mine > 0u ? mine : 1u; nx = cnt > 0u ? cnt : 1u;
}

__device__ __forceinline__ void xcd_barrier(const XcdBarrier& b) {
    asm volatile("s_waitcnt vmcnt(0)" ::: "memory");
    __syncthreads();
    if (threadIdx.x == 0) {
        unsigned* bar = b.bar;
        __builtin_amdgcn_s_waitcnt(0);
        unsigned nloc = b.st[0], nx = b.st[1];
        if (nloc == 0u) { xcd_barrier_complete(bar, b.x, nloc, nx); b.st[0] = nloc; b.st[1] = nx; }
        const unsigned old = xb_add(&bar[XB_XSUB(b.x)], 1u);
        const unsigned gen = old / nloc;
        if (old + 1u == (gen + 1u) * nloc) {
            __builtin_amdgcn_fence(__ATOMIC_RELEASE, "agent");
            asm volatile("s_waitcnt vmcnt(0)" ::: "memory");
            const unsigned og = xb_add(&bar[XB_TOP], 1u);
            const unsigned tg = og / nx;
            if (og + 1u == (tg + 1u) * nx) xb_add(&bar[XB_TOPGEN], 1u);
            else XB_SPIN(xb_ld(&bar[XB_TOPGEN]) == tg, bar);
            __builtin_amdgcn_fence(__ATOMIC_ACQUIRE, "agent");
            xb_add(&bar[XB_XGEN(b.x)], 1u);
            asm volatile("s_waitcnt vmcnt(0)" ::: "memory");
        } else {
            XB_SPIN(xb_ld(&bar[XB_XGEN(b.x)]) == gen, bar);
            __builtin_amdgcn_fence(__ATOMIC_ACQUIRE, "agent");
            asm volatile("s_waitcnt vmcnt(0)" ::: "memory");
        }
    }
    __syncthreads();
}
constexpr int ATT_NSLOT0 = 23, ATT_NSLOT1 = 15, ATT_STAGES = 6, ATT_LAND = 1;
constexpr int ATT_BLK0[8] = {15, 14, 13, 12, 8, 9, 10, 11}, ATT_BLK1[8] = {7, 6, 5, 4, 0, 1, 2, 3};
__device__ const unsigned short ATT_SCHED[38][12] = {
    {0x8001, 0x8403, 0x8805, 0x0000, 0x0000, 0x0000, 0x0000, 0x0000, 0x0000, 0x0000, 0x0000, 0x0000},
    {0x8c00, 0x9004, 0x9406, 0x8001, 0x8001, 0x8001, 0x8001, 0x8805, 0x8805, 0x8805, 0x8805, 0x0000},
    {0x0000, 0x0000, 0x0000, 0x8805, 0x8805, 0x8805, 0x8805, 0x8001, 0x8001, 0x8001, 0x8001, 0x0000},
    {0x8008, 0x8807, 0x0000, 0x8403, 0x8403, 0x8403, 0x8403, 0x8403, 0x8403, 0x8403, 0x8403, 0x0000},
    {0x8402, 0x0000, 0x0000, 0x9004, 0x9004, 0x9004, 0x9004, 0x9004, 0x9004, 0x9004, 0x9004, 0x0000},
    {0x9009, 0x0000, 0x0000, 0x8c00, 0x8c00, 0x8c00, 0x8c00, 0x8c00, 0x8c00, 0x8c00, 0x8c00, 0x0000},
    {0x8c0a, 0x0000, 0x0000, 0x9406, 0x9406, 0x9406, 0x9406, 0x9406, 0x9406, 0x9406, 0x9406, 0x0000},
    {0x940b, 0x0000, 0x0000, 0x8807, 0x8807, 0x8807, 0x8807, 0x8008, 0x8008, 0x8008, 0x8008, 0x0000},
    {0x0000, 0x0000, 0x0000, 0x8008, 0x8008, 0x8008, 0x8008, 0x8807, 0x8807, 0x8807, 0x8807, 0x0000},
    {0x800c, 0x8908, 0x0000, 0x8c0a, 0x8c0a, 0x8c0a, 0x8c0a, 0x8402, 0x8402, 0x8c0a, 0x940b, 0x0000},
    {0x0000, 0x0000, 0x0000, 0x8402, 0x8402, 0x8402, 0x8402, 0x8908, 0x8908, 0x8402, 0x8c0a, 0x0000},
    {0x8e09, 0x8a08, 0x0000, 0x940b, 0x940b, 0x940b, 0x940b, 0x0000, 0x9009, 0x9009, 0x8402, 0x0000},
    {0x870a, 0x9708, 0x0000, 0x9009, 0x9009, 0x9009, 0x9009, 0x8a08, 0x8e09, 0x8e09, 0x9009, 0x0000},
    {0x900d, 0x8d0b, 0x0000, 0x800c, 0x800c, 0x800c, 0x800c, 0x9708, 0x8a08, 0x870a, 0x870a, 0x0000},
    {0x830e, 0x890c, 0x8709, 0x900d, 0x900d, 0x900d, 0x8d0b, 0x0000, 0x9708, 0x0000, 0x8d0b, 0x0000},
    {0x940e, 0x920a, 0x8f0c, 0x830e, 0x830e, 0x890c, 0x890c, 0x0000, 0x8709, 0x8709, 0x0000, 0x0000},
    {0x820e, 0x8a0b, 0x8509, 0x940e, 0x940e, 0x8f0c, 0x8f0c, 0x0000, 0x0000, 0x920a, 0x920a, 0x0000},
    {0x950e, 0x920c, 0x8d0a, 0x820e, 0x820e, 0x0000, 0x8a0b, 0x0000, 0xc509, 0x8509, 0x8a0b, 0x0000},
    {0x820d, 0x8b0b, 0x860f, 0x950e, 0x950e, 0x920c, 0x920c, 0x0000, 0x0000, 0xcd0a, 0x8d0a, 0x0000},
    {0x950d, 0x9307, 0x8d0f, 0x860f, 0x820d, 0x820d, 0xcb0b, 0x0000, 0x0000, 0x0000, 0xcb0b, 0x0000},
    {0x830d, 0x880f, 0x8607, 0x8d0f, 0x950d, 0x950d, 0x0000, 0x9307, 0x0000, 0x0000, 0x0000, 0x0000},
    {0x9507, 0x930f, 0x0000, 0x880f, 0xc30d, 0xc30d, 0x0000, 0x8607, 0x0000, 0x0000, 0x0000, 0x0000},
    {0x0000, 0x0000, 0x0000, 0xd30f, 0x0000, 0x0000, 0x0000, 0xd507, 0x0000, 0x0000, 0x0000, 0x0000},
    {0x8000, 0x8401, 0x8802, 0x0000, 0x0000, 0x0000, 0x0000, 0x0000, 0x0000, 0x0000, 0x0000, 0x0000},
    {0x8d00, 0x9003, 0x9404, 0x8802, 0x8802, 0x8802, 0x8802, 0x8000, 0x8401, 0x8802, 0x8802, 0x0000},
    {0x8a00, 0x0000, 0x0000, 0x9404, 0x9404, 0x9404, 0x9404, 0x8d00, 0x8d00, 0x8401, 0x9003, 0x0000},
    {0x8f02, 0x9700, 0x0000, 0x9003, 0x9003, 0x9003, 0x9003, 0x8a00, 0x8a00, 0x8000, 0x8401, 0x0000},
    {0x9102, 0x8805, 0x0000, 0x8401, 0x8401, 0x8401, 0x8401, 0xd700, 0x9700, 0x8f02, 0x8f02, 0x0000},
    {0x8701, 0x8f04, 0x9506, 0x8805, 0x8805, 0x8805, 0x8000, 0x0000, 0x8000, 0x9102, 0x9102, 0x0000},
    {0x9203, 0x8901, 0x0000, 0x9506, 0x9506, 0x8f04, 0x8f04, 0x0000, 0x8701, 0x8701, 0x8000, 0x0000},
    {0x8606, 0x8d04, 0x9602, 0x8000, 0x8000, 0x8000, 0x9203, 0x0000, 0x8901, 0x8901, 0x9203, 0x0000},
    {0x8306, 0x9204, 0x8a01, 0x8606, 0x8606, 0x8d04, 0x8d04, 0x0000, 0x0000, 0x9602, 0x9602, 0x0000},
    {0x8406, 0x8f03, 0x9705, 0x8306, 0x8306, 0x9204, 0x9204, 0x0000, 0xca01, 0xca01, 0x0000, 0x0000},
    {0x8103, 0x9105, 0x8807, 0x8406, 0x9705, 0x9705, 0x8f03, 0x0000, 0x0000, 0x0000, 0x8f03, 0x0000},
    {0x8e05, 0x9707, 0x0000, 0x8807, 0x8406, 0x9105, 0xc103, 0x0000, 0x0000, 0x0000, 0xc103, 0x0000},
    {0x8507, 0x8207, 0x0000, 0x9707, 0x9105, 0xce05, 0x0000, 0x0000, 0x0000, 0x0000, 0x0000, 0x0000},
    {0x0000, 0x0000, 0x0000, 0x8207, 0xce05, 0x0000, 0x0000, 0x0000, 0x0000, 0x0000, 0x0000, 0x0000},
    {0x0000, 0x0000, 0x0000, 0xc507, 0x0000, 0x0000, 0x0000, 0x0000, 0x0000, 0x0000, 0x0000, 0x0000},
};

constexpr int NWAVES = 8;
constexpr int BATCH = 8, SEQ = 2048, DM = 2048, M = BATCH * SEQ;
constexpr int NAH = 12, NMH = 4, ATTN_W = 1536, IN_W = 6664, IN_WP = 6912, DFF = 5632, UPW = 11264;
#ifndef MK_N_LAUNCHES
#define MK_N_LAUNCHES 1
#endif
#ifndef WGM_IN
#define WGM_IN 8
#endif
#ifndef WGM_OUT
#define WGM_OUT 4
#endif
#ifndef WGM_UP
#define WGM_UP 8
#endif
#ifndef WGM_DOWN
#define WGM_DOWN 4
#endif
constexpr int N_LAUNCHES = MK_N_LAUNCHES;
enum { PH_PRO = 0, PH_IN = 1, PH_PRE = 2, PH_MIX = 3, PH_OUT = 4, PH_UP = 5, PH_FIX = 6, PH_DOWN = 7 };
constexpr int PER_PHASE = 8;

constexpr size_t MiB = 1u << 20;
constexpr size_t WS_CTL = 0, CTL_ZERO_BYTES = 128 * 1024;
constexpr size_t WS_ROPE = 1 * MiB, WS_G = 2 * MiB, WS_SS = 2 * MiB + 512 * 1024, WS_IR = 3 * MiB;
constexpr size_t WS_WIN = 4 * MiB, WS_WOUT = 31 * MiB, WS_WUP = 39 * MiB, WS_WDN = 83 * MiB;
constexpr size_t WS_XN = 105 * MiB;
constexpr size_t WS_QB = 169 * MiB, WS_KB = 217 * MiB, WS_VB = 265 * MiB, WS_ML = 313 * MiB;
constexpr size_t WS_MIX = 377 * MiB;
constexpr size_t WS_RAW = 377 * MiB;
constexpr size_t WS_ACT = 169 * MiB;
constexpr size_t WS_MLC = 441 * MiB;
constexpr size_t WS_GA = 473 * MiB;
constexpr size_t WS_X1 = 441 * MiB;
constexpr size_t WS_END = 505 * MiB;
static_assert(WS_WIN + (size_t)IN_WP * DM * 2 <= WS_WOUT && WS_WOUT + (size_t)DM * DM * 2 <= WS_WUP && WS_WUP + (size_t)UPW * DM * 2 <= WS_WDN && WS_WDN + (size_t)DM * DFF * 2 <= WS_XN, "weights map");
static_assert(WS_XN + (size_t)M * DM * 2 <= WS_QB && WS_ML + (size_t)M * 2048 * 2 <= WS_MIX && WS_MIX + (size_t)M * 2048 * 2 <= WS_MLC && WS_MLC + (size_t)M * 1024 * 2 <= WS_GA && WS_GA + (size_t)32 * 16 * 3 * 128 * 4 <= WS_END && WS_X1 + (size_t)M * DM * 2 <= WS_END && WS_RAW + (size_t)256 * 4 * UPW * 4 <= WS_MLC && WS_ACT + (size_t)M * DFF * 2 <= WS_MIX, "activation map");
constexpr int CW_TMO = 0, CW_BAR = 4096, CW_QUEUE = 16384;

constexpr int RING_OFF = 0, RING_BYTES = 131072;
constexpr int SCR_OFF = RING_BYTES, SCR_BYTES = 24576;
constexpr int LDSCTL_OFF = SCR_OFF + SCR_BYTES, MISC_OFF = LDSCTL_OFF + 320;
constexpr int LDS_BYTES = 156672;
static_assert(MISC_OFF + 128 <= LDS_BYTES, "LDS map");

#define DI __device__ __forceinline__
typedef float f32x16 __attribute__((ext_vector_type(16)));
typedef short s16x4 __attribute__((ext_vector_type(4)));
typedef unsigned u32x2 __attribute__((ext_vector_type(2)));
#define MFMA32(a, b, c) __builtin_amdgcn_mfma_f32_32x32x16_bf16((a), (b), (c), 0, 0, 0)
constexpr float LOG2E = 1.4426950408889634f;

struct Frame {
    LAS unsigned char* lds; volatile LAS unsigned* MISC; gu32* ctl;
    int tid, lane, wave, vcu, G;
    float* out; unsigned char* ws;
};

DI unsigned swz_b(unsigned row) { return ((row & 3u) << 2) | ((row >> 2) & 3u); }
DI unsigned off_b(unsigned row, unsigned ch) { return 256u * row + 16u * (ch ^ swz_b(row)); }
DI bf16x8 lds_b128(LAS unsigned char* p) { return *(const LAS bf16x8*)p; }
DI LAS unsigned char* lp(unsigned a) { return (LAS unsigned char*)(size_t)a; }
typedef short v4i16_t __attribute__((ext_vector_type(4)));
DI s16x4 lds_tr(LAS unsigned char* p) { return __builtin_bit_cast(s16x4, __builtin_amdgcn_ds_read_tr16_b64_v4i16((LAS v4i16_t*)p)); }
DI int crow(int reg, int hh) { return (reg & 3) + 8 * (reg >> 2) + 4 * hh; }
typedef unsigned u32x4 __attribute__((ext_vector_type(4)));
typedef float f32x2_t __attribute__((ext_vector_type(2)));
typedef __bf16 bf16x2_t __attribute__((ext_vector_type(2)));
DI unsigned cvtpk(float lo, float hi) { f32x2_t v = {lo, hi}; bf16x2_t b = __builtin_convertvector(v, bf16x2_t); return __builtin_bit_cast(unsigned, b); }
DI bf16x8 pack8(float a0, float a1, float a2, float a3, float a4, float a5, float a6, float a7) {
    u32x4 p; p.x = cvtpk(a0, a1); p.y = cvtpk(a2, a3); p.z = cvtpk(a4, a5); p.w = cvtpk(a6, a7); return __builtin_bit_cast(bf16x8, p);
}
DI float bf_lo(unsigned w) { return __builtin_bit_cast(float, w << 16); }
DI float bf_hi(unsigned w) { return __builtin_bit_cast(float, w & 0xffff0000u); }

DI float wave_sum(float v) {
#pragma unroll
    for (int o = 1; o < 64; o <<= 1) v += __shfl_xor(v, o);
    return v;
}
template <int MAT> DI int colmap(int n) {
    if (MAT == 0) return n < 2 * ATTN_W ? (n & ~127) + ((n & 127) >> 1) + 64 * (n & 1) : (n < IN_W ? n : -1);
    if (MAT == 2) return DFF * ((n >> 7) & 1) + 128 * (n >> 8) + (n & 127);
    return n;
}
template <int MAT, bool SCALE, bool VEC> DI void transpose_items(const float* W, const float* gk, int K, int N, bf16* WT, LAS float* scr, int it0, int step, int it_end, int nblk, int lane) {
    if (it0 >= it_end) return;
    float cur[32], nxt[32];
    auto issue = [&](float (&r)[32], int item) {
        const int kb = item / nblk, nb = item % nblk, k0 = 64 * kb, n0 = 32 * nb;
        if (VEC) { const int q = lane & 7, kr = lane >> 3; const int col = colmap<MAT>(n0 + 4 * q);
#pragma unroll
            for (int i = 0; i < 8; ++i) { const f32x4 v = __builtin_nontemporal_load((const GAS f32x4*)(W + (size_t)(k0 + 8 * i + kr) * N + col)); r[4 * i] = v[0]; r[4 * i + 1] = v[1]; r[4 * i + 2] = v[2]; r[4 * i + 3] = v[3]; } }
        else { const int col = colmap<MAT>(n0 + (lane & 31));
#pragma unroll
            for (int i = 0; i < 32; ++i) r[i] = col >= 0 ? __builtin_nontemporal_load((const GAS float*)(W + (size_t)(k0 + 2 * i + (lane >> 5)) * N + col)) : 0.f; }
    };
    issue(cur, it0);
    for (int item = it0; item < it_end; item += step) {
        const bool has_next = item + step < it_end;
        if (has_next) issue(nxt, item + step);
        const int kb = item / nblk, nb = item % nblk, k0 = 64 * kb, n0 = 32 * nb;
        if (VEC) { const int q = lane & 7, kr = lane >> 3;
#pragma unroll
            for (int i = 0; i < 8; ++i)
#pragma unroll
                for (int j = 0; j < 4; ++j) scr[(8 * i + kr) * 33 + 4 * q + j] = cur[4 * i + j]; }
        else {
#pragma unroll
            for (int i = 0; i < 32; ++i) scr[(2 * i + (lane >> 5)) * 33 + (lane & 31)] = cur[i]; }
        const int c = lane & 7;
        f32x4 g0 = {1.f, 1.f, 1.f, 1.f}, g1v = g0;
        if (SCALE) { g0 = *(const GAS f32x4*)(gk + k0 + 8 * c); g1v = *(const GAS f32x4*)(gk + k0 + 8 * c + 4); }
        LDS_WAIT(); asm volatile("" ::: "memory");
#pragma unroll
        for (int j = 0; j < 4; ++j) { const int n = (lane >> 3) + 8 * j; const LAS float* sp = scr + (8 * c) * 33 + n;
            v4u o; o.x = cvtpk(sp[0 * 33] * g0[0], sp[1 * 33] * g0[1]); o.y = cvtpk(sp[2 * 33] * g0[2], sp[3 * 33] * g0[3]); o.z = cvtpk(sp[4 * 33] * g1v[0], sp[5 * 33] * g1v[1]); o.w = cvtpk(sp[6 * 33] * g1v[2], sp[7 * 33] * g1v[3]);
            if (VEC) __builtin_nontemporal_store(o, (GAS v4u*)(WT + (size_t)(n0 + n) * K + k0 + 8 * c)); else *(GAS v4u*)(WT + (size_t)(n0 + n) * K + k0 + 8 * c) = o; }
        LDS_WAIT(); asm volatile("" ::: "memory");
        if (has_next) {
#pragma unroll
            for (int i = 0; i < 32; ++i) cur[i] = nxt[i]; }
    }
}
DI void p0_prologue(Frame& F, const float* x, const float* g1, const float* w_in) {
    LAS float* scr = (LAS float*)(F.lds + RING_OFF + F.wave * 16384);
    const int gw = F.vcu * NWAVES + F.wave, NGW = F.G * NWAVES;
    constexpr int NB0 = IN_WP / 32, I0 = (DM / 64) * NB0;
    bf16* Win = (bf16*)(F.ws + WS_WIN);
    transpose_items<0, true, false>(w_in, g1, DM, IN_W, Win, scr, gw, NGW, I0, NB0, F.lane);
    {
        bf16* XN = (bf16*)(F.ws + WS_XN);
        f32x4 v[8], vn[8];
#pragma unroll
        for (int j = 0; j < 8; ++j) v[j] = __builtin_nontemporal_load((const GAS f32x4*)(x + (size_t)gw * DM) + F.lane + 64 * j);
        for (int m = gw; m < M; m += NGW) {
            const bool has_next = m + NGW < M;
            if (has_next) {
#pragma unroll
                for (int j = 0; j < 8; ++j) vn[j] = __builtin_nontemporal_load((const GAS f32x4*)(x + (size_t)(m + NGW) * DM) + F.lane + 64 * j); }
            float s = 0.f;
#pragma unroll
            for (int j = 0; j < 8; ++j) s += (v[j].x * v[j].x + v[j].y * v[j].y) + (v[j].z * v[j].z + v[j].w * v[j].w);
            const float rms = sqrtf(wave_sum(s) * (1.f / DM) + 1e-6f), rstd = 1.f / rms;
            if (F.lane == 0) ((float*)(F.ws + WS_IR))[m] = rms;
            GAS unsigned long long* o8 = (GAS unsigned long long*)(XN + (size_t)m * DM) + F.lane;
#pragma unroll
            for (int j = 0; j < 8; ++j) o8[64 * j] = (unsigned long long)cvtpk(v[j].x * rstd, v[j].y * rstd) | ((unsigned long long)cvtpk(v[j].z * rstd, v[j].w * rstd) << 32);
            if (has_next) {
#pragma unroll
                for (int j = 0; j < 8; ++j) v[j] = vn[j]; }
        }
    }
    {
        float* rope = (float*)(F.ws + WS_ROPE);
        for (int idx = gw * 64 + F.lane; idx < SEQ * 64; idx += NGW * 64) {
            const int t = idx >> 6, i = idx & 63; const double ang = (double)t * pow(10000.0, -(double)i / 64.0);
            rope[2 * idx] = (float)cos(ang); rope[2 * idx + 1] = (float)sin(ang);
        }
    }
}

DI void xhalf_swap(float& a, float& b) { asm("s_nop 1\n\tv_permlane32_swap_b32 %0, %1" : "+v"(a), "+v"(b)); }
DI float xhalf_max(float x) { float a = x, b = x; xhalf_swap(a, b); return fmaxf(a, b); }
DI float xhalf_sum(float x) { float a = x, b = x; xhalf_swap(a, b); return a + b; }
DI void att_dma_tile(const unsigned char* gbase, const unsigned (&voff)[8], LAS unsigned char* ldst) {
#pragma unroll
    for (int it = 0; it < 8; ++it) __builtin_amdgcn_global_load_lds((const unsigned*)(gbase + voff[it]), (LAS unsigned*)(ldst + it * 1024), 16, 0, 0);
}
constexpr int ATT_LUT_BYTES = 10 * 2048;
DI void att_build_lut(LAS unsigned char* lut, int tid) {
    for (int idx = tid; idx < 10 * 64 * 8; idx += NWAVES * 64) {
        const int type = idx >> 9, rem = idx & 511, ln = rem >> 3, pair = rem & 7, q = ln & 31, hh = ln >> 5;
        const int d0 = type < 6 ? 32 * type : 32 * (type & 1);
        unsigned w = 0;
#pragma unroll
        for (int k = 0; k < 2; ++k) {
            const int e = 2 * pair + k, d = d0 + q - 4 * hh - ((e & 3) + 8 * (e >> 2));
            int c;
            if (type < 6) c = (d >= 0 && d <= 128 ? 1 : 0) + (d >= 0 && (d & 3) == 0 ? 1 : 0) + (d >= 0 && d <= 32 ? 1 : 0);
            else if (type < 8) c = (d >= 0 && d <= 31) ? 1 : 0;
            else c = (d >= 1 && d <= 32) ? 1 : 0;
            const unsigned bits = c == 0 ? 0xFF80u : (c == 1 ? 0x0000u : (c == 2 ? 0x3F80u : 0x3FCBu));
            w |= bits << (16 * k);
        }
        *(LAS unsigned*)(lut + type * 2048 + (pair >> 2) * 1024 + ln * 16 + (pair & 3) * 4) = w;
    }
}
constexpr int AT_RING = RING_OFF, AT_STAGE = 16384, AT_OUT = RING_OFF + ATT_STAGES * AT_STAGE, AT_TAB = SCR_OFF + ATT_LUT_BYTES;
static_assert(AT_OUT + NWAVES * 4096 <= RING_OFF + RING_BYTES && AT_TAB + (ATT_NSLOT0 + ATT_NSLOT1) * 24 <= SCR_OFF + SCR_BYTES, "attention LDS map");
DI void attn_items(Frame& F, int qword0, const bf16* QB, const bf16* KB, const bf16* VB, bf16* MIX) {
    const int lane = F.lane, w = F.wave;
    const int q = lane & 31, hh = lane >> 5;
    LAS unsigned char* lut = F.lds + SCR_OFF;
    LAS unsigned char* ring = F.lds + AT_RING;
    const unsigned prow = 4u * (unsigned)w + ((unsigned)lane >> 4), pvoff = prow * 3072u + (((unsigned)lane & 15u) ^ swz_b(prow)) * 16u;
    const unsigned qi = (lane & 15) >> 2, pp = lane & 3, g16 = (lane >> 4) & 1;
    const unsigned swl = 16u * swz_b((unsigned)q), rowb_l = 256u * (unsigned)q;
    unsigned tp[2];
#pragma unroll
    for (int t = 0; t < 2; ++t) tp[t] = 2048u * t + 1024u * hh + 256u * qi + 8u * (pp & 1) + 16u * ((2u * g16 + (pp >> 1)) ^ ((2u * t + hh) & 3u));
    int qsel = (int)(xb_xcc_id() & 7u), tries = 0;
    auto fetch = [&]() -> unsigned {
        while (tries < 8) {
            const unsigned u = xb_add((unsigned*)(F.ctl + qword0 + 64 * qsel), 1u);
            if (u < 96u) return ((unsigned)qsel << 8) | u;
            qsel = (qsel + 1) & 7; ++tries;
        }
        return 0xFFFFFFFFu; };
    auto load_tile = [&](unsigned le, int r, const unsigned char* kbase, const unsigned char* vbase) {
        const unsigned st = (le >> 10) & 7u, kind = (le >> 8) & 3u, k = le & 15u; const unsigned rc = (unsigned)(r + kind) & 3u;
        const size_t goff = (size_t)(rc * 512u + 32u * k) * 3072u;
        LAS unsigned char* dst = ring + st * AT_STAGE + w * 1024;
        __builtin_amdgcn_global_load_lds((const unsigned*)(kbase + goff + pvoff), (LAS unsigned*)dst, 16, 0, 0);
        __builtin_amdgcn_global_load_lds((const unsigned*)(vbase + goff + pvoff), (LAS unsigned*)(dst + 8192), 16, 0, 0); };
    auto load_row = [&](unsigned ev, int r, const unsigned char* kbase, const unsigned char* vbase) {
#pragma unroll
        for (int j = 0; j < 3; ++j) { const unsigned le = (unsigned)__builtin_amdgcn_readlane((int)ev, j); if (le & 0x8000u) load_tile(le, r, kbase, vbase); } };
#define AT_SLOT_END() do { asm volatile("s_waitcnt vmcnt(0)\n\ts_waitcnt lgkmcnt(0)" ::: "memory"); __builtin_amdgcn_s_barrier(); asm volatile("" ::: "memory"); } while (0)
    if (F.tid == 0) F.MISC[4] = fetch();
    __syncthreads();
    unsigned code = F.MISC[4];
    if (code == 0xFFFFFFFFu) return;
    bf16x8 qf[8];
    int b, h, r, pass, ib; const LAS unsigned short* tab; int nslot; const unsigned char* kbase; const unsigned char* vbase;
    auto decode = [&](unsigned c) { const int u = (int)(c & 255u), qs = (int)(c >> 8); pass = u >= 48 ? 1 : 0; const int idx = u - 48 * pass; b = qs; h = idx >> 2; r = idx & 3;
        ib = pass ? ATT_BLK1[w] : ATT_BLK0[w]; tab = (const LAS unsigned short*)(F.lds + AT_TAB) + (pass ? ATT_NSLOT0 * 12 : 0); nslot = pass ? ATT_NSLOT1 : ATT_NSLOT0;
        kbase = (const unsigned char*)(KB + (size_t)b * 2048 * 1536 + h * 128); vbase = (const unsigned char*)(VB + (size_t)b * 2048 * 1536 + h * 128); };
    auto load_q = [&]() { const bf16* qp = QB + ((size_t)b * 2048 + r * 512 + 32 * ib + q) * 1536 + h * 128 + 8 * hh;
#pragma unroll
        for (int ks = 0; ks < 8; ++ks) asm volatile("global_load_dwordx4 %0, %1, off" : "=&v"(qf[ks]) : "v"(qp + 16 * ks) : "memory"); };
    decode(code);
    f32x16 o[4]; float mrun = -1e30f, lsum = 0.f;
    int ob_ = 0, oh = 0, orr = 0, oib = 0; bool have_prev = false;
    auto finalize = [&]() {
            lsum = xhalf_sum(lsum);
            const float inv = 1.0f / lsum;
            LAS unsigned char* og = F.lds + AT_OUT + w * 4096;
            unsigned char* ob = (unsigned char*)(MIX + ((size_t)ob_ * 2048 + 4 * 32 * oib + orr) * 2048 + oh * 128);
#pragma unroll
            for (int hf = 0; hf < 2; ++hf) {
#pragma unroll
                for (int cl = 0; cl < 2; ++cl)
#pragma unroll
                    for (int g = 0; g < 4; ++g) {
                        const int c = 2 * hf + cl;
                        u32x2 wv; wv.x = cvtpk(o[c][4 * g] * inv, o[c][4 * g + 1] * inv); wv.y = cvtpk(o[c][4 * g + 2] * inv, o[c][4 * g + 3] * inv);
                        *(LAS u32x2*)(og + 128u * (unsigned)q + 16u * ((unsigned)(4 * cl + g) ^ ((unsigned)q & 7u)) + 8u * hh) = wv;
                    }
                asm volatile("s_waitcnt lgkmcnt(0)" ::: "memory");
#pragma unroll
                for (int it = 0; it < 4; ++it) {
                    const unsigned row = 8 * it + (lane >> 3), ch = lane & 7;
                    const u32x4 v = *(const LAS u32x4*)(og + 128u * row + 16u * (ch ^ (row & 7u)));
                    *(GAS u32x4*)(ob + (size_t)row * 16384 + hf * 128 + ch * 16) = v;
                }
                asm volatile("s_waitcnt lgkmcnt(0)" ::: "memory");
            }
    };
    for (;;) {
        load_row(tab[lane < 12 ? lane : 11], r, kbase, vbase);
        if (have_prev) finalize();
        load_q();
        AT_SLOT_END();
        unsigned nxt = 0xFFFFFFFFu; if (F.tid == 0) nxt = fetch();
#pragma unroll
        for (int c = 0; c < 4; ++c)
#pragma unroll
            for (int e = 0; e < 16; ++e) o[c][e] = 0.f;
        mrun = -1e30f; lsum = 0.f;
        unsigned evn = tab[12 + (lane < 12 ? lane : 11)];
        for (int u = 1; u < nslot; ++u) {
            const unsigned ev = evn; evn = tab[(u + 1) * 12 + (lane < 12 ? lane : 11)];
            const unsigned ce = (unsigned)__builtin_amdgcn_readlane((int)ev, 3 + w);
            load_row(ev, r, kbase, vbase);
            if (ce & 0x8000u) {
                const unsigned st = (ce >> 10) & 7u, kind = (ce >> 8) & 3u, k = ce & 15u; const int d = ib - (int)k;
                const unsigned rc = (unsigned)(r + kind) & 3u;
                const int ty = kind == 0 ? (d < 5 ? d : 5) : ((unsigned)r > rc ? 6 : 8) + d;
                LAS unsigned char* Kt = ring + st * AT_STAGE; LAS unsigned char* Vt = Kt + 8192;
                const u32x4 bw0 = *(const LAS u32x4*)(lut + ty * 2048 + lane * 16), bw1 = *(const LAS u32x4*)(lut + ty * 2048 + 1024 + lane * 16);
                bf16x8 kf[8];
#pragma unroll
                for (int ks = 0; ks < 8; ++ks) kf[ks] = lds_b128(Kt + rowb_l + ((unsigned)(32 * ks + 16 * hh) ^ swl));
                f32x16 s;
#pragma unroll
                for (int e = 0; e < 16; ++e) s[e] = 0.f;
#pragma unroll
                for (int ks = 0; ks < 8; ++ks) s = MFMA32(kf[ks], qf[ks], s);
                s16x4 vlo[4][2], vhi[4][2];
#pragma unroll
                for (int c = 0; c < 4; ++c) {
                    const unsigned xc = 64u * ((unsigned)c ^ qi), a0 = (unsigned)(size_t)Vt + tp[0] + xc, a1 = (unsigned)(size_t)Vt + tp[1] + xc;
                    asm volatile("ds_read_b64_tr_b16 %0, %1" : "=&v"(vlo[c][0]) : "v"(a0) : "memory");
                    asm volatile("ds_read_b64_tr_b16 %0, %1" : "=&v"(vhi[c][0]) : "v"(a1) : "memory");
                    asm volatile("ds_read_b64_tr_b16 %0, %1 offset:4096" : "=&v"(vlo[c][1]) : "v"(a0) : "memory");
                    asm volatile("ds_read_b64_tr_b16 %0, %1 offset:4096" : "=&v"(vhi[c][1]) : "v"(a1) : "memory");
                }
                s[0] += bf_lo(bw0.x); s[1] += bf_hi(bw0.x); s[2] += bf_lo(bw0.y); s[3] += bf_hi(bw0.y); s[4] += bf_lo(bw0.z); s[5] += bf_hi(bw0.z); s[6] += bf_lo(bw0.w); s[7] += bf_hi(bw0.w);
                s[8] += bf_lo(bw1.x); s[9] += bf_hi(bw1.x); s[10] += bf_lo(bw1.y); s[11] += bf_hi(bw1.y); s[12] += bf_lo(bw1.z); s[13] += bf_hi(bw1.z); s[14] += bf_lo(bw1.w); s[15] += bf_hi(bw1.w);
                float mx = fmaxf(fmaxf(fmaxf(s[0], s[1]), fmaxf(s[2], s[3])), fmaxf(fmaxf(s[4], s[5]), fmaxf(s[6], s[7])));
                mx = fmaxf(mx, fmaxf(fmaxf(fmaxf(s[8], s[9]), fmaxf(s[10], s[11])), fmaxf(fmaxf(s[12], s[13]), fmaxf(s[14], s[15]))));
                mx = xhalf_max(mx);
                const float mnew = fmaxf(mrun, mx), alpha = __builtin_amdgcn_exp2f(mrun - mnew);
                float ps = 0.f;
#pragma unroll
                for (int e = 0; e < 16; ++e) { s[e] = __builtin_amdgcn_exp2f(s[e] - mnew); ps += s[e]; }
                lsum = lsum * alpha + ps;
                if (__any(mnew > mrun)) {
#pragma unroll
                    for (int c = 0; c < 4; ++c)
#pragma unroll
                        for (int e = 0; e < 16; ++e) o[c][e] *= alpha;
                }
                mrun = mnew;
                const bf16x8 pf0 = pack8(s[0], s[1], s[2], s[3], s[4], s[5], s[6], s[7]), pf1 = pack8(s[8], s[9], s[10], s[11], s[12], s[13], s[14], s[15]);
                asm volatile("s_waitcnt lgkmcnt(0)" ::: "memory");
                __builtin_amdgcn_sched_barrier(0);
#pragma unroll
                for (int c = 0; c < 4; ++c) {
                    o[c] = MFMA32(__builtin_shufflevector(vlo[c][0], vhi[c][0], 0, 1, 2, 3, 4, 5, 6, 7), pf0, o[c]);
                    o[c] = MFMA32(__builtin_shufflevector(vlo[c][1], vhi[c][1], 0, 1, 2, 3, 4, 5, 6, 7), pf1, o[c]);
                }
            }
            if (u == nslot - 1 && F.tid == 0) F.MISC[4] = nxt;
            AT_SLOT_END();
        }
        const unsigned code_n = F.MISC[4];
        ob_ = b; oh = h; orr = r; oib = ib; have_prev = true;
        if (code_n == 0xFFFFFFFFu) break;
        decode(code_n);
    }
    finalize();
#undef AT_SLOT_END
}
constexpr int CV_NB1 = DM / 32, CV_NB2 = UPW / 32, CV_NB3 = DM / 32, CV_I1 = (DM / 64) * CV_NB1, CV_I2 = (DM / 64) * CV_NB2, CV_I3 = (DFF / 64) * CV_NB3;
constexpr int CV_EARLY = 7424;
DI void convert_range(Frame& F, LAS float* scr, const float* w_out, const float* w_up, const float* g2, const float* w_down, int lo, int hi, int cw0, int cwn) {
    bf16* Wout = (bf16*)(F.ws + WS_WOUT); bf16* Wup = (bf16*)(F.ws + WS_WUP); bf16* Wdn = (bf16*)(F.ws + WS_WDN);
    auto clampi = [](int v, int a, int b) { return v < a ? a : (v > b ? b : v); };
    { const int a = clampi(lo, 0, CV_I1), b = clampi(hi, 0, CV_I1); if (b > a) transpose_items<1, false, true>(w_out, nullptr, DM, DM, Wout, scr, a + cw0, cwn, b, CV_NB1, F.lane); }
    { const int a = clampi(lo - CV_I1, 0, CV_I2), b = clampi(hi - CV_I1, 0, CV_I2); if (b > a) transpose_items<2, true, true>(w_up, g2, DM, UPW, Wup, scr, a + cw0, cwn, b, CV_NB2, F.lane); }
    { const int a = clampi(lo - CV_I1 - CV_I2, 0, CV_I3), b = clampi(hi - CV_I1 - CV_I2, 0, CV_I3); if (b > a) transpose_items<3, false, true>(w_down, nullptr, DFF, DM, Wdn, scr, a + cw0, cwn, b, CV_NB3, F.lane); }
}
constexpr int ML_SPLIT = 11;
constexpr int ML_WGS = 2 * BATCH * NMH;
DI void attn_phase(Frame& F, int qword0, const float* w_out, const float* w_up, const float* g2, const float* w_down, bool skip_conv) {
    const bf16* QB = (const bf16*)(F.ws + WS_QB); const bf16* KB = (const bf16*)(F.ws + WS_KB); const bf16* VB = (const bf16*)(F.ws + WS_VB); bf16* MIX = (bf16*)(F.ws + WS_MIX);
    if (!skip_conv)
        convert_range(F, (LAS float*)(F.lds + RING_OFF + F.wave * 16384), w_out, w_up, g2, w_down, F.G == 256 ? CV_EARLY : 0, CV_I1 + CV_I2 + CV_I3, ((int)blockIdx.x - ML_WGS) * NWAVES + F.wave, (F.G - ML_WGS) * NWAVES);
    __syncthreads();
    att_build_lut(F.lds + SCR_OFF, F.tid);
    for (int i = F.tid; i < (ATT_NSLOT0 + ATT_NSLOT1) * 12; i += NWAVES * 64) ((LAS unsigned short*)(F.lds + AT_TAB))[i] = ATT_SCHED[i / 12][i % 12];
    __syncthreads();
    attn_items(F, qword0, QB, KB, VB, MIX);
}

DI float scan_add64(float v, int lane) {
#pragma unroll
    for (int d = 1; d < 64; d <<= 1) { const float t = __shfl_up(v, d); if (lane >= d) v += t; }
    return v;
}
DI float scan_max64(float v, int lane) {
#pragma unroll
    for (int d = 1; d < 64; d <<= 1) { const float t = __shfl_up(v, d); if (lane >= d) v = fmaxf(v, t); }
    return v;
}
DI float silu_f(float y) { return y * __builtin_amdgcn_rcpf(1.0f + __builtin_amdgcn_exp2f(-LOG2E * y)); }
DI void mixer_prepass(Frame& F, const float* mcw, const float* mcb) {
    const bf16* ML = (const bf16*)(F.ws + WS_ML); bf16* MLC = (bf16*)(F.ws + WS_MLC); const float* G = (const float*)(F.ws + WS_G); float* GA = (float*)(F.ws + WS_GA);
    const int gw = F.vcu * NWAVES + F.wave, NGW = F.G * NWAVES;
    for (int it = gw; it < 32 * 16; it += NGW) {
        const int seq = it >> 4, ch = it & 15, b = seq >> 2, hm = seq & 3; const size_t mrow0 = (size_t)b * 2048 + ch * 128;
        const float gi0 = G[(mrow0 + F.lane) * 8 + hm], gf0 = G[(mrow0 + F.lane) * 8 + 4 + hm], gi1 = G[(mrow0 + 64 + F.lane) * 8 + hm], gf1 = G[(mrow0 + 64 + F.lane) * 8 + 4 + hm];
        const float lf0 = fminf(gf0, 0.f) - log1pf(expf(-fabsf(gf0))), lf1 = fminf(gf1, 0.f) - log1pf(expf(-fabsf(gf1)));
        const float b0 = scan_add64(lf0, F.lane); const float tot0 = __shfl(b0, 63); const float b1 = scan_add64(lf1, F.lane) + tot0;
        const float a0 = gi0 - b0, a1 = gi1 - b1;
        const float cm0 = scan_max64(a0, F.lane); const float M0 = __shfl(cm0, 63); const float cm1 = fmaxf(scan_max64(a1, F.lane), M0);
        float* o = GA + (size_t)it * 384;
        o[F.lane] = b0; o[64 + F.lane] = b1; o[128 + F.lane] = a0; o[192 + F.lane] = a1; o[256 + F.lane] = cm0; o[320 + F.lane] = cm1;
    }
    for (int it = gw * 64 + F.lane; it < (M / 4) * 128; it += NGW * 64) {
        const int c8 = it & 127, r4 = it >> 7, m0 = 4 * r4, t0 = m0 & 2047, ch0 = 8 * c8;
        u32x4 raw[7];
#pragma unroll
        for (int i = 0; i < 7; ++i) { u32x4 rv = *(const GAS u32x4*)(ML + (size_t)(m0 - 3 + i) * 2048 + ch0); if (t0 - 3 + i < 0) rv = (u32x4){0u, 0u, 0u, 0u}; raw[i] = rv; }
        float wt[5][8];
#pragma unroll
        for (int tap = 0; tap < 5; ++tap) { const float* wp = tap < 4 ? mcw + tap * 1024 + ch0 : mcb + ch0; const f32x4 a = *(const f32x4*)wp, bq = *(const f32x4*)(wp + 4);
            wt[tap][0] = a[0]; wt[tap][1] = a[1]; wt[tap][2] = a[2]; wt[tap][3] = a[3]; wt[tap][4] = bq[0]; wt[tap][5] = bq[1]; wt[tap][6] = bq[2]; wt[tap][7] = bq[3]; }
        const float osc = ch0 >= 512 ? 0.08838834764831845f : 1.0f;
#pragma unroll
        for (int rho = 0; rho < 4; ++rho) {
            float y[8];
#pragma unroll
            for (int j = 0; j < 8; ++j) y[j] = wt[4][j];
#pragma unroll
            for (int tap = 0; tap < 4; ++tap) { const u32x4 x = raw[rho + tap];
                y[0] += wt[tap][0] * bf_lo(x.x); y[1] += wt[tap][1] * bf_hi(x.x); y[2] += wt[tap][2] * bf_lo(x.y); y[3] += wt[tap][3] * bf_hi(x.y);
                y[4] += wt[tap][4] * bf_lo(x.z); y[5] += wt[tap][5] * bf_hi(x.z); y[6] += wt[tap][6] * bf_lo(x.w); y[7] += wt[tap][7] * bf_hi(x.w); }
#pragma unroll
            for (int j = 0; j < 8; ++j) y[j] = silu_f(y[j]) * osc;
            *(GAS bf16x8*)(MLC + (size_t)(m0 + rho) * 1024 + ch0) = pack8(y[0], y[1], y[2], y[3], y[4], y[5], y[6], y[7]);
        }
    }
}

constexpr int ML_Q = 0, ML_K = 32768, ML_V = 65536, ML_C = 98304;
constexpr int MS_A = 0, MS_U = 512, MS_WI = 1024, MS_WK = 1536, MS_EM = 2048, MS_NV = 2560, MS_GV = 3072, MS_CW = 3584, MS_NR = 8704, MS_RS = 12800, MS_SC = 13824;
DI void mlstm_seq(Frame& F, int b, int hm, const float* mng, int c0, int c1) {
    LAS unsigned char* L = F.lds + RING_OFF; LAS unsigned char* S = F.lds + SCR_OFF;
    LAS float* A_ = (LAS float*)(S + MS_A); LAS float* U_ = (LAS float*)(S + MS_U); LAS float* WI = (LAS float*)(S + MS_WI); LAS float* WK = (LAS float*)(S + MS_WK); LAS float* EM = (LAS float*)(S + MS_EM);
    LAS float* NV = (LAS float*)(S + MS_NV); LAS float* GV = (LAS float*)(S + MS_GV); LAS float* CW = (LAS float*)(S + MS_CW); LAS float* NR = (LAS float*)(S + MS_NR); LAS float* RS = (LAS float*)(S + MS_RS); LAS float* SC = (LAS float*)(S + MS_SC);
    const int w = F.wave;
    const bf16* ML = (const bf16*)(F.ws + WS_ML); const bf16* MLC = (const bf16*)(F.ws + WS_MLC); const float* GA = (const float*)(F.ws + WS_GA) + (size_t)(b * 4 + hm) * 16 * 384; bf16* MIX = (bf16*)(F.ws + WS_MIX);
    if (F.tid < 128) { GV[F.tid] = mng[hm * 128 + F.tid]; NV[F.tid] = 0.f; }
    for (int i = F.tid; i < 32768 / 16; i += 512) *(LAS u32x4*)(L + ML_C + 16 * i) = (u32x4){0u, 0u, 0u, 0u};
    f32x16 Cacc[2];
#pragma unroll
    for (int i = 0; i < 2; ++i)
#pragma unroll
        for (int e = 0; e < 16; ++e) Cacc[i][e] = 0.f;
    float mc = 0.f;
    const int tb = (w & 3) ^ (3 * (w >> 2)), eh = w >> 2;
    const int ebF = w >> 1, dbF0 = 2 * (w & 1);
#define ML_BAR() do { asm volatile("s_waitcnt lgkmcnt(0)" ::: "memory"); __builtin_amdgcn_s_barrier(); asm volatile("" ::: "memory"); } while (0)
#define ML_OPAQUE_TID(name) int name = F.tid; asm volatile("" : "+v"(name))
#define ML_THREAD_MAP(tidv) const int c16 = (tidv) & 15, rg = (tidv) >> 4; const unsigned rg16 = 16u * rg, c32 = 32u * c16; unsigned sa[4]; \
        _Pragma("unroll") for (int rho = 0; rho < 4; ++rho) sa[rho] = 1024u * rg + 256u * rho + 64u * (((unsigned)c16 >> 2) ^ (unsigned)rho) + 16u * (((unsigned)c16 & 3u) ^ ((unsigned)rg & 3u))
#define ML_LANE_MAP(tidv) const int lane = (tidv) & 63, hh = lane >> 5, l31 = lane & 31; const unsigned qi = (lane & 15) >> 2, pp = lane & 3, g16 = (lane >> 4) & 1; \
        const unsigned swl_ = 16u * swz_b((unsigned)l31), rowb_ = 256u * (unsigned)l31, hh8 = 8u * hh, hh16 = 16u * hh; unsigned tn[2], tp[2]; \
        _Pragma("unroll") for (int t = 0; t < 2; ++t) { tn[t] = 2048u * hh + 1024u * t + 256u * qi + 8u * (pp & 1) + 16u * ((2u * g16 + (pp >> 1)) ^ ((2u * hh + t) & 3u)); \
                                                       tp[t] = 2048u * t + 1024u * hh + 256u * qi + 8u * (pp & 1) + 16u * ((2u * g16 + (pp >> 1)) ^ ((2u * t + hh) & 3u)); }
#define SF(off) (*(LAS float*)(S + (off)))
#define SF4(off) (*(const LAS f32x4*)(S + (off)))
    u32x4 rq[4], rk_[4], rv4[4]; float pgt[6] = {0.f, 0.f, 0.f, 0.f, 0.f, 0.f};
    {
        const int c16 = F.tid & 15, rg = F.tid >> 4;
        const unsigned char* cq0 = (const unsigned char*)MLC + (size_t)b * 2048 * 2048 + 8192u * rg + 256u * hm + 16u * c16;
        const unsigned char* cv0 = (const unsigned char*)ML + (size_t)b * 2048 * 4096 + 16384u * rg + 2048 + 256u * hm + 16u * c16;
#pragma unroll
        for (int rho = 0; rho < 4; ++rho) { rk_[rho] = *(const GAS u32x4*)(cq0 + rho * 2048 + 1024); rv4[rho] = *(const GAS u32x4*)(cv0 + rho * 4096); }
        if (w == 0) {
#pragma unroll
            for (int i = 0; i < 6; ++i) pgt[i] = GA[64 * i + F.lane]; }
    }
    __syncthreads();
    for (int ch = 0; ch < c0; ++ch) {
        {
        ML_OPAQUE_TID(tidA); ML_THREAD_MAP(tidA);
#pragma unroll
        for (int rho = 0; rho < 4; ++rho) { *(LAS u32x4*)(lp(sa[rho]) + ML_K) = rk_[rho]; *(LAS u32x4*)lp(sa[rho] + ML_V) = rv4[rho]; }
        }
        if (w == 0) {
            ML_OPAQUE_TID(tidB); const int lane = tidB & 63; const unsigned l4 = 4u * lane;
            const float b1 = pgt[1], a0 = pgt[2], a1 = pgt[3], cm1 = pgt[5];
            const float Mall = __shfl(cm1, 63), blast = __shfl(b1, 63), mxa = fmaxf(mc, Mall);
            SF(MS_WK + l4) = __builtin_amdgcn_exp2f(LOG2E * (a0 - mxa)); SF(MS_WK + 256 + l4) = __builtin_amdgcn_exp2f(LOG2E * (a1 - mxa));
            if (lane == 0) SC[0] = __builtin_amdgcn_exp2f(LOG2E * (mc - mxa));
            mc = blast + mxa;
        }
        ML_BAR();
        {
            ML_OPAQUE_TID(tidP); const int c16 = tidP & 15, rg = tidP >> 4;
            int cn = ch + 1; asm volatile("" : "+s"(cn));
            const unsigned char* cq1 = (const unsigned char*)MLC + ((size_t)b * 2048 + cn * 128) * 2048 + 8192u * rg + 256u * hm + 16u * c16;
            const unsigned char* cv1 = (const unsigned char*)ML + ((size_t)b * 2048 + cn * 128) * 4096 + 16384u * rg + 2048 + 256u * hm + 16u * c16;
#pragma unroll
            for (int rho = 0; rho < 4; ++rho) { rk_[rho] = *(const GAS u32x4*)(cq1 + rho * 2048 + 1024); rv4[rho] = *(const GAS u32x4*)(cv1 + rho * 4096); }
            if (w == 0) { const float* ga1 = GA + cn * 384 + (tidP & 63);
#pragma unroll
                for (int i = 0; i < 6; ++i) pgt[i] = ga1[64 * i]; }
        }
        {
            ML_OPAQUE_TID(tidK); ML_THREAD_MAP(tidK); const int lane = tidK & 63;
            float ps[8] = {0.f, 0.f, 0.f, 0.f, 0.f, 0.f, 0.f, 0.f};
#pragma unroll
            for (int rho = 0; rho < 4; ++rho) {
                const float wk = SF(MS_WK + 4 * rho + rg16); const u32x4 kk = *(const LAS u32x4*)(lp(sa[rho]) + ML_K);
                const float v0 = bf_lo(kk.x) * wk, v1 = bf_hi(kk.x) * wk, v2 = bf_lo(kk.y) * wk, v3 = bf_hi(kk.y) * wk, v4 = bf_lo(kk.z) * wk, v5 = bf_hi(kk.z) * wk, v6 = bf_lo(kk.w) * wk, v7 = bf_hi(kk.w) * wk;
                ps[0] += v0; ps[1] += v1; ps[2] += v2; ps[3] += v3; ps[4] += v4; ps[5] += v5; ps[6] += v6; ps[7] += v7;
                *(LAS bf16x8*)(lp(sa[rho]) + ML_Q) = pack8(v0, v1, v2, v3, v4, v5, v6, v7);
            }
#pragma unroll
            for (int j = 0; j < 8; ++j) { ps[j] += __shfl_xor(ps[j], 16); ps[j] += __shfl_xor(ps[j], 32); }
            if ((lane >> 4) == 0) {
#pragma unroll
                for (int j = 0; j < 8; ++j) SF(MS_NR + 512 * w + 4 * j + c32) = ps[j];
            }
        }
        ML_BAR();
        {
        const float decay = SC[0];
        ML_OPAQUE_TID(tidF); const unsigned t4 = 4u * tidF;
        if (tidF < 128) { float a = 0.f;
#pragma unroll
            for (int ww = 0; ww < 8; ++ww) a += SF(MS_NR + 512 * ww + t4);
            SF(MS_NV + t4) = decay * SF(MS_NV + t4) + a; }
#pragma unroll
        for (int i = 0; i < 2; ++i)
#pragma unroll
            for (int e = 0; e < 16; ++e) Cacc[i][e] *= decay;
        ML_LANE_MAP(tidF);
        const unsigned xc_eF = 64u * ((unsigned)ebF ^ qi), xc_d0 = 64u * ((unsigned)dbF0 ^ qi), xc_d1 = 64u * ((unsigned)(dbF0 + 1) ^ qi);
        const unsigned aF0 = ML_V + tn[0] + xc_eF, aF1 = ML_V + tn[1] + xc_eF, aK00 = ML_Q + tn[0] + xc_d0, aK01 = ML_Q + tn[1] + xc_d0, aK10 = ML_Q + tn[0] + xc_d1, aK11 = ML_Q + tn[1] + xc_d1;
        bf16x8 af[8];
#pragma unroll
        for (int ks = 0; ks < 8; ++ks) { const s16x4 alo = lds_tr(lp(aF0) + 4096 * ks), ahi = lds_tr(lp(aF1) + 4096 * ks); af[ks] = __builtin_shufflevector(alo, ahi, 0, 1, 2, 3, 4, 5, 6, 7); }
#pragma unroll
        for (int i = 0; i < 2; ++i) {
            bf16x8 bk[8];
#pragma unroll
            for (int ks = 0; ks < 8; ++ks) { const s16x4 blo = lds_tr(lp(i ? aK10 : aK00) + 4096 * ks), bhi = lds_tr(lp(i ? aK11 : aK01) + 4096 * ks); bk[ks] = __builtin_shufflevector(blo, bhi, 0, 1, 2, 3, 4, 5, 6, 7); }
#pragma unroll
            for (int ks = 0; ks < 8; ++ks) Cacc[i] = MFMA32(af[ks], bk[ks], Cacc[i]);
        }
        }
        ML_BAR();
    }
    if (c0 > 0) {
        ML_OPAQUE_TID(tidW); ML_LANE_MAP(tidW);
#pragma unroll
        for (int i = 0; i < 2; ++i)
#pragma unroll
            for (int g = 0; g < 4; ++g) {
                u32x2 wv; wv.x = cvtpk(Cacc[i][4 * g], Cacc[i][4 * g + 1]); wv.y = cvtpk(Cacc[i][4 * g + 2], Cacc[i][4 * g + 3]);
                *(LAS u32x2*)lp(rowb_ + ((unsigned)(16 * (4 * ebF + g)) ^ swl_) + hh8 + ML_C + 8192u * (dbF0 + i)) = wv;
            }
    }
    {
        const int c16 = F.tid & 15, rg = F.tid >> 4;
        const unsigned char* cq0 = (const unsigned char*)MLC + ((size_t)b * 2048 + c0 * 128) * 2048 + 8192u * rg + 256u * hm + 16u * c16;
#pragma unroll
        for (int rho = 0; rho < 4; ++rho) rq[rho] = *(const GAS u32x4*)(cq0 + rho * 2048);
    }
    __syncthreads();
    for (int ch = c0; ch < c1; ++ch) {
        int t0 = ch * 128; asm volatile("" : "+s"(t0));
        const size_t mrow0 = (size_t)b * 2048 + t0;
        const unsigned char* cb0 = (const unsigned char*)ML + mrow0 * 4096;
        unsigned char* mb0 = (unsigned char*)MIX + mrow0 * 4096;
        {
        ML_OPAQUE_TID(tidA); ML_THREAD_MAP(tidA);
#pragma unroll
        for (int rho = 0; rho < 4; ++rho) { *(LAS u32x4*)(lp(sa[rho]) + ML_Q) = rq[rho]; *(LAS u32x4*)(lp(sa[rho]) + ML_K) = rk_[rho]; *(LAS u32x4*)lp(sa[rho] + ML_V) = rv4[rho]; }
        }
        __builtin_amdgcn_sched_barrier(0);
        if (w == 0) {
            ML_OPAQUE_TID(tidB); const int lane = tidB & 63; const unsigned l4 = 4u * lane;
            const float b0 = pgt[0], b1 = pgt[1], a0 = pgt[2], a1 = pgt[3], cm0 = pgt[4], cm1 = pgt[5];
            const float mx0 = fmaxf(mc, cm0), mx1 = fmaxf(mc, cm1);
            SF(MS_A + l4) = a0; SF(MS_A + 256 + l4) = a1; SF(MS_U + l4) = -mx0; SF(MS_U + 256 + l4) = -mx1;
            SF(MS_WI + l4) = __builtin_amdgcn_exp2f(LOG2E * (mc - mx0)); SF(MS_WI + 256 + l4) = __builtin_amdgcn_exp2f(LOG2E * (mc - mx1));
            SF(MS_EM + l4) = __builtin_amdgcn_exp2f(-LOG2E * (b0 + mx0)); SF(MS_EM + 256 + l4) = __builtin_amdgcn_exp2f(-LOG2E * (b1 + mx1));
            const float Mall = __shfl(cm1, 63), blast = __shfl(b1, 63), mxa = fmaxf(mc, Mall);
            SF(MS_WK + l4) = __builtin_amdgcn_exp2f(LOG2E * (a0 - mxa)); SF(MS_WK + 256 + l4) = __builtin_amdgcn_exp2f(LOG2E * (a1 - mxa));
            if (lane == 0) SC[0] = __builtin_amdgcn_exp2f(LOG2E * (mc - mxa));
            mc = blast + mxa;
        }
        ML_BAR();
        ML_OPAQUE_TID(tidC); ML_LANE_MAP(tidC);
        const unsigned tq4 = 4u * (32u * tb + l31);
        const unsigned voffO = 4096u * (32u * tb + l31) + 3072u + 256u * hm + 128u * eh + 8u * hh;
        unsigned rk[8];
#pragma unroll
        for (int ks = 0; ks < 8; ++ks) rk[ks] = rowb_ + ((unsigned)(32 * ks + 2 * hh8) ^ swl_);
        const unsigned xc_e0 = 64u * ((unsigned)(2 * eh) ^ qi), xc_e1 = 64u * ((unsigned)(2 * eh + 1) ^ qi);
        const unsigned aC00 = ML_C + tn[0] + xc_e0, aC01 = ML_C + tn[1] + xc_e0, aC10 = ML_C + tn[0] + xc_e1, aC11 = ML_C + tn[1] + xc_e1;
        const unsigned aV00 = ML_V + tp[0] + xc_e0, aV01 = ML_V + tp[1] + xc_e0, aV10 = ML_V + tp[0] + xc_e1, aV11 = ML_V + tp[1] + xc_e1;
        __builtin_amdgcn_sched_barrier(0);
        const int tq = 32 * tb + l31;
        const unsigned qoff = ML_Q + 8192u * tb;
        const float ut = SF(MS_U + tq4), wint = SF(MS_WI + tq4), emt = SF(MS_EM + tq4);
        bf16x8 qf[8];
#pragma unroll
        for (int ks = 0; ks < 8; ++ks) qf[ks] = lds_b128(lp(rk[ks] + qoff));
        f32x16 acc[2];
#pragma unroll
        for (int c = 0; c < 2; ++c) {
            __builtin_amdgcn_sched_barrier(0);
            bf16x8 cf[8];
#pragma unroll
            for (int ks = 0; ks < 8; ++ks) {
                const s16x4 lo = lds_tr(lp(c ? aC10 : aC00) + 4096 * ks);
                const s16x4 hi = lds_tr(lp(c ? aC11 : aC01) + 4096 * ks);
                cf[ks] = __builtin_shufflevector(lo, hi, 0, 1, 2, 3, 4, 5, 6, 7);
            }
#pragma unroll
            for (int e = 0; e < 16; ++e) acc[c][e] = 0.f;
#pragma unroll
            for (int ks = 0; ks < 8; ++ks) acc[c] = MFMA32(cf[ks], qf[ks], acc[c]);
#pragma unroll
            for (int e = 0; e < 16; ++e) acc[c][e] *= wint;
        }
        float qn = 0.f;
#pragma unroll
        for (int ks = 0; ks < 8; ++ks) { const f32x4 n0 = SF4(MS_NV + 64 * ks + 2 * hh16), n1 = SF4(MS_NV + 64 * ks + 16 + 2 * hh16); const u32x4 qq = __builtin_bit_cast(u32x4, qf[ks]);
            qn += bf_lo(qq.x) * n0[0] + bf_hi(qq.x) * n0[1] + bf_lo(qq.y) * n0[2] + bf_hi(qq.y) * n0[3] + bf_lo(qq.z) * n1[0] + bf_hi(qq.z) * n1[1] + bf_lo(qq.w) * n1[2] + bf_hi(qq.w) * n1[3]; }
        __builtin_amdgcn_sched_barrier(0);
        u32x4 og[4];
        { ML_OPAQUE_TID(tidO); const unsigned char* co = cb0 + 3072 + 256u * hm + 16384u * (tidO >> 4) + 16u * (tidO & 15);
#pragma unroll
          for (int rho = 0; rho < 4; ++rho) og[rho] = *(const GAS u32x4*)(co + rho * 4096); }
        float sumP = 0.f;
#pragma unroll
        for (int sb = 0; sb < 4; ++sb) {
            if (sb <= tb) {
                __builtin_amdgcn_sched_barrier(0);
                f32x16 s; bf16x8 kf[8];
#pragma unroll
                for (int e = 0; e < 16; ++e) s[e] = 0.f;
#pragma unroll
                for (int ks = 0; ks < 8; ++ks) kf[ks] = lds_b128(lp(rk[ks]) + ML_K + 8192 * sb);
#pragma unroll
                for (int ks = 0; ks < 8; ++ks) s = MFMA32(kf[ks], qf[ks], s);
#pragma unroll
                for (int g = 0; g < 4; ++g) { const f32x4 av = SF4(MS_A + 4 * (32 * sb + 8 * g) + hh16);
#pragma unroll
                    for (int j = 0; j < 4; ++j) { const int e = 4 * g + j; float p = s[e] * __builtin_amdgcn_exp2f(LOG2E * (ut + av[j])); if (sb == tb && crow(e, hh) > l31) p = 0.f; s[e] = p; sumP += p; } }
                const bf16x8 pf0 = pack8(s[0], s[1], s[2], s[3], s[4], s[5], s[6], s[7]), pf1 = pack8(s[8], s[9], s[10], s[11], s[12], s[13], s[14], s[15]);
                __builtin_amdgcn_sched_barrier(0);
                bf16x8 vf[2][2];
#pragma unroll
                for (int c = 0; c < 2; ++c)
#pragma unroll
                    for (int s2 = 0; s2 < 2; ++s2) {
                        const s16x4 lo = lds_tr(lp(c ? aV10 : aV00) + 8192 * sb + 4096 * s2);
                        const s16x4 hi = lds_tr(lp(c ? aV11 : aV01) + 8192 * sb + 4096 * s2);
                        vf[c][s2] = __builtin_shufflevector(lo, hi, 0, 1, 2, 3, 4, 5, 6, 7);
                    }
#pragma unroll
                for (int c = 0; c < 2; ++c) { acc[c] = MFMA32(vf[c][0], pf0, acc[c]); acc[c] = MFMA32(vf[c][1], pf1, acc[c]); }
            }
        }
        qn += __shfl_xor(qn, 32); sumP += __shfl_xor(sumP, 32);
        const float den = wint * qn + sumP, rden = 1.0f / fmaxf(fabsf(den), emt);
        __builtin_amdgcn_sched_barrier(0);
        ML_BAR();
#pragma unroll
        for (int c = 0; c < 2; ++c)
#pragma unroll
            for (int g = 0; g < 4; ++g) {
                u32x2 wv; wv.x = cvtpk(acc[c][4 * g] * rden, acc[c][4 * g + 1] * rden); wv.y = cvtpk(acc[c][4 * g + 2] * rden, acc[c][4 * g + 3] * rden);
                *(LAS u32x2*)lp(ML_Q + 8192u * tb + rowb_ + ((unsigned)(16 * (4 * (2 * eh + c) + g)) ^ swl_) + hh8) = wv;
            }
        ML_BAR();
        {
            ML_OPAQUE_TID(tidE); ML_THREAD_MAP(tidE);
            const f32x4 g0 = SF4(MS_GV + c32), g1v = SF4(MS_GV + 16 + c32);
            unsigned char* mo = mb0 + 3072 + 256u * hm + 16384u * rg + 16u * c16;
#pragma unroll
            for (int rho = 0; rho < 4; ++rho) {
                const u32x4 hv = *(const LAS u32x4*)(lp(sa[rho]) + ML_Q); const u32x4 ov = og[rho];
                float h[8] = {bf_lo(hv.x), bf_hi(hv.x), bf_lo(hv.y), bf_hi(hv.y), bf_lo(hv.z), bf_hi(hv.z), bf_lo(hv.w), bf_hi(hv.w)};
                const float o[8] = {bf_lo(ov.x), bf_hi(ov.x), bf_lo(ov.y), bf_hi(ov.y), bf_lo(ov.z), bf_hi(ov.z), bf_lo(ov.w), bf_hi(ov.w)};
                float ssq = 0.f;
#pragma unroll
                for (int j = 0; j < 8; ++j) { h[j] *= __builtin_amdgcn_rcpf(1.0f + __builtin_amdgcn_exp2f(-LOG2E * o[j])); ssq += h[j] * h[j]; }
                ssq += __shfl_xor(ssq, 1); ssq += __shfl_xor(ssq, 2); ssq += __shfl_xor(ssq, 4); ssq += __shfl_xor(ssq, 8);
                const float rstd = 1.0f / sqrtf(ssq * (1.0f / 128.0f) + 1e-6f);
                u32x4 wv; wv.x = cvtpk(h[0] * rstd * g0[0], h[1] * rstd * g0[1]); wv.y = cvtpk(h[2] * rstd * g0[2], h[3] * rstd * g0[3]); wv.z = cvtpk(h[4] * rstd * g1v[0], h[5] * rstd * g1v[1]); wv.w = cvtpk(h[6] * rstd * g1v[2], h[7] * rstd * g1v[3]);
                *(GAS u32x4*)(mo + rho * 4096) = wv;
            }
        }
        __builtin_amdgcn_sched_barrier(0);
        __builtin_amdgcn_sched_barrier(0);
        {
            ML_OPAQUE_TID(tidP); const int c16 = tidP & 15, rg = tidP >> 4;
            int cn1 = (ch + 1 < c1 ? ch + 1 : ch); asm volatile("" : "+s"(cn1));
            const unsigned char* cq1 = (const unsigned char*)MLC + ((size_t)b * 2048 + cn1 * 128) * 2048 + 8192u * rg + 256u * hm + 16u * c16;
            const unsigned char* cv1 = (const unsigned char*)ML + ((size_t)b * 2048 + cn1 * 128) * 4096 + 16384u * rg + 2048 + 256u * hm + 16u * c16;
#pragma unroll
            for (int rho = 0; rho < 4; ++rho) { rk_[rho] = *(const GAS u32x4*)(cq1 + rho * 2048 + 1024); rv4[rho] = *(const GAS u32x4*)(cv1 + rho * 4096); }
        }
        __builtin_amdgcn_sched_barrier(0);
        {
            ML_OPAQUE_TID(tidK); ML_THREAD_MAP(tidK); const int lane = tidK & 63;
            float ps[8] = {0.f, 0.f, 0.f, 0.f, 0.f, 0.f, 0.f, 0.f};
#pragma unroll
            for (int rho = 0; rho < 4; ++rho) {
                const float wk = SF(MS_WK + 4 * rho + rg16); const u32x4 kk = *(const LAS u32x4*)(lp(sa[rho]) + ML_K);
                const float v0 = bf_lo(kk.x) * wk, v1 = bf_hi(kk.x) * wk, v2 = bf_lo(kk.y) * wk, v3 = bf_hi(kk.y) * wk, v4 = bf_lo(kk.z) * wk, v5 = bf_hi(kk.z) * wk, v6 = bf_lo(kk.w) * wk, v7 = bf_hi(kk.w) * wk;
                ps[0] += v0; ps[1] += v1; ps[2] += v2; ps[3] += v3; ps[4] += v4; ps[5] += v5; ps[6] += v6; ps[7] += v7;
                *(LAS bf16x8*)(lp(sa[rho]) + ML_Q) = pack8(v0, v1, v2, v3, v4, v5, v6, v7);
            }
#pragma unroll
            for (int j = 0; j < 8; ++j) { ps[j] += __shfl_xor(ps[j], 16); ps[j] += __shfl_xor(ps[j], 32); }
            if ((lane >> 4) == 0) {
#pragma unroll
                for (int j = 0; j < 8; ++j) SF(MS_NR + 512 * w + 4 * j + c32) = ps[j];
            }
        }
        ML_BAR();
        {
            ML_OPAQUE_TID(tidP2); const int c16 = tidP2 & 15, rg = tidP2 >> 4;
            int cn1 = (ch + 1 < c1 ? ch + 1 : ch); asm volatile("" : "+s"(cn1));
            const unsigned char* cq1 = (const unsigned char*)MLC + ((size_t)b * 2048 + cn1 * 128) * 2048 + 8192u * rg + 256u * hm + 16u * c16;
#pragma unroll
            for (int rho = 0; rho < 4; ++rho) rq[rho] = *(const GAS u32x4*)(cq1 + rho * 2048);
            if (w == 0) { const float* ga1 = GA + cn1 * 384 + (tidP2 & 63);
#pragma unroll
                for (int i = 0; i < 6; ++i) pgt[i] = ga1[64 * i]; }
        }
        __builtin_amdgcn_sched_barrier(0);
        const float decay = SC[0];
        ML_OPAQUE_TID(tidF); const unsigned t4 = 4u * tidF;
        if (tidF < 128) { float a = 0.f;
#pragma unroll
            for (int ww = 0; ww < 8; ++ww) a += SF(MS_NR + 512 * ww + t4);
            SF(MS_NV + t4) = decay * SF(MS_NV + t4) + a; }
#pragma unroll
        for (int i = 0; i < 2; ++i)
#pragma unroll
            for (int e = 0; e < 16; ++e) Cacc[i][e] *= decay;
        {
        ML_LANE_MAP(tidF);
        const unsigned xc_eF = 64u * ((unsigned)ebF ^ qi), xc_d0 = 64u * ((unsigned)dbF0 ^ qi), xc_d1 = 64u * ((unsigned)(dbF0 + 1) ^ qi);
        const unsigned aF0 = ML_V + tn[0] + xc_eF, aF1 = ML_V + tn[1] + xc_eF, aK00 = ML_Q + tn[0] + xc_d0, aK01 = ML_Q + tn[1] + xc_d0, aK10 = ML_Q + tn[0] + xc_d1, aK11 = ML_Q + tn[1] + xc_d1;
        unsigned cwr[4];
#pragma unroll
        for (int g = 0; g < 4; ++g) cwr[g] = rowb_ + ((unsigned)(16 * (4 * ebF + g)) ^ swl_) + hh8;
        bf16x8 af[8];
#pragma unroll
        for (int ks = 0; ks < 8; ++ks) {
            const s16x4 alo = lds_tr(lp(aF0) + 4096 * ks);
            const s16x4 ahi = lds_tr(lp(aF1) + 4096 * ks);
            af[ks] = __builtin_shufflevector(alo, ahi, 0, 1, 2, 3, 4, 5, 6, 7);
        }
#pragma unroll
        for (int i = 0; i < 2; ++i) {
            bf16x8 bk[8];
#pragma unroll
            for (int ks = 0; ks < 8; ++ks) {
                const s16x4 blo = lds_tr(lp(i ? aK10 : aK00) + 4096 * ks);
                const s16x4 bhi = lds_tr(lp(i ? aK11 : aK01) + 4096 * ks);
                bk[ks] = __builtin_shufflevector(blo, bhi, 0, 1, 2, 3, 4, 5, 6, 7);
            }
#pragma unroll
            for (int ks = 0; ks < 8; ++ks) Cacc[i] = MFMA32(af[ks], bk[ks], Cacc[i]);
        }
#pragma unroll
        for (int i = 0; i < 2; ++i)
#pragma unroll
            for (int g = 0; g < 4; ++g) {
                u32x2 wv; wv.x = cvtpk(Cacc[i][4 * g], Cacc[i][4 * g + 1]); wv.y = cvtpk(Cacc[i][4 * g + 2], Cacc[i][4 * g + 3]);
                *(LAS u32x2*)lp(cwr[g] + ML_C + 8192u * (dbF0 + i)) = wv;
            }
        }
        ML_BAR();
    }
}

DI void ffn_fixup(Frame& F, const float* cw, const float* cb) {
    const bf16* RAWB = (const bf16*)(F.ws + WS_RAW); bf16* ACT = (bf16*)(F.ws + WS_ACT);
    const int gt = (F.vcu * NWAVES + F.wave) * 64 + F.lane, NT = F.G * NWAVES * 64;
    auto ld4 = [](const bf16* p) { const u32x2 w = *(const GAS u32x2*)p; return (f32x4){bf_lo(w.x), bf_hi(w.x), bf_lo(w.y), bf_hi(w.y)}; };
    for (int it = gt; it < 256 * 2 * (DFF / 4); it += NT) {
        const int j4 = it % (DFF / 4), rs = it / (DFF / 4), rho = rs & 1, strip = rs >> 1, j = 4 * j4;
        const int pg = (j >> 7) * 256 + (j & 127);
        const bool first = (strip & 31) == 0;
        const bf16* own = RAWB + (size_t)strip * 4 * UPW; const bf16* prv = RAWB + (size_t)(strip - 1) * 4 * UPW;
        const f32x4 z = {0.f, 0.f, 0.f, 0.f};
        f32x4 gm2, gm1, g0, vm2, vm1, v0;
        if (rho == 0) { gm2 = first ? z : ld4(prv + 2 * UPW + pg); gm1 = first ? z : ld4(prv + 3 * UPW + pg); g0 = ld4(own + pg);
                        vm2 = first ? z : ld4(prv + 2 * UPW + pg + 128); vm1 = first ? z : ld4(prv + 3 * UPW + pg + 128); v0 = ld4(own + pg + 128); }
        else { gm2 = first ? z : ld4(prv + 3 * UPW + pg); gm1 = ld4(own + pg); g0 = ld4(own + UPW + pg);
               vm2 = first ? z : ld4(prv + 3 * UPW + pg + 128); vm1 = ld4(own + pg + 128); v0 = ld4(own + UPW + pg + 128); }
        const f32x4 yg = *(const f32x4*)(cb + j) + *(const f32x4*)(cw + j) * gm2 + *(const f32x4*)(cw + UPW + j) * gm1 + *(const f32x4*)(cw + 2 * UPW + j) * g0;
        const f32x4 yv = *(const f32x4*)(cb + DFF + j) + *(const f32x4*)(cw + DFF + j) * vm2 + *(const f32x4*)(cw + UPW + DFF + j) * vm1 + *(const f32x4*)(cw + 2 * UPW + DFF + j) * v0;
        u32x2 wv; wv.x = cvtpk(silu_f(yg[0]) * yv[0], silu_f(yg[1]) * yv[1]); wv.y = cvtpk(silu_f(yg[2]) * yv[2], silu_f(yg[3]) * yv[3]);
        *(GAS u32x2*)(ACT + (size_t)(64 * strip + rho) * DFF + j) = wv;
    }
}

struct Args { const float* in[16]; float* out; unsigned char* ws; int ph_lo, ph_hi, li, pad; };
__global__ void __launch_bounds__(NWAVES * 64, 2) fwd_kernel(Args args) {
    extern __shared__ __attribute__((aligned(16))) unsigned char lds[];
    Frame F;
    F.lds = (LAS unsigned char*)lds; F.MISC = (volatile LAS unsigned*)(F.lds + MISC_OFF);
    F.tid = threadIdx.x; F.lane = F.tid & 63; F.wave = __builtin_amdgcn_readfirstlane(F.tid >> 6);
    F.G = gridDim.x; { const int bx = blockIdx.x; F.vcu = (F.G % 8 == 0) ? (bx % 8) * (F.G / 8) + bx / 8 : bx; }
    F.ws = args.ws; F.ctl = (gu32*)(args.ws + WS_CTL); F.out = args.out;
    for (int u = F.tid; u < (LDS_BYTES - LDSCTL_OFF) / 4; u += NWAVES * 64) ((LAS unsigned*)(F.lds + LDSCTL_OFF))[u] = 0u;
    __syncthreads();
    XcdBarrier bar; bar.bar = (unsigned*)(F.ctl + CW_BAR) + args.li * XCD_BAR_WORDS; bar.x = 0; bar.st = nullptr;
    if (N_LAUNCHES != PER_PHASE) bar = xcd_barrier_post((unsigned*)(F.ctl + CW_BAR) + args.li * XCD_BAR_WORDS, F.MISC + 8);
#define GRID_BAR(seam) do { if (N_LAUNCHES == PER_PHASE) { if (F.tid == 0) __hip_atomic_store(F.ctl + CW_TMO, 0xBADBA0u | (unsigned)(seam), RLX_AGENT); } else { xcd_barrier(bar); } } while (0)
    const int lo = args.ph_lo, hi = args.ph_hi;
#define IN(k) (lo <= (k) && (k) < hi)
#define BOTH(k) (IN(k) && IN((k) + 1))
    PG8_LAS float* escr = (PG8_LAS float*)(F.lds + SCR_OFF);
    if (IN(PH_PRO)) { p0_prologue(F, args.in[0], args.in[1], args.in[2]); if (BOTH(PH_PRO)) GRID_BAR(PH_PRO); }
    if (IN(PH_IN)) {
        pg8::Gemm g{(const pg8::bf16_t*)(F.ws + WS_XN), (const pg8::bf16_t*)(F.ws + WS_WIN), M, IN_WP, DM}; pg8::StaticOrder S; S.init(M, IN_WP, F.G, (int)blockIdx.x, WGM_IN);
        pg8::Epi1 E{(pg8::bf16_t*)(F.ws + WS_QB), (pg8::bf16_t*)(F.ws + WS_KB), (pg8::bf16_t*)(F.ws + WS_VB), (pg8::bf16_t*)(F.ws + WS_ML), (float*)(F.ws + WS_G), (const float*)(F.ws + WS_ROPE), args.in[3], args.in[4], args.in[7], args.in[8], escr};
        pg8::gemm_phase<pg8::Epi1, pg8::StaticOrder, true, true>(F.lds + RING_OFF, g, S, E);
        { constexpr int IDLE0 = (M / 256) * (IN_WP / 256) % 256;
          if (F.G == 256 && (int)blockIdx.x >= IDLE0)
              convert_range(F, (LAS float*)(F.lds + RING_OFF + F.wave * 16384), args.in[10], args.in[12], args.in[11], args.in[15], 0, CV_EARLY, ((int)blockIdx.x - IDLE0) * NWAVES + F.wave, (256 - IDLE0) * NWAVES);
        }
        if (BOTH(PH_IN)) GRID_BAR(PH_IN);
    }
    if (IN(PH_PRE)) { mixer_prepass(F, args.in[5], args.in[6]); if (BOTH(PH_PRE)) GRID_BAR(PH_PRE); }
    if (IN(PH_MIX)) {
#ifndef PROBE_P2
#define PROBE_P2 0
#endif
#ifndef PROBE_LIGHT_UP
#define PROBE_LIGHT_UP 0
#endif
        const bool skip_ml = PROBE_P2 >= 2 && args.li == 1, skip_at = PROBE_P2 == 1 && args.li == 1;
        const bool is_ml = (int)blockIdx.x < ML_WGS;
        if (is_ml && !skip_ml) { const int seq = (int)blockIdx.x & 31, part = (int)blockIdx.x >> 5; mlstm_seq(F, seq >> 2, seq & 3, args.in[9], part ? ML_SPLIT : 0, part ? SEQ / 128 : ML_SPLIT); __syncthreads(); }
        if (!skip_at) attn_phase(F, CW_QUEUE + 1024 * args.li, args.in[10], args.in[12], args.in[11], args.in[15], is_ml || (PROBE_P2 == 3 && args.li == 1));
        if (BOTH(PH_MIX)) GRID_BAR(PH_MIX);
    }
    if (IN(PH_OUT)) {
        pg8::Gemm g{(const pg8::bf16_t*)(F.ws + WS_MIX), (const pg8::bf16_t*)(F.ws + WS_WOUT), M, DM, DM}; pg8::StaticOrder S; S.init(M, DM, F.G, (int)blockIdx.x, WGM_OUT);
        pg8::Epi3 E{(const pg8::bf16_t*)(F.ws + WS_XN), (const float*)(F.ws + WS_IR), (pg8::bf16_t*)(F.ws + WS_X1), (float*)(F.ws + WS_SS), escr};
        pg8::gemm_phase<pg8::Epi3, pg8::StaticOrder, true, true>(F.lds + RING_OFF, g, S, E);
        if (BOTH(PH_OUT)) GRID_BAR(PH_OUT);
    }
    if (IN(PH_UP)) {
        pg8::Gemm g{(const pg8::bf16_t*)(F.ws + WS_X1), (const pg8::bf16_t*)(F.ws + WS_WUP), M, UPW, DM}; pg8::StaticOrder S; S.init(M, UPW, F.G, (int)blockIdx.x, WGM_UP);
        pg8::Epi4 E{(pg8::bf16_t*)(F.ws + WS_ACT), (pg8::bf16_t*)(F.ws + WS_RAW), (const float*)(F.ws + WS_SS), args.in[13], args.in[14], escr, args.li == 0 ? PROBE_LIGHT_UP : 0};
        pg8::gemm_phase<pg8::Epi4, pg8::StaticOrder, true, true>(F.lds + RING_OFF, g, S, E);
        if (BOTH(PH_UP)) GRID_BAR(PH_UP);
    }
    if (IN(PH_FIX)) { ffn_fixup(F, args.in[13], args.in[14]); if (BOTH(PH_FIX)) GRID_BAR(PH_FIX); }
    if (IN(PH_DOWN)) {
        pg8::Gemm g{(const pg8::bf16_t*)(F.ws + WS_ACT), (const pg8::bf16_t*)(F.ws + WS_WDN), M, DM, DFF}; pg8::StaticOrder S; S.init(M, DM, F.G, (int)blockIdx.x, WGM_DOWN);
        pg8::Epi5 E{F.out, (const pg8::bf16_t*)(F.ws + WS_X1)};
        pg8::gemm_phase<pg8::Epi5, pg8::StaticOrder, true, true>(F.lds + RING_OFF, g, S, E);
    }
#undef IN
#undef BOTH
}

extern "C" void kernel_launch(void* const* d_in, const int* in_sizes, int n_in, void* d_out, int out_size, void* d_ws, size_t ws_size, hipStream_t stream) {
    static int grid = 0;
    if (grid == 0) {
        if (n_in != 16 || in_sizes[0] != M * DM || out_size != M * DM || ws_size < WS_END) { fprintf(stderr, "kernel_launch: unexpected shapes (n_in %d in0 %d out %d ws %zu)\n", n_in, n_in > 0 ? in_sizes[0] : -1, out_size, ws_size); grid = -1; return; }
        int dev = 0, cus = 0, per_cu = 0;
        if (hipGetDevice(&dev) != hipSuccess || hipDeviceGetAttribute(&cus, hipDeviceAttributeMultiprocessorCount, dev) != hipSuccess) { grid = -1; return; }
        if (hipFuncSetAttribute((const void*)fwd_kernel, hipFuncAttributeMaxDynamicSharedMemorySize, LDS_BYTES) != hipSuccess) { fprintf(stderr, "kernel_launch: hipFuncSetAttribute failed\n"); grid = -1; return; }
        if (hipOccupancyMaxActiveBlocksPerMultiprocessor(&per_cu, (const void*)fwd_kernel, NWAVES * 64, LDS_BYTES) != hipSuccess || per_cu < 1) fprintf(stderr, "kernel_launch: occupancy query reports %d blocks per CU\n", per_cu);
        (void)hipGetLastError();
        grid = cus;
    }
    if (grid < 0) return;
    if (hipMemsetAsync((char*)d_ws + WS_CTL, 0, CTL_ZERO_BYTES, stream) != hipSuccess) return;
    Args a{};
    for (int i = 0; i < 16; ++i) a.in[i] = (const float*)d_in[i];
    a.out = (float*)d_out; a.ws = (unsigned char*)d_ws;
#ifdef PROBE_REPEAT
    { const int k = PROBE_REPEAT; const int lo[3] = {0, k, k + 1}, hi[3] = {k + 1, k + 1, PER_PHASE};
      for (int li = 0; li < 3; ++li) { a.ph_lo = lo[li]; a.ph_hi = hi[li]; a.li = li; hipLaunchKernelGGL(fwd_kernel, dim3(grid), dim3(NWAVES * 64), LDS_BYTES, stream, a); } }
#else
    if (N_LAUNCHES == 1) { a.ph_lo = 0; a.ph_hi = PER_PHASE; a.li = 0; hipLaunchKernelGGL(fwd_kernel, dim3(grid), dim3(NWAVES * 64), LDS_BYTES, stream, a); }
    else for (int li = 0; li < PER_PHASE; ++li) { a.ph_lo = li; a.ph_hi = li + 1; a.li = 0; hipLaunchKernelGGL(fwd_kernel, dim3(grid), dim3(NWAVES * 64), LDS_BYTES, stream, a); }
#endif
}
```

```cpp
#include <hip/hip_runtime.h>
#include <cstdio>
#include <cstdint>
#include <cmath>
namespace pg8 {
#define PG8_LAS __attribute__((address_space(3)))
typedef unsigned short bf16_t;
typedef short bf16x8 __attribute__((ext_vector_type(8)));
typedef float f32x4 __attribute__((ext_vector_type(4)));
typedef unsigned u32x4 __attribute__((ext_vector_type(4)));
constexpr int BM = 256, BK = 64, HALF = 128, HTB = HALF * BK * 2  , STAGE_BYTES = 8 * HTB, NXCD = 8, WGM = 8;

__host__ __device__ __forceinline__ int lds_byte(int r, int c) { const int st = (r >> 4) * 2 + (c >> 5), rr = r & 15, cc = c & 31, ob = rr * 64 + cc * 2; return st * 1024 + (ob ^ (((ob >> 9) & 1) << 5)); }
__host__ __device__ __forceinline__ void stage_rc(int b, int& R, int& C) { const int st = b / 1024, sb = b % 1024, swz = sb ^ (((sb >> 9) & 1) << 5); R = (st >> 1) * 16 + swz / 64; C = (st & 1) * 32 + (swz % 64) / 2; }
__host__ __device__ __forceinline__ int perm32(int rho) { const int n = rho >> 4, i = rho & 15; return 8 * (i >> 2) + 4 * n + (i & 3); }

struct Unit { int pm, pn; };
struct Gemm { const bf16_t* A; const bf16_t* Bt; int M, N, K; };

struct StaticOrder {
    int nM, nN, nwg, G, c, wgm;
    __host__ __device__ void init(int M, int N, int G_, int c_, int wgm_ = WGM) { nM = M / BM; nN = N / BM; nwg = nM * nN; G = G_; c = c_; wgm = wgm_; }
    __host__ __device__ bool next(int i, Unit& u) const {
        const long L = (long)i * G + c; if (L >= nwg) return false;
        int wgid = (int)L; { const int q = nwg / NXCD, r = nwg % NXCD, xcd = wgid % NXCD, off = wgid / NXCD; wgid = (xcd < r ? xcd * (q + 1) : r * (q + 1) + (xcd - r) * q) + off; }
        const int nig = wgm * nN, gid = wgid / nig, fm = gid * wgm, gsz = (nM - fm) < wgm ? (nM - fm) : wgm;
        u.pm = fm + ((wgid % nig) % gsz); u.pn = (wgid % nig) / gsz; return true;
    }
    __device__ __forceinline__ void a_ready(const Unit&) const {}
    __device__ __forceinline__ void done(const Unit&) const {}
};

__device__ __forceinline__ unsigned cvt_pk_bf16(float lo, float hi) { unsigned r; asm volatile("v_cvt_pk_bf16_f32 %0, %1, %2" : "=v"(r) : "v"(lo), "v"(hi)); return r; }

typedef float f32x2 __attribute__((ext_vector_type(2)));
#define EPI_BAR() do { asm volatile("s_waitcnt lgkmcnt(0)" ::: "memory"); __builtin_amdgcn_s_barrier(); asm volatile("" ::: "memory"); } while (0)
constexpr float kEps = 1e-6f;

struct Epi1 {
    static constexpr bool PERM = true, AFTER_DRAIN = false, APERM = false;
    __device__ __forceinline__ void pre(const Unit&, int, int) const {}
    bf16_t *QB, *KB, *VB, *ML; float* G; const float* rope; const float *qg, *kg, *b_i, *b_f; PG8_LAS float* scr;
    __device__ __forceinline__ void operator()(const f32x4 (&acc)[2][2][4][2], const Unit& u, int wr, int wc, int fr, int fq) const {
        const int pn = u.pn;
        if (pn < 12) {
            const bool isq = pn < 6;
#pragma unroll
            for (int ai = 0; ai < 2; ++ai)
#pragma unroll
                for (int m = 0; m < 4; ++m)
#pragma unroll
                    for (int bj = 0; bj < 2; ++bj) {
                        const f32x4 a = acc[ai][bj][m][0], b = acc[ai][bj][m][1];
                        float s = (a[0] * a[0] + a[1] * a[1]) + (a[2] * a[2] + a[3] * a[3]) + (b[0] * b[0] + b[1] * b[1]) + (b[2] * b[2] + b[3] * b[3]);
                        s += __shfl_xor(s, 16); s += __shfl_xor(s, 32);
                        if (fq == 0) scr[((ai * HALF + wr * 64 + m * 16 + fr) * 2 + bj) * 4 + wc] = s;
                    }
            EPI_BAR();
            const float* gsrc = isq ? qg : kg; const float gscale = isq ? 0.08838834764831845f * 1.4426950408889634f : 1.0f;
            f32x4 gva, gvb;
#pragma unroll
            for (int e = 0; e < 4; ++e) { const int p = 32 * wc + 8 * fq + e; gva[e] = gsrc[(p >> 1) + 64 * (p & 1)] * gscale; gvb[e] = gsrc[((p + 4) >> 1) + 64 * (p & 1)] * gscale; }
            bf16_t* dst = isq ? QB : KB; const int head0 = (isq ? pn : pn - 6) * 2;
#pragma unroll
            for (int ai = 0; ai < 2; ++ai)
#pragma unroll
                for (int m = 0; m < 4; ++m) {
                    const int rl = ai * HALF + wr * 64 + m * 16 + fr, grow = u.pm * BM + rl, t = grow & 2047, bb = grow >> 11;
                    const size_t drow = (size_t)bb * 2048 + (size_t)(t & 3) * 512 + (t >> 2);
                    const f32x4 cs0 = *(const f32x4*)(rope + ((size_t)t * 64 + 16 * wc + 4 * fq) * 2), cs1 = *(const f32x4*)(rope + ((size_t)t * 64 + 16 * wc + 4 * fq) * 2 + 4);
#pragma unroll
                    for (int bj = 0; bj < 2; ++bj) {
                        const f32x4 pp = *(const PG8_LAS f32x4*)(scr + (rl * 2 + bj) * 4);
                        const float rstd = 1.0f / sqrtf(((pp[0] + pp[1]) + (pp[2] + pp[3])) * (1.0f / 128.0f) + kEps);
                        const f32x4 a = acc[ai][bj][m][0] * (gva * rstd), b = acc[ai][bj][m][1] * (gvb * rstd);
                        const f32x2 xe0 = {a[0], a[2]}, xo0 = {a[1], a[3]}, xe1 = {b[0], b[2]}, xo1 = {b[1], b[3]};
                        const f32x2 c0 = {cs0[0], cs0[2]}, s0 = {cs0[1], cs0[3]}, c1 = {cs1[0], cs1[2]}, s1 = {cs1[1], cs1[3]};
                        const f32x2 oe0 = xe0 * c0 - xo0 * s0, oo0 = xe0 * s0 + xo0 * c0, oe1 = xe1 * c1 - xo1 * s1, oo1 = xe1 * s1 + xo1 * c1;
                        u32x4 w;
                        w.x = cvt_pk_bf16(oe0[0], oo0[0]); w.y = cvt_pk_bf16(oe0[1], oo0[1]); w.z = cvt_pk_bf16(oe1[0], oo1[0]); w.w = cvt_pk_bf16(oe1[1], oo1[1]);
                        *(u32x4*)(dst + drow * 1536 + (head0 + bj) * 128 + 32 * wc + 8 * fq) = w;
                    }
                }
        } else if (pn < 26) {
            const bool isv = pn < 18;
#pragma unroll
            for (int ai = 0; ai < 2; ++ai)
#pragma unroll
                for (int m = 0; m < 4; ++m) {
                    const int rl = ai * HALF + wr * 64 + m * 16 + fr, grow = u.pm * BM + rl, t = grow & 2047, bb = grow >> 11;
                    bf16_t* rowp = isv ? VB + ((size_t)bb * 2048 + (size_t)(t & 3) * 512 + (t >> 2)) * 1536 + (pn - 12) * 256 : ML + (size_t)grow * 2048 + (pn - 18) * 256;
#pragma unroll
                    for (int bj = 0; bj < 2; ++bj) {
                        const f32x4 a = acc[ai][bj][m][0], b = acc[ai][bj][m][1];
                        u32x4 w; w.x = cvt_pk_bf16(a[0], a[1]); w.y = cvt_pk_bf16(a[2], a[3]); w.z = cvt_pk_bf16(b[0], b[1]); w.w = cvt_pk_bf16(b[2], b[3]);
                        *(u32x4*)(rowp + bj * HALF + 32 * wc + 8 * fq) = w;
                    }
                }
        } else {
            if (wc == 0 && fq == 0) {
                const f32x4 bi = *(const f32x4*)b_i, bf = *(const f32x4*)b_f;
#pragma unroll
                for (int ai = 0; ai < 2; ++ai)
#pragma unroll
                    for (int m = 0; m < 4; ++m) {
                        const int grow = u.pm * BM + ai * HALF + wr * 64 + m * 16 + fr;
                        *(f32x4*)(G + (size_t)grow * 8) = acc[ai][0][m][0] + bi; *(f32x4*)(G + (size_t)grow * 8 + 4) = acc[ai][0][m][1] + bf;
                    }
            }
        }
    }
};

struct Epi3 {
    static constexpr bool PERM = true, AFTER_DRAIN = false, APERM = false;
    __device__ __forceinline__ void pre(const Unit&, int, int) const {}
    const bf16_t* XN; const float* IR; bf16_t* X1; float* SS; PG8_LAS float* scr;
    __device__ __forceinline__ void operator()(const f32x4 (&acc)[2][2][4][2], const Unit& u, int wr, int wc, int fr, int fq) const {
        const int col0 = u.pn * BM + 32 * wc + 8 * fq;
#pragma unroll
        for (int ai = 0; ai < 2; ++ai)
#pragma unroll
            for (int m = 0; m < 4; ++m) {
                const int rl = ai * HALF + wr * 64 + m * 16 + fr; const size_t off = (size_t)(u.pm * BM + rl) * 2048 + col0;
                const float ir = IR[u.pm * BM + rl];
                float s = 0.f;
#pragma unroll
                for (int bj = 0; bj < 2; ++bj) {
                    const u32x4 xw = __builtin_nontemporal_load((const u32x4*)(XN + off + bj * HALF));
                    const f32x4 x0 = {__builtin_bit_cast(float, xw.x << 16), __builtin_bit_cast(float, xw.x & 0xffff0000u), __builtin_bit_cast(float, xw.y << 16), __builtin_bit_cast(float, xw.y & 0xffff0000u)};
                    const f32x4 x1 = {__builtin_bit_cast(float, xw.z << 16), __builtin_bit_cast(float, xw.z & 0xffff0000u), __builtin_bit_cast(float, xw.w << 16), __builtin_bit_cast(float, xw.w & 0xffff0000u)};
                    const f32x4 a = acc[ai][bj][m][0] + x0 * ir, b = acc[ai][bj][m][1] + x1 * ir;
                    s += (a[0] * a[0] + a[1] * a[1]) + (a[2] * a[2] + a[3] * a[3]) + (b[0] * b[0] + b[1] * b[1]) + (b[2] * b[2] + b[3] * b[3]);
                    u32x4 w; w.x = cvt_pk_bf16(a[0], a[1]); w.y = cvt_pk_bf16(a[2], a[3]); w.z = cvt_pk_bf16(b[0], b[1]); w.w = cvt_pk_bf16(b[2], b[3]);
                    *(u32x4*)(X1 + off + bj * HALF) = w;
                }
                s += __shfl_xor(s, 16); s += __shfl_xor(s, 32);
                if (fq == 0) scr[rl * 4 + wc] = s;
            }
        EPI_BAR();
        if (wc == 0 && fq == 0) {
#pragma unroll
            for (int ai = 0; ai < 2; ++ai)
#pragma unroll
                for (int m = 0; m < 4; ++m) {
                    const int rl = ai * HALF + wr * 64 + m * 16 + fr; const f32x4 pp = *(const PG8_LAS f32x4*)(scr + rl * 4);
                    SS[(size_t)(u.pm * BM + rl) * 8 + u.pn] = (pp[0] + pp[1]) + (pp[2] + pp[3]);
                }
        }
    }
};

__device__ __forceinline__ float dpp_shr1(float v) { return __builtin_bit_cast(float, __builtin_amdgcn_update_dpp(0, __builtin_bit_cast(int, v), 0x111, 0xf, 0xf, true)); }
struct Epi4 {
    static constexpr bool PERM = true, AFTER_DRAIN = false, APERM = true;
    bf16_t* ACT; bf16_t* RAWB; const float* SS; const float *cw, *cb; PG8_LAS float* scr; int light;
    __device__ __forceinline__ void pre(const Unit& u, int wid, int lane) const {
        __builtin_amdgcn_global_load_lds((const unsigned*)((const char*)(SS + (size_t)u.pm * BM * 8) + wid * 1024 + lane * 16), (PG8_LAS unsigned*)((PG8_LAS char*)scr + wid * 1024), 16, 0, 0);
        if (wid < 4) { const int seg = 2 * wid + (lane >> 5), q4 = seg >> 1, gv = seg & 1;
            const float* src = (q4 < 3 ? cw + q4 * 11264 : cb) + (gv ? 5632 : 0) + u.pn * 128 + 4 * (lane & 31);
            __builtin_amdgcn_global_load_lds((const unsigned*)src, (PG8_LAS unsigned*)((PG8_LAS char*)scr + 8192 + wid * 1024), 16, 0, 0); }
    }
    __device__ __forceinline__ void operator()(f32x4 (&acc)[2][2][4][2], const Unit& u, int wr, int wc, int fr, int fq) const {
        if (light == 1) return;
        const int j0 = u.pn * 128 + 32 * wc + 8 * fq;
#pragma unroll
        for (int ai = 0; ai < 2; ++ai)
#pragma unroll
            for (int m = 0; m < 4; ++m) {
                const PG8_LAS float* sp = scr + (ai * HALF + wr * 64 + 4 * fr + m) * 8; const f32x4 s0 = *(const PG8_LAS f32x4*)sp, s1 = *(const PG8_LAS f32x4*)(sp + 4);
                const float rstd = 1.0f / sqrtf((((s0[0] + s0[1]) + (s0[2] + s0[3])) + ((s1[0] + s1[1]) + (s1[2] + s1[3]))) * (1.0f / 2048.0f) + kEps);
#pragma unroll
                for (int bj = 0; bj < 2; ++bj) { acc[ai][bj][m][0] = acc[ai][bj][m][0] * rstd; acc[ai][bj][m][1] = acc[ai][bj][m][1] * rstd; }
            }
        if (fr == 0 && light != 2) {
#pragma unroll
            for (int ai = 0; ai < 2; ++ai)
#pragma unroll
                for (int mm = 0; mm < 2; ++mm)
#pragma unroll
                    for (int bj = 0; bj < 2; ++bj) { bf16_t* p = RAWB + ((size_t)(u.pm * 4 + ai * 2 + wr) * 4 + mm) * 11264 + u.pn * 256 + bj * HALF + 32 * wc + 8 * fq; const f32x4 a = acc[ai][bj][mm][0], b = acc[ai][bj][mm][1];
                        u32x4 w; w.x = cvt_pk_bf16(a[0], a[1]); w.y = cvt_pk_bf16(a[2], a[3]); w.z = cvt_pk_bf16(b[0], b[1]); w.w = cvt_pk_bf16(b[2], b[3]); *(u32x4*)p = w; }
        }
        if (fr == 15 && light != 2) {
#pragma unroll
            for (int ai = 0; ai < 2; ++ai)
#pragma unroll
                for (int mm = 0; mm < 2; ++mm)
#pragma unroll
                    for (int bj = 0; bj < 2; ++bj) { bf16_t* p = RAWB + ((size_t)(u.pm * 4 + ai * 2 + wr) * 4 + 2 + mm) * 11264 + u.pn * 256 + bj * HALF + 32 * wc + 8 * fq; const f32x4 a = acc[ai][bj][2 + mm][0], b = acc[ai][bj][2 + mm][1];
                        u32x4 w; w.x = cvt_pk_bf16(a[0], a[1]); w.y = cvt_pk_bf16(a[2], a[3]); w.z = cvt_pk_bf16(b[0], b[1]); w.w = cvt_pk_bf16(b[2], b[3]); *(u32x4*)p = w; }
        }
#pragma unroll
        for (int ai = 0; ai < 2; ++ai) {
            unsigned pk[4][4];
#pragma unroll
            for (int n = 0; n < 2; ++n) {
                const PG8_LAS float* wl = scr + 2048 + 32 * wc + 8 * fq + 4 * n;
                const f32x4 wg0 = *(const PG8_LAS f32x4*)wl, wg1 = *(const PG8_LAS f32x4*)(wl + 256), wg2 = *(const PG8_LAS f32x4*)(wl + 512), bg = *(const PG8_LAS f32x4*)(wl + 768);
                const f32x4 wv0 = *(const PG8_LAS f32x4*)(wl + 128), wv1 = *(const PG8_LAS f32x4*)(wl + 384), wv2 = *(const PG8_LAS f32x4*)(wl + 640), bv = *(const PG8_LAS f32x4*)(wl + 896);
                f32x4 ug[6], uv[6];
#pragma unroll
                for (int j = 0; j < 4; ++j) { ug[0][j] = dpp_shr1(acc[ai][0][2][n][j]); ug[1][j] = dpp_shr1(acc[ai][0][3][n][j]); uv[0][j] = dpp_shr1(acc[ai][1][2][n][j]); uv[1][j] = dpp_shr1(acc[ai][1][3][n][j]); }
#pragma unroll
                for (int m = 0; m < 4; ++m) { ug[2 + m] = acc[ai][0][m][n]; uv[2 + m] = acc[ai][1][m][n]; }
#pragma unroll
                for (int m = 0; m < 4; ++m) {
                    const f32x4 yg = bg + wg0 * ug[m] + wg1 * ug[m + 1] + wg2 * ug[m + 2];
                    const f32x4 yv = bv + wv0 * uv[m] + wv1 * uv[m + 1] + wv2 * uv[m + 2];
                    const f32x4 t = yg * -1.4426950408889634f;
                    f32x4 sg; sg[0] = __builtin_amdgcn_rcpf(1.0f + __builtin_amdgcn_exp2f(t[0])); sg[1] = __builtin_amdgcn_rcpf(1.0f + __builtin_amdgcn_exp2f(t[1])); sg[2] = __builtin_amdgcn_rcpf(1.0f + __builtin_amdgcn_exp2f(t[2])); sg[3] = __builtin_amdgcn_rcpf(1.0f + __builtin_amdgcn_exp2f(t[3]));
                    const f32x4 res = (yg * yv) * sg;
                    pk[m][2 * n] = cvt_pk_bf16(res[0], res[1]); pk[m][2 * n + 1] = cvt_pk_bf16(res[2], res[3]);
                }
            }
#pragma unroll
            for (int m = 0; m < 4; ++m) {
                if ((m < 2 && fr == 0) || (light == 2 && pk[m][0] != 0x12345678u)) continue;
                const int grow = u.pm * BM + ai * HALF + wr * 64 + 4 * fr + m;
                u32x4 w; w.x = pk[m][0]; w.y = pk[m][1]; w.z = pk[m][2]; w.w = pk[m][3];
                *(u32x4*)(ACT + (size_t)grow * 5632 + j0) = w;
            }
        }
    }
};

struct Epi5 {
    static constexpr bool PERM = true, AFTER_DRAIN = false, APERM = false;
    __device__ __forceinline__ void pre(const Unit&, int, int) const {}
    float* out; const bf16_t* X1;
    __device__ __forceinline__ void operator()(const f32x4 (&acc)[2][2][4][2], const Unit& u, int wr, int wc, int fr, int fq) const {
        const int col0 = u.pn * BM + 32 * wc + 8 * fq;
#pragma unroll
        for (int ai = 0; ai < 2; ++ai)
#pragma unroll
            for (int m = 0; m < 4; ++m) {
                const size_t off = (size_t)(u.pm * BM + ai * HALF + wr * 64 + m * 16 + fr) * 2048 + col0;
#pragma unroll
                for (int bj = 0; bj < 2; ++bj) {
                    const u32x4 w = __builtin_nontemporal_load((const u32x4*)(X1 + off + bj * HALF));
                    const f32x4 r0 = {__builtin_bit_cast(float, w.x << 16), __builtin_bit_cast(float, w.x & 0xffff0000u), __builtin_bit_cast(float, w.y << 16), __builtin_bit_cast(float, w.y & 0xffff0000u)};
                    const f32x4 r1 = {__builtin_bit_cast(float, w.z << 16), __builtin_bit_cast(float, w.z & 0xffff0000u), __builtin_bit_cast(float, w.w << 16), __builtin_bit_cast(float, w.w & 0xffff0000u)};
                    __builtin_nontemporal_store(acc[ai][bj][m][0] + r0, (f32x4*)(out + off + bj * HALF)); __builtin_nontemporal_store(acc[ai][bj][m][1] + r1, (f32x4*)(out + off + bj * HALF + 4));
                }
            }
    }
};
template <class Epi, class Sched, bool ALIGN_EPI = false, bool SP2 = false>
__device__ __forceinline__ void gemm_phase(PG8_LAS unsigned char* lds, const Gemm g, const Sched& S, const Epi& E) {
    const int tid = threadIdx.x, wid = __builtin_amdgcn_readfirstlane(tid >> 6), lane = tid & 63, wr = wid >> 2, wc = wid & 3, fr = lane & 15, fq = lane >> 4;
    const int K = g.K, nt = K / BK;
    unsigned voffA[2], voffB[2];
#pragma unroll
    for (int i = 0; i < 2; ++i) { int R, C; stage_rc(tid * 16 + i * 8192, R, C); const int Rb = Epi::PERM ? ((R & ~31) + perm32(R & 31)) : R;
        const int Ra = Epi::APERM ? ((R & ~63) + 4 * (R & 15) + ((R >> 4) & 3)) : R;
        voffA[i] = (unsigned)(Ra * K + C) * 2u; voffB[i] = (unsigned)(Rb * K + C) * 2u; }
    const size_t kstep = (size_t)(BK * 2);
    const size_t hstep = (size_t)HALF * K * 2;
    const size_t tstep = 2 * hstep;
    const unsigned ldsw = (unsigned)wid * 1024u;
    const int aoff = lds_byte(wr * 64 + fr, fq * 8), boff = lds_byte(wc * 32 + fr, fq * 8);
#define PG8_SA(b, h) (((b) * 2 + (h)) * HTB)
#define PG8_SB(b, h) ((4 + (b) * 2 + (h)) * HTB)
#define PG8_STAGE(bufoff, gbase, voff) do { _Pragma("unroll") for (int _i = 0; _i < 2; ++_i) \
        __builtin_amdgcn_global_load_lds((const unsigned*)((const char*)(gbase) + (voff)[_i]), (PG8_LAS unsigned*)(lds + (bufoff) + ldsw + _i * 8192), 16, 0, 0); } while (0)
#define PG8_LDA(dst, b, h) do { _Pragma("unroll") for (int m = 0; m < 4; ++m) _Pragma("unroll") for (int k = 0; k < 2; ++k) dst[m][k] = *(const PG8_LAS bf16x8*)(lds + PG8_SA(b, h) + aoff + m * 2048 + k * 1024); } while (0)
#define PG8_LDB(dst, b, h) do { _Pragma("unroll") for (int n = 0; n < 2; ++n) _Pragma("unroll") for (int k = 0; k < 2; ++k) dst[n][k] = *(const PG8_LAS bf16x8*)(lds + PG8_SB(b, h) + boff + n * 2048 + k * 1024); } while (0)
#define PG8_MMA(ai, bj, At, Bt) do { __builtin_amdgcn_s_setprio(1); _Pragma("unroll") for (int m = 0; m < 4; ++m) _Pragma("unroll") for (int n = 0; n < 2; ++n) _Pragma("unroll") for (int k = 0; k < 2; ++k) \
        acc[ai][bj][m][n] = __builtin_amdgcn_mfma_f32_16x16x32_bf16(Bt[n][k], At[m][k], acc[ai][bj][m][n], 0, 0, 0); __builtin_amdgcn_s_setprio(0); } while (0)
#define PG8_WAIT_V(n) asm volatile("s_waitcnt vmcnt(" #n ")" ::: "memory")
#define PG8_WAIT_L(n) asm volatile("s_waitcnt lgkmcnt(" #n ")" ::: "memory")
#define PG8_BAR __builtin_amdgcn_s_barrier()
#define PG8_SCHED __builtin_amdgcn_sched_barrier(0)
    Unit cur, nxt; int ui = 0;
    if (!S.next(0, cur)) return;
    f32x4 acc[2][2][4][2];
#pragma unroll
    for (int a = 0; a < 2; ++a)
#pragma unroll
        for (int b = 0; b < 2; ++b)
#pragma unroll
            for (int m = 0; m < 4; ++m)
#pragma unroll
                for (int n = 0; n < 2; ++n) acc[a][b][m][n] = (f32x4){0.f, 0.f, 0.f, 0.f};
    bf16x8 At[4][2], B0[2][2], B1[2][2];
    const char* cA = (const char*)g.A + (size_t)cur.pm * tstep; const char* cB = (const char*)g.Bt + (size_t)cur.pn * tstep;
    S.a_ready(cur);
    if constexpr (SP2) {
        PG8_STAGE(PG8_SB(0, 0), cB, voffB); PG8_STAGE(PG8_SB(0, 1), cB + hstep, voffB); PG8_STAGE(PG8_SA(0, 0), cA, voffA); PG8_STAGE(PG8_SA(0, 1), cA + hstep, voffA);
        if (wr == 1) PG8_BAR;
        PG8_WAIT_V(2); PG8_BAR;
        PG8_STAGE(PG8_SB(1, 0), cB + kstep, voffB); PG8_STAGE(PG8_SA(1, 0), cA + kstep, voffA); PG8_STAGE(PG8_SB(1, 1), cB + hstep + kstep, voffB);
        PG8_WAIT_V(6); PG8_BAR;
    } else {
        PG8_STAGE(PG8_SB(0, 0), cB, voffB); PG8_STAGE(PG8_SA(0, 0), cA, voffA); PG8_STAGE(PG8_SB(0, 1), cB + hstep, voffB); PG8_STAGE(PG8_SA(0, 1), cA + hstep, voffA);
        if (wr == 1) PG8_BAR;
        PG8_WAIT_V(4); PG8_BAR;
        PG8_STAGE(PG8_SB(1, 0), cB + kstep, voffB); PG8_STAGE(PG8_SA(1, 0), cA + kstep, voffA); PG8_STAGE(PG8_SB(1, 1), cB + hstep + kstep, voffB);
        PG8_WAIT_V(6); PG8_BAR;
    }
    for (;;) {
        const bool has_next = S.next(ui + 1, nxt);
        const char* nA = has_next ? (const char*)g.A + (size_t)nxt.pm * tstep : cA; const char* nB = has_next ? (const char*)g.Bt + (size_t)nxt.pn * tstep : cB;
        for (int t = 0; t < nt; t += 2) {
            const bool last = (t == nt - 2);
            const char* a1 = cA + (size_t)(t + 1) * kstep;
            const char* a2 = last ? nA : cA + (size_t)(t + 2) * kstep; const char* b2 = last ? nB : cB + (size_t)(t + 2) * kstep;
            const char* a3 = a2 + kstep; const char* b3 = b2 + kstep;
            if (last && has_next) S.a_ready(nxt);
            if (last) E.pre(cur, wid, lane);
            if constexpr (SP2) {
            PG8_LDB(B0, 0, 0); PG8_LDB(B1, 0, 1); PG8_SCHED; PG8_LDA(At, 0, 0); PG8_STAGE(PG8_SA(1, 1), a1 + hstep, voffA);
            PG8_WAIT_V(8); PG8_WAIT_L(0); PG8_BAR; PG8_MMA(0, 0, At, B0); PG8_MMA(0, 1, At, B1); PG8_BAR; PG8_SCHED;
            PG8_LDA(At, 0, 1); PG8_STAGE(PG8_SB(0, 0), b2, voffB); PG8_STAGE(PG8_SB(0, 1), b2 + hstep, voffB); PG8_STAGE(PG8_SA(0, 0), a2, voffA);
            PG8_WAIT_V(8); PG8_WAIT_L(0); PG8_BAR; PG8_MMA(1, 0, At, B0); PG8_MMA(1, 1, At, B1); PG8_BAR; PG8_SCHED;
            PG8_LDB(B0, 1, 0); PG8_LDB(B1, 1, 1); PG8_SCHED; PG8_LDA(At, 1, 0); PG8_STAGE(PG8_SA(0, 1), a2 + hstep, voffA);
            PG8_WAIT_V(8); PG8_WAIT_L(0); PG8_BAR; PG8_MMA(0, 0, At, B0); PG8_MMA(0, 1, At, B1); PG8_BAR; PG8_SCHED;
            PG8_LDA(At, 1, 1); PG8_STAGE(PG8_SB(1, 0), b3, voffB); PG8_STAGE(PG8_SB(1, 1), b3 + hstep, voffB); PG8_STAGE(PG8_SA(1, 0), a3, voffA);
            PG8_WAIT_V(8); PG8_WAIT_L(0); PG8_BAR; PG8_MMA(1, 0, At, B0); PG8_MMA(1, 1, At, B1); PG8_BAR; PG8_SCHED;
            } else {
            PG8_LDB(B0, 0, 0); PG8_SCHED; PG8_LDA(At, 0, 0); PG8_STAGE(PG8_SA(1, 1), a1 + hstep, voffA);
            PG8_WAIT_L(8); PG8_BAR; PG8_WAIT_L(0); PG8_MMA(0, 0, At, B0); PG8_BAR; PG8_SCHED;
            PG8_LDB(B1, 0, 1); PG8_STAGE(PG8_SB(0, 0), b2, voffB);
            PG8_BAR; PG8_WAIT_L(0); PG8_MMA(0, 1, At, B1); PG8_BAR;
            PG8_LDA(At, 0, 1); PG8_STAGE(PG8_SA(0, 0), a2, voffA);
            PG8_BAR; PG8_WAIT_L(0); PG8_MMA(1, 0, At, B0); PG8_BAR; PG8_SCHED;
            PG8_STAGE(PG8_SB(0, 1), b2 + hstep, voffB);
            PG8_WAIT_V(6); PG8_BAR; PG8_MMA(1, 1, At, B1); PG8_BAR;
            PG8_LDB(B0, 1, 0); PG8_SCHED; PG8_LDA(At, 1, 0); PG8_STAGE(PG8_SA(0, 1), a2 + hstep, voffA);
            PG8_WAIT_L(8); PG8_BAR; PG8_WAIT_L(0); PG8_MMA(0, 0, At, B0); PG8_BAR; PG8_SCHED;
            PG8_LDB(B1, 1, 1); PG8_STAGE(PG8_SB(1, 0), b3, voffB);
            PG8_BAR; PG8_WAIT_L(0); PG8_MMA(0, 1, At, B1); PG8_BAR;
            PG8_LDA(At, 1, 1); PG8_STAGE(PG8_SA(1, 0), a3, voffA);
            PG8_BAR; PG8_WAIT_L(0); PG8_MMA(1, 0, At, B0); PG8_BAR; PG8_SCHED;
            PG8_STAGE(PG8_SB(1, 1), b3 + hstep, voffB);
            PG8_WAIT_V(6); PG8_BAR; PG8_MMA(1, 1, At, B1); PG8_BAR;
            }
        }
        if constexpr (ALIGN_EPI) { if (wr == 0) PG8_BAR; }
        if constexpr (!Epi::AFTER_DRAIN) { E(acc, cur, wr, wc, fr, fq); S.done(cur); }
        if (!has_next) break;
#pragma unroll
        for (int a = 0; a < 2; ++a)
#pragma unroll
            for (int b = 0; b < 2; ++b)
#pragma unroll
                for (int m = 0; m < 4; ++m)
#pragma unroll
                    for (int n = 0; n < 2; ++n) acc[a][b][m][n] = (f32x4){0.f, 0.f, 0.f, 0.f};
        cur = nxt; cA = nA; cB = nB; ++ui;
        if constexpr (ALIGN_EPI) { if (wr == 1) PG8_BAR; }
    }
    PG8_WAIT_V(0);
    if constexpr (!ALIGN_EPI) { if (wr == 0) PG8_BAR; }
    PG8_BAR;
    if constexpr (Epi::AFTER_DRAIN) { E.fused(acc, cur, wr, wc, fr, fq, lds, wid, lane); S.done(cur); }
#undef PG8_SA
#undef PG8_SB
#undef PG8_STAGE
#undef PG8_LDA
#undef PG8_LDB
#undef PG8_MMA
#undef PG8_WAIT_V
#undef PG8_WAIT_L
#undef PG8_BAR
#undef PG8_SCHED
}
}
#define GAS __attribute__((address_space(1)))
#define LAS __attribute__((address_space(3)))
typedef unsigned short bf16;
typedef unsigned v4u __attribute__((ext_vector_type(4)));
typedef float f32x4 __attribute__((ext_vector_type(4)));
typedef short bf16x8 __attribute__((ext_vector_type(8)));
typedef GAS unsigned gu32;
typedef GAS unsigned long long gu64;
#define RLX_AGENT __ATOMIC_RELAXED, __HIP_MEMORY_SCOPE_AGENT
#define LDS_WAIT() asm volatile("s_waitcnt lgkmcnt(0)" ::: "memory")
#define VM_WAIT() asm volatile("s_waitcnt vmcnt(0)" ::: "memory")
__device__ __forceinline__ unsigned long long rt() { return __builtin_amdgcn_s_memrealtime(); }
__device__ __forceinline__ unsigned f2bf(float f) { unsigned u = __builtin_bit_cast(unsigned, f); return (u + 0x7fffu + ((u >> 16) & 1u)) >> 16; }
__device__ __forceinline__ unsigned pk2(float lo, float hi) { return f2bf(lo) | (f2bf(hi) << 16); }

#define XB_TMO      128
#define XB_XCNT(j)  (256  + 64 * (j))
#define XB_XSUB(j)  (1280 + 64 * (j))
#define XB_XGEN(j)  (2304 + 64 * (j))
#define XB_TOP      3328
#define XB_TOPGEN   3392
#define XCD_BAR_WORDS 3456
#define XB_SPIN_CAP (1u << 18)

__device__ __forceinline__ unsigned xb_ld(unsigned* p)              { return __hip_atomic_load(p, __ATOMIC_RELAXED, __HIP_MEMORY_SCOPE_AGENT); }
__device__ __forceinline__ unsigned xb_add(unsigned* p, unsigned v) { return __hip_atomic_fetch_add(p, v, __ATOMIC_RELAXED, __HIP_MEMORY_SCOPE_AGENT); }
__device__ __forceinline__ unsigned xb_xcc_id() { return (unsigned)__builtin_amdgcn_s_getreg((3 << 11) | 20) & 0xFu; }
#define XB_SPIN(cond, bar) do { unsigned _sp = 0; while (cond) { __builtin_amdgcn_s_sleep(1); \
    if ((++_sp & 255u) == 0u) { if (xb_ld(&(bar)[XB_TMO])) break; if (_sp > XB_SPIN_CAP) { atomicAdd(&(bar)[XB_TMO], 1u); break; } } } } while (0)

struct XcdBarrier {
    unsigned* bar; unsigned x;
    volatile LAS unsigned* st;
};

__device__ __forceinline__ XcdBarrier xcd_barrier_post(unsigned* bar, volatile LAS unsigned* st) {
    XcdBarrier b; b.bar = bar; b.x = xb_xcc_id(); b.st = st;
    if (threadIdx.x == 0) (void)xb_add(&bar[XB_XCNT(b.x)], 1u);
    return b;
}
__device__ __forceinline__ void xcd_barrier_complete(unsigned* bar, unsigned x, unsigned& nloc, unsigned& nx) {
    const unsigned G = gridDim.x * gridDim.y * gridDim.z;
    unsigned sum, cnt, mine, sp = 0u;
    for (;;) {
        sum = 0u; cnt = 0u; mine = 0u;
#pragma unroll
        for (unsigned j = 0; j < 16; ++j) { const unsigned c = xb_ld(&bar[XB_XCNT(j)]); sum += c; cnt += (c > 0u) ? 1u : 0u; mine = (j == x) ? c : mine; }
        if (sum == G) break;
        __builtin_amdgcn_s_sleep(1);
        if ((++sp & 255u) == 0u) { if (xb_ld(&bar[XB_TMO])) break; if (sp > XB_SPIN_CAP) { atomicAdd(&bar[XB_TMO], 1u); break; } }
    }
    nloc = mine > 0u ? mine : 1u; nx = cnt > 0u ? cnt : 1u;
}

__device__ __forceinline__ void xcd_barrier(const XcdBarrier& b) {
    asm volatile("s_waitcnt vmcnt(0)" ::: "memory");
    __syncthreads();
    if (threadIdx.x == 0) {
        unsigned* bar = b.bar;
        __builtin_amdgcn_s_waitcnt(0);
        unsigned nloc = b.st[0], nx = b.st[1];
        if (nloc == 0u) { xcd_barrier_complete(bar, b.x, nloc, nx); b.st[0] = nloc; b.st[1] = nx; }
        const unsigned old = xb_add(&bar[XB_XSUB(b.x)], 1u);
        const unsigned gen = old / nloc;
        if (old + 1u == (gen + 1u) * nloc) {
            __builtin_amdgcn_fence(__ATOMIC_RELEASE, "agent");
            asm volatile("s_waitcnt vmcnt(0)" ::: "memory");
            const unsigned og = xb_add(&bar[XB_TOP], 1u);
            const unsigned tg = og / nx;
            if (og + 1u == (tg + 1u) * nx) xb_add(&bar[XB_TOPGEN], 1u);
            else XB_SPIN(xb_ld(&bar[XB_TOPGEN]) == tg, bar);
            __builtin_amdgcn_fence(__ATOMIC_ACQUIRE, "agent");
            xb_add(&bar[XB_XGEN(b.x)], 1u);
            asm volatile("s_waitcnt vmcnt(0)" ::: "memory");
        } else {
            XB_SPIN(xb_ld(&bar[XB_XGEN(b.x)]) == gen, bar);
            __builtin_amdgcn_fence(__ATOMIC_ACQUIRE, "agent");
            asm volatile("s_waitcnt vmcnt(0)" ::: "memory");
        }
    }
    __syncthreads();
}
constexpr int ATT_NSLOT0 = 23, ATT_NSLOT1 = 15, ATT_STAGES = 6, ATT_LAND = 1;
constexpr int ATT_BLK0[8] = {15, 14, 13, 12, 8, 9, 10, 11}, ATT_BLK1[8] = {7, 6, 5, 4, 0, 1, 2, 3};
__device__ const unsigned short ATT_SCHED[38][12] = {
    {0x8001, 0x8403, 0x8805, 0x0000, 0x0000, 0x0000, 0x0000, 0x0000, 0x0000, 0x0000, 0x0000, 0x0000},
    {0x8c00, 0x9004, 0x9406, 0x8001, 0x8001, 0x8001, 0x8001, 0x8805, 0x8805, 0x8805, 0x8805, 0x0000},
    {0x0000, 0x0000, 0x0000, 0x8805, 0x8805, 0x8805, 0x8805, 0x8001, 0x8001, 0x8001, 0x8001, 0x0000},
    {0x8008, 0x8807, 0x0000, 0x8403, 0x8403, 0x8403, 0x8403, 0x8403, 0x8403, 0x8403, 0x8403, 0x0000},
    {0x8402, 0x0000, 0x0000, 0x9004, 0x9004, 0x9004, 0x9004, 0x9004, 0x9004, 0x9004, 0x9004, 0x0000},
    {0x9009, 0x0000, 0x0000, 0x8c00, 0x8c00, 0x8c00, 0x8c00, 0x8c00, 0x8c00, 0x8c00, 0x8c00, 0x0000},
    {0x8c0a, 0x0000, 0x0000, 0x9406, 0x9406, 0x9406, 0x9406, 0x9406, 0x9406, 0x9406, 0x9406, 0x0000},
    {0x940b, 0x0000, 0x0000, 0x8807, 0x8807, 0x8807, 0x8807, 0x8008, 0x8008, 0x8008, 0x8008, 0x0000},
    {0x0000, 0x0000, 0x0000, 0x8008, 0x8008, 0x8008, 0x8008, 0x8807, 0x8807, 0x8807, 0x8807, 0x0000},
    {0x800c, 0x8908, 0x0000, 0x8c0a, 0x8c0a, 0x8c0a, 0x8c0a, 0x8402, 0x8402, 0x8c0a, 0x940b, 0x0000},
    {0x0000, 0x0000, 0x0000, 0x8402, 0x8402, 0x8402, 0x8402, 0x8908, 0x8908, 0x8402, 0x8c0a, 0x0000},
    {0x8e09, 0x8a08, 0x0000, 0x940b, 0x940b, 0x940b, 0x940b, 0x0000, 0x9009, 0x9009, 0x8402, 0x0000},
    {0x870a, 0x9708, 0x0000, 0x9009, 0x9009, 0x9009, 0x9009, 0x8a08, 0x8e09, 0x8e09, 0x9009, 0x0000},
    {0x900d, 0x8d0b, 0x0000, 0x800c, 0x800c, 0x800c, 0x800c, 0x9708, 0x8a08, 0x870a, 0x870a, 0x0000},
    {0x830e, 0x890c, 0x8709, 0x900d, 0x900d, 0x900d, 0x8d0b, 0x0000, 0x9708, 0x0000, 0x8d0b, 0x0000},
    {0x940e, 0x920a, 0x8f0c, 0x830e, 0x830e, 0x890c, 0x890c, 0x0000, 0x8709, 0x8709, 0x0000, 0x0000},
    {0x820e, 0x8a0b, 0x8509, 0x940e, 0x940e, 0x8f0c, 0x8f0c, 0x0000, 0x0000, 0x920a, 0x920a, 0x0000},
    {0x950e, 0x920c, 0x8d0a, 0x820e, 0x820e, 0x0000, 0x8a0b, 0x0000, 0xc509, 0x8509, 0x8a0b, 0x0000},
    {0x820d, 0x8b0b, 0x860f, 0x950e, 0x950e, 0x920c, 0x920c, 0x0000, 0x0000, 0xcd0a, 0x8d0a, 0x0000},
    {0x950d, 0x9307, 0x8d0f, 0x860f, 0x820d, 0x820d, 0xcb0b, 0x0000, 0x0000, 0x0000, 0xcb0b, 0x0000},
    {0x830d, 0x880f, 0x8607, 0x8d0f, 0x950d, 0x950d, 0x0000, 0x9307, 0x0000, 0x0000, 0x0000, 0x0000},
    {0x9507, 0x930f, 0x0000, 0x880f, 0xc30d, 0xc30d, 0x0000, 0x8607, 0x0000, 0x0000, 0x0000, 0x0000},
    {0x0000, 0x0000, 0x0000, 0xd30f, 0x0000, 0x0000, 0x0000, 0xd507, 0x0000, 0x0000, 0x0000, 0x0000},
    {0x8000, 0x8401, 0x8802, 0x0000, 0x0000, 0x0000, 0x0000, 0x0000, 0x0000, 0x0000, 0x0000, 0x0000},
    {0x8d00, 0x9003, 0x9404, 0x8802, 0x8802, 0x8802, 0x8802, 0x8000, 0x8401, 0x8802, 0x8802, 0x0000},
    {0x8a00, 0x0000, 0x0000, 0x9404, 0x9404, 0x9404, 0x9404, 0x8d00, 0x8d00, 0x8401, 0x9003, 0x0000},
    {0x8f02, 0x9700, 0x0000, 0x9003, 0x9003, 0x9003, 0x9003, 0x8a00, 0x8a00, 0x8000, 0x8401, 0x0000},
    {0x9102, 0x8805, 0x0000, 0x8401, 0x8401, 0x8401, 0x8401, 0xd700, 0x9700, 0x8f02, 0x8f02, 0x0000},
    {0x8701, 0x8f04, 0x9506, 0x8805, 0x8805, 0x8805, 0x8000, 0x0000, 0x8000, 0x9102, 0x9102, 0x0000},
    {0x9203, 0x8901, 0x0000, 0x9506, 0x9506, 0x8f04, 0x8f04, 0x0000, 0x8701, 0x8701, 0x8000, 0x0000},
    {0x8606, 0x8d04, 0x9602, 0x8000, 0x8000, 0x8000, 0x9203, 0x0000, 0x8901, 0x8901, 0x9203, 0x0000},
    {0x8306, 0x9204, 0x8a01, 0x8606, 0x8606, 0x8d04, 0x8d04, 0x0000, 0x0000, 0x9602, 0x9602, 0x0000},
    {0x8406, 0x8f03, 0x9705, 0x8306, 0x8306, 0x9204, 0x9204, 0x0000, 0xca01, 0xca01, 0x0000, 0x0000},
    {0x8103, 0x9105, 0x8807, 0x8406, 0x9705, 0x9705, 0x8f03, 0x0000, 0x0000, 0x0000, 0x8f03, 0x0000},
    {0x8e05, 0x9707, 0x0000, 0x8807, 0x8406, 0x9105, 0xc103, 0x0000, 0x0000, 0x0000, 0xc103, 0x0000},
    {0x8507, 0x8207, 0x0000, 0x9707, 0x9105, 0xce05, 0x0000, 0x0000, 0x0000, 0x0000, 0x0000, 0x0000},
    {0x0000, 0x0000, 0x0000, 0x8207, 0xce05, 0x0000, 0x0000, 0x0000, 0x0000, 0x0000, 0x0000, 0x0000},
    {0x0000, 0x0000, 0x0000, 0xc507, 0x0000, 0x0000, 0x0000, 0x0000, 0x0000, 0x0000, 0x0000, 0x0000},
};

constexpr int NWAVES = 8;
constexpr int BATCH = 8, SEQ = 2048, DM = 2048, M = BATCH * SEQ;
constexpr int NAH = 12, NMH = 4, ATTN_W = 1536, IN_W = 6664, IN_WP = 6912, DFF = 5632, UPW = 11264;
#ifndef MK_N_LAUNCHES
#define MK_N_LAUNCHES 1
#endif
#ifndef WGM_IN
#define WGM_IN 8
#endif
#ifndef WGM_OUT
#define WGM_OUT 4
#endif
#ifndef WGM_UP
#define WGM_UP 8
#endif
#ifndef WGM_DOWN
#define WGM_DOWN 4
#endif
constexpr int N_LAUNCHES = MK_N_LAUNCHES;
enum { PH_PRO = 0, PH_IN = 1, PH_PRE = 2, PH_MIX = 3, PH_OUT = 4, PH_UP = 5, PH_FIX = 6, PH_DOWN = 7 };
constexpr int PER_PHASE = 8;

constexpr size_t MiB = 1u << 20;
constexpr size_t WS_CTL = 0, CTL_ZERO_BYTES = 128 * 1024;
constexpr size_t WS_ROPE = 1 * MiB, WS_G = 2 * MiB, WS_SS = 2 * MiB + 512 * 1024, WS_IR = 3 * MiB;
constexpr size_t WS_WIN = 4 * MiB, WS_WOUT = 31 * MiB, WS_WUP = 39 * MiB, WS_WDN = 83 * MiB;
constexpr size_t WS_XN = 105 * MiB;
constexpr size_t WS_QB = 169 * MiB, WS_KB = 217 * MiB, WS_VB = 265 * MiB, WS_ML = 313 * MiB;
constexpr size_t WS_MIX = 377 * MiB;
constexpr size_t WS_RAW = 377 * MiB;
constexpr size_t WS_ACT = 169 * MiB;
constexpr size_t WS_MLC = 441 * MiB;
constexpr size_t WS_GA = 473 * MiB;
constexpr size_t WS_X1 = 441 * MiB;
constexpr size_t WS_END = 505 * MiB;
static_assert(WS_WIN + (size_t)IN_WP * DM * 2 <= WS_WOUT && WS_WOUT + (size_t)DM * DM * 2 <= WS_WUP && WS_WUP + (size_t)UPW * DM * 2 <= WS_WDN && WS_WDN + (size_t)DM * DFF * 2 <= WS_XN, "weights map");
static_assert(WS_XN + (size_t)M * DM * 2 <= WS_QB && WS_ML + (size_t)M * 2048 * 2 <= WS_MIX && WS_MIX + (size_t)M * 2048 * 2 <= WS_MLC && WS_MLC + (size_t)M * 1024 * 2 <= WS_GA && WS_GA + (size_t)32 * 16 * 3 * 128 * 4 <= WS_END && WS_X1 + (size_t)M * DM * 2 <= WS_END && WS_RAW + (size_t)256 * 4 * UPW * 4 <= WS_MLC && WS_ACT + (size_t)M * DFF * 2 <= WS_MIX, "activation map");
constexpr int CW_TMO = 0, CW_BAR = 4096, CW_QUEUE = 16384;

constexpr int RING_OFF = 0, RING_BYTES = 131072;
constexpr int SCR_OFF = RING_BYTES, SCR_BYTES = 24576;
constexpr int LDSCTL_OFF = SCR_OFF + SCR_BYTES, MISC_OFF = LDSCTL_OFF + 320;
constexpr int LDS_BYTES = 156672;
static_assert(MISC_OFF + 128 <= LDS_BYTES, "LDS map");

#define DI __device__ __forceinline__
typedef float f32x16 __attribute__((ext_vector_type(16)));
typedef short s16x4 __attribute__((ext_vector_type(4)));
typedef unsigned u32x2 __attribute__((ext_vector_type(2)));
#define MFMA32(a, b, c) __builtin_amdgcn_mfma_f32_32x32x16_bf16((a), (b), (c), 0, 0, 0)
constexpr float LOG2E = 1.4426950408889634f;

struct Frame {
    LAS unsigned char* lds; volatile LAS unsigned* MISC; gu32* ctl;
    int tid, lane, wave, vcu, G;
    float* out; unsigned char* ws;
};

DI unsigned swz_b(unsigned row) { return ((row & 3u) << 2) | ((row >> 2) & 3u); }
DI unsigned off_b(unsigned row, unsigned ch) { return 256u * row + 16u * (ch ^ swz_b(row)); }
DI bf16x8 lds_b128(LAS unsigned char* p) { return *(const LAS bf16x8*)p; }
DI LAS unsigned char* lp(unsigned a) { return (LAS unsigned char*)(size_t)a; }
typedef short v4i16_t __attribute__((ext_vector_type(4)));
DI s16x4 lds_tr(LAS unsigned char* p) { return __builtin_bit_cast(s16x4, __builtin_amdgcn_ds_read_tr16_b64_v4i16((LAS v4i16_t*)p)); }
DI int crow(int reg, int hh) { return (reg & 3) + 8 * (reg >> 2) + 4 * hh; }
typedef unsigned u32x4 __attribute__((ext_vector_type(4)));
typedef float f32x2_t __attribute__((ext_vector_type(2)));
typedef __bf16 bf16x2_t __attribute__((ext_vector_type(2)));
DI unsigned cvtpk(float lo, float hi) { f32x2_t v = {lo, hi}; bf16x2_t b = __builtin_convertvector(v, bf16x2_t); return __builtin_bit_cast(unsigned, b); }
DI bf16x8 pack8(float a0, float a1, float a2, float a3, float a4, float a5, float a6, float a7) {
    u32x4 p; p.x = cvtpk(a0, a1); p.y = cvtpk(a2, a3); p.z = cvtpk(a4, a5); p.w = cvtpk(a6, a7); return __builtin_bit_cast(bf16x8, p);
}
DI float bf_lo(unsigned w) { return __builtin_bit_cast(float, w << 16); }
DI float bf_hi(unsigned w) { return __builtin_bit_cast(float, w & 0xffff0000u); }

DI float wave_sum(float v) {
#pragma unroll
    for (int o = 1; o < 64; o <<= 1) v += __shfl_xor(v, o);
    return v;
}
template <int MAT> DI int colmap(int n) {
    if (MAT == 0) return n < 2 * ATTN_W ? (n & ~127) + ((n & 127) >> 1) + 64 * (n & 1) : (n < IN_W ? n : -1);
    if (MAT == 2) return DFF * ((n >> 7) & 1) + 128 * (n >> 8) + (n & 127);
    return n;
}
template <int MAT, bool SCALE, bool VEC> DI void transpose_items(const float* W, const float* gk, int K, int N, bf16* WT, LAS float* scr, int it0, int step, int it_end, int nblk, int lane) {
    if (it0 >= it_end) return;
    float cur[32], nxt[32];
    auto issue = [&](float (&r)[32], int item) {
        const int kb = item / nblk, nb = item % nblk, k0 = 64 * kb, n0 = 32 * nb;
        if (VEC) { const int q = lane & 7, kr = lane >> 3; const int col = colmap<MAT>(n0 + 4 * q);
#pragma unroll
            for (int i = 0; i < 8; ++i) { const f32x4 v = __builtin_nontemporal_load((const GAS f32x4*)(W + (size_t)(k0 + 8 * i + kr) * N + col)); r[4 * i] = v[0]; r[4 * i + 1] = v[1]; r[4 * i + 2] = v[2]; r[4 * i + 3] = v[3]; } }
        else { const int col = colmap<MAT>(n0 + (lane & 31));
#pragma unroll
            for (int i = 0; i < 32; ++i) r[i] = col >= 0 ? __builtin_nontemporal_load((const GAS float*)(W + (size_t)(k0 + 2 * i + (lane >> 5)) * N + col)) : 0.f; }
    };
    issue(cur, it0);
    for (int item = it0; item < it_end; item += step) {
        const bool has_next = item + step < it_end;
        if (has_next) issue(nxt, item + step);
        const int kb = item / nblk, nb = item % nblk, k0 = 64 * kb, n0 = 32 * nb;
        if (VEC) { const int q = lane & 7, kr = lane >> 3;
#pragma unroll
            for (int i = 0; i < 8; ++i)
#pragma unroll
                for (int j = 0; j < 4; ++j) scr[(8 * i + kr) * 33 + 4 * q + j] = cur[4 * i + j]; }
        else {
#pragma unroll
            for (int i = 0; i < 32; ++i) scr[(2 * i + (lane >> 5)) * 33 + (lane & 31)] = cur[i]; }
        const int c = lane & 7;
        f32x4 g0 = {1.f, 1.f, 1.f, 1.f}, g1v = g0;
        if (SCALE) { g0 = *(const GAS f32x4*)(gk + k0 + 8 * c); g1v = *(const GAS f32x4*)(gk + k0 + 8 * c + 4); }
        LDS_WAIT(); asm volatile("" ::: "memory");
#pragma unroll
        for (int j = 0; j < 4; ++j) { const int n = (lane >> 3) + 8 * j; const LAS float* sp = scr + (8 * c) * 33 + n;
            v4u o; o.x = cvtpk(sp[0 * 33] * g0[0], sp[1 * 33] * g0[1]); o.y = cvtpk(sp[2 * 33] * g0[2], sp[3 * 33] * g0[3]); o.z = cvtpk(sp[4 * 33] * g1v[0], sp[5 * 33] * g1v[1]); o.w = cvtpk(sp[6 * 33] * g1v[2], sp[7 * 33] * g1v[3]);
            if (VEC) __builtin_nontemporal_store(o, (GAS v4u*)(WT + (size_t)(n0 + n) * K + k0 + 8 * c)); else *(GAS v4u*)(WT + (size_t)(n0 + n) * K + k0 + 8 * c) = o; }
        LDS_WAIT(); asm volatile("" ::: "memory");
        if (has_next) {
#pragma unroll
            for (int i = 0; i < 32; ++i) cur[i] = nxt[i]; }
    }
}
DI void p0_prologue(Frame& F, const float* x, const float* g1, const float* w_in) {
    LAS float* scr = (LAS float*)(F.lds + RING_OFF + F.wave * 16384);
    const int gw = F.vcu * NWAVES + F.wave, NGW = F.G * NWAVES;
    constexpr int NB0 = IN_WP / 32, I0 = (DM / 64) * NB0;
    bf16* Win = (bf16*)(F.ws + WS_WIN);
    transpose_items<0, true, false>(w_in, g1, DM, IN_W, Win, scr, gw, NGW, I0, NB0, F.lane);
    {
        bf16* XN = (bf16*)(F.ws + WS_XN);
        f32x4 v[8], vn[8];
#pragma unroll
        for (int j = 0; j < 8; ++j) v[j] = __builtin_nontemporal_load((const GAS f32x4*)(x + (size_t)gw * DM) + F.lane + 64 * j);
        for (int m = gw; m < M; m += NGW) {
            const bool has_next = m + NGW < M;
            if (has_next) {
#pragma unroll
                for (int j = 0; j < 8; ++j) vn[j] = __builtin_nontemporal_load((const GAS f32x4*)(x + (size_t)(m + NGW) * DM) + F.lane + 64 * j); }
            float s = 0.f;
#pragma unroll
            for (int j = 0; j < 8; ++j) s += (v[j].x * v[j].x + v[j].y * v[j].y) + (v[j].z * v[j].z + v[j].w * v[j].w);
            const float rms = sqrtf(wave_sum(s) * (1.f / DM) + 1e-6f), rstd = 1.f / rms;
            if (F.lane == 0) ((float*)(F.ws + WS_IR))[m] = rms;
            GAS unsigned long long* o8 = (GAS unsigned long long*)(XN + (size_t)m * DM) + F.lane;
#pragma unroll
            for (int j = 0; j < 8; ++j) o8[64 * j] = (unsigned long long)cvtpk(v[j].x * rstd, v[j].y * rstd) | ((unsigned long long)cvtpk(v[j].z * rstd, v[j].w * rstd) << 32);
            if (has_next) {
#pragma unroll
                for (int j = 0; j < 8; ++j) v[j] = vn[j]; }
        }
    }
    {
        float* rope = (float*)(F.ws + WS_ROPE);
        for (int idx = gw * 64 + F.lane; idx < SEQ * 64; idx += NGW * 64) {
            const int t = idx >> 6, i = idx & 63; const double ang = (double)t * pow(10000.0, -(double)i / 64.0);
            rope[2 * idx] = (float)cos(ang); rope[2 * idx + 1] = (float)sin(ang);
        }
    }
}

DI void xhalf_swap(float& a, float& b) { asm("s_nop 1\n\tv_permlane32_swap_b32 %0, %1" : "+v"(a), "+v"(b)); }
DI float xhalf_max(float x) { float a = x, b = x; xhalf_swap(a, b); return fmaxf(a, b); }
DI float xhalf_sum(float x) { float a = x, b = x; xhalf_swap(a, b); return a + b; }
DI void att_dma_tile(const unsigned char* gbase, const unsigned (&voff)[8], LAS unsigned char* ldst) {
#pragma unroll
    for (int it = 0; it < 8; ++it) __builtin_amdgcn_global_load_lds((const unsigned*)(gbase + voff[it]), (LAS unsigned*)(ldst + it * 1024), 16, 0, 0);
}
constexpr int ATT_LUT_BYTES = 10 * 2048;
DI void att_build_lut(LAS unsigned char* lut, int tid) {
    for (int idx = tid; idx < 10 * 64 * 8; idx += NWAVES * 64) {
        const int type = idx >> 9, rem = idx & 511, ln = rem >> 3, pair = rem & 7, q = ln & 31, hh = ln >> 5;
        const int d0 = type < 6 ? 32 * type : 32 * (type & 1);
        unsigned w = 0;
#pragma unroll
        for (int k = 0; k < 2; ++k) {
            const int e = 2 * pair + k, d = d0 + q - 4 * hh - ((e & 3) + 8 * (e >> 2));
            int c;
            if (type < 6) c = (d >= 0 && d <= 128 ? 1 : 0) + (d >= 0 && (d & 3) == 0 ? 1 : 0) + (d >= 0 && d <= 32 ? 1 : 0);
            else if (type < 8) c = (d >= 0 && d <= 31) ? 1 : 0;
            else c = (d >= 1 && d <= 32) ? 1 : 0;
            const unsigned bits = c == 0 ? 0xFF80u : (c == 1 ? 0x0000u : (c == 2 ? 0x3F80u : 0x3FCBu));
            w |= bits << (16 * k);
        }
        *(LAS unsigned*)(lut + type * 2048 + (pair >> 2) * 1024 + ln * 16 + (pair & 3) * 4) = w;
    }
}
constexpr int AT_RING = RING_OFF, AT_STAGE = 16384, AT_OUT = RING_OFF + ATT_STAGES * AT_STAGE, AT_TAB = SCR_OFF + ATT_LUT_BYTES;
static_assert(AT_OUT + NWAVES * 4096 <= RING_OFF + RING_BYTES && AT_TAB + (ATT_NSLOT0 + ATT_NSLOT1) * 24 <= SCR_OFF + SCR_BYTES, "attention LDS map");
struct AtTagFast { static constexpr bool value = true; }; struct AtTagOnline { static constexpr bool value = false; };
DI void attn_items(Frame& F, int qword0, const bf16* QB, const bf16* KB, const bf16* VB, bf16* MIX, const float* qg, const float* kg) {
    const int lane = F.lane, w = F.wave;
    bool fastsm;
    { float mq = 0.f, mk = 0.f;
      for (int i = 0; i < 128; ++i) { mq = fmaxf(mq, fabsf(qg[i])); mk = fmaxf(mk, fabsf(kg[i])); }
      fastsm = __builtin_amdgcn_readfirstlane((int)(11.3137085f * LOG2E * mq * mk <= 60.f)) != 0; }
    const int q = lane & 31, hh = lane >> 5;
    LAS unsigned char* lut = F.lds + SCR_OFF;
    LAS unsigned char* ring = F.lds + AT_RING;
    const unsigned prow = 4u * (unsigned)w + ((unsigned)lane >> 4), pvoff = prow * 3072u + (((unsigned)lane & 15u) ^ swz_b(prow)) * 16u;
    const unsigned qi = (lane & 15) >> 2, pp = lane & 3, g16 = (lane >> 4) & 1;
    const unsigned swl = 16u * swz_b((unsigned)q), rowb_l = 256u * (unsigned)q;
    unsigned tp[2];
#pragma unroll
    for (int t = 0; t < 2; ++t) tp[t] = 2048u * t + 1024u * hh + 256u * qi + 8u * (pp & 1) + 16u * ((2u * g16 + (pp >> 1)) ^ ((2u * t + hh) & 3u));
    int qsel = (int)(xb_xcc_id() & 7u), tries = 0;
    auto fetch = [&]() -> unsigned {
        while (tries < 8) {
            const unsigned u = xb_add((unsigned*)(F.ctl + qword0 + 64 * qsel), 1u);
            if (u < 96u) return ((unsigned)qsel << 8) | u;
            qsel = (qsel + 1) & 7; ++tries;
        }
        return 0xFFFFFFFFu; };
    auto load_tile = [&](unsigned le, int r, const unsigned char* kbase, const unsigned char* vbase) {
        const unsigned st = (le >> 10) & 7u, kind = (le >> 8) & 3u, k = le & 15u; const unsigned rc = (unsigned)(r + kind) & 3u;
        const size_t goff = (size_t)(rc * 512u + 32u * k) * 3072u;
        LAS unsigned char* dst = ring + st * AT_STAGE + w * 1024;
        __builtin_amdgcn_global_load_lds((const unsigned*)(kbase + goff + pvoff), (LAS unsigned*)dst, 16, 0, 0);
        __builtin_amdgcn_global_load_lds((const unsigned*)(vbase + goff + pvoff), (LAS unsigned*)(dst + 8192), 16, 0, 0); };
    auto load_row = [&](unsigned ev, int r, const unsigned char* kbase, const unsigned char* vbase) {
#pragma unroll
        for (int j = 0; j < 3; ++j) { const unsigned le = (unsigned)__builtin_amdgcn_readlane((int)ev, j); if (le & 0x8000u) load_tile(le, r, kbase, vbase); } };
#define AT_SLOT_END() do { asm volatile("s_waitcnt vmcnt(0)\n\ts_waitcnt lgkmcnt(0)" ::: "memory"); __builtin_amdgcn_s_barrier(); asm volatile("" ::: "memory"); } while (0)
    if (F.tid == 0) F.MISC[4] = fetch();
    __syncthreads();
    unsigned code = F.MISC[4];
    if (code == 0xFFFFFFFFu) return;
    bf16x8 qf[8];
    int b, h, r, pass, ib; const LAS unsigned short* tab; int nslot; const unsigned char* kbase; const unsigned char* vbase;
    auto decode = [&](unsigned c) { const int u = (int)(c & 255u), qs = (int)(c >> 8); pass = u >= 48 ? 1 : 0; const int idx = u - 48 * pass; b = qs; h = idx >> 2; r = idx & 3;
        ib = pass ? ATT_BLK1[w] : ATT_BLK0[w]; tab = (const LAS unsigned short*)(F.lds + AT_TAB) + (pass ? ATT_NSLOT0 * 12 : 0); nslot = pass ? ATT_NSLOT1 : ATT_NSLOT0;
        kbase = (const unsigned char*)(KB + (size_t)b * 2048 * 1536 + h * 128); vbase = (const unsigned char*)(VB + (size_t)b * 2048 * 1536 + h * 128); };
    auto load_q = [&]() { const bf16* qp = QB + ((size_t)b * 2048 + r * 512 + 32 * ib + q) * 1536 + h * 128 + 8 * hh;
#pragma unroll
        for (int ks = 0; ks < 8; ++ks) asm volatile("global_load_dwordx4 %0, %1, off" : "=&v"(qf[ks]) : "v"(qp + 16 * ks) : "memory"); };
    decode(code);
    f32x16 o[4]; float mrun = -1e30f, lsum = 0.f;
    int ob_ = 0, oh = 0, orr = 0, oib = 0; bool have_prev = false;
    auto finalize = [&]() {
            lsum = xhalf_sum(lsum);
            const float inv = 1.0f / lsum;
            LAS unsigned char* og = F.lds + AT_OUT + w * 4096;
            unsigned char* ob = (unsigned char*)(MIX + ((size_t)ob_ * 2048 + 4 * 32 * oib + orr) * 2048 + oh * 128);
#pragma unroll
            for (int hf = 0; hf < 2; ++hf) {
#pragma unroll
                for (int cl = 0; cl < 2; ++cl)
#pragma unroll
                    for (int g = 0; g < 4; ++g) {
                        const int c = 2 * hf + cl;
                        u32x2 wv; wv.x = cvtpk(o[c][4 * g] * inv, o[c][4 * g + 1] * inv); wv.y = cvtpk(o[c][4 * g + 2] * inv, o[c][4 * g + 3] * inv);
                        *(LAS u32x2*)(og + 128u * (unsigned)q + 16u * ((unsigned)(4 * cl + g) ^ ((unsigned)q & 7u)) + 8u * hh) = wv;
                    }
                asm volatile("s_waitcnt lgkmcnt(0)" ::: "memory");
#pragma unroll
                for (int it = 0; it < 4; ++it) {
                    const unsigned row = 8 * it + (lane >> 3), ch = lane & 7;
                    const u32x4 v = *(const LAS u32x4*)(og + 128u * row + 16u * (ch ^ (row & 7u)));
                    *(GAS u32x4*)(ob + (size_t)row * 16384 + hf * 128 + ch * 16) = v;
                }
                asm volatile("s_waitcnt lgkmcnt(0)" ::: "memory");
            }
    };
    for (;;) {
        load_row(tab[lane < 12 ? lane : 11], r, kbase, vbase);
        if (have_prev) finalize();
        load_q();
        AT_SLOT_END();
        unsigned nxt = 0xFFFFFFFFu; if (F.tid == 0) nxt = fetch();
#pragma unroll
        for (int c = 0; c < 4; ++c)
#pragma unroll
            for (int e = 0; e < 16; ++e) o[c][e] = 0.f;
        mrun = -1e30f; lsum = 0.f;
        auto run_slots = [&](auto FAST) {
        unsigned evn = tab[12 + (lane < 12 ? lane : 11)];
        for (int u = 1; u < nslot; ++u) {
            const unsigned ev = evn; evn = tab[(u + 1) * 12 + (lane < 12 ? lane : 11)];
            const unsigned ce = (unsigned)__builtin_amdgcn_readlane((int)ev, 3 + w);
            load_row(ev, r, kbase, vbase);
            if (ce & 0x8000u) {
                const unsigned st = (ce >> 10) & 7u, kind = (ce >> 8) & 3u, k = ce & 15u; const int d = ib - (int)k;
                const unsigned rc = (unsigned)(r + kind) & 3u;
                const int ty = kind == 0 ? (d < 5 ? d : 5) : ((unsigned)r > rc ? 6 : 8) + d;
                LAS unsigned char* Kt = ring + st * AT_STAGE; LAS unsigned char* Vt = Kt + 8192;
                const u32x4 bw0 = *(const LAS u32x4*)(lut + ty * 2048 + lane * 16), bw1 = *(const LAS u32x4*)(lut + ty * 2048 + 1024 + lane * 16);
                bf16x8 kf[8];
#pragma unroll
                for (int ks = 0; ks < 8; ++ks) kf[ks] = lds_b128(Kt + rowb_l + ((unsigned)(32 * ks + 16 * hh) ^ swl));
                f32x16 s;
                s[0] = bf_lo(bw0.x); s[1] = bf_hi(bw0.x); s[2] = bf_lo(bw0.y); s[3] = bf_hi(bw0.y); s[4] = bf_lo(bw0.z); s[5] = bf_hi(bw0.z); s[6] = bf_lo(bw0.w); s[7] = bf_hi(bw0.w);
                s[8] = bf_lo(bw1.x); s[9] = bf_hi(bw1.x); s[10] = bf_lo(bw1.y); s[11] = bf_hi(bw1.y); s[12] = bf_lo(bw1.z); s[13] = bf_hi(bw1.z); s[14] = bf_lo(bw1.w); s[15] = bf_hi(bw1.w);
#pragma unroll
                for (int ks = 0; ks < 8; ++ks) s = MFMA32(kf[ks], qf[ks], s);
                s16x4 vlo[4][2], vhi[4][2];
#pragma unroll
                for (int c = 0; c < 4; ++c) {
                    const unsigned xc = 64u * ((unsigned)c ^ qi), a0 = (unsigned)(size_t)Vt + tp[0] + xc, a1 = (unsigned)(size_t)Vt + tp[1] + xc;
                    asm volatile("ds_read_b64_tr_b16 %0, %1" : "=&v"(vlo[c][0]) : "v"(a0) : "memory");
                    asm volatile("ds_read_b64_tr_b16 %0, %1" : "=&v"(vhi[c][0]) : "v"(a1) : "memory");
                    asm volatile("ds_read_b64_tr_b16 %0, %1 offset:4096" : "=&v"(vlo[c][1]) : "v"(a0) : "memory");
                    asm volatile("ds_read_b64_tr_b16 %0, %1 offset:4096" : "=&v"(vhi[c][1]) : "v"(a1) : "memory");
                }
                asm volatile("s_waitcnt lgkmcnt(0)" ::: "memory");
                __builtin_amdgcn_sched_barrier(0);
                auto pv = [&]() {
                    const bf16x8 pf0 = pack8(s[0], s[1], s[2], s[3], s[4], s[5], s[6], s[7]), pf1 = pack8(s[8], s[9], s[10], s[11], s[12], s[13], s[14], s[15]);
#pragma unroll
                    for (int c = 0; c < 4; ++c) {
                        o[c] = MFMA32(__builtin_shufflevector(vlo[c][0], vhi[c][0], 0, 1, 2, 3, 4, 5, 6, 7), pf0, o[c]);
                        o[c] = MFMA32(__builtin_shufflevector(vlo[c][1], vhi[c][1], 0, 1, 2, 3, 4, 5, 6, 7), pf1, o[c]);
                    } };
                if constexpr (decltype(FAST)::value) {
#pragma unroll
                    for (int e = 0; e < 16; ++e) s[e] = __builtin_amdgcn_exp2f(s[e]);
                    lsum += (((s[0] + s[1]) + (s[2] + s[3])) + ((s[4] + s[5]) + (s[6] + s[7]))) + (((s[8] + s[9]) + (s[10] + s[11])) + ((s[12] + s[13]) + (s[14] + s[15])));
                    pv();
                } else {
                    float mx = fmaxf(fmaxf(fmaxf(s[0], s[1]), fmaxf(s[2], s[3])), fmaxf(fmaxf(s[4], s[5]), fmaxf(s[6], s[7])));
                    mx = fmaxf(mx, fmaxf(fmaxf(fmaxf(s[8], s[9]), fmaxf(s[10], s[11])), fmaxf(fmaxf(s[12], s[13]), fmaxf(s[14], s[15]))));
                    mx = xhalf_max(mx);
                    const float mnew = fmaxf(mrun, mx), alpha = __builtin_amdgcn_exp2f(mrun - mnew);
#pragma unroll
                    for (int e = 0; e < 16; ++e) s[e] = __builtin_amdgcn_exp2f(s[e] - mnew);
                    lsum = lsum * alpha + (((s[0] + s[1]) + (s[2] + s[3])) + ((s[4] + s[5]) + (s[6] + s[7]))) + (((s[8] + s[9]) + (s[10] + s[11])) + ((s[12] + s[13]) + (s[14] + s[15])));
                    if (__any(mnew > mrun)) {
#pragma unroll
                        for (int c = 0; c < 4; ++c)
#pragma unroll
                            for (int e = 0; e < 16; ++e) o[c][e] *= alpha;
                    }
                    mrun = mnew;
                    pv();
                }
            }
            if (u == nslot - 1 && F.tid == 0) F.MISC[4] = nxt;
            AT_SLOT_END();
        }
        };
        if (fastsm) run_slots(AtTagFast{}); else run_slots(AtTagOnline{});
        const unsigned code_n = F.MISC[4];
        ob_ = b; oh = h; orr = r; oib = ib; have_prev = true;
        if (code_n == 0xFFFFFFFFu) break;
        decode(code_n);
    }
    finalize();
#undef AT_SLOT_END
}
constexpr int CV_NB1 = DM / 32, CV_NB2 = UPW / 32, CV_NB3 = DM / 32, CV_I1 = (DM / 64) * CV_NB1, CV_I2 = (DM / 64) * CV_NB2, CV_I3 = (DFF / 64) * CV_NB3;
constexpr int CV_EARLY = 7424;
DI void convert_range(Frame& F, LAS float* scr, const float* w_out, const float* w_up, const float* g2, const float* w_down, int lo, int hi, int cw0, int cwn) {
    bf16* Wout = (bf16*)(F.ws + WS_WOUT); bf16* Wup = (bf16*)(F.ws + WS_WUP); bf16* Wdn = (bf16*)(F.ws + WS_WDN);
    auto clampi = [](int v, int a, int b) { return v < a ? a : (v > b ? b : v); };
    { const int a = clampi(lo, 0, CV_I1), b = clampi(hi, 0, CV_I1); if (b > a) transpose_items<1, false, true>(w_out, nullptr, DM, DM, Wout, scr, a + cw0, cwn, b, CV_NB1, F.lane); }
    { const int a = clampi(lo - CV_I1, 0, CV_I2), b = clampi(hi - CV_I1, 0, CV_I2); if (b > a) transpose_items<2, true, true>(w_up, g2, DM, UPW, Wup, scr, a + cw0, cwn, b, CV_NB2, F.lane); }
    { const int a = clampi(lo - CV_I1 - CV_I2, 0, CV_I3), b = clampi(hi - CV_I1 - CV_I2, 0, CV_I3); if (b > a) transpose_items<3, false, true>(w_down, nullptr, DFF, DM, Wdn, scr, a + cw0, cwn, b, CV_NB3, F.lane); }
}
constexpr int ML_SPLIT = 11;
constexpr int ML_WGS = 2 * BATCH * NMH;
DI void attn_phase(Frame& F, int qword0, const float* w_out, const float* w_up, const float* g2, const float* w_down, bool skip_conv, const float* qg, const float* kg) {
    const bf16* QB = (const bf16*)(F.ws + WS_QB); const bf16* KB = (const bf16*)(F.ws + WS_KB); const bf16* VB = (const bf16*)(F.ws + WS_VB); bf16* MIX = (bf16*)(F.ws + WS_MIX);
    if (!skip_conv)
        convert_range(F, (LAS float*)(F.lds + RING_OFF + F.wave * 16384), w_out, w_up, g2, w_down, F.G == 256 ? CV_EARLY : 0, CV_I1 + CV_I2 + CV_I3, ((int)blockIdx.x - ML_WGS) * NWAVES + F.wave, (F.G - ML_WGS) * NWAVES);
    __syncthreads();
    att_build_lut(F.lds + SCR_OFF, F.tid);
    for (int i = F.tid; i < (ATT_NSLOT0 + ATT_NSLOT1) * 12; i += NWAVES * 64) ((LAS unsigned short*)(F.lds + AT_TAB))[i] = ATT_SCHED[i / 12][i % 12];
    __syncthreads();
    attn_items(F, qword0, QB, KB, VB, MIX, qg, kg);
}

DI float scan_add64(float v, int lane) {
#pragma unroll
    for (int d = 1; d < 64; d <<= 1) { const float t = __shfl_up(v, d); if (lane >= d) v += t; }
    return v;
}
DI float scan_max64(float v, int lane) {
#pragma unroll
    for (int d = 1; d < 64; d <<= 1) { const float t = __shfl_up(v, d); if (lane >= d) v = fmaxf(v, t); }
    return v;
}
DI float silu_f(float y) { return y * __builtin_amdgcn_rcpf(1.0f + __builtin_amdgcn_exp2f(-LOG2E * y)); }
DI void mixer_prepass(Frame& F, const float* mcw, const float* mcb) {
    const bf16* ML = (const bf16*)(F.ws + WS_ML); bf16* MLC = (bf16*)(F.ws + WS_MLC); const float* G = (const float*)(F.ws + WS_G); float* GA = (float*)(F.ws + WS_GA);
    const int gw = F.vcu * NWAVES + F.wave, NGW = F.G * NWAVES;
    for (int it = gw; it < 32 * 16; it += NGW) {
        const int seq = it >> 4, ch = it & 15, b = seq >> 2, hm = seq & 3; const size_t mrow0 = (size_t)b * 2048 + ch * 128;
        const float gi0 = G[(mrow0 + F.lane) * 8 + hm], gf0 = G[(mrow0 + F.lane) * 8 + 4 + hm], gi1 = G[(mrow0 + 64 + F.lane) * 8 + hm], gf1 = G[(mrow0 + 64 + F.lane) * 8 + 4 + hm];
        const float lf0 = fminf(gf0, 0.f) - log1pf(expf(-fabsf(gf0))), lf1 = fminf(gf1, 0.f) - log1pf(expf(-fabsf(gf1)));
        const float b0 = scan_add64(lf0, F.lane); const float tot0 = __shfl(b0, 63); const float b1 = scan_add64(lf1, F.lane) + tot0;
        const float a0 = gi0 - b0, a1 = gi1 - b1;
        const float cm0 = scan_max64(a0, F.lane); const float M0 = __shfl(cm0, 63); const float cm1 = fmaxf(scan_max64(a1, F.lane), M0);
        float* o = GA + (size_t)it * 384;
        o[F.lane] = b0; o[64 + F.lane] = b1; o[128 + F.lane] = a0; o[192 + F.lane] = a1; o[256 + F.lane] = cm0; o[320 + F.lane] = cm1;
    }
    for (int it = gw * 64 + F.lane; it < (M / 4) * 128; it += NGW * 64) {
        const int c8 = it & 127, r4 = it >> 7, m0 = 4 * r4, t0 = m0 & 2047, ch0 = 8 * c8;
        u32x4 raw[7];
#pragma unroll
        for (int i = 0; i < 7; ++i) { u32x4 rv = *(const GAS u32x4*)(ML + (size_t)(m0 - 3 + i) * 2048 + ch0); if (t0 - 3 + i < 0) rv = (u32x4){0u, 0u, 0u, 0u}; raw[i] = rv; }
        float wt[5][8];
#pragma unroll
        for (int tap = 0; tap < 5; ++tap) { const float* wp = tap < 4 ? mcw + tap * 1024 + ch0 : mcb + ch0; const f32x4 a = *(const f32x4*)wp, bq = *(const f32x4*)(wp + 4);
            wt[tap][0] = a[0]; wt[tap][1] = a[1]; wt[tap][2] = a[2]; wt[tap][3] = a[3]; wt[tap][4] = bq[0]; wt[tap][5] = bq[1]; wt[tap][6] = bq[2]; wt[tap][7] = bq[3]; }
        const float osc = ch0 >= 512 ? 0.08838834764831845f : 1.0f;
#pragma unroll
        for (int rho = 0; rho < 4; ++rho) {
            float y[8];
#pragma unroll
            for (int j = 0; j < 8; ++j) y[j] = wt[4][j];
#pragma unroll
            for (int tap = 0; tap < 4; ++tap) { const u32x4 x = raw[rho + tap];
                y[0] += wt[tap][0] * bf_lo(x.x); y[1] += wt[tap][1] * bf_hi(x.x); y[2] += wt[tap][2] * bf_lo(x.y); y[3] += wt[tap][3] * bf_hi(x.y);
                y[4] += wt[tap][4] * bf_lo(x.z); y[5] += wt[tap][5] * bf_hi(x.z); y[6] += wt[tap][6] * bf_lo(x.w); y[7] += wt[tap][7] * bf_hi(x.w); }
#pragma unroll
            for (int j = 0; j < 8; ++j) y[j] = silu_f(y[j]) * osc;
            *(GAS bf16x8*)(MLC + (size_t)(m0 + rho) * 1024 + ch0) = pack8(y[0], y[1], y[2], y[3], y[4], y[5], y[6], y[7]);
        }
    }
}

constexpr int ML_Q = 0, ML_K = 32768, ML_V = 65536, ML_C = 98304;
constexpr int MS_A = 0, MS_U = 512, MS_WI = 1024, MS_WK = 1536, MS_EM = 2048, MS_NV = 2560, MS_GV = 3072, MS_CW = 3584, MS_NR = 8704, MS_RS = 12800, MS_SC = 13824;
DI void mlstm_seq(Frame& F, int b, int hm, const float* mng, int c0, int c1) {
    LAS unsigned char* L = F.lds + RING_OFF; LAS unsigned char* S = F.lds + SCR_OFF;
    LAS float* A_ = (LAS float*)(S + MS_A); LAS float* U_ = (LAS float*)(S + MS_U); LAS float* WI = (LAS float*)(S + MS_WI); LAS float* WK = (LAS float*)(S + MS_WK); LAS float* EM = (LAS float*)(S + MS_EM);
    LAS float* NV = (LAS float*)(S + MS_NV); LAS float* GV = (LAS float*)(S + MS_GV); LAS float* CW = (LAS float*)(S + MS_CW); LAS float* NR = (LAS float*)(S + MS_NR); LAS float* RS = (LAS float*)(S + MS_RS); LAS float* SC = (LAS float*)(S + MS_SC);
    const int w = F.wave;
    const bf16* ML = (const bf16*)(F.ws + WS_ML); const bf16* MLC = (const bf16*)(F.ws + WS_MLC); const float* GA = (const float*)(F.ws + WS_GA) + (size_t)(b * 4 + hm) * 16 * 384; bf16* MIX = (bf16*)(F.ws + WS_MIX);
    if (F.tid < 128) { GV[F.tid] = mng[hm * 128 + F.tid]; NV[F.tid] = 0.f; }
    for (int i = F.tid; i < 32768 / 16; i += 512) *(LAS u32x4*)(L + ML_C + 16 * i) = (u32x4){0u, 0u, 0u, 0u};
    f32x16 Cacc[2];
#pragma unroll
    for (int i = 0; i < 2; ++i)
#pragma unroll
        for (int e = 0; e < 16; ++e) Cacc[i][e] = 0.f;
    float mc = 0.f;
    const int tb = (w & 3) ^ (3 * (w >> 2)), eh = w >> 2;
    const int ebF = w >> 1, dbF0 = 2 * (w & 1);
#define ML_BAR() do { asm volatile("s_waitcnt lgkmcnt(0)" ::: "memory"); __builtin_amdgcn_s_barrier(); asm volatile("" ::: "memory"); } while (0)
#define ML_OPAQUE_TID(name) int name = F.tid; asm volatile("" : "+v"(name))
#define ML_THREAD_MAP(tidv) const int c16 = (tidv) & 15, rg = (tidv) >> 4; const unsigned rg16 = 16u * rg, c32 = 32u * c16; unsigned sa[4]; \
        _Pragma("unroll") for (int rho = 0; rho < 4; ++rho) sa[rho] = 1024u * rg + 256u * rho + 64u * (((unsigned)c16 >> 2) ^ (unsigned)rho) + 16u * (((unsigned)c16 & 3u) ^ ((unsigned)rg & 3u))
#define ML_LANE_MAP(tidv) const int lane = (tidv) & 63, hh = lane >> 5, l31 = lane & 31; const unsigned qi = (lane & 15) >> 2, pp = lane & 3, g16 = (lane >> 4) & 1; \
        const unsigned swl_ = 16u * swz_b((unsigned)l31), rowb_ = 256u * (unsigned)l31, hh8 = 8u * hh, hh16 = 16u * hh; unsigned tn[2], tp[2]; \
        _Pragma("unroll") for (int t = 0; t < 2; ++t) { tn[t] = 2048u * hh + 1024u * t + 256u * qi + 8u * (pp & 1) + 16u * ((2u * g16 + (pp >> 1)) ^ ((2u * hh + t) & 3u)); \
                                                       tp[t] = 2048u * t + 1024u * hh + 256u * qi + 8u * (pp & 1) + 16u * ((2u * g16 + (pp >> 1)) ^ ((2u * t + hh) & 3u)); }
#define SF(off) (*(LAS float*)(S + (off)))
#define SF4(off) (*(const LAS f32x4*)(S + (off)))
    u32x4 rq[4], rk_[4], rv4[4]; float pgt[6] = {0.f, 0.f, 0.f, 0.f, 0.f, 0.f};
    {
        const int c16 = F.tid & 15, rg = F.tid >> 4;
        const unsigned char* cq0 = (const unsigned char*)MLC + (size_t)b * 2048 * 2048 + 8192u * rg + 256u * hm + 16u * c16;
        const unsigned char* cv0 = (const unsigned char*)ML + (size_t)b * 2048 * 4096 + 16384u * rg + 2048 + 256u * hm + 16u * c16;
#pragma unroll
        for (int rho = 0; rho < 4; ++rho) { rk_[rho] = *(const GAS u32x4*)(cq0 + rho * 2048 + 1024); rv4[rho] = *(const GAS u32x4*)(cv0 + rho * 4096); }
        if (w == 0) {
#pragma unroll
            for (int i = 0; i < 6; ++i) pgt[i] = GA[64 * i + F.lane]; }
    }
    __syncthreads();
    for (int ch = 0; ch < c0; ++ch) {
        {
        ML_OPAQUE_TID(tidA); ML_THREAD_MAP(tidA);
#pragma unroll
        for (int rho = 0; rho < 4; ++rho) { *(LAS u32x4*)(lp(sa[rho]) + ML_K) = rk_[rho]; *(LAS u32x4*)lp(sa[rho] + ML_V) = rv4[rho]; }
        }
        if (w == 0) {
            ML_OPAQUE_TID(tidB); const int lane = tidB & 63; const unsigned l4 = 4u * lane;
            const float b1 = pgt[1], a0 = pgt[2], a1 = pgt[3], cm1 = pgt[5];
            const float Mall = __shfl(cm1, 63), blast = __shfl(b1, 63), mxa = fmaxf(mc, Mall);
            SF(MS_WK + l4) = __builtin_amdgcn_exp2f(LOG2E * (a0 - mxa)); SF(MS_WK + 256 + l4) = __builtin_amdgcn_exp2f(LOG2E * (a1 - mxa));
            if (lane == 0) SC[0] = __builtin_amdgcn_exp2f(LOG2E * (mc - mxa));
            mc = blast + mxa;
        }
        ML_BAR();
        {
            ML_OPAQUE_TID(tidP); const int c16 = tidP & 15, rg = tidP >> 4;
            int cn = ch + 1; asm volatile("" : "+s"(cn));
            const unsigned char* cq1 = (const unsigned char*)MLC + ((size_t)b * 2048 + cn * 128) * 2048 + 8192u * rg + 256u * hm + 16u * c16;
            const unsigned char* cv1 = (const unsigned char*)ML + ((size_t)b * 2048 + cn * 128) * 4096 + 16384u * rg + 2048 + 256u * hm + 16u * c16;
#pragma unroll
            for (int rho = 0; rho < 4; ++rho) { rk_[rho] = *(const GAS u32x4*)(cq1 + rho * 2048 + 1024); rv4[rho] = *(const GAS u32x4*)(cv1 + rho * 4096); }
            if (w == 0) { const float* ga1 = GA + cn * 384 + (tidP & 63);
#pragma unroll
                for (int i = 0; i < 6; ++i) pgt[i] = ga1[64 * i]; }
        }
        {
            ML_OPAQUE_TID(tidK); ML_THREAD_MAP(tidK); const int lane = tidK & 63;
            float ps[8] = {0.f, 0.f, 0.f, 0.f, 0.f, 0.f, 0.f, 0.f};
#pragma unroll
            for (int rho = 0; rho < 4; ++rho) {
                const float wk = SF(MS_WK + 4 * rho + rg16); const u32x4 kk = *(const LAS u32x4*)(lp(sa[rho]) + ML_K);
                const float v0 = bf_lo(kk.x) * wk, v1 = bf_hi(kk.x) * wk, v2 = bf_lo(kk.y) * wk, v3 = bf_hi(kk.y) * wk, v4 = bf_lo(kk.z) * wk, v5 = bf_hi(kk.z) * wk, v6 = bf_lo(kk.w) * wk, v7 = bf_hi(kk.w) * wk;
                ps[0] += v0; ps[1] += v1; ps[2] += v2; ps[3] += v3; ps[4] += v4; ps[5] += v5; ps[6] += v6; ps[7] += v7;
                *(LAS bf16x8*)(lp(sa[rho]) + ML_Q) = pack8(v0, v1, v2, v3, v4, v5, v6, v7);
            }
#pragma unroll
            for (int j = 0; j < 8; ++j) { ps[j] += __shfl_xor(ps[j], 16); ps[j] += __shfl_xor(ps[j], 32); }
            if ((lane >> 4) == 0) {
#pragma unroll
                for (int j = 0; j < 8; ++j) SF(MS_NR + 512 * w + 4 * j + c32) = ps[j];
            }
        }
        ML_BAR();
        {
        const float decay = SC[0];
        ML_OPAQUE_TID(tidF); const unsigned t4 = 4u * tidF;
        if (tidF < 128) { float a = 0.f;
#pragma unroll
            for (int ww = 0; ww < 8; ++ww) a += SF(MS_NR + 512 * ww + t4);
            SF(MS_NV + t4) = decay * SF(MS_NV + t4) + a; }
#pragma unroll
        for (int i = 0; i < 2; ++i)
#pragma unroll
            for (int e = 0; e < 16; ++e) Cacc[i][e] *= decay;
        ML_LANE_MAP(tidF);
        const unsigned xc_eF = 64u * ((unsigned)ebF ^ qi), xc_d0 = 64u * ((unsigned)dbF0 ^ qi), xc_d1 = 64u * ((unsigned)(dbF0 + 1) ^ qi);
        const unsigned aF0 = ML_V + tn[0] + xc_eF, aF1 = ML_V + tn[1] + xc_eF, aK00 = ML_Q + tn[0] + xc_d0, aK01 = ML_Q + tn[1] + xc_d0, aK10 = ML_Q + tn[0] + xc_d1, aK11 = ML_Q + tn[1] + xc_d1;
        bf16x8 af[8];
#pragma unroll
        for (int ks = 0; ks < 8; ++ks) { const s16x4 alo = lds_tr(lp(aF0) + 4096 * ks), ahi = lds_tr(lp(aF1) + 4096 * ks); af[ks] = __builtin_shufflevector(alo, ahi, 0, 1, 2, 3, 4, 5, 6, 7); }
#pragma unroll
        for (int i = 0; i < 2; ++i) {
            bf16x8 bk[8];
#pragma unroll
            for (int ks = 0; ks < 8; ++ks) { const s16x4 blo = lds_tr(lp(i ? aK10 : aK00) + 4096 * ks), bhi = lds_tr(lp(i ? aK11 : aK01) + 4096 * ks); bk[ks] = __builtin_shufflevector(blo, bhi, 0, 1, 2, 3, 4, 5, 6, 7); }
#pragma unroll
            for (int ks = 0; ks < 8; ++ks) Cacc[i] = MFMA32(af[ks], bk[ks], Cacc[i]);
        }
        }
        ML_BAR();
    }
    if (c0 > 0) {
        ML_OPAQUE_TID(tidW); ML_LANE_MAP(tidW);
#pragma unroll
        for (int i = 0; i < 2; ++i)
#pragma unroll
            for (int g = 0; g < 4; ++g) {
                u32x2 wv; wv.x = cvtpk(Cacc[i][4 * g], Cacc[i][4 * g + 1]); wv.y = cvtpk(Cacc[i][4 * g + 2], Cacc[i][4 * g + 3]);
                *(LAS u32x2*)lp(rowb_ + ((unsigned)(16 * (4 * ebF + g)) ^ swl_) + hh8 + ML_C + 8192u * (dbF0 + i)) = wv;
            }
    }
    {
        const int c16 = F.tid & 15, rg = F.tid >> 4;
        const unsigned char* cq0 = (const unsigned char*)MLC + ((size_t)b * 2048 + c0 * 128) * 2048 + 8192u * rg + 256u * hm + 16u * c16;
#pragma unroll
        for (int rho = 0; rho < 4; ++rho) rq[rho] = *(const GAS u32x4*)(cq0 + rho * 2048);
    }
    __syncthreads();
    for (int ch = c0; ch < c1; ++ch) {
        int t0 = ch * 128; asm volatile("" : "+s"(t0));
        const size_t mrow0 = (size_t)b * 2048 + t0;
        const unsigned char* cb0 = (const unsigned char*)ML + mrow0 * 4096;
        unsigned char* mb0 = (unsigned char*)MIX + mrow0 * 4096;
        {
        ML_OPAQUE_TID(tidA); ML_THREAD_MAP(tidA);
#pragma unroll
        for (int rho = 0; rho < 4; ++rho) { *(LAS u32x4*)(lp(sa[rho]) + ML_Q) = rq[rho]; *(LAS u32x4*)(lp(sa[rho]) + ML_K) = rk_[rho]; *(LAS u32x4*)lp(sa[rho] + ML_V) = rv4[rho]; }
        }
        __builtin_amdgcn_sched_barrier(0);
        if (w == 0) {
            ML_OPAQUE_TID(tidB); const int lane = tidB & 63; const unsigned l4 = 4u * lane;
            const float b0 = pgt[0], b1 = pgt[1], a0 = pgt[2], a1 = pgt[3], cm0 = pgt[4], cm1 = pgt[5];
            const float mx0 = fmaxf(mc, cm0), mx1 = fmaxf(mc, cm1);
            SF(MS_A + l4) = a0; SF(MS_A + 256 + l4) = a1; SF(MS_U + l4) = -mx0; SF(MS_U + 256 + l4) = -mx1;
            SF(MS_WI + l4) = __builtin_amdgcn_exp2f(LOG2E * (mc - mx0)); SF(MS_WI + 256 + l4) = __builtin_amdgcn_exp2f(LOG2E * (mc - mx1));
            SF(MS_EM + l4) = __builtin_amdgcn_exp2f(-LOG2E * (b0 + mx0)); SF(MS_EM + 256 + l4) = __builtin_amdgcn_exp2f(-LOG2E * (b1 + mx1));
            const float Mall = __shfl(cm1, 63), blast = __shfl(b1, 63), mxa = fmaxf(mc, Mall);
            SF(MS_WK + l4) = __builtin_amdgcn_exp2f(LOG2E * (a0 - mxa)); SF(MS_WK + 256 + l4) = __builtin_amdgcn_exp2f(LOG2E * (a1 - mxa));
            if (lane == 0) SC[0] = __builtin_amdgcn_exp2f(LOG2E * (mc - mxa));
            mc = blast + mxa;
        }
        ML_BAR();
        ML_OPAQUE_TID(tidC); ML_LANE_MAP(tidC);
        const unsigned tq4 = 4u * (32u * tb + l31);
        const unsigned voffO = 4096u * (32u * tb + l31) + 3072u + 256u * hm + 128u * eh + 8u * hh;
        unsigned rk[8];
#pragma unroll
        for (int ks = 0; ks < 8; ++ks) rk[ks] = rowb_ + ((unsigned)(32 * ks + 2 * hh8) ^ swl_);
        const unsigned xc_e0 = 64u * ((unsigned)(2 * eh) ^ qi), xc_e1 = 64u * ((unsigned)(2 * eh + 1) ^ qi);
        const unsigned aC00 = ML_C + tn[0] + xc_e0, aC01 = ML_C + tn[1] + xc_e0, aC10 = ML_C + tn[0] + xc_e1, aC11 = ML_C + tn[1] + xc_e1;
        const unsigned aV00 = ML_V + tp[0] + xc_e0, aV01 = ML_V + tp[1] + xc_e0, aV10 = ML_V + tp[0] + xc_e1, aV11 = ML_V + tp[1] + xc_e1;
        __builtin_amdgcn_sched_barrier(0);
        const int tq = 32 * tb + l31;
        const unsigned qoff = ML_Q + 8192u * tb;
        const float ut = SF(MS_U + tq4), wint = SF(MS_WI + tq4), emt = SF(MS_EM + tq4);
        bf16x8 qf[8];
#pragma unroll
        for (int ks = 0; ks < 8; ++ks) qf[ks] = lds_b128(lp(rk[ks] + qoff));
        f32x16 acc[2];
#pragma unroll
        for (int c = 0; c < 2; ++c) {
            __builtin_amdgcn_sched_barrier(0);
            bf16x8 cf[8];
#pragma unroll
            for (int ks = 0; ks < 8; ++ks) {
                const s16x4 lo = lds_tr(lp(c ? aC10 : aC00) + 4096 * ks);
                const s16x4 hi = lds_tr(lp(c ? aC11 : aC01) + 4096 * ks);
                cf[ks] = __builtin_shufflevector(lo, hi, 0, 1, 2, 3, 4, 5, 6, 7);
            }
#pragma unroll
            for (int e = 0; e < 16; ++e) acc[c][e] = 0.f;
#pragma unroll
            for (int ks = 0; ks < 8; ++ks) acc[c] = MFMA32(cf[ks], qf[ks], acc[c]);
#pragma unroll
            for (int e = 0; e < 16; ++e) acc[c][e] *= wint;
        }
        float qn = 0.f;
#pragma unroll
        for (int ks = 0; ks < 8; ++ks) { const f32x4 n0 = SF4(MS_NV + 64 * ks + 2 * hh16), n1 = SF4(MS_NV + 64 * ks + 16 + 2 * hh16); const u32x4 qq = __builtin_bit_cast(u32x4, qf[ks]);
            qn += bf_lo(qq.x) * n0[0] + bf_hi(qq.x) * n0[1] + bf_lo(qq.y) * n0[2] + bf_hi(qq.y) * n0[3] + bf_lo(qq.z) * n1[0] + bf_hi(qq.z) * n1[1] + bf_lo(qq.w) * n1[2] + bf_hi(qq.w) * n1[3]; }
        __builtin_amdgcn_sched_barrier(0);
        u32x4 og[4];
        { ML_OPAQUE_TID(tidO); const unsigned char* co = cb0 + 3072 + 256u * hm + 16384u * (tidO >> 4) + 16u * (tidO & 15);
#pragma unroll
          for (int rho = 0; rho < 4; ++rho) og[rho] = *(const GAS u32x4*)(co + rho * 4096); }
        float sumP = 0.f;
#pragma unroll
        for (int sb = 0; sb < 4; ++sb) {
            if (sb <= tb) {
                __builtin_amdgcn_sched_barrier(0);
                f32x16 s; bf16x8 kf[8];
#pragma unroll
                for (int e = 0; e < 16; ++e) s[e] = 0.f;
#pragma unroll
                for (int ks = 0; ks < 8; ++ks) kf[ks] = lds_b128(lp(rk[ks]) + ML_K + 8192 * sb);
#pragma unroll
                for (int ks = 0; ks < 8; ++ks) s = MFMA32(kf[ks], qf[ks], s);
#pragma unroll
                for (int g = 0; g < 4; ++g) { const f32x4 av = SF4(MS_A + 4 * (32 * sb + 8 * g) + hh16);
#pragma unroll
                    for (int j = 0; j < 4; ++j) { const int e = 4 * g + j; float p = s[e] * __builtin_amdgcn_exp2f(LOG2E * (ut + av[j])); if (sb == tb && crow(e, hh) > l31) p = 0.f; s[e] = p; sumP += p; } }
                const bf16x8 pf0 = pack8(s[0], s[1], s[2], s[3], s[4], s[5], s[6], s[7]), pf1 = pack8(s[8], s[9], s[10], s[11], s[12], s[13], s[14], s[15]);
                __builtin_amdgcn_sched_barrier(0);
                bf16x8 vf[2][2];
#pragma unroll
                for (int c = 0; c < 2; ++c)
#pragma unroll
                    for (int s2 = 0; s2 < 2; ++s2) {
                        const s16x4 lo = lds_tr(lp(c ? aV10 : aV00) + 8192 * sb + 4096 * s2);
                        const s16x4 hi = lds_tr(lp(c ? aV11 : aV01) + 8192 * sb + 4096 * s2);
                        vf[c][s2] = __builtin_shufflevector(lo, hi, 0, 1, 2, 3, 4, 5, 6, 7);
                    }
#pragma unroll
                for (int c = 0; c < 2; ++c) { acc[c] = MFMA32(vf[c][0], pf0, acc[c]); acc[c] = MFMA32(vf[c][1], pf1, acc[c]); }
            }
        }
        qn += __shfl_xor(qn, 32); sumP += __shfl_xor(sumP, 32);
        const float den = wint * qn + sumP, rden = 1.0f / fmaxf(fabsf(den), emt);
        __builtin_amdgcn_sched_barrier(0);
        ML_BAR();
#pragma unroll
        for (int c = 0; c < 2; ++c)
#pragma unroll
            for (int g = 0; g < 4; ++g) {
                u32x2 wv; wv.x = cvtpk(acc[c][4 * g] * rden, acc[c][4 * g + 1] * rden); wv.y = cvtpk(acc[c][4 * g + 2] * rden, acc[c][4 * g + 3] * rden);
                *(LAS u32x2*)lp(ML_Q + 8192u * tb + rowb_ + ((unsigned)(16 * (4 * (2 * eh + c) + g)) ^ swl_) + hh8) = wv;
            }
        ML_BAR();
        {
            ML_OPAQUE_TID(tidE); ML_THREAD_MAP(tidE);
            const f32x4 g0 = SF4(MS_GV + c32), g1v = SF4(MS_GV + 16 + c32);
            unsigned char* mo = mb0 + 3072 + 256u * hm + 16384u * rg + 16u * c16;
#pragma unroll
            for (int rho = 0; rho < 4; ++rho) {
                const u32x4 hv = *(const LAS u32x4*)(lp(sa[rho]) + ML_Q); const u32x4 ov = og[rho];
                float h[8] = {bf_lo(hv.x), bf_hi(hv.x), bf_lo(hv.y), bf_hi(hv.y), bf_lo(hv.z), bf_hi(hv.z), bf_lo(hv.w), bf_hi(hv.w)};
                const float o[8] = {bf_lo(ov.x), bf_hi(ov.x), bf_lo(ov.y), bf_hi(ov.y), bf_lo(ov.z), bf_hi(ov.z), bf_lo(ov.w), bf_hi(ov.w)};
                float ssq = 0.f;
#pragma unroll
                for (int j = 0; j < 8; ++j) { h[j] *= __builtin_amdgcn_rcpf(1.0f + __builtin_amdgcn_exp2f(-LOG2E * o[j])); ssq += h[j] * h[j]; }
                ssq += __shfl_xor(ssq, 1); ssq += __shfl_xor(ssq, 2); ssq += __shfl_xor(ssq, 4); ssq += __shfl_xor(ssq, 8);
                const float rstd = 1.0f / sqrtf(ssq * (1.0f / 128.0f) + 1e-6f);
                u32x4 wv; wv.x = cvtpk(h[0] * rstd * g0[0], h[1] * rstd * g0[1]); wv.y = cvtpk(h[2] * rstd * g0[2], h[3] * rstd * g0[3]); wv.z = cvtpk(h[4] * rstd * g1v[0], h[5] * rstd * g1v[1]); wv.w = cvtpk(h[6] * rstd * g1v[2], h[7] * rstd * g1v[3]);
                *(GAS u32x4*)(mo + rho * 4096) = wv;
            }
        }
        __builtin_amdgcn_sched_barrier(0);
        __builtin_amdgcn_sched_barrier(0);
        {
            ML_OPAQUE_TID(tidP); const int c16 = tidP & 15, rg = tidP >> 4;
            int cn1 = (ch + 1 < c1 ? ch + 1 : ch); asm volatile("" : "+s"(cn1));
            const unsigned char* cq1 = (const unsigned char*)MLC + ((size_t)b * 2048 + cn1 * 128) * 2048 + 8192u * rg + 256u * hm + 16u * c16;
            const unsigned char* cv1 = (const unsigned char*)ML + ((size_t)b * 2048 + cn1 * 128) * 4096 + 16384u * rg + 2048 + 256u * hm + 16u * c16;
#pragma unroll
            for (int rho = 0; rho < 4; ++rho) { rk_[rho] = *(const GAS u32x4*)(cq1 + rho * 2048 + 1024); rv4[rho] = *(const GAS u32x4*)(cv1 + rho * 4096); }
        }
        __builtin_amdgcn_sched_barrier(0);
        {
            ML_OPAQUE_TID(tidK); ML_THREAD_MAP(tidK); const int lane = tidK & 63;
            float ps[8] = {0.f, 0.f, 0.f, 0.f, 0.f, 0.f, 0.f, 0.f};
#pragma unroll
            for (int rho = 0; rho < 4; ++rho) {
                const float wk = SF(MS_WK + 4 * rho + rg16); const u32x4 kk = *(const LAS u32x4*)(lp(sa[rho]) + ML_K);
                const float v0 = bf_lo(kk.x) * wk, v1 = bf_hi(kk.x) * wk, v2 = bf_lo(kk.y) * wk, v3 = bf_hi(kk.y) * wk, v4 = bf_lo(kk.z) * wk, v5 = bf_hi(kk.z) * wk, v6 = bf_lo(kk.w) * wk, v7 = bf_hi(kk.w) * wk;
                ps[0] += v0; ps[1] += v1; ps[2] += v2; ps[3] += v3; ps[4] += v4; ps[5] += v5; ps[6] += v6; ps[7] += v7;
                *(LAS bf16x8*)(lp(sa[rho]) + ML_Q) = pack8(v0, v1, v2, v3, v4, v5, v6, v7);
            }
#pragma unroll
            for (int j = 0; j < 8; ++j) { ps[j] += __shfl_xor(ps[j], 16); ps[j] += __shfl_xor(ps[j], 32); }
            if ((lane >> 4) == 0) {
#pragma unroll
                for (int j = 0; j < 8; ++j) SF(MS_NR + 512 * w + 4 * j + c32) = ps[j];
            }
        }
        ML_BAR();
        {
            ML_OPAQUE_TID(tidP2); const int c16 = tidP2 & 15, rg = tidP2 >> 4;
            int cn1 = (ch + 1 < c1 ? ch + 1 : ch); asm volatile("" : "+s"(cn1));
            const unsigned char* cq1 = (const unsigned char*)MLC + ((size_t)b * 2048 + cn1 * 128) * 2048 + 8192u * rg + 256u * hm + 16u * c16;
#pragma unroll
            for (int rho = 0; rho < 4; ++rho) rq[rho] = *(const GAS u32x4*)(cq1 + rho * 2048);
            if (w == 0) { const float* ga1 = GA + cn1 * 384 + (tidP2 & 63);
#pragma unroll
                for (int i = 0; i < 6; ++i) pgt[i] = ga1[64 * i]; }
        }
        __builtin_amdgcn_sched_barrier(0);
        const float decay = SC[0];
        ML_OPAQUE_TID(tidF); const unsigned t4 = 4u * tidF;
        if (tidF < 128) { float a = 0.f;
#pragma unroll
            for (int ww = 0; ww < 8; ++ww) a += SF(MS_NR + 512 * ww + t4);
            SF(MS_NV + t4) = decay * SF(MS_NV + t4) + a; }
#pragma unroll
        for (int i = 0; i < 2; ++i)
#pragma unroll
            for (int e = 0; e < 16; ++e) Cacc[i][e] *= decay;
        {
        ML_LANE_MAP(tidF);
        const unsigned xc_eF = 64u * ((unsigned)ebF ^ qi), xc_d0 = 64u * ((unsigned)dbF0 ^ qi), xc_d1 = 64u * ((unsigned)(dbF0 + 1) ^ qi);
        const unsigned aF0 = ML_V + tn[0] + xc_eF, aF1 = ML_V + tn[1] + xc_eF, aK00 = ML_Q + tn[0] + xc_d0, aK01 = ML_Q + tn[1] + xc_d0, aK10 = ML_Q + tn[0] + xc_d1, aK11 = ML_Q + tn[1] + xc_d1;
        unsigned cwr[4];
#pragma unroll
        for (int g = 0; g < 4; ++g) cwr[g] = rowb_ + ((unsigned)(16 * (4 * ebF + g)) ^ swl_) + hh8;
        bf16x8 af[8];
#pragma unroll
        for (int ks = 0; ks < 8; ++ks) {
            const s16x4 alo = lds_tr(lp(aF0) + 4096 * ks);
            const s16x4 ahi = lds_tr(lp(aF1) + 4096 * ks);
            af[ks] = __builtin_shufflevector(alo, ahi, 0, 1, 2, 3, 4, 5, 6, 7);
        }
#pragma unroll
        for (int i = 0; i < 2; ++i) {
            bf16x8 bk[8];
#pragma unroll
            for (int ks = 0; ks < 8; ++ks) {
                const s16x4 blo = lds_tr(lp(i ? aK10 : aK00) + 4096 * ks);
                const s16x4 bhi = lds_tr(lp(i ? aK11 : aK01) + 4096 * ks);
                bk[ks] = __builtin_shufflevector(blo, bhi, 0, 1, 2, 3, 4, 5, 6, 7);
            }
#pragma unroll
            for (int ks = 0; ks < 8; ++ks) Cacc[i] = MFMA32(af[ks], bk[ks], Cacc[i]);
        }
#pragma unroll
        for (int i = 0; i < 2; ++i)
#pragma unroll
            for (int g = 0; g < 4; ++g) {
                u32x2 wv; wv.x = cvtpk(Cacc[i][4 * g], Cacc[i][4 * g + 1]); wv.y = cvtpk(Cacc[i][4 * g + 2], Cacc[i][4 * g + 3]);
                *(LAS u32x2*)lp(cwr[g] + ML_C + 8192u * (dbF0 + i)) = wv;
            }
        }
        ML_BAR();
    }
}

DI void ffn_fixup(Frame& F, const float* cw, const float* cb) {
    const bf16* RAWB = (const bf16*)(F.ws + WS_RAW); bf16* ACT = (bf16*)(F.ws + WS_ACT);
    const int gt = (F.vcu * NWAVES + F.wave) * 64 + F.lane, NT = F.G * NWAVES * 64;
    auto ld4 = [](const bf16* p) { const u32x2 w = *(const GAS u32x2*)p; return (f32x4){bf_lo(w.x), bf_hi(w.x), bf_lo(w.y), bf_hi(w.y)}; };
    for (int it = gt; it < 256 * 2 * (DFF / 4); it += NT) {
        const int j4 = it % (DFF / 4), rs = it / (DFF / 4), rho = rs & 1, strip = rs >> 1, j = 4 * j4;
        const int pg = (j >> 7) * 256 + (j & 127);
        const bool first = (strip & 31) == 0;
        const bf16* own = RAWB + (size_t)strip * 4 * UPW; const bf16* prv = RAWB + (size_t)(strip - 1) * 4 * UPW;
        const f32x4 z = {0.f, 0.f, 0.f, 0.f};
        f32x4 gm2, gm1, g0, vm2, vm1, v0;
        if (rho == 0) { gm2 = first ? z : ld4(prv + 2 * UPW + pg); gm1 = first ? z : ld4(prv + 3 * UPW + pg); g0 = ld4(own + pg);
                        vm2 = first ? z : ld4(prv + 2 * UPW + pg + 128); vm1 = first ? z : ld4(prv + 3 * UPW + pg + 128); v0 = ld4(own + pg + 128); }
        else { gm2 = first ? z : ld4(prv + 3 * UPW + pg); gm1 = ld4(own + pg); g0 = ld4(own + UPW + pg);
               vm2 = first ? z : ld4(prv + 3 * UPW + pg + 128); vm1 = ld4(own + pg + 128); v0 = ld4(own + UPW + pg + 128); }
        const f32x4 yg = *(const f32x4*)(cb + j) + *(const f32x4*)(cw + j) * gm2 + *(const f32x4*)(cw + UPW + j) * gm1 + *(const f32x4*)(cw + 2 * UPW + j) * g0;
        const f32x4 yv = *(const f32x4*)(cb + DFF + j) + *(const f32x4*)(cw + DFF + j) * vm2 + *(const f32x4*)(cw + UPW + DFF + j) * vm1 + *(const f32x4*)(cw + 2 * UPW + DFF + j) * v0;
        u32x2 wv; wv.x = cvtpk(silu_f(yg[0]) * yv[0], silu_f(yg[1]) * yv[1]); wv.y = cvtpk(silu_f(yg[2]) * yv[2], silu_f(yg[3]) * yv[3]);
        *(GAS u32x2*)(ACT + (size_t)(64 * strip + rho) * DFF + j) = wv;
    }
}

struct Args { const float* in[16]; float* out; unsigned char* ws; int ph_lo, ph_hi, li, pad; };
__global__ void __launch_bounds__(NWAVES * 64, 2) fwd_kernel(Args args) {
    extern __shared__ __attribute__((aligned(16))) unsigned char lds[];
    Frame F;
    F.lds = (LAS unsigned char*)lds; F.MISC = (volatile LAS unsigned*)(F.lds + MISC_OFF);
    F.tid = threadIdx.x; F.lane = F.tid & 63; F.wave = __builtin_amdgcn_readfirstlane(F.tid >> 6);
    F.G = gridDim.x; { const int bx = blockIdx.x; F.vcu = (F.G % 8 == 0) ? (bx % 8) * (F.G / 8) + bx / 8 : bx; }
    F.ws = args.ws; F.ctl = (gu32*)(args.ws + WS_CTL); F.out = args.out;
    for (int u = F.tid; u < (LDS_BYTES - LDSCTL_OFF) / 4; u += NWAVES * 64) ((LAS unsigned*)(F.lds + LDSCTL_OFF))[u] = 0u;
    __syncthreads();
    XcdBarrier bar; bar.bar = (unsigned*)(F.ctl + CW_BAR) + args.li * XCD_BAR_WORDS; bar.x = 0; bar.st = nullptr;
    if (N_LAUNCHES != PER_PHASE) bar = xcd_barrier_post((unsigned*)(F.ctl + CW_BAR) + args.li * XCD_BAR_WORDS, F.MISC + 8);
#define GRID_BAR(seam) do { if (N_LAUNCHES == PER_PHASE) { if (F.tid == 0) __hip_atomic_store(F.ctl + CW_TMO, 0xBADBA0u | (unsigned)(seam), RLX_AGENT); } else { xcd_barrier(bar); } } while (0)
    const int lo = args.ph_lo, hi = args.ph_hi;
#define IN(k) (lo <= (k) && (k) < hi)
#define BOTH(k) (IN(k) && IN((k) + 1))
    PG8_LAS float* escr = (PG8_LAS float*)(F.lds + SCR_OFF);
    if (IN(PH_PRO)) { p0_prologue(F, args.in[0], args.in[1], args.in[2]); if (BOTH(PH_PRO)) GRID_BAR(PH_PRO); }
    if (IN(PH_IN)) {
        pg8::Gemm g{(const pg8::bf16_t*)(F.ws + WS_XN), (const pg8::bf16_t*)(F.ws + WS_WIN), M, IN_WP, DM}; pg8::StaticOrder S; S.init(M, IN_WP, F.G, (int)blockIdx.x, WGM_IN);
        pg8::Epi1 E{(pg8::bf16_t*)(F.ws + WS_QB), (pg8::bf16_t*)(F.ws + WS_KB), (pg8::bf16_t*)(F.ws + WS_VB), (pg8::bf16_t*)(F.ws + WS_ML), (float*)(F.ws + WS_G), (const float*)(F.ws + WS_ROPE), args.in[3], args.in[4], args.in[7], args.in[8], escr};
        pg8::gemm_phase<pg8::Epi1, pg8::StaticOrder, true, true>(F.lds + RING_OFF, g, S, E);
        { constexpr int IDLE0 = (M / 256) * (IN_WP / 256) % 256;
          if (F.G == 256 && (int)blockIdx.x >= IDLE0)
              convert_range(F, (LAS float*)(F.lds + RING_OFF + F.wave * 16384), args.in[10], args.in[12], args.in[11], args.in[15], 0, CV_EARLY, ((int)blockIdx.x - IDLE0) * NWAVES + F.wave, (256 - IDLE0) * NWAVES);
        }
        if (BOTH(PH_IN)) GRID_BAR(PH_IN);
    }
    if (IN(PH_PRE)) { mixer_prepass(F, args.in[5], args.in[6]); if (BOTH(PH_PRE)) GRID_BAR(PH_PRE); }
    if (IN(PH_MIX)) {
#ifndef PROBE_P2
#define PROBE_P2 0
#endif
#ifndef PROBE_LIGHT_UP
#define PROBE_LIGHT_UP 0
#endif
        const bool skip_ml = PROBE_P2 >= 2 && args.li == 1, skip_at = PROBE_P2 == 1 && args.li == 1;
        const bool is_ml = (int)blockIdx.x < ML_WGS;
        if (is_ml && !skip_ml) { const int seq = (int)blockIdx.x & 31, part = (int)blockIdx.x >> 5; mlstm_seq(F, seq >> 2, seq & 3, args.in[9], part ? ML_SPLIT : 0, part ? SEQ / 128 : ML_SPLIT); __syncthreads(); }
        if (!skip_at) attn_phase(F, CW_QUEUE + 1024 * args.li, args.in[10], args.in[12], args.in[11], args.in[15], is_ml || (PROBE_P2 == 3 && args.li == 1), args.in[3], args.in[4]);
        if (BOTH(PH_MIX)) GRID_BAR(PH_MIX);
    }
    if (IN(PH_OUT)) {
        pg8::Gemm g{(const pg8::bf16_t*)(F.ws + WS_MIX), (const pg8::bf16_t*)(F.ws + WS_WOUT), M, DM, DM}; pg8::StaticOrder S; S.init(M, DM, F.G, (int)blockIdx.x, WGM_OUT);
        pg8::Epi3 E{(const pg8::bf16_t*)(F.ws + WS_XN), (const float*)(F.ws + WS_IR), (pg8::bf16_t*)(F.ws + WS_X1), (float*)(F.ws + WS_SS), escr};
        pg8::gemm_phase<pg8::Epi3, pg8::StaticOrder, true, true>(F.lds + RING_OFF, g, S, E);
        if (BOTH(PH_OUT)) GRID_BAR(PH_OUT);
    }
    if (IN(PH_UP)) {
        pg8::Gemm g{(const pg8::bf16_t*)(F.ws + WS_X1), (const pg8::bf16_t*)(F.ws + WS_WUP), M, UPW, DM}; pg8::StaticOrder S; S.init(M, UPW, F.G, (int)blockIdx.x, WGM_UP);
        pg8::Epi4 E{(pg8::bf16_t*)(F.ws + WS_ACT), (pg8::bf16_t*)(F.ws + WS_RAW), (const float*)(F.ws + WS_SS), args.in[13], args.in[14], escr, args.li == 0 ? PROBE_LIGHT_UP : 0};
        pg8::gemm_phase<pg8::Epi4, pg8::StaticOrder, true, true>(F.lds + RING_OFF, g, S, E);
        if (BOTH(PH_UP)) GRID_BAR(PH_UP);
    }
    if (IN(PH_FIX)) { ffn_fixup(F, args.in[13], args.in[14]); if (BOTH(PH_FIX)) GRID_BAR(PH_FIX); }
    if (IN(PH_DOWN)) {
        pg8::Gemm g{(const pg8::bf16_t*)(F.ws + WS_ACT), (const pg8::bf16_t*)(F.ws + WS_WDN), M, DM, DFF}; pg8::StaticOrder S; S.init(M, DM, F.G, (int)blockIdx.x, WGM_DOWN);
        pg8::Epi5 E{F.out, (const pg8::bf16_t*)(F.ws + WS_X1)};
        pg8::gemm_phase<pg8::Epi5, pg8::StaticOrder, true, true>(F.lds + RING_OFF, g, S, E);
    }
#undef IN
#undef BOTH
}

extern "C" void kernel_launch(void* const* d_in, const int* in_sizes, int n_in, void* d_out, int out_size, void* d_ws, size_t ws_size, hipStream_t stream) {
    static int grid = 0;
    if (grid == 0) {
        if (n_in != 16 || in_sizes[0] != M * DM || out_size != M * DM || ws_size < WS_END) { fprintf(stderr, "kernel_launch: unexpected shapes (n_in %d in0 %d out %d ws %zu)\n", n_in, n_in > 0 ? in_sizes[0] : -1, out_size, ws_size); grid = -1; return; }
        int dev = 0, cus = 0, per_cu = 0;
        if (hipGetDevice(&dev) != hipSuccess || hipDeviceGetAttribute(&cus, hipDeviceAttributeMultiprocessorCount, dev) != hipSuccess) { grid = -1; return; }
        if (hipFuncSetAttribute((const void*)fwd_kernel, hipFuncAttributeMaxDynamicSharedMemorySize, LDS_BYTES) != hipSuccess) { fprintf(stderr, "kernel_launch: hipFuncSetAttribute failed\n"); grid = -1; return; }
        if (hipOccupancyMaxActiveBlocksPerMultiprocessor(&per_cu, (const void*)fwd_kernel, NWAVES * 64, LDS_BYTES) != hipSuccess || per_cu < 1) fprintf(stderr, "kernel_launch: occupancy query reports %d blocks per CU\n", per_cu);
        (void)hipGetLastError();
        grid = cus;
    }
    if (grid < 0) return;
    if (hipMemsetAsync((char*)d_ws + WS_CTL, 0, CTL_ZERO_BYTES, stream) != hipSuccess) return;
    Args a{};
    for (int i = 0; i < 16; ++i) a.in[i] = (const float*)d_in[i];
    a.out = (float*)d_out; a.ws = (unsigned char*)d_ws;
#ifdef PROBE_REPEAT
    { const int k = PROBE_REPEAT; const int lo[3] = {0, k, k + 1}, hi[3] = {k + 1, k + 1, PER_PHASE};
      for (int li = 0; li < 3; ++li) { a.ph_lo = lo[li]; a.ph_hi = hi[li]; a.li = li; hipLaunchKernelGGL(fwd_kernel, dim3(grid), dim3(NWAVES * 64), LDS_BYTES, stream, a); } }
#else
    if (N_LAUNCHES == 1) { a.ph_lo = 0; a.ph_hi = PER_PHASE; a.li = 0; hipLaunchKernelGGL(fwd_kernel, dim3(grid), dim3(NWAVES * 64), LDS_BYTES, stream, a); }
    else for (int li = 0; li < PER_PHASE; ++li) { a.ph_lo = li; a.ph_hi = li + 1; a.li = 0; hipLaunchKernelGGL(fwd_kernel, dim3(grid), dim3(NWAVES * 64), LDS_BYTES, stream, a); }
#endif
}
```
